# Optimizing an MI355X kernel written in HIP

```python
import jax, jax.numpy as jnp
from jax import lax
import numpy as np


D_MODEL = 1024
BATCH = 8
SEQ = 2048
DEPTH = 2

GRID_W = 64
ROPE_THETA = 10000.0
EPS = 1e-6
Q_BLOCK = 128
A_HEADS = 8
A_KV_HEADS = 2
A_HEAD_DIM = 64
B_HEADS = 8
B_NOPE_DIM = 64
B_ROPE_DIM = 32
B_V_DIM = 64
B_Q_RANK = 256
B_KV_RANK = 256
C_HEADS = 4
C_DK = 128
C_DV = 128
C_GATE_RANK = 16
C_TAU = 16.0
C_CHUNK = 64
N_BRANCH = 3
D_FF = 2816
N_EXPERTS = 8
TOP_K = 2
D_FF_EXPERT = 3584
N_DENSE = (DEPTH + 1) // 2
N_MOE = DEPTH // 2
IN_SIZES = (A_HEADS * A_HEAD_DIM, A_KV_HEADS * A_HEAD_DIM, A_KV_HEADS * A_HEAD_DIM,
            B_Q_RANK, B_KV_RANK, B_ROPE_DIM,
            C_HEADS * C_DK, C_HEADS * C_DK, C_HEADS * C_DV, C_HEADS * C_DV, C_GATE_RANK, C_GATE_RANK,
            N_BRANCH * D_MODEL)
IN_WIDTH = sum(IN_SIZES)

kernel_name = 'hybrid_gated_gqa_mla_gla_moe_encoder'


def rmsnorm(x, g):
    xf = x.astype(jnp.float32)
    y = xf * lax.rsqrt(jnp.mean(xf * xf, axis=-1, keepdims=True) + EPS)
    return (y * g.astype(jnp.float32)).astype(x.dtype)


def axial_angles(T, rot_dim):
    rows = T // GRID_W
    row = jnp.repeat(jnp.arange(rows, dtype=jnp.float32), GRID_W)
    col = jnp.tile(jnp.arange(GRID_W, dtype=jnp.float32), rows)
    n_freq = rot_dim // 4
    inv_freq = ROPE_THETA ** (-jnp.arange(n_freq, dtype=jnp.float32) / n_freq)
    return row[:, None] * inv_freq, col[:, None] * inv_freq


def rope_1d(x, ang):
    x1, x2 = jnp.split(x, 2, axis=-1)
    c, s = jnp.cos(ang), jnp.sin(ang)
    return jnp.concatenate([x1 * c - x2 * s, x2 * c + x1 * s], axis=-1)


def axial_rope(x, ang_row, ang_col):
    xf = x.astype(jnp.float32)
    half = x.shape[-1] // 2
    y = jnp.concatenate([rope_1d(xf[..., :half], ang_row), rope_1d(xf[..., half:], ang_col)], axis=-1)
    return y.astype(x.dtype)


def heads(t, n):
    Bsz, T, w = t.shape
    return t.reshape(Bsz, T, n, w // n).transpose(0, 2, 1, 3)


def merge_heads(t):
    Bsz, n, T, d = t.shape
    return t.transpose(0, 2, 1, 3).reshape(Bsz, T, n * d)


def blocked_attention(q, k, v, scale):
    Bsz, Hk, G, T, dq = q.shape
    n_blk = T // Q_BLOCK
    qb = jnp.moveaxis(q.reshape(Bsz, Hk, G, n_blk, Q_BLOCK, dq), 3, 0)

    def one_block(q_blk):
        s = jnp.einsum('bhgqd,bhkd->bhgqk', q_blk, k).astype(jnp.float32) * scale
        p = jax.nn.softmax(s, axis=-1).astype(v.dtype)
        return jnp.einsum('bhgqk,bhkv->bhgqv', p, v)

    out = lax.map(one_block, qb)
    return jnp.moveaxis(out, 0, 3).reshape(Bsz, Hk, G, T, v.shape[-1])


def gla_chunked(q, k, v, log_a):
    Bsz, H, T, dk = q.shape
    dv = v.shape[-1]
    n = T // C_CHUNK
    shp = (Bsz, H, n, C_CHUNK)
    q = q.reshape(shp + (dk,))
    k = k.reshape(shp + (dk,))
    v = v.reshape(shp + (dv,))
    b = jnp.cumsum(log_a.reshape(shp + (dk,)), axis=3)
    q_t = q * jnp.exp(b)
    k_t = k * jnp.exp(-b)
    causal = jnp.tril(jnp.ones((C_CHUNK, C_CHUNK), dtype=bool))
    scores = jnp.where(causal, jnp.einsum('bhncd,bhnsd->bhncs', q_t, k_t), 0.0)
    intra = jnp.einsum('bhncs,bhnsv->bhncv', scores, v)
    b_last = b[:, :, :, -1:, :]
    chunk_kv = jnp.einsum('bhncd,bhncv->bhndv', k * jnp.exp(b_last - b), v)
    chunk_decay = jnp.exp(b_last[:, :, :, 0, :])

    def step(state, inp):
        dec, kv = inp
        return dec[..., None] * state + kv, state

    init = jnp.zeros((Bsz, H, dk, dv), q.dtype)
    _, prev = lax.scan(step, init, (jnp.moveaxis(chunk_decay, 2, 0), jnp.moveaxis(chunk_kv, 2, 0)))
    prev = jnp.moveaxis(prev, 0, 2)
    inter = jnp.einsum('bhncd,bhndv->bhncv', q_t, prev)
    return (intra + inter).reshape(Bsz, H, T, dv)


def bidir_gla(q, k, v, log_a_fwd, log_a_bwd):
    flip = lambda t: jnp.flip(t, axis=2)
    fwd = gla_chunked(q, k, v, log_a_fwd)
    bwd = flip(gla_chunked(flip(q), flip(k), flip(v), flip(log_a_bwd)))
    return fwd + bwd


def token_mixer(h, w_in, b_gate, g_a_q, g_a_k, g_b_q, w_b_q_up, g_b_kv, w_b_kv_up,
                w_c_af_up, b_c_af, w_c_ab_up, b_c_ab, g_c_out, w_pa, w_pb, w_pc, w_out, ang_a, ang_b):
    Bsz, T, _ = h.shape
    f32 = jnp.float32
    proj = h @ w_in
    offs = []
    acc = 0
    for s in IN_SIZES[:-1]:
        acc += s
        offs.append(acc)
    (a_q, a_k, a_v, b_cq, b_ckv, b_kr, c_q, c_k, c_v, c_g, c_af, c_ab, gates) = jnp.split(proj, offs, axis=-1)

    qa = axial_rope(rmsnorm(heads(a_q, A_HEADS), g_a_q), *ang_a)
    ka = axial_rope(rmsnorm(heads(a_k, A_KV_HEADS), g_a_k), *ang_a)
    va = heads(a_v, A_KV_HEADS)
    qa = qa.reshape(Bsz, A_KV_HEADS, A_HEADS // A_KV_HEADS, T, A_HEAD_DIM)
    ya = blocked_attention(qa, ka, va, A_HEAD_DIM ** -0.5).reshape(Bsz, A_HEADS, T, A_HEAD_DIM)
    ya = merge_heads(ya)

    qb = heads(rmsnorm(b_cq, g_b_q) @ w_b_q_up, B_HEADS)
    q_nope, q_rope = qb[..., :B_NOPE_DIM], qb[..., B_NOPE_DIM:]
    kvb = heads(rmsnorm(b_ckv, g_b_kv) @ w_b_kv_up, B_HEADS)
    k_nope, vb = kvb[..., :B_NOPE_DIM], kvb[..., B_NOPE_DIM:]
    k_rope = axial_rope(b_kr[:, None], *ang_b)
    qb = jnp.concatenate([q_nope, axial_rope(q_rope, *ang_b)], axis=-1)
    kb = jnp.concatenate([k_nope, jnp.broadcast_to(k_rope, k_nope.shape[:-1] + (B_ROPE_DIM,))], axis=-1)
    yb = blocked_attention(qb[:, :, None], kb, vb, (B_NOPE_DIM + B_ROPE_DIM) ** -0.5)[:, :, 0]
    yb = merge_heads(yb)

    qc = heads(c_q, C_HEADS).astype(f32) * (C_DK ** -0.5)
    kc = heads(c_k, C_HEADS).astype(f32)
    vc = heads(c_v, C_HEADS).astype(f32)
    la_f = heads(jax.nn.log_sigmoid((c_af @ w_c_af_up + b_c_af).astype(f32)) / C_TAU, C_HEADS)
    la_b = heads(jax.nn.log_sigmoid((c_ab @ w_c_ab_up + b_c_ab).astype(f32)) / C_TAU, C_HEADS)
    oc = bidir_gla(qc, kc, vc, la_f, la_b)
    yc = merge_heads(rmsnorm(oc, g_c_out)).astype(h.dtype) * jax.nn.silu(c_g)

    gb = jax.nn.sigmoid(gates + b_gate).reshape(Bsz, T, N_BRANCH, D_MODEL)
    m = gb[:, :, 0] * (ya @ w_pa) + gb[:, :, 1] * (yb @ w_pb) + gb[:, :, 2] * (yc @ w_pc)
    return m @ w_out


def swiglu(h, wg, wu, wd):
    return (jax.nn.silu(h @ wg) * (h @ wu)) @ wd


def moe_ffn(h, w_router, w_e_gate, w_e_up, w_e_down):
    logits = jnp.einsum('btd,de->bte', h.astype(jnp.float32), w_router.astype(jnp.float32))
    top_v, top_i = lax.top_k(logits, TOP_K)
    top_w = jax.nn.softmax(top_v, axis=-1)
    gate = jnp.einsum('btk,btke->bte', top_w, jax.nn.one_hot(top_i, N_EXPERTS, dtype=jnp.float32)).astype(h.dtype)
    out = jnp.zeros_like(h)
    for e in range(N_EXPERTS):
        out = out + gate[..., e:e + 1] * swiglu(h, w_e_gate[e], w_e_up[e], w_e_down[e])
    return out


def setup_inputs(seed: int = 0) -> dict:
    key = jax.random.key(seed)
    keys = jax.random.split(key, 28)

    def nrm(i, shape, scale):
        return scale * jax.random.normal(keys[i], shape, dtype=jnp.float32)

    def gain(i, shape):
        return 1.0 + nrm(i, shape, 0.01)

    return {
        'x': nrm(0, (BATCH, SEQ, D_MODEL), 1.0),
        'w_in': nrm(1, (DEPTH, D_MODEL, IN_WIDTH), D_MODEL ** -0.5),
        'b_gate': nrm(2, (DEPTH, N_BRANCH * D_MODEL), 0.02),
        'g_mix': gain(3, (DEPTH, D_MODEL)),
        'g_a_q': gain(4, (DEPTH, A_HEAD_DIM)),
        'g_a_k': gain(5, (DEPTH, A_HEAD_DIM)),
        'g_b_q': gain(6, (DEPTH, B_Q_RANK)),
        'w_b_q_up': nrm(7, (DEPTH, B_Q_RANK, B_HEADS * (B_NOPE_DIM + B_ROPE_DIM)), B_Q_RANK ** -0.5),
        'g_b_kv': gain(8, (DEPTH, B_KV_RANK)),
        'w_b_kv_up': nrm(9, (DEPTH, B_KV_RANK, B_HEADS * (B_NOPE_DIM + B_V_DIM)), B_KV_RANK ** -0.5),
        'w_c_af_up': nrm(10, (DEPTH, C_GATE_RANK, C_HEADS * C_DK), C_GATE_RANK ** -0.5),
        'b_c_af': nrm(11, (DEPTH, C_HEADS * C_DK), 0.1),
        'w_c_ab_up': nrm(12, (DEPTH, C_GATE_RANK, C_HEADS * C_DK), C_GATE_RANK ** -0.5),
        'b_c_ab': nrm(13, (DEPTH, C_HEADS * C_DK), 0.1),
        'g_c_out': gain(14, (DEPTH, C_DV)),
        'w_pa': nrm(15, (DEPTH, A_HEADS * A_HEAD_DIM, D_MODEL), (A_HEADS * A_HEAD_DIM) ** -0.5),
        'w_pb': nrm(16, (DEPTH, B_HEADS * B_V_DIM, D_MODEL), (B_HEADS * B_V_DIM) ** -0.5),
        'w_pc': nrm(17, (DEPTH, C_HEADS * C_DV, D_MODEL), (C_HEADS * C_DV) ** -0.5),
        'w_out': nrm(18, (DEPTH, D_MODEL, D_MODEL), D_MODEL ** -0.5),
        'g_ffn': gain(19, (DEPTH, D_MODEL)),
        'w_ff_gate': nrm(20, (N_DENSE, D_MODEL, D_FF), D_MODEL ** -0.5),
        'w_ff_up': nrm(21, (N_DENSE, D_MODEL, D_FF), D_MODEL ** -0.5),
        'w_ff_down': nrm(22, (N_DENSE, D_FF, D_MODEL), D_FF ** -0.5),
        'w_router': nrm(23, (N_MOE, D_MODEL, N_EXPERTS), D_MODEL ** -0.5),
        'w_e_gate': nrm(24, (N_MOE, N_EXPERTS, D_MODEL, D_FF_EXPERT), D_MODEL ** -0.5),
        'w_e_up': nrm(25, (N_MOE, N_EXPERTS, D_MODEL, D_FF_EXPERT), D_MODEL ** -0.5),
        'w_e_down': nrm(26, (N_MOE, N_EXPERTS, D_FF_EXPERT, D_MODEL), D_FF_EXPERT ** -0.5),
        'g_final': gain(27, (D_MODEL,)),
    }


def reference(x, w_in, b_gate, g_mix, g_a_q, g_a_k, g_b_q, w_b_q_up, g_b_kv, w_b_kv_up,
              w_c_af_up, b_c_af, w_c_ab_up, b_c_ab, g_c_out, w_pa, w_pb, w_pc, w_out, g_ffn,
              w_ff_gate, w_ff_up, w_ff_down, w_router, w_e_gate, w_e_up, w_e_down, g_final):
    T = x.shape[1]
    ang_a = axial_angles(T, A_HEAD_DIM)
    ang_b = axial_angles(T, B_ROPE_DIM)
    for i in range(DEPTH):
        h = rmsnorm(x, g_mix[i])
        x = x + token_mixer(h, w_in[i], b_gate[i], g_a_q[i], g_a_k[i], g_b_q[i], w_b_q_up[i],
                            g_b_kv[i], w_b_kv_up[i], w_c_af_up[i], b_c_af[i], w_c_ab_up[i], b_c_ab[i],
                            g_c_out[i], w_pa[i], w_pb[i], w_pc[i], w_out[i], ang_a, ang_b)
        h = rmsnorm(x, g_ffn[i])
        j = i // 2
        if i % 2 == 0:
            x = x + swiglu(h, w_ff_gate[j], w_ff_up[j], w_ff_down[j])
        else:
            x = x + moe_ffn(h, w_router[j], w_e_gate[j], w_e_up[j], w_e_down[j])
    return rmsnorm(x, g_final)
```

```cpp
#include <hip/hip_runtime.h>
#include <cstdio>
#include <cstdint>

#ifndef N_LAUNCH_MODE
#define N_LAUNCH_MODE 0
#endif
#ifndef NAIVE_GEMM
#define NAIVE_GEMM 1
#endif
#ifndef NAIVE_ATTN
#define NAIVE_ATTN 1
#endif
#ifndef NAIVE_GLA
#define NAIVE_GLA 1
#endif

#define LAS __attribute__((address_space(3)))
#define GAS __attribute__((address_space(1)))
typedef unsigned short bf16_t;
typedef short bf16x8 __attribute__((ext_vector_type(8)));
typedef float f32x4 __attribute__((ext_vector_type(4)));
typedef unsigned u32x4 __attribute__((ext_vector_type(4)));
typedef unsigned u32x2 __attribute__((ext_vector_type(2)));

constexpr int M = 16384, D = 1024, T = 2048, NBATCH = 8, NWAVES = 8, NTHR = 512;
constexpr float EPS = 1e-6f;
constexpr int PW = 3456;
constexpr int PC_AQ = 0, PC_AK = 512, PC_AV = 640, PC_BCQ = 768, PC_BCKV = 1024, PC_CQ = 1280, PC_CK = 1792, PC_CV = 2304, PC_CG = 2816, PC_SMALL = 3328;
constexpr int NIN = 6656;
constexpr int DFF = 2816, DFE = 3584, NEXP = 8;
constexpr int MAXTILES = 136, MAXROWS = MAXTILES * 256;
constexpr float LOG2E = 1.4426950408889634f;
constexpr float C2A = 0.125f * LOG2E;
constexpr float C2B = 0.10206207261596575f * LOG2E;
constexpr float GLA_QSCALE = 0.08838834764831845f;

constexpr size_t CTL_BYTES = 1u << 20;
constexpr size_t SZ_WIN1 = (size_t)NIN * 1024 * 2, SZ_WQUP1 = 768 * 256 * 2, SZ_WKVUP1 = 1024 * 256 * 2, SZ_WP1 = 1024 * 512 * 2, SZ_WOUT1 = 1024 * 1024 * 2;
constexpr size_t O_WIN = CTL_BYTES;
constexpr size_t O_WQUP = O_WIN + 2 * SZ_WIN1;
constexpr size_t O_WKVUP = O_WQUP + 2 * SZ_WQUP1;
constexpr size_t O_WP = O_WKVUP + 2 * SZ_WKVUP1;
constexpr size_t O_WOUT = O_WP + 6 * SZ_WP1;
constexpr size_t O_WFFGU = O_WOUT + 2 * SZ_WOUT1;
constexpr size_t O_WFFD = O_WFFGU + (size_t)2 * DFF * 1024 * 2;
constexpr size_t O_TABA = O_WFFD + (size_t)1024 * DFF * 2;
constexpr size_t O_TABB = O_TABA + (size_t)T * 64 * 4;
constexpr size_t O_XB = O_TABB + (size_t)T * 32 * 4;
constexpr size_t O_SSQ = O_XB + (size_t)M * 1024 * 2;
constexpr size_t O_RSP = O_SSQ + (size_t)M * 16 * 4;
constexpr size_t O_MOEI = O_RSP + (size_t)M * 64 * 4;
constexpr size_t SZ_MOEI = 2u << 20;
constexpr size_t O_R = O_MOEI + SZ_MOEI;
constexpr size_t O_P = O_R;
constexpr size_t O_GATES = O_P + (size_t)M * PW * 2;
constexpr size_t O_QA = O_GATES + (size_t)M * 3072 * 2;
constexpr size_t O_KA = O_QA + (size_t)M * 512 * 2;
constexpr size_t O_KROPE = O_KA + (size_t)M * 128 * 2;
constexpr size_t O_QB = O_KROPE + (size_t)M * 32 * 2;
constexpr size_t O_KNOPE = O_QB + (size_t)M * 768 * 2;
constexpr size_t O_VB = O_KNOPE + (size_t)M * 512 * 2;
constexpr size_t O_QT = O_VB + (size_t)M * 512 * 2;
constexpr size_t O_DEC = O_QT + (size_t)4 * M * 512 * 2;
constexpr size_t O_YA = O_DEC + (size_t)2 * 256 * 512 * 4;
constexpr size_t O_YB = O_YA + (size_t)M * 512 * 2;
constexpr size_t O_YC = O_YB + (size_t)M * 512 * 2;
constexpr size_t O_MIX_END = O_YC + (size_t)M * 512 * 2;
constexpr size_t O_PART = O_QT;
constexpr size_t O_MB = O_P;
constexpr size_t O_HID = O_P;
constexpr size_t O_WEGU = O_R;
constexpr size_t O_WED = O_WEGU + (size_t)NEXP * 2 * DFE * 1024 * 2;
constexpr size_t O_HIDS = O_WED + (size_t)NEXP * 1024 * DFE * 2;
constexpr size_t O_MOE_END = O_HIDS + (size_t)MAXROWS * DFE * 2;
constexpr size_t O_OUTS = O_WEGU;
constexpr size_t WS_NEED = O_MIX_END > O_MOE_END ? O_MIX_END : O_MOE_END;
static_assert(WS_NEED <= 531851264ull, "workspace map exceeds the guaranteed ws_size");
static_assert((size_t)M * 1024 * 4 <= (size_t)4 * M * 512 * 2, "PART overlay");
static_assert((size_t)MAXROWS * 1024 * 2 <= (size_t)NEXP * 2 * DFE * 1024 * 2, "OUTS overlay");
constexpr int MI_CNT = 0;
constexpr int MI_TOKE = 4096;
constexpr int MI_TOKR = MI_TOKE + M;
constexpr int MI_TOKW = MI_TOKR + M;
constexpr int MI_TOKPOS = MI_TOKW + 2 * M;
constexpr int MI_ROWTOK = MI_TOKPOS + 2 * M;
constexpr int MI_ROWW = MI_ROWTOK + MAXROWS;
constexpr int MI_TILEE = MI_ROWW + MAXROWS;
constexpr int MI_END = MI_TILEE + MAXTILES + 8;
static_assert((size_t)MI_END * 4 <= SZ_MOEI, "moe lists");

constexpr int CW_TMO = 0;
constexpr int CW_Q = 1024;
constexpr int CW_BAR = 4096;

constexpr int LDS_RING = 131072, LDS_CTL = 145408, LDS_MISC = LDS_CTL + 320, LDS_BYTES = 147456;

__device__ __forceinline__ float bf2f(unsigned v) { return __uint_as_float(v << 16); }
__device__ __forceinline__ unsigned f2bf(float f) { unsigned u = __float_as_uint(f); return (u + 0x7fffu + ((u >> 16) & 1u)) >> 16; }
__device__ __forceinline__ unsigned pk2(float lo, float hi) { return f2bf(lo) | (f2bf(hi) << 16); }
__device__ __forceinline__ void unpack8(const u32x4 w, float (&f)[8]) {
    f[0] = __uint_as_float(w.x << 16); f[1] = __uint_as_float(w.x & 0xffff0000u); f[2] = __uint_as_float(w.y << 16); f[3] = __uint_as_float(w.y & 0xffff0000u);
    f[4] = __uint_as_float(w.z << 16); f[5] = __uint_as_float(w.z & 0xffff0000u); f[6] = __uint_as_float(w.w << 16); f[7] = __uint_as_float(w.w & 0xffff0000u);
}
__device__ __forceinline__ u32x4 pack8(const float (&f)[8]) { u32x4 w; w.x = pk2(f[0], f[1]); w.y = pk2(f[2], f[3]); w.z = pk2(f[4], f[5]); w.w = pk2(f[6], f[7]); return w; }
__device__ __forceinline__ void load8(const bf16_t* p, float (&f)[8]) { unpack8(*(const u32x4*)p, f); }
__device__ __forceinline__ void store8(bf16_t* p, const float (&f)[8]) { *(u32x4*)p = pack8(f); }
__device__ __forceinline__ float wave_sum(float v) {
#pragma unroll
    for (int o = 1; o < 64; o <<= 1) v += __shfl_xor(v, o);
    return v;
}
__device__ __forceinline__ float row_rstd16(const float* ssq, int row) {
    const f32x4* p = (const f32x4*)(ssq + (size_t)row * 16);
    const f32x4 a = p[0], b = p[1], c = p[2], d = p[3];
    const float s = ((a.x + a.y) + (a.z + a.w)) + ((b.x + b.y) + (b.z + b.w)) + ((c.x + c.y) + (c.z + c.w)) + ((d.x + d.y) + (d.z + d.w));
    return rsqrtf(s * (1.0f / 1024.0f) + EPS);
}
__device__ __forceinline__ float sigmoidf_(float x) { return 1.0f / (1.0f + __expf(-x)); }

#define XB_TMO      128
#define XB_XCNT(j)  (256  + 64 * (j))
#define XB_XSUB(j)  (1280 + 64 * (j))
#define XB_XGEN(j)  (2304 + 64 * (j))
#define XB_TOP      3328
#define XB_TOPGEN   3392
#define XCD_BAR_WORDS 3456
#define XB_SPIN_CAP (1u << 18)
__device__ __forceinline__ unsigned xb_ld(unsigned* p)              { return __hip_atomic_load(p, __ATOMIC_RELAXED, __HIP_MEMORY_SCOPE_AGENT); }
__device__ __forceinline__ unsigned xb_add(unsigned* p, unsigned v) { return __hip_atomic_fetch_add(p, v, __ATOMIC_RELAXED, __HIP_MEMORY_SCOPE_AGENT); }
__device__ __forceinline__ unsigned xb_xcc_id() { return (unsigned)__builtin_amdgcn_s_getreg((3 << 11) | 20) & 0xFu; }
#define XB_SPIN(cond, bar) do { unsigned _sp = 0; while (cond) { __builtin_amdgcn_s_sleep(1); \
    if ((++_sp & 255u) == 0u) { if (xb_ld(&(bar)[XB_TMO])) break; if (_sp > XB_SPIN_CAP) { atomicAdd(&(bar)[XB_TMO], 1u); break; } } } } while (0)
struct XcdBarrier { unsigned* bar; unsigned x; volatile LAS unsigned* st; };
__device__ __forceinline__ XcdBarrier xcd_barrier_post(unsigned* bar, volatile LAS unsigned* st) {
    XcdBarrier b; b.bar = bar; b.x = xb_xcc_id(); b.st = st;
    if (threadIdx.x == 0) (void)xb_add(&bar[XB_XCNT(b.x)], 1u);
    return b;
}
__device__ __forceinline__ void xcd_barrier_complete(unsigned* bar, unsigned x, unsigned& nloc, unsigned& nx) {
    const unsigned G = gridDim.x * gridDim.y * gridDim.z;
    unsigned sum, cnt, mine, sp = 0u;
    for (;;) {
        sum = 0u; cnt = 0u; mine = 0u;
#pragma unroll
        for (unsigned j = 0; j < 16; ++j) { const unsigned c = xb_ld(&bar[XB_XCNT(j)]); sum += c; cnt += (c > 0u) ? 1u : 0u; mine = (j == x) ? c : mine; }
        if (sum == G) break;
        __builtin_amdgcn_s_sleep(1);
        if ((++sp & 255u) == 0u) { if (xb_ld(&bar[XB_TMO])) break; if (sp > XB_SPIN_CAP) { atomicAdd(&bar[XB_TMO], 1u); break; } }
    }
    nloc = mine > 0u ? mine : 1u; nx = cnt > 0u ? cnt : 1u;
}
__device__ __forceinline__ void xcd_barrier(const XcdBarrier& b) {
    asm volatile("s_waitcnt vmcnt(0)" ::: "memory");
    __syncthreads();
    if (threadIdx.x == 0) {
        unsigned* bar = b.bar;
        __builtin_amdgcn_s_waitcnt(0);
        unsigned nloc = b.st[0], nx = b.st[1];
        if (nloc == 0u) { xcd_barrier_complete(bar, b.x, nloc, nx); b.st[0] = nloc; b.st[1] = nx; }
        const unsigned old = xb_add(&bar[XB_XSUB(b.x)], 1u);
        const unsigned gen = old / nloc;
        if (old + 1u == (gen + 1u) * nloc) {
            __builtin_amdgcn_fence(__ATOMIC_RELEASE, "agent");
            asm volatile("s_waitcnt vmcnt(0)" ::: "memory");
            const unsigned og = xb_add(&bar[XB_TOP], 1u);
            const unsigned tg = og / nx;
            if (og + 1u == (tg + 1u) * nx) xb_add(&bar[XB_TOPGEN], 1u);
            else XB_SPIN(xb_ld(&bar[XB_TOPGEN]) == tg, bar);
            __builtin_amdgcn_fence(__ATOMIC_ACQUIRE, "agent");
            xb_add(&bar[XB_XGEN(b.x)], 1u);
            asm volatile("s_waitcnt vmcnt(0)" ::: "memory");
        } else {
            XB_SPIN(xb_ld(&bar[XB_XGEN(b.x)]) == gen, bar);
            __builtin_amdgcn_fence(__ATOMIC_ACQUIRE, "agent");
            asm volatile("s_waitcnt vmcnt(0)" ::: "memory");
        }
    }
    __syncthreads();
}

struct Args { const float* in[28]; float* out; unsigned char* ws; int ph_lo, ph_hi, li, pad; };
enum { I_X = 0, I_WIN, I_BGATE, I_GMIX, I_GAQ, I_GAK, I_GBQ, I_WBQUP, I_GBKV, I_WBKVUP, I_WCAF, I_BCAF, I_WCAB, I_BCAB, I_GCOUT, I_WPA, I_WPB, I_WPC, I_WOUT, I_GFFN,
       I_WFFG, I_WFFU, I_WFFD, I_WROUTER, I_WEG, I_WEU, I_WED, I_GFINAL };

struct GUnit { const bf16_t* A; const bf16_t* B; const int* rows; int pm, pn, aux; };
__device__ __forceinline__ void tile_order(int L, int nM, int nN, int& pm, int& pn) {
    const int nwg = nM * nN; int wgid = L;
    { const int q = nwg / 8, r = nwg % 8, xcd = wgid % 8, off = wgid / 8; wgid = (xcd < r ? xcd * (q + 1) : r * (q + 1) + (xcd - r) * q) + off; }
    const int nig = 8 * nN, gid = wgid / nig, fm = gid * 8, gsz = (nM - fm) < 8 ? (nM - fm) : 8;
    pm = fm + ((wgid % nig) % gsz); pn = (wgid % nig) / gsz;
}
struct SchedDense {
    const bf16_t* A; const bf16_t* B; int lda, K, nM, nN, G, c;
    __device__ __forceinline__ bool next(int i, GUnit& u) const {
        const long L = (long)i * G + c; if (L >= (long)nM * nN) return false;
        tile_order((int)L, nM, nN, u.pm, u.pn);
        u.A = A + (size_t)u.pm * 256 * lda; u.B = B + (size_t)u.pn * 256 * K; u.rows = nullptr; u.aux = 0; return true;
    }
};
struct SchedUp {
    const bf16_t* P; const bf16_t* Wq; const bf16_t* Wkv; int G, c;
    __device__ __forceinline__ bool next(int i, GUnit& u) const {
        const int L = i * G + c; if (L >= 448) return false;
        if (L < 192) { tile_order(L, 64, 3, u.pm, u.pn); u.aux = 0; u.A = P + (size_t)u.pm * 256 * PW + PC_BCQ; u.B = Wq + (size_t)u.pn * 256 * 256; }
        else { tile_order(L - 192, 64, 4, u.pm, u.pn); u.aux = 1; u.A = P + (size_t)u.pm * 256 * PW + PC_BCKV; u.B = Wkv + (size_t)u.pn * 256 * 256; }
        u.rows = nullptr; return true;
    }
};
struct SchedMerge {
    const bf16_t* Y0; const bf16_t* W; int G, c;
    __device__ __forceinline__ bool next(int i, GUnit& u) const {
        const int tile = (i / 3) * G + c, br = i % 3; if (tile >= 256) return false;
        tile_order(tile, 64, 4, u.pm, u.pn); u.aux = br;
        u.A = Y0 + (size_t)br * M * 512 + (size_t)u.pm * 256 * 512; u.B = W + (size_t)br * 1024 * 512 + (size_t)u.pn * 256 * 512; u.rows = nullptr; return true;
    }
};
struct SchedMoe {
    const bf16_t* A; const bf16_t* B; const int* tile_e; const int* rowtok; int lda, K, nN, G, c; size_t bstride; bool gather;
    __device__ __forceinline__ bool next(int i, GUnit& u) const {
        const int nM = tile_e[MAXTILES]; const long L = (long)i * G + c; if (L >= (long)nM * nN) return false;
        tile_order((int)L, nM, nN, u.pm, u.pn); const int e = tile_e[u.pm]; u.aux = e;
        u.B = B + (size_t)e * bstride + (size_t)u.pn * 256 * K;
        if (gather) { u.A = A; u.rows = rowtok + u.pm * 256; } else { u.A = A + (size_t)u.pm * 256 * lda; u.rows = nullptr; }
        return true;
    }
};

struct EpiInProj {
    bf16_t* P; bf16_t* GATES; const float* ssq; const float* bgate; float* rsp;
    static constexpr bool HAS_SSQ = false;
    __device__ __forceinline__ void half(int H, int row, int c, const float (&v)[8], float rstd) const {
        float o[8];
        if (H < 26) {
#pragma unroll
            for (int j = 0; j < 8; ++j) o[j] = v[j] * rstd;
            store8(P + (size_t)row * PW + H * 128 + c, o);
            if (H >= 6 && H < 10) { float s = 0.f;
#pragma unroll
                for (int j = 0; j < 8; ++j) s += o[j] * o[j];
                rsp[(size_t)row * 64 + (H - 6) * 16 + (c >> 3)] = s; }
        } else if (H < 50) {
            const int gc = (H - 26) * 128 + c; const f32x4 b0 = *(const f32x4*)(bgate + gc), b1 = *(const f32x4*)(bgate + gc + 4);
            o[0] = sigmoidf_(v[0] * rstd + b0.x); o[1] = sigmoidf_(v[1] * rstd + b0.y); o[2] = sigmoidf_(v[2] * rstd + b0.z); o[3] = sigmoidf_(v[3] * rstd + b0.w);
            o[4] = sigmoidf_(v[4] * rstd + b1.x); o[5] = sigmoidf_(v[5] * rstd + b1.y); o[6] = sigmoidf_(v[6] * rstd + b1.z); o[7] = sigmoidf_(v[7] * rstd + b1.w);
            store8(GATES + (size_t)row * 3072 + gc, o);
        } else if (H == 50 && c < 64) {
#pragma unroll
            for (int j = 0; j < 8; ++j) o[j] = v[j] * rstd;
            store8(P + (size_t)row * PW + PC_SMALL + c, o);
        }
    }
    __device__ __forceinline__ float operator()(const GUnit& u, int r, int c, const float (&v0)[8], const float (&v1)[8]) const {
        const int row = u.pm * 256 + r; const float rstd = row_rstd16(ssq, row);
        half(u.pn * 2, row, c, v0, rstd); half(u.pn * 2 + 1, row, c, v1, rstd); return 0.f;
    }
};
struct EpiUpProj {
    const float* rsp; bf16_t* QB; bf16_t* KNOPE; bf16_t* VB;
    static constexpr bool HAS_SSQ = false;
    __device__ __forceinline__ float operator()(const GUnit& u, int r, int c, const float (&v0)[8], const float (&v1)[8]) const {
        const int row = u.pm * 256 + r; const f32x4* p = (const f32x4*)(rsp + (size_t)row * 64 + u.aux * 32);
        float s = 0.f;
#pragma unroll
        for (int j = 0; j < 8; ++j) { const f32x4 a = p[j]; s += (a.x + a.y) + (a.z + a.w); }
        float rstd = rsqrtf(s * (1.0f / 256.0f) + EPS);
        float o0[8], o1[8];
        if (u.aux == 0) {
            rstd *= C2B;
#pragma unroll
            for (int j = 0; j < 8; ++j) { o0[j] = v0[j] * rstd; o1[j] = v1[j] * rstd; }
            bf16_t* q = QB + (size_t)row * 768 + u.pn * 256 + c; store8(q, o0); store8(q + 128, o1);
        } else {
#pragma unroll
            for (int j = 0; j < 8; ++j) { o0[j] = v0[j] * rstd; o1[j] = v1[j] * rstd; }
            bf16_t* q = (u.pn < 2 ? KNOPE + (size_t)row * 512 + u.pn * 256 : VB + (size_t)row * 512 + (u.pn - 2) * 256) + c; store8(q, o0); store8(q + 128, o1);
        }
        return 0.f;
    }
};
struct EpiMerge {
    const bf16_t* GATES; float* PART; bf16_t* MB;
    static constexpr bool HAS_SSQ = false;
    __device__ __forceinline__ float operator()(const GUnit& u, int r, int c, const float (&v0)[8], const float (&v1)[8]) const {
        const int row = u.pm * 256 + r, col = u.pn * 256 + c, br = u.aux;
#pragma unroll
        for (int h = 0; h < 2; ++h) {
            const int cc = col + h * 128; float g[8], o[8]; load8(GATES + (size_t)row * 3072 + br * 1024 + cc, g);
            float* pp = PART + (size_t)row * 1024 + cc;
#pragma unroll
            for (int j = 0; j < 8; ++j) o[j] = g[j] * (h ? v1[j] : v0[j]);
            if (br > 0) { const f32x4 a = *(const f32x4*)pp, b = *(const f32x4*)(pp + 4); o[0] += a.x; o[1] += a.y; o[2] += a.z; o[3] += a.w; o[4] += b.x; o[5] += b.y; o[6] += b.z; o[7] += b.w; }
            if (br < 2) { *(f32x4*)pp = (f32x4){o[0], o[1], o[2], o[3]}; *(f32x4*)(pp + 4) = (f32x4){o[4], o[5], o[6], o[7]}; }
            else store8(MB + (size_t)row * 1024 + cc, o);
        }
        return 0.f;
    }
};
struct EpiResid {
    const float* xin; float* xout; bf16_t* XB; float* ssq;
    static constexpr bool HAS_SSQ = true;
    __device__ __forceinline__ float operator()(const GUnit& u, int r, int c, const float (&v0)[8], const float (&v1)[8]) const {
        const int row = u.pm * 256 + r, col = u.pn * 256 + c; float ss = 0.f;
#pragma unroll
        for (int h = 0; h < 2; ++h) {
            const size_t off = (size_t)row * 1024 + col + h * 128; const f32x4 a = *(const f32x4*)(xin + off), b = *(const f32x4*)(xin + off + 4);
            float o[8] = {a.x, a.y, a.z, a.w, b.x, b.y, b.z, b.w};
#pragma unroll
            for (int j = 0; j < 8; ++j) { o[j] += (h ? v1[j] : v0[j]); ss += o[j] * o[j]; }
            *(f32x4*)(xout + off) = (f32x4){o[0], o[1], o[2], o[3]}; *(f32x4*)(xout + off + 4) = (f32x4){o[4], o[5], o[6], o[7]};
            store8(XB + off, o);
        }
        return ss;
    }
    __device__ __forceinline__ void put_ssq(const GUnit& u, int r, int slot, float s) const { ssq[(size_t)(u.pm * 256 + r) * 16 + u.pn * 4 + slot] = s; }
};
struct EpiSwiGLU {
    const float* ssq; const int* rowtok; bf16_t* HID; int ldh;
    static constexpr bool HAS_SSQ = false;
    __device__ __forceinline__ float operator()(const GUnit& u, int r, int c, const float (&v0)[8], const float (&v1)[8]) const {
        const int row = u.pm * 256 + r; const int tok = rowtok ? rowtok[row] : row; const float rstd = row_rstd16(ssq, tok);
        float o[8];
#pragma unroll
        for (int j = 0; j < 8; ++j) { const float g = v0[j] * rstd, up = v1[j] * rstd; o[j] = g * sigmoidf_(g) * up; }
        store8(HID + (size_t)row * ldh + u.pn * 128 + c, o); return 0.f;
    }
};
struct EpiMoeDown {
    const float* roww; bf16_t* OUTS;
    static constexpr bool HAS_SSQ = false;
    __device__ __forceinline__ float operator()(const GUnit& u, int r, int c, const float (&v0)[8], const float (&v1)[8]) const {
        const int row = u.pm * 256 + r; const float w = roww[row]; float o0[8], o1[8];
#pragma unroll
        for (int j = 0; j < 8; ++j) { o0[j] = v0[j] * w; o1[j] = v1[j] * w; }
        bf16_t* q = OUTS + (size_t)row * 1024 + u.pn * 256 + c; store8(q, o0); store8(q + 128, o1); return 0.f;
    }
};

template <class Sched, class Epi>
__device__ __forceinline__ void gemm_naive(const Sched& S, const Epi& E, int K, int lda) {
    const int tid = threadIdx.x, r = tid & 255, s = __builtin_amdgcn_readfirstlane(tid >> 8);
    GUnit u;
    for (int i = 0; S.next(i, u); ++i) {
        const bf16_t* arow = u.rows ? u.A + (size_t)u.rows[r] * lda : u.A + (size_t)r * lda;
        float ss = 0.f;
        for (int g = 0; g < 8; ++g) {
            const int c = s * 64 + g * 8;
            float a0[8], a1[8];
#pragma unroll
            for (int j = 0; j < 8; ++j) { a0[j] = 0.f; a1[j] = 0.f; }
            for (int k = 0; k < K; k += 8) {
                float af[8]; load8(arow + k, af);
#pragma unroll
                for (int j = 0; j < 8; ++j) {
                    float b0[8], b1[8]; load8(u.B + (size_t)(c + j) * K + k, b0); load8(u.B + (size_t)(128 + c + j) * K + k, b1);
#pragma unroll
                    for (int e = 0; e < 8; ++e) { a0[j] = fmaf(af[e], b0[e], a0[j]); a1[j] = fmaf(af[e], b1[e], a1[j]); }
                }
            }
            ss += E(u, r, c, a0, a1);
        }
        if constexpr (Epi::HAS_SSQ) { E.put_ssq(u, r, s, ss); E.put_ssq(u, r, 2 + s, 0.f); }
    }
}

__device__ __forceinline__ int rowmap(int code, int n) {
    switch (code) {
        case 1: return n < 1280 ? n : (n < 1312 ? n + 5120 : (n < 3360 ? n - 32 : (n < 3392 ? n + 3072 : n - 64)));
        case 2: { const int h = n >> 7, j = n & 127; return j < 64 ? h * 64 + j : 512 + h * 64 + (j - 64); }
        case 3: return (n >> 7) * 256 + (n & 127);
        case 4: return (n >> 7) * 256 + 128 + (n & 127);
        default: return n;
    }
}
struct TJob { const float* W; bf16_t* WT; const float* g; int K, N, code; };
__device__ __forceinline__ void transpose_item(const TJob& jb, LAS float* scr, int item, int lane) {
    const int K = jb.K, N = jb.N, nblk = N / 32, kb = item / nblk, nb = item % nblk, k0 = 64 * kb, n0 = 32 * nb;
#pragma unroll 8
    for (int i = 0; i < 32; ++i) { const int kk = 2 * i + (lane >> 5); float w = jb.W[(size_t)(k0 + kk) * N + n0 + (lane & 31)]; if (jb.g) w *= jb.g[k0 + kk]; scr[kk * 33 + (lane & 31)] = w; }
    asm volatile("s_waitcnt lgkmcnt(0)" ::: "memory");
    const int c = lane & 7;
#pragma unroll
    for (int j = 0; j < 4; ++j) { const int n = (lane >> 3) + 8 * j; const LAS float* s = scr + (8 * c) * 33 + n;
        u32x4 o; o.x = pk2(s[0 * 33], s[1 * 33]); o.y = pk2(s[2 * 33], s[3 * 33]); o.z = pk2(s[4 * 33], s[5 * 33]); o.w = pk2(s[6 * 33], s[7 * 33]);
        *(u32x4*)(jb.WT + (size_t)rowmap(jb.code, n0 + n) * K + k0 + 8 * c) = o; }
    asm volatile("s_waitcnt lgkmcnt(0)" ::: "memory");
}
__device__ __forceinline__ bool common_job(const Args& a, int j, TJob& jb) {
    unsigned char* ws = a.ws;
    if (j < 14) { const int l = j / 7, k = j % 7;
        switch (k) {
            case 0: jb = TJob{a.in[I_WIN] + (size_t)l * 1024 * 6464, (bf16_t*)(ws + O_WIN + l * SZ_WIN1), a.in[I_GMIX] + l * 1024, 1024, 6464, 1}; break;
            case 1: jb = TJob{a.in[I_WBQUP] + (size_t)l * 256 * 768, (bf16_t*)(ws + O_WQUP + l * SZ_WQUP1), a.in[I_GBQ] + l * 256, 256, 768, 0}; break;
            case 2: jb = TJob{a.in[I_WBKVUP] + (size_t)l * 256 * 1024, (bf16_t*)(ws + O_WKVUP + l * SZ_WKVUP1), a.in[I_GBKV] + l * 256, 256, 1024, 2}; break;
            case 3: jb = TJob{a.in[I_WPA] + (size_t)l * 512 * 1024, (bf16_t*)(ws + O_WP + (l * 3 + 0) * SZ_WP1), nullptr, 512, 1024, 0}; break;
            case 4: jb = TJob{a.in[I_WPB] + (size_t)l * 512 * 1024, (bf16_t*)(ws + O_WP + (l * 3 + 1) * SZ_WP1), nullptr, 512, 1024, 0}; break;
            case 5: jb = TJob{a.in[I_WPC] + (size_t)l * 512 * 1024, (bf16_t*)(ws + O_WP + (l * 3 + 2) * SZ_WP1), nullptr, 512, 1024, 0}; break;
            default: jb = TJob{a.in[I_WOUT] + (size_t)l * 1024 * 1024, (bf16_t*)(ws + O_WOUT + l * SZ_WOUT1), nullptr, 1024, 1024, 0}; break;
        }
        return true; }
    if (j == 14) { jb = TJob{a.in[I_WFFG], (bf16_t*)(ws + O_WFFGU), a.in[I_GFFN], 1024, DFF, 3}; return true; }
    if (j == 15) { jb = TJob{a.in[I_WFFU], (bf16_t*)(ws + O_WFFGU), a.in[I_GFFN], 1024, DFF, 4}; return true; }
    if (j == 16) { jb = TJob{a.in[I_WFFD], (bf16_t*)(ws + O_WFFD), nullptr, DFF, 1024, 0}; return true; }
    return false;
}
__device__ __forceinline__ bool expert_job(const Args& a, int j, TJob& jb) {
    if (j >= 24) return false;
    unsigned char* ws = a.ws; const int e = j / 3, k = j % 3;
    if (k == 0) jb = TJob{a.in[I_WEG] + (size_t)e * 1024 * DFE, (bf16_t*)(ws + O_WEGU) + (size_t)e * 2 * DFE * 1024, a.in[I_GFFN] + 1024, 1024, DFE, 3};
    else if (k == 1) jb = TJob{a.in[I_WEU] + (size_t)e * 1024 * DFE, (bf16_t*)(ws + O_WEGU) + (size_t)e * 2 * DFE * 1024, a.in[I_GFFN] + 1024, 1024, DFE, 4};
    else jb = TJob{a.in[I_WED] + (size_t)e * DFE * 1024, (bf16_t*)(ws + O_WED) + (size_t)e * 1024 * DFE, nullptr, DFE, 1024, 0};
    return true;
}
template <bool EXPERTS>
__device__ __forceinline__ void run_transposes(const Args& a, LAS unsigned char* lds, int gw, int NGW, int wave, int lane) {
    LAS float* scr = (LAS float*)(lds + wave * 16384);
    TJob jb;
    for (int j = 0; EXPERTS ? expert_job(a, j, jb) : common_job(a, j, jb); ++j) {
        const int nitems = (jb.K / 64) * (jb.N / 32);
        for (int it = gw; it < nitems; it += NGW) transpose_item(jb, scr, it, lane);
    }
}
__device__ __forceinline__ void phase_prologue(const Args& a, LAS unsigned char* lds, int vcu, int G, int tid) {
    const int wave = __builtin_amdgcn_readfirstlane(tid >> 6), lane = tid & 63, gw = vcu * NWAVES + wave, NGW = G * NWAVES;
    unsigned char* ws = a.ws;
    run_transposes<false>(a, lds, gw, NGW, wave, lane);
    for (int l = 0; l < 2; ++l) { u32x4* p = (u32x4*)(ws + O_WIN + l * SZ_WIN1 + (size_t)6464 * 1024 * 2); const int n16 = 192 * 1024 * 2 / 16;
        for (int i = gw * 64 + lane; i < n16; i += NGW * 64) p[i] = (u32x4){0u, 0u, 0u, 0u}; }
    float* ta = (float*)(ws + O_TABA); float* tb = (float*)(ws + O_TABB);
    for (int i = gw * 64 + lane; i < T * 32; i += NGW * 64) { const int t = i >> 5, k = i & 31, blk = k >> 4, fi = k & 15;
        const float inv = exp2f(-(float)fi * (13.287712379549449f / 16.0f)); const float pos = (float)(blk ? (t & 63) : (t >> 6)); const float ang = pos * inv;
        ta[t * 64 + k] = cosf(ang); ta[t * 64 + 32 + k] = sinf(ang); }
    for (int i = gw * 64 + lane; i < T * 16; i += NGW * 64) { const int t = i >> 4, k = i & 15, blk = k >> 3, fi = k & 7;
        const float inv = exp2f(-(float)fi * (13.287712379549449f / 8.0f)); const float pos = (float)(blk ? (t & 63) : (t >> 6)); const float ang = pos * inv;
        tb[t * 32 + k] = cosf(ang); tb[t * 32 + 16 + k] = sinf(ang); }
    const float* x = a.in[I_X]; bf16_t* XB = (bf16_t*)(ws + O_XB); float* ssq = (float*)(ws + O_SSQ);
    for (int m = gw; m < M; m += NGW) {
        const f32x4* xr = (const f32x4*)(x + (size_t)m * D) + lane; float s = 0.f;
#pragma unroll
        for (int j = 0; j < 4; ++j) { const f32x4 v = xr[64 * j]; s += (v.x * v.x + v.y * v.y) + (v.z * v.z + v.w * v.w);
            *(u32x2*)(XB + (size_t)m * D + (lane + 64 * j) * 4) = (u32x2){pk2(v.x, v.y), pk2(v.z, v.w)}; }
        s = wave_sum(s);
        if (lane < 16) ssq[(size_t)m * 16 + lane] = lane == 0 ? s : 0.f;
    }
}

template <bool WRITE_LA>
__device__ __forceinline__ void post_item(const Args& a, int layer, int it, LAS unsigned char* lds, int tid) {
    unsigned char* ws = a.ws; const int wave = __builtin_amdgcn_readfirstlane(tid >> 6), lane = tid & 63;
    const bf16_t* P = (const bf16_t*)(ws + O_P); const float* ta = (const float*)(ws + O_TABA); const float* tb = (const float*)(ws + O_TABB);
    bf16_t* QA = (bf16_t*)(ws + O_QA); bf16_t* KA = (bf16_t*)(ws + O_KA); bf16_t* KR = (bf16_t*)(ws + O_KROPE);
    const int r0 = it * 64;
    LAS float* caf = (LAS float*)lds;
    __syncthreads();
    for (int i = tid; i < 64 * 32; i += NTHR) { const int r = i >> 5, j = i & 31; caf[i] = bf2f(P[(size_t)(r0 + r) * PW + PC_SMALL + 32 + j]); }
    const float* gaq = a.in[I_GAQ] + layer * 64; const float* gak = a.in[I_GAK] + layer * 64;
    for (int j = 0; j < 8; ++j) {
        const int row = r0 + wave * 8 + j, t = row & (T - 1);
        {
            const int seg = lane & 7; float x[8]; load8(P + (size_t)row * PW + PC_AQ + lane * 8, x);
            float ss = 0.f;
#pragma unroll
            for (int e = 0; e < 8; ++e) ss += x[e] * x[e];
            ss += __shfl_xor(ss, 1); ss += __shfl_xor(ss, 2); ss += __shfl_xor(ss, 4);
            const float rstd = rsqrtf(ss * (1.0f / 64.0f) + EPS); const int tb_ = t * 64 + (seg >> 2) * 16 + (seg & 1) * 8; float o[8];
#pragma unroll
            for (int e = 0; e < 8; ++e) { const float xn = x[e] * rstd * gaq[seg * 8 + e]; const float pr = __shfl_xor(xn, 2); const float cs = ta[tb_ + e], sn = ta[tb_ + 32 + e];
                o[e] = ((seg & 2) ? xn * cs + pr * sn : xn * cs - pr * sn) * C2A; }
            store8(QA + (size_t)row * 512 + lane * 8, o);
        }
        {
            const int l2 = lane & 15, seg = l2 & 7; float x[8]; load8(P + (size_t)row * PW + PC_AK + l2 * 8, x);
            float ss = 0.f;
#pragma unroll
            for (int e = 0; e < 8; ++e) ss += x[e] * x[e];
            ss += __shfl_xor(ss, 1); ss += __shfl_xor(ss, 2); ss += __shfl_xor(ss, 4);
            const float rstd = rsqrtf(ss * (1.0f / 64.0f) + EPS); const int tb_ = t * 64 + (seg >> 2) * 16 + (seg & 1) * 8; float o[8];
#pragma unroll
            for (int e = 0; e < 8; ++e) { const float xn = x[e] * rstd * gak[seg * 8 + e]; const float pr = __shfl_xor(xn, 2); const float cs = ta[tb_ + e], sn = ta[tb_ + 32 + e];
                o[e] = (seg & 2) ? xn * cs + pr * sn : xn * cs - pr * sn; }
            if (lane < 16) store8(KA + (size_t)row * 128 + l2 * 8, o);
        }
        {
            const int seg = lane & 3; float x[8]; load8(P + (size_t)row * PW + PC_SMALL + seg * 8, x);
            const int tb_ = t * 32 + (seg >> 1) * 8; float o[8];
#pragma unroll
            for (int e = 0; e < 8; ++e) { const float pr = __shfl_xor(x[e], 1); const float cs = tb[tb_ + e], sn = tb[tb_ + 16 + e];
                o[e] = (seg & 1) ? x[e] * cs + pr * sn : x[e] * cs - pr * sn; }
            if (lane < 4) store8(KR + (size_t)row * 32 + seg * 8, o);
        }
    }
    __syncthreads();
    const int col = tid;
    for (int dir = 0; dir < 2; ++dir) {
        const float* Wup = a.in[dir ? I_WCAB : I_WCAF] + (size_t)layer * 16 * 512; const float bias = a.in[dir ? I_BCAB : I_BCAF][layer * 512 + col];
        float w[16];
#pragma unroll
        for (int j = 0; j < 16; ++j) w[j] = Wup[j * 512 + col];
        bf16_t* QT = (bf16_t*)(ws + O_QT) + (size_t)(dir * 2) * M * 512; bf16_t* KT = QT + (size_t)M * 512;
        float* LA = (float*)(ws + O_QT) + (size_t)dir * M * 512;
        float b = 0.f;
        for (int s = 0; s < 64; ++s) {
            const int r = dir ? 63 - s : s; const LAS float* cr = caf + r * 32 + dir * 16; float z = bias;
#pragma unroll
            for (int j = 0; j < 16; ++j) z = fmaf(cr[j], w[j], z);
            const float la = (fminf(z, 0.f) - __logf(1.0f + __expf(-fabsf(z)))) * (1.0f / 16.0f);
            b += la;
            const size_t row = (size_t)(r0 + r);
            if (WRITE_LA) LA[row * 512 + col] = la;
            else { const float e = __expf(b); const float q = bf2f(P[row * PW + PC_CQ + col]), k = bf2f(P[row * PW + PC_CK + col]);
                QT[row * 512 + col] = (bf16_t)f2bf(q * e * GLA_QSCALE); KT[row * 512 + col] = (bf16_t)f2bf(k / e); }
        }
        if (!WRITE_LA) ((float*)(ws + O_DEC))[(size_t)dir * 256 * 512 + (size_t)it * 512 + col] = __expf(b);
    }
}

template <int BR>
__device__ __forceinline__ void attn_naive_unit(const Args& a, int b, int h, int qb, LAS unsigned char* lds, int tid) {
    unsigned char* ws = a.ws; constexpr int DQ = BR ? 96 : 64;
    const bf16_t* P = (const bf16_t*)(ws + O_P);
    LAS float* Ks = (LAS float*)lds;
    LAS float* Vs = Ks + 64 * 96;
    LAS float* Qs = Vs + 64 * 64;
    const int r = tid >> 1, half = tid & 1; const size_t row0 = (size_t)b * T + qb * 256; const size_t row = row0 + r;
    __syncthreads();
    for (int i = tid; i < 256 * (DQ / 8); i += NTHR) { const int rr = i / (DQ / 8), ch = i % (DQ / 8); float f[8];
        if (BR == 0) load8((const bf16_t*)(ws + O_QA) + (row0 + rr) * 512 + h * 64 + ch * 8, f); else load8((const bf16_t*)(ws + O_QB) + (row0 + rr) * 768 + h * 96 + ch * 8, f);
#pragma unroll
        for (int e = 0; e < 8; ++e) Qs[rr * 97 + ch * 8 + e] = f[e]; }
    __syncthreads();
    if (BR == 1 && tid < 256) {
        const int t = (int)((row0 + tid) & (T - 1)); const float* tb = (const float*)(ws + O_TABB) + t * 32; LAS float* q = Qs + tid * 97 + 64;
        for (int blk = 0; blk < 2; ++blk)
            for (int e = 0; e < 8; ++e) { const float cs = tb[blk * 8 + e], sn = tb[16 + blk * 8 + e]; const float x1 = q[blk * 16 + e], x2 = q[blk * 16 + 8 + e];
                q[blk * 16 + e] = x1 * cs - x2 * sn; q[blk * 16 + 8 + e] = x2 * cs + x1 * sn; } }
    float m = -1e30f, l = 0.f, o[32];
#pragma unroll
    for (int j = 0; j < 32; ++j) o[j] = 0.f;
    for (int kt = 0; kt < T / 64; ++kt) {
        __syncthreads();
        for (int i = tid; i < 64 * (DQ / 8); i += NTHR) { const int kr = i / (DQ / 8), ch = i % (DQ / 8); const size_t krow = (size_t)b * T + kt * 64 + kr; float f[8];
            if (BR == 0) load8((const bf16_t*)(ws + O_KA) + krow * 128 + (h >> 2) * 64 + ch * 8, f);
            else if (ch < 8) load8((const bf16_t*)(ws + O_KNOPE) + krow * 512 + h * 64 + ch * 8, f);
            else load8((const bf16_t*)(ws + O_KROPE) + krow * 32 + (ch - 8) * 8, f);
#pragma unroll
            for (int e = 0; e < 8; ++e) Ks[kr * 96 + ch * 8 + e] = f[e]; }
        for (int i = tid; i < 64 * 8; i += NTHR) { const int kr = i >> 3, ch = i & 7; const size_t krow = (size_t)b * T + kt * 64 + kr; float f[8];
            if (BR == 0) load8(P + krow * PW + PC_AV + (h >> 2) * 64 + ch * 8, f); else load8((const bf16_t*)(ws + O_VB) + krow * 512 + h * 64 + ch * 8, f);
#pragma unroll
            for (int e = 0; e < 8; ++e) Vs[kr * 64 + ch * 8 + e] = f[e]; }
        __syncthreads();
#pragma unroll 1
        for (int kr = 0; kr < 64; ++kr) { float s = 0.f;
#pragma unroll 8
            for (int d = 0; d < DQ; ++d) s = fmaf(Qs[r * 97 + d], Ks[kr * 96 + d], s);
            if (s > m) { const float al = exp2f(m - s); l *= al;
#pragma unroll
                for (int j = 0; j < 32; ++j) o[j] *= al;
                m = s; }
            const float p = exp2f(s - m); l += p;
#pragma unroll
            for (int j = 0; j < 32; ++j) o[j] = fmaf(p, Vs[kr * 64 + half * 32 + j], o[j]); }
    }
    const float inv = 1.0f / l; bf16_t* Y = (bf16_t*)(ws + (BR ? O_YB : O_YA)) + row * 512 + h * 64 + half * 32;
#pragma unroll
    for (int j = 0; j < 32; j += 8) { float f[8];
#pragma unroll
        for (int e = 0; e < 8; ++e) f[e] = o[j + e] * inv;
        store8(Y + j, f); }
}

__device__ __forceinline__ void gla_naive_unit(const Args& a, int layer, int b, int h, LAS unsigned char* lds, int tid) {
    unsigned char* ws = a.ws; const bf16_t* P = (const bf16_t*)(ws + O_P); bf16_t* YC = (bf16_t*)(ws + O_YC);
    LAS float* qs = (LAS float*)lds; LAS float* ks = qs + 128; LAS float* as = ks + 128; LAS float* part = as + 128; LAS float* red = part + 512;
    const int j = tid & 127, qd = tid >> 7; const float gco = a.in[I_GCOUT][layer * 128 + j];
    for (int dir = 0; dir < 2; ++dir) {
        const float* LA = (const float*)(ws + O_QT) + (size_t)dir * M * 512;
        float S[32];
#pragma unroll
        for (int i = 0; i < 32; ++i) S[i] = 0.f;
        for (int step = 0; step < T; ++step) {
            const int tok = dir ? T - 1 - step : step; const size_t row = (size_t)b * T + tok;
            __syncthreads();
            if (tid < 128) { qs[tid] = bf2f(P[row * PW + PC_CQ + h * 128 + tid]) * GLA_QSCALE; ks[tid] = bf2f(P[row * PW + PC_CK + h * 128 + tid]); as[tid] = __expf(LA[row * 512 + h * 128 + tid]); }
            const float v = bf2f(P[row * PW + PC_CV + h * 128 + j]);
            __syncthreads();
            float o = 0.f;
#pragma unroll
            for (int i = 0; i < 32; ++i) { const int dk = qd * 32 + i; S[i] = as[dk] * S[i] + ks[dk] * v; o = fmaf(qs[dk], S[i], o); }
            part[qd * 128 + j] = o;
            __syncthreads();
            float v2 = 0.f;
            if (tid < 128) {
                const float tot = (part[tid] + part[128 + tid]) + (part[256 + tid] + part[384 + tid]);
                if (dir == 0) YC[row * 512 + h * 128 + tid] = (bf16_t)f2bf(tot);
                else { v2 = tot + bf2f(YC[row * 512 + h * 128 + tid]); const float ss = wave_sum(v2 * v2); if ((tid & 63) == 0) red[tid >> 6] = ss; }
            }
            if (dir == 1) {
                __syncthreads();
                if (tid < 128) {
                    const float rstd = rsqrtf((red[0] + red[1]) * (1.0f / 128.0f) + EPS);
                    const float g = bf2f(P[row * PW + PC_CG + h * 128 + tid]);
                    YC[row * 512 + h * 128 + tid] = (bf16_t)f2bf(v2 * rstd * gco * (g * sigmoidf_(g)));
                }
            }
        }
    }
}

__device__ __forceinline__ void router_item(const Args& a, int blk, LAS unsigned char* lds, int tid) {
    unsigned char* ws = a.ws; int* mi = (int*)(ws + O_MOEI); float* mf = (float*)(ws + O_MOEI);
    const int wave = __builtin_amdgcn_readfirstlane(tid >> 6), lane = tid & 63;
    LAS float* lg = (LAS float*)lds;
    const float* x1 = a.out; const float* g = a.in[I_GFFN] + 1024; const float* wr = a.in[I_WROUTER];
    __syncthreads();
    for (int j = 0; j < 8; ++j) {
        const int tok = blk * 64 + wave * 8 + j; float acc[8], ss = 0.f;
#pragma unroll
        for (int e = 0; e < 8; ++e) acc[e] = 0.f;
#pragma unroll
        for (int jj = 0; jj < 4; ++jj) { const int idx = (lane + 64 * jj) * 4; const f32x4 v = *(const f32x4*)(x1 + (size_t)tok * D + idx), gg = *(const f32x4*)(g + idx);
            ss += (v.x * v.x + v.y * v.y) + (v.z * v.z + v.w * v.w);
            const float hv[4] = {v.x * gg.x, v.y * gg.y, v.z * gg.z, v.w * gg.w};
#pragma unroll
            for (int c = 0; c < 4; ++c) { const f32x4 w0 = *(const f32x4*)(wr + (size_t)(idx + c) * 8), w1 = *(const f32x4*)(wr + (size_t)(idx + c) * 8 + 4);
                acc[0] = fmaf(hv[c], w0.x, acc[0]); acc[1] = fmaf(hv[c], w0.y, acc[1]); acc[2] = fmaf(hv[c], w0.z, acc[2]); acc[3] = fmaf(hv[c], w0.w, acc[3]);
                acc[4] = fmaf(hv[c], w1.x, acc[4]); acc[5] = fmaf(hv[c], w1.y, acc[5]); acc[6] = fmaf(hv[c], w1.z, acc[6]); acc[7] = fmaf(hv[c], w1.w, acc[7]); } }
        ss = wave_sum(ss); const float rstd = rsqrtf(ss * (1.0f / 1024.0f) + EPS);
#pragma unroll
        for (int e = 0; e < 8; ++e) { const float s = wave_sum(acc[e]); if (lane == 0) lg[(wave * 8 + j) * 8 + e] = s * rstd; }
    }
    __syncthreads();
    if (wave == 0) {
        const int tok = blk * 64 + lane; float v[8];
#pragma unroll
        for (int e = 0; e < 8; ++e) v[e] = lg[lane * 8 + e];
        int e1 = 0; float v1 = v[0];
#pragma unroll
        for (int e = 1; e < 8; ++e) if (v[e] > v1) { v1 = v[e]; e1 = e; }
        int e2 = -1; float v2 = -3.0e38f;
#pragma unroll
        for (int e = 0; e < 8; ++e) if (e != e1 && v[e] > v2) { v2 = v[e]; e2 = e; }
        const float w1 = 1.0f / (1.0f + __expf(v2 - v1)), w2 = 1.0f - w1;
        const unsigned long long lt = (1ull << lane) - 1ull; int ra = 0, rb = 0, mycnt = 0;
#pragma unroll
        for (int e = 0; e < 8; ++e) { const unsigned long long m0 = __ballot(e1 == e), m1 = __ballot(e2 == e); const int c0 = __popcll(m0);
            if (e1 == e) ra = __popcll(m0 & lt); if (e2 == e) rb = c0 + __popcll(m1 & lt); if (lane == e) mycnt = c0 + __popcll(m1); }
        mi[MI_TOKE + tok] = e1 | (e2 << 8); mi[MI_TOKR + tok] = ra | (rb << 16); mf[MI_TOKW + tok * 2] = w1; mf[MI_TOKW + tok * 2 + 1] = w2;
        if (lane < 8) mi[MI_CNT + blk * 8 + lane] = mycnt;
    }
}
__device__ __forceinline__ void positions_phase(const Args& a, LAS unsigned char* lds, int G, int bid, int tid) {
    unsigned char* ws = a.ws; int* mi = (int*)(ws + O_MOEI); float* mf = (float*)(ws + O_MOEI);
    LAS int* cnt = (LAS int*)lds; LAS int* base = cnt + 2048;
    __syncthreads();
    for (int i = tid; i < 2048; i += NTHR) cnt[i] = mi[MI_CNT + i];
    __syncthreads();
    if (tid < 8) { int run = 0; for (int b = 0; b < 256; ++b) { const int c = cnt[b * 8 + tid]; cnt[b * 8 + tid] = run; run += c; } base[8 + tid] = run; }
    __syncthreads();
    if (tid == 0) { int off = 0; for (int e = 0; e < 8; ++e) { base[e] = off; off += (base[8 + e] + 255) & ~255; } base[16] = off >> 8; }
    __syncthreads();
    if (bid == 0) {
        const int nt = base[16];
        for (int t = tid; t < nt; t += NTHR) { int e = 0;
#pragma unroll
            for (int k = 1; k < 8; ++k) if (t * 256 >= base[k]) e = k;
            mi[MI_TILEE + t] = e; }
        if (tid == 0) mi[MI_TILEE + MAXTILES] = nt;
        for (int e = 0; e < 8; ++e) { const int lo = base[e] + base[8 + e], hi = base[e] + ((base[8 + e] + 255) & ~255);
            for (int r = lo + tid; r < hi; r += NTHR) { mi[MI_ROWTOK + r] = 0; mf[MI_ROWW + r] = 0.f; } }
    }
    for (int blk = bid; blk < 256; blk += G) if (tid < 64) {
        const int tok = blk * 64 + tid; const int ee = mi[MI_TOKE + tok], rr = mi[MI_TOKR + tok]; const int e1 = ee & 255, e2 = ee >> 8;
        const int pa = base[e1] + cnt[blk * 8 + e1] + (rr & 0xffff), pb = base[e2] + cnt[blk * 8 + e2] + (rr >> 16);
        mi[MI_ROWTOK + pa] = tok; mf[MI_ROWW + pa] = mf[MI_TOKW + tok * 2]; mi[MI_ROWTOK + pb] = tok; mf[MI_ROWW + pb] = mf[MI_TOKW + tok * 2 + 1];
        mi[MI_TOKPOS + tok * 2] = pa; mi[MI_TOKPOS + tok * 2 + 1] = pb;
    }
}
__device__ __forceinline__ void final_phase(const Args& a, int gw, int NGW, int lane) {
    unsigned char* ws = a.ws; const int* mi = (const int*)(ws + O_MOEI); const bf16_t* OUTS = (const bf16_t*)(ws + O_OUTS); const float* gf = a.in[I_GFINAL];
    for (int m = gw; m < M; m += NGW) {
        const int pa = mi[MI_TOKPOS + m * 2], pb = mi[MI_TOKPOS + m * 2 + 1]; f32x4 v[4]; float s = 0.f;
#pragma unroll
        for (int j = 0; j < 4; ++j) { const int idx = (lane + 64 * j) * 4; v[j] = *(const f32x4*)(a.out + (size_t)m * D + idx);
            const u32x2 ua = *(const u32x2*)(OUTS + (size_t)pa * 1024 + idx), ub = *(const u32x2*)(OUTS + (size_t)pb * 1024 + idx);
            v[j].x += bf2f(ua.x & 0xffffu) + bf2f(ub.x & 0xffffu); v[j].y += bf2f(ua.x >> 16) + bf2f(ub.x >> 16); v[j].z += bf2f(ua.y & 0xffffu) + bf2f(ub.y & 0xffffu); v[j].w += bf2f(ua.y >> 16) + bf2f(ub.y >> 16);
            s += (v[j].x * v[j].x + v[j].y * v[j].y) + (v[j].z * v[j].z + v[j].w * v[j].w); }
        s = wave_sum(s); const float rstd = rsqrtf(s * (1.0f / 1024.0f) + EPS);
#pragma unroll
        for (int j = 0; j < 4; ++j) { const int idx = (lane + 64 * j) * 4; const f32x4 g = *(const f32x4*)(gf + idx);
            *(f32x4*)(a.out + (size_t)m * D + idx) = (f32x4){v[j].x * rstd * g.x, v[j].y * rstd * g.y, v[j].z * rstd * g.z, v[j].w * rstd * g.w}; }
    }
}

template <class Sched, class Epi>
__device__ __forceinline__ void gemm_run(LAS unsigned char* lds, const Sched& S, const Epi& E, int K, int lda) {
    gemm_naive(S, E, K, lda);
}

constexpr int NPHASE = 18;
__global__ void __launch_bounds__(NTHR, 2) mega_fwd(Args args) {
    extern __shared__ __attribute__((aligned(16))) unsigned char lds_raw[];
    LAS unsigned char* lds = (LAS unsigned char*)lds_raw;
    volatile LAS unsigned* MISC = (volatile LAS unsigned*)(lds + LDS_MISC);
    const int tid = threadIdx.x, lane = tid & 63, wave = __builtin_amdgcn_readfirstlane(tid >> 6);
    const int G = gridDim.x, bid = blockIdx.x; const int vcu = (G % 8 == 0) ? (bid % 8) * (G / 8) + bid / 8 : bid;
    unsigned char* ws = args.ws; unsigned* ctl = (unsigned*)ws;
    for (int u = tid; u < (LDS_BYTES - LDS_CTL) / 4; u += NTHR) ((LAS unsigned*)(lds + LDS_CTL))[u] = 0u;
    __syncthreads();
    XcdBarrier bar; bar.bar = ctl + CW_BAR; bar.x = 0; bar.st = nullptr;
#if N_LAUNCH_MODE == 1
    bar = xcd_barrier_post(ctl + CW_BAR, MISC + 8);
#endif
    const int lo = args.ph_lo, hi = args.ph_hi;
#define IN(k) (lo <= (k) && (k) < hi)
#if N_LAUNCH_MODE == 1
#define SEAM(k) do { if (IN(k) && IN((k) + 1)) xcd_barrier(bar); } while (0)
#else
#define SEAM(k) do { } while (0)
#endif
    const int gw = vcu * NWAVES + wave, NGW = G * NWAVES;
    bf16_t* XB = (bf16_t*)(ws + O_XB); float* SSQ = (float*)(ws + O_SSQ); float* RSP = (float*)(ws + O_RSP);
    bf16_t* P = (bf16_t*)(ws + O_P); bf16_t* GATES = (bf16_t*)(ws + O_GATES);
    int* mi = (int*)(ws + O_MOEI); float* mf = (float*)(ws + O_MOEI);

    if (IN(0)) { phase_prologue(args, lds, vcu, G, tid); SEAM(0); }

    for (int l = 0; l < 2; ++l) {
        const int pb = l ? 8 : 1;
        if (IN(pb)) {
            SchedDense S{XB, (const bf16_t*)(ws + O_WIN + l * SZ_WIN1), 1024, 1024, 64, NIN / 256, G, bid};
            EpiInProj E{P, GATES, SSQ, args.in[I_BGATE] + l * 3072, RSP};
            gemm_run(lds, S, E, 1024, 1024);
            SEAM(pb);
        }
        if (IN(pb + 1)) {
            for (int it = bid; it < 256; it += G) post_item<(NAIVE_GLA != 0)>(args, l, it, lds, tid);
            __syncthreads();
            SchedUp S{P, (const bf16_t*)(ws + O_WQUP + l * SZ_WQUP1), (const bf16_t*)(ws + O_WKVUP + l * SZ_WKVUP1), G, bid};
            EpiUpProj E{RSP, (bf16_t*)(ws + O_QB), (bf16_t*)(ws + O_KNOPE), (bf16_t*)(ws + O_VB)};
            gemm_run(lds, S, E, 256, PW);
            SEAM(pb + 1);
        }
        if (IN(pb + 2)) {
            unsigned* qh = ctl + CW_Q + 64 * l; LAS unsigned* slot = (LAS unsigned*)(lds + LDS_CTL + 64);
            for (;;) {
                __syncthreads();
                if (tid == 0) *slot = __hip_atomic_fetch_add(qh, 1u, __ATOMIC_RELAXED, __HIP_MEMORY_SCOPE_AGENT);
                __syncthreads();
                const int u = (int)*slot;
                if (u >= 64 + 1024) break;
                if (u < 64) gla_naive_unit(args, l, u >> 2, u & 3, lds, tid);
                else if (u < 64 + 512) { const int v = u - 64; attn_naive_unit<1>(args, v >> 6, (v >> 3) & 7, v & 7, lds, tid); }
                else { const int v = u - 576; attn_naive_unit<0>(args, v >> 6, (v >> 3) & 7, v & 7, lds, tid); }
            }
            SEAM(pb + 2);
        }
        if (IN(pb + 3)) {
            SchedMerge S{(const bf16_t*)(ws + O_YA), (const bf16_t*)(ws + O_WP + l * 3 * SZ_WP1), G, bid};
            EpiMerge E{GATES, (float*)(ws + O_PART), (bf16_t*)(ws + O_MB)};
            gemm_run(lds, S, E, 512, 512);
            SEAM(pb + 3);
        }
        if (IN(pb + 4)) {
            SchedDense S{(const bf16_t*)(ws + O_MB), (const bf16_t*)(ws + O_WOUT + l * SZ_WOUT1), 1024, 1024, 64, 4, G, bid};
            EpiResid E{l ? args.out : args.in[I_X], args.out, XB, SSQ};
            gemm_run(lds, S, E, 1024, 1024);
            SEAM(pb + 4);
        }
        if (l == 0) {
            if (IN(6)) {
                SchedDense S{XB, (const bf16_t*)(ws + O_WFFGU), 1024, 1024, 64, 2 * DFF / 256, G, bid};
                EpiSwiGLU E{SSQ, nullptr, (bf16_t*)(ws + O_HID), DFF};
                gemm_run(lds, S, E, 1024, 1024);
                SEAM(6);
            }
            if (IN(7)) {
                SchedDense S{(const bf16_t*)(ws + O_HID), (const bf16_t*)(ws + O_WFFD), DFF, DFF, 64, 4, G, bid};
                EpiResid E{args.out, args.out, XB, SSQ};
                gemm_run(lds, S, E, DFF, DFF);
                SEAM(7);
            }
        }
    }
    if (IN(13)) {
        for (int blk = bid; blk < 256; blk += G) router_item(args, blk, lds, tid);
        __syncthreads();
        run_transposes<true>(args, lds, gw, NGW, wave, lane);
        SEAM(13);
    }
    if (IN(14)) { positions_phase(args, lds, G, bid, tid); SEAM(14); }
    if (IN(15)) {
        SchedMoe S{XB, (const bf16_t*)(ws + O_WEGU), mi + MI_TILEE, mi + MI_ROWTOK, 1024, 1024, 2 * DFE / 256, G, bid, (size_t)2 * DFE * 1024, true};
        EpiSwiGLU E{SSQ, mi + MI_ROWTOK, (bf16_t*)(ws + O_HIDS), DFE};
        gemm_run(lds, S, E, 1024, 1024);
        SEAM(15);
    }
    if (IN(16)) {
        SchedMoe S{(const bf16_t*)(ws + O_HIDS), (const bf16_t*)(ws + O_WED), mi + MI_TILEE, mi + MI_ROWTOK, DFE, DFE, 4, G, bid, (size_t)1024 * DFE, false};
        EpiMoeDown E{mf + MI_ROWW, (bf16_t*)(ws + O_OUTS)};
        gemm_run(lds, S, E, DFE, DFE);
        SEAM(16);
    }
    if (IN(17)) final_phase(args, gw, NGW, lane);
#undef IN
#undef SEAM
}

extern "C" void kernel_launch(void* const* d_in, const int* in_sizes, int n_in, void* d_out, int out_size, void* d_ws, size_t ws_size, hipStream_t stream) {
    static int grid = 0;
    if (grid == 0) {
        if (n_in != 28 || out_size != M * D || ws_size < WS_NEED) { fprintf(stderr, "kernel_launch: unexpected shapes (n_in %d out %d ws %zu need %zu)\n", n_in, out_size, ws_size, (size_t)WS_NEED); grid = -1; return; }
        int dev = 0, cus = 0;
        if (hipGetDevice(&dev) != hipSuccess || hipDeviceGetAttribute(&cus, hipDeviceAttributeMultiprocessorCount, dev) != hipSuccess) { grid = -1; return; }
        if (hipFuncSetAttribute((const void*)mega_fwd, hipFuncAttributeMaxDynamicSharedMemorySize, LDS_BYTES) != hipSuccess) { grid = -1; return; }
        int per_cu = 0;
        if (hipOccupancyMaxActiveBlocksPerMultiprocessor(&per_cu, (const void*)mega_fwd, NTHR, LDS_BYTES) != hipSuccess || per_cu < 1) { fprintf(stderr, "kernel_launch: occupancy query says %d\n", per_cu); }
        (void)hipGetLastError();
        grid = cus;
    }
    if (grid < 0) return;
    (void)hipMemsetAsync(d_ws, 0, CTL_BYTES, stream);
    Args a{};
    for (int i = 0; i < 28; ++i) a.in[i] = (const float*)d_in[i];
    a.out = (float*)d_out; a.ws = (unsigned char*)d_ws; a.li = 0; a.pad = 0;
#if N_LAUNCH_MODE == 1
    a.ph_lo = 0; a.ph_hi = NPHASE;
    hipLaunchKernelGGL(mega_fwd, dim3(grid), dim3(NTHR), LDS_BYTES, stream, a);
#else
    for (int p = 0; p < NPHASE; ++p) { a.ph_lo = p; a.ph_hi = p + 1; hipLaunchKernelGGL(mega_fwd, dim3(grid), dim3(NTHR), LDS_BYTES, stream, a); }
#endif
}
```

```cpp
#include <hip/hip_runtime.h>
#include <cstdio>
#include <cstdint>

#ifndef N_LAUNCH_MODE
#define N_LAUNCH_MODE 1
#endif
#ifndef NAIVE_GEMM
#define NAIVE_GEMM 1
#endif
#ifndef NAIVE_ATTN
#define NAIVE_ATTN 1
#endif
#ifndef NAIVE_GLA
#define NAIVE_GLA 1
#endif

#define LAS __attribute__((address_space(3)))
#define GAS __attribute__((address_space(1)))
typedef unsigned short bf16_t;
typedef short bf16x8 __attribute__((ext_vector_type(8)));
typedef float f32x4 __attribute__((ext_vector_type(4)));
typedef unsigned u32x4 __attribute__((ext_vector_type(4)));
typedef unsigned u32x2 __attribute__((ext_vector_type(2)));

constexpr int M = 16384, D = 1024, T = 2048, NBATCH = 8, NWAVES = 8, NTHR = 512;
constexpr float EPS = 1e-6f;
constexpr int PW = 3456;
constexpr int PC_AQ = 0, PC_AK = 512, PC_AV = 640, PC_BCQ = 768, PC_BCKV = 1024, PC_CQ = 1280, PC_CK = 1792, PC_CV = 2304, PC_CG = 2816, PC_SMALL = 3328;
constexpr int NIN = 6656;
constexpr int DFF = 2816, DFE = 3584, NEXP = 8;
constexpr int MAXTILES = 136, MAXROWS = MAXTILES * 256;
constexpr float LOG2E = 1.4426950408889634f;
constexpr float C2A = 0.125f * LOG2E;
constexpr float C2B = 0.10206207261596575f * LOG2E;
constexpr float GLA_QSCALE = 0.08838834764831845f;

constexpr size_t CTL_BYTES = 1u << 20;
constexpr size_t SZ_WIN1 = (size_t)NIN * 1024 * 2, SZ_WQUP1 = 768 * 256 * 2, SZ_WKVUP1 = 1024 * 256 * 2, SZ_WP1 = 1024 * 512 * 2, SZ_WOUT1 = 1024 * 1024 * 2;
constexpr size_t O_WIN = CTL_BYTES;
constexpr size_t O_WQUP = O_WIN + 2 * SZ_WIN1;
constexpr size_t O_WKVUP = O_WQUP + 2 * SZ_WQUP1;
constexpr size_t O_WP = O_WKVUP + 2 * SZ_WKVUP1;
constexpr size_t O_WOUT = O_WP + 6 * SZ_WP1;
constexpr size_t O_WFFGU = O_WOUT + 2 * SZ_WOUT1;
constexpr size_t O_WFFD = O_WFFGU + (size_t)2 * DFF * 1024 * 2;
constexpr size_t O_TABA = O_WFFD + (size_t)1024 * DFF * 2;
constexpr size_t O_TABB = O_TABA + (size_t)T * 64 * 4;
constexpr size_t O_XB = O_TABB + (size_t)T * 32 * 4;
constexpr size_t O_SSQ = O_XB + (size_t)M * 1024 * 2;
constexpr size_t O_RSP = O_SSQ + (size_t)M * 16 * 4;
constexpr size_t O_MOEI = O_RSP + (size_t)M * 64 * 4;
constexpr size_t SZ_MOEI = 2u << 20;
constexpr size_t O_R = O_MOEI + SZ_MOEI;
constexpr size_t O_P = O_R;
constexpr size_t O_GATES = O_P + (size_t)M * PW * 2;
constexpr size_t O_QA = O_GATES + (size_t)M * 3072 * 2;
constexpr size_t O_KA = O_QA + (size_t)M * 512 * 2;
constexpr size_t O_KROPE = O_KA + (size_t)M * 128 * 2;
constexpr size_t O_QB = O_KROPE + (size_t)M * 32 * 2;
constexpr size_t O_KNOPE = O_QB + (size_t)M * 768 * 2;
constexpr size_t O_VB = O_KNOPE + (size_t)M * 512 * 2;
constexpr size_t O_QT = O_VB + (size_t)M * 512 * 2;
constexpr size_t O_DEC = O_QT + (size_t)4 * M * 512 * 2;
constexpr size_t O_YA = O_DEC + (size_t)2 * 256 * 512 * 4;
constexpr size_t O_YB = O_YA + (size_t)M * 512 * 2;
constexpr size_t O_YC = O_YB + (size_t)M * 512 * 2;
constexpr size_t O_MIX_END = O_YC + (size_t)M * 512 * 2;
constexpr size_t O_PART = O_QT;
constexpr size_t O_MB = O_P;
constexpr size_t O_HID = O_P;
constexpr size_t O_WEGU = O_R;
constexpr size_t O_WED = O_WEGU + (size_t)NEXP * 2 * DFE * 1024 * 2;
constexpr size_t O_HIDS = O_WED + (size_t)NEXP * 1024 * DFE * 2;
constexpr size_t O_MOE_END = O_HIDS + (size_t)MAXROWS * DFE * 2;
constexpr size_t O_OUTS = O_WEGU;
constexpr size_t WS_NEED = O_MIX_END > O_MOE_END ? O_MIX_END : O_MOE_END;
static_assert(WS_NEED <= 531851264ull, "workspace map exceeds the guaranteed ws_size");
static_assert((size_t)M * 1024 * 4 <= (size_t)4 * M * 512 * 2, "PART overlay");
static_assert((size_t)MAXROWS * 1024 * 2 <= (size_t)NEXP * 2 * DFE * 1024 * 2, "OUTS overlay");
constexpr int MI_CNT = 0;
constexpr int MI_TOKE = 4096;
constexpr int MI_TOKR = MI_TOKE + M;
constexpr int MI_TOKW = MI_TOKR + M;
constexpr int MI_TOKPOS = MI_TOKW + 2 * M;
constexpr int MI_ROWTOK = MI_TOKPOS + 2 * M;
constexpr int MI_ROWW = MI_ROWTOK + MAXROWS;
constexpr int MI_TILEE = MI_ROWW + MAXROWS;
constexpr int MI_END = MI_TILEE + MAXTILES + 8;
static_assert((size_t)MI_END * 4 <= SZ_MOEI, "moe lists");

constexpr int CW_TMO = 0;
constexpr int CW_Q = 1024;
constexpr int CW_BAR = 4096;

constexpr int LDS_RING = 131072, LDS_CTL = 145408, LDS_MISC = LDS_CTL + 320, LDS_BYTES = 147456;

__device__ __forceinline__ float bf2f(unsigned v) { return __uint_as_float(v << 16); }
__device__ __forceinline__ unsigned f2bf(float f) { unsigned u = __float_as_uint(f); return (u + 0x7fffu + ((u >> 16) & 1u)) >> 16; }
__device__ __forceinline__ unsigned pk2(float lo, float hi) { return f2bf(lo) | (f2bf(hi) << 16); }
__device__ __forceinline__ void unpack8(const u32x4 w, float (&f)[8]) {
    f[0] = __uint_as_float(w.x << 16); f[1] = __uint_as_float(w.x & 0xffff0000u); f[2] = __uint_as_float(w.y << 16); f[3] = __uint_as_float(w.y & 0xffff0000u);
    f[4] = __uint_as_float(w.z << 16); f[5] = __uint_as_float(w.z & 0xffff0000u); f[6] = __uint_as_float(w.w << 16); f[7] = __uint_as_float(w.w & 0xffff0000u);
}
__device__ __forceinline__ u32x4 pack8(const float (&f)[8]) { u32x4 w; w.x = pk2(f[0], f[1]); w.y = pk2(f[2], f[3]); w.z = pk2(f[4], f[5]); w.w = pk2(f[6], f[7]); return w; }
__device__ __forceinline__ void load8(const bf16_t* p, float (&f)[8]) { unpack8(*(const u32x4*)p, f); }
__device__ __forceinline__ void store8(bf16_t* p, const float (&f)[8]) { *(u32x4*)p = pack8(f); }
__device__ __forceinline__ float wave_sum(float v) {
#pragma unroll
    for (int o = 1; o < 64; o <<= 1) v += __shfl_xor(v, o);
    return v;
}
__device__ __forceinline__ float row_rstd16(const float* ssq, int row) {
    const f32x4* p = (const f32x4*)(ssq + (size_t)row * 16);
    const f32x4 a = p[0], b = p[1], c = p[2], d = p[3];
    const float s = ((a.x + a.y) + (a.z + a.w)) + ((b.x + b.y) + (b.z + b.w)) + ((c.x + c.y) + (c.z + c.w)) + ((d.x + d.y) + (d.z + d.w));
    return rsqrtf(s * (1.0f / 1024.0f) + EPS);
}
__device__ __forceinline__ float sigmoidf_(float x) { return 1.0f / (1.0f + __expf(-x)); }

#define XB_TMO      128
#define XB_XCNT(j)  (256  + 64 * (j))
#define XB_XSUB(j)  (1280 + 64 * (j))
#define XB_XGEN(j)  (2304 + 64 * (j))
#define XB_TOP      3328
#define XB_TOPGEN   3392
#define XCD_BAR_WORDS 3456
#define XB_SPIN_CAP (1u << 18)
__device__ __forceinline__ unsigned xb_ld(unsigned* p)              { return __hip_atomic_load(p, __ATOMIC_RELAXED, __HIP_MEMORY_SCOPE_AGENT); }
__device__ __forceinline__ unsigned xb_add(unsigned* p, unsigned v) { return __hip_atomic_fetch_add(p, v, __ATOMIC_RELAXED, __HIP_MEMORY_SCOPE_AGENT); }
__device__ __forceinline__ unsigned xb_xcc_id() { return (unsigned)__builtin_amdgcn_s_getreg((3 << 11) | 20) & 0xFu; }
#define XB_SPIN(cond, bar) do { unsigned _sp = 0; while (cond) { __builtin_amdgcn_s_sleep(1); \
    if ((++_sp & 255u) == 0u) { if (xb_ld(&(bar)[XB_TMO])) break; if (_sp > XB_SPIN_CAP) { atomicAdd(&(bar)[XB_TMO], 1u); break; } } } } while (0)
struct XcdBarrier { unsigned* bar; unsigned x; volatile LAS unsigned* st; };
__device__ __forceinline__ XcdBarrier xcd_barrier_post(unsigned* bar, volatile LAS unsigned* st) {
    XcdBarrier b; b.bar = bar; b.x = xb_xcc_id(); b.st = st;
    if (threadIdx.x == 0) (void)xb_add(&bar[XB_XCNT(b.x)], 1u);
    return b;
}
__device__ __forceinline__ void xcd_barrier_complete(unsigned* bar, unsigned x, unsigned& nloc, unsigned& nx) {
    const unsigned G = gridDim.x * gridDim.y * gridDim.z;
    unsigned sum, cnt, mine, sp = 0u;
    for (;;) {
        sum = 0u; cnt = 0u; mine = 0u;
#pragma unroll
        for (unsigned j = 0; j < 16; ++j) { const unsigned c = xb_ld(&bar[XB_XCNT(j)]); sum += c; cnt += (c > 0u) ? 1u : 0u; mine = (j == x) ? c : mine; }
        if (sum == G) break;
        __builtin_amdgcn_s_sleep(1);
        if ((++sp & 255u) == 0u) { if (xb_ld(&bar[XB_TMO])) break; if (sp > XB_SPIN_CAP) { atomicAdd(&bar[XB_TMO], 1u); break; } }
    }
    nloc = mine > 0u ? mine : 1u; nx = cnt > 0u ? cnt : 1u;
}
__device__ __forceinline__ void xcd_barrier(const XcdBarrier& b) {
    asm volatile("s_waitcnt vmcnt(0)" ::: "memory");
    __syncthreads();
    if (threadIdx.x == 0) {
        unsigned* bar = b.bar;
        __builtin_amdgcn_s_waitcnt(0);
        unsigned nloc = b.st[0], nx = b.st[1];
        if (nloc == 0u) { xcd_barrier_complete(bar, b.x, nloc, nx); b.st[0] = nloc; b.st[1] = nx; }
        const unsigned old = xb_add(&bar[XB_XSUB(b.x)], 1u);
        const unsigned gen = old / nloc;
        if (old + 1u == (gen + 1u) * nloc) {
            __builtin_amdgcn_fence(__ATOMIC_RELEASE, "agent");
            asm volatile("s_waitcnt vmcnt(0)" ::: "memory");
            const unsigned og = xb_add(&bar[XB_TOP], 1u);
            const unsigned tg = og / nx;
            if (og + 1u == (tg + 1u) * nx) xb_add(&bar[XB_TOPGEN], 1u);
            else XB_SPIN(xb_ld(&bar[XB_TOPGEN]) == tg, bar);
            __builtin_amdgcn_fence(__ATOMIC_ACQUIRE, "agent");
            xb_add(&bar[XB_XGEN(b.x)], 1u);
            asm volatile("s_waitcnt vmcnt(0)" ::: "memory");
        } else {
            XB_SPIN(xb_ld(&bar[XB_XGEN(b.x)]) == gen, bar);
            __builtin_amdgcn_fence(__ATOMIC_ACQUIRE, "agent");
            asm volatile("s_waitcnt vmcnt(0)" ::: "memory");
        }
    }
    __syncthreads();
}

struct Args { const float* in[28]; float* out; unsigned char* ws; int ph_lo, ph_hi, li, pad; };
enum { I_X = 0, I_WIN, I_BGATE, I_GMIX, I_GAQ, I_GAK, I_GBQ, I_WBQUP, I_GBKV, I_WBKVUP, I_WCAF, I_BCAF, I_WCAB, I_BCAB, I_GCOUT, I_WPA, I_WPB, I_WPC, I_WOUT, I_GFFN,
       I_WFFG, I_WFFU, I_WFFD, I_WROUTER, I_WEG, I_WEU, I_WED, I_GFINAL };

struct GUnit { const bf16_t* A; const bf16_t* B; const int* rows; int pm, pn, aux; };
__device__ __forceinline__ void tile_order(int L, int nM, int nN, int& pm, int& pn) {
    const int nwg = nM * nN; int wgid = L;
    { const int q = nwg / 8, r = nwg % 8, xcd = wgid % 8, off = wgid / 8; wgid = (xcd < r ? xcd * (q + 1) : r * (q + 1) + (xcd - r) * q) + off; }
    const int nig = 8 * nN, gid = wgid / nig, fm = gid * 8, gsz = (nM - fm) < 8 ? (nM - fm) : 8;
    pm = fm + ((wgid % nig) % gsz); pn = (wgid % nig) / gsz;
}
struct SchedDense {
    const bf16_t* A; const bf16_t* B; int lda, K, nM, nN, G, c;
    __device__ __forceinline__ bool next(int i, GUnit& u) const {
        const long L = (long)i * G + c; if (L >= (long)nM * nN) return false;
        tile_order((int)L, nM, nN, u.pm, u.pn);
        u.A = A + (size_t)u.pm * 256 * lda; u.B = B + (size_t)u.pn * 256 * K; u.rows = nullptr; u.aux = 0; return true;
    }
};
struct SchedUp {
    const bf16_t* P; const bf16_t* Wq; const bf16_t* Wkv; int G, c;
    __device__ __forceinline__ bool next(int i, GUnit& u) const {
        const int L = i * G + c; if (L >= 448) return false;
        if (L < 192) { tile_order(L, 64, 3, u.pm, u.pn); u.aux = 0; u.A = P + (size_t)u.pm * 256 * PW + PC_BCQ; u.B = Wq + (size_t)u.pn * 256 * 256; }
        else { tile_order(L - 192, 64, 4, u.pm, u.pn); u.aux = 1; u.A = P + (size_t)u.pm * 256 * PW + PC_BCKV; u.B = Wkv + (size_t)u.pn * 256 * 256; }
        u.rows = nullptr; return true;
    }
};
struct SchedMerge {
    const bf16_t* Y0; const bf16_t* W; int G, c;
    __device__ __forceinline__ bool next(int i, GUnit& u) const {
        const int tile = (i / 3) * G + c, br = i % 3; if (tile >= 256) return false;
        tile_order(tile, 64, 4, u.pm, u.pn); u.aux = br;
        u.A = Y0 + (size_t)br * M * 512 + (size_t)u.pm * 256 * 512; u.B = W + (size_t)br * 1024 * 512 + (size_t)u.pn * 256 * 512; u.rows = nullptr; return true;
    }
};
struct SchedMoe {
    const bf16_t* A; const bf16_t* B; const int* tile_e; const int* rowtok; int lda, K, nN, G, c; size_t bstride; bool gather;
    __device__ __forceinline__ bool next(int i, GUnit& u) const {
        const int nM = tile_e[MAXTILES]; const long L = (long)i * G + c; if (L >= (long)nM * nN) return false;
        tile_order((int)L, nM, nN, u.pm, u.pn); const int e = tile_e[u.pm]; u.aux = e;
        u.B = B + (size_t)e * bstride + (size_t)u.pn * 256 * K;
        if (gather) { u.A = A; u.rows = rowtok + u.pm * 256; } else { u.A = A + (size_t)u.pm * 256 * lda; u.rows = nullptr; }
        return true;
    }
};

struct EpiInProj {
    bf16_t* P; bf16_t* GATES; const float* ssq; const float* bgate; float* rsp;
    static constexpr bool HAS_SSQ = false;
    __device__ __forceinline__ void half(int H, int row, int c, const float (&v)[8], float rstd) const {
        float o[8];
        if (H < 26) {
#pragma unroll
            for (int j = 0; j < 8; ++j) o[j] = v[j] * rstd;
            store8(P + (size_t)row * PW + H * 128 + c, o);
            if (H >= 6 && H < 10) { float s = 0.f;
#pragma unroll
                for (int j = 0; j < 8; ++j) s += o[j] * o[j];
                rsp[(size_t)row * 64 + (H - 6) * 16 + (c >> 3)] = s; }
        } else if (H < 50) {
            const int gc = (H - 26) * 128 + c; const f32x4 b0 = *(const f32x4*)(bgate + gc), b1 = *(const f32x4*)(bgate + gc + 4);
            o[0] = sigmoidf_(v[0] * rstd + b0.x); o[1] = sigmoidf_(v[1] * rstd + b0.y); o[2] = sigmoidf_(v[2] * rstd + b0.z); o[3] = sigmoidf_(v[3] * rstd + b0.w);
            o[4] = sigmoidf_(v[4] * rstd + b1.x); o[5] = sigmoidf_(v[5] * rstd + b1.y); o[6] = sigmoidf_(v[6] * rstd + b1.z); o[7] = sigmoidf_(v[7] * rstd + b1.w);
            store8(GATES + (size_t)row * 3072 + gc, o);
        } else if (H == 50 && c < 64) {
#pragma unroll
            for (int j = 0; j < 8; ++j) o[j] = v[j] * rstd;
            store8(P + (size_t)row * PW + PC_SMALL + c, o);
        }
    }
    __device__ __forceinline__ float operator()(const GUnit& u, int r, int c, const float (&v0)[8], const float (&v1)[8]) const {
        const int row = u.pm * 256 + r; const float rstd = row_rstd16(ssq, row);
        half(u.pn * 2, row, c, v0, rstd); half(u.pn * 2 + 1, row, c, v1, rstd); return 0.f;
    }
};
struct EpiUpProj {
    const float* rsp; bf16_t* QB; bf16_t* KNOPE; bf16_t* VB;
    static constexpr bool HAS_SSQ = false;
    __device__ __forceinline__ float operator()(const GUnit& u, int r, int c, const float (&v0)[8], const float (&v1)[8]) const {
        const int row = u.pm * 256 + r; const f32x4* p = (const f32x4*)(rsp + (size_t)row * 64 + u.aux * 32);
        float s = 0.f;
#pragma unroll
        for (int j = 0; j < 8; ++j) { const f32x4 a = p[j]; s += (a.x + a.y) + (a.z + a.w); }
        float rstd = rsqrtf(s * (1.0f / 256.0f) + EPS);
        float o0[8], o1[8];
        if (u.aux == 0) {
            rstd *= C2B;
#pragma unroll
            for (int j = 0; j < 8; ++j) { o0[j] = v0[j] * rstd; o1[j] = v1[j] * rstd; }
            bf16_t* q = QB + (size_t)row * 768 + u.pn * 256 + c; store8(q, o0); store8(q + 128, o1);
        } else {
#pragma unroll
            for (int j = 0; j < 8; ++j) { o0[j] = v0[j] * rstd; o1[j] = v1[j] * rstd; }
            bf16_t* q = (u.pn < 2 ? KNOPE + (size_t)row * 512 + u.pn * 256 : VB + (size_t)row * 512 + (u.pn - 2) * 256) + c; store8(q, o0); store8(q + 128, o1);
        }
        return 0.f;
    }
};
struct EpiMerge {
    const bf16_t* GATES; float* PART; bf16_t* MB;
    static constexpr bool HAS_SSQ = false;
    __device__ __forceinline__ float operator()(const GUnit& u, int r, int c, const float (&v0)[8], const float (&v1)[8]) const {
        const int row = u.pm * 256 + r, col = u.pn * 256 + c, br = u.aux;
#pragma unroll
        for (int h = 0; h < 2; ++h) {
            const int cc = col + h * 128; float g[8], o[8]; load8(GATES + (size_t)row * 3072 + br * 1024 + cc, g);
            float* pp = PART + (size_t)row * 1024 + cc;
#pragma unroll
            for (int j = 0; j < 8; ++j) o[j] = g[j] * (h ? v1[j] : v0[j]);
            if (br > 0) { const f32x4 a = *(const f32x4*)pp, b = *(const f32x4*)(pp + 4); o[0] += a.x; o[1] += a.y; o[2] += a.z; o[3] += a.w; o[4] += b.x; o[5] += b.y; o[6] += b.z; o[7] += b.w; }
            if (br < 2) { *(f32x4*)pp = (f32x4){o[0], o[1], o[2], o[3]}; *(f32x4*)(pp + 4) = (f32x4){o[4], o[5], o[6], o[7]}; }
            else store8(MB + (size_t)row * 1024 + cc, o);
        }
        return 0.f;
    }
};
struct EpiResid {
    const float* xin; float* xout; bf16_t* XB; float* ssq;
    static constexpr bool HAS_SSQ = true;
    __device__ __forceinline__ float operator()(const GUnit& u, int r, int c, const float (&v0)[8], const float (&v1)[8]) const {
        const int row = u.pm * 256 + r, col = u.pn * 256 + c; float ss = 0.f;
#pragma unroll
        for (int h = 0; h < 2; ++h) {
            const size_t off = (size_t)row * 1024 + col + h * 128; const f32x4 a = *(const f32x4*)(xin + off), b = *(const f32x4*)(xin + off + 4);
            float o[8] = {a.x, a.y, a.z, a.w, b.x, b.y, b.z, b.w};
#pragma unroll
            for (int j = 0; j < 8; ++j) { o[j] += (h ? v1[j] : v0[j]); ss += o[j] * o[j]; }
            *(f32x4*)(xout + off) = (f32x4){o[0], o[1], o[2], o[3]}; *(f32x4*)(xout + off + 4) = (f32x4){o[4], o[5], o[6], o[7]};
            store8(XB + off, o);
        }
        return ss;
    }
    __device__ __forceinline__ void put_ssq(const GUnit& u, int r, int slot, float s) const { ssq[(size_t)(u.pm * 256 + r) * 16 + u.pn * 4 + slot] = s; }
};
struct EpiSwiGLU {
    const float* ssq; const int* rowtok; bf16_t* HID; int ldh;
    static constexpr bool HAS_SSQ = false;
    __device__ __forceinline__ float operator()(const GUnit& u, int r, int c, const float (&v0)[8], const float (&v1)[8]) const {
        const int row = u.pm * 256 + r; const int tok = rowtok ? rowtok[row] : row; const float rstd = row_rstd16(ssq, tok);
        float o[8];
#pragma unroll
        for (int j = 0; j < 8; ++j) { const float g = v0[j] * rstd, up = v1[j] * rstd; o[j] = g * sigmoidf_(g) * up; }
        store8(HID + (size_t)row * ldh + u.pn * 128 + c, o); return 0.f;
    }
};
struct EpiMoeDown {
    const float* roww; bf16_t* OUTS;
    static constexpr bool HAS_SSQ = false;
    __device__ __forceinline__ float operator()(const GUnit& u, int r, int c, const float (&v0)[8], const float (&v1)[8]) const {
        const int row = u.pm * 256 + r; const float w = roww[row]; float o0[8], o1[8];
#pragma unroll
        for (int j = 0; j < 8; ++j) { o0[j] = v0[j] * w; o1[j] = v1[j] * w; }
        bf16_t* q = OUTS + (size_t)row * 1024 + u.pn * 256 + c; store8(q, o0); store8(q + 128, o1); return 0.f;
    }
};

template <class Sched, class Epi>
__device__ __forceinline__ void gemm_naive(const Sched& S, const Epi& E, int K, int lda) {
    const int tid = threadIdx.x, r = tid & 255, s = __builtin_amdgcn_readfirstlane(tid >> 8);
    GUnit u;
    for (int i = 0; S.next(i, u); ++i) {
        const bf16_t* arow = u.rows ? u.A + (size_t)u.rows[r] * lda : u.A + (size_t)r * lda;
        float ss = 0.f;
        for (int g = 0; g < 8; ++g) {
            const int c = s * 64 + g * 8;
            float a0[8], a1[8];
#pragma unroll
            for (int j = 0; j < 8; ++j) { a0[j] = 0.f; a1[j] = 0.f; }
#pragma unroll 1
            for (int k = 0; k < K; k += 8) {
                float af[8]; load8(arow + k, af);
#pragma unroll
                for (int j = 0; j < 8; ++j) {
                    float b0[8], b1[8]; load8(u.B + (size_t)(c + j) * K + k, b0); load8(u.B + (size_t)(128 + c + j) * K + k, b1);
#pragma unroll
                    for (int e = 0; e < 8; ++e) { a0[j] = fmaf(af[e], b0[e], a0[j]); a1[j] = fmaf(af[e], b1[e], a1[j]); }
                }
            }
            ss += E(u, r, c, a0, a1);
        }
        if constexpr (Epi::HAS_SSQ) { E.put_ssq(u, r, s, ss); E.put_ssq(u, r, 2 + s, 0.f); }
    }
}

__device__ __forceinline__ int rowmap(int code, int n) {
    switch (code) {
        case 1: return n < 1280 ? n : (n < 1312 ? n + 5120 : (n < 3360 ? n - 32 : (n < 3392 ? n + 3072 : n - 64)));
        case 2: { const int h = n >> 7, j = n & 127; return j < 64 ? h * 64 + j : 512 + h * 64 + (j - 64); }
        case 3: return (n >> 7) * 256 + (n & 127);
        case 4: return (n >> 7) * 256 + 128 + (n & 127);
        default: return n;
    }
}
struct TJob { const float* W; bf16_t* WT; const float* g; int K, N, code; };
__device__ __forceinline__ void transpose_item(const TJob& jb, LAS float* scr, int item, int lane) {
    const int K = jb.K, N = jb.N, nblk = N / 32, kb = item / nblk, nb = item % nblk, k0 = 64 * kb, n0 = 32 * nb;
#pragma unroll 8
    for (int i = 0; i < 32; ++i) { const int kk = 2 * i + (lane >> 5); float w = jb.W[(size_t)(k0 + kk) * N + n0 + (lane & 31)]; if (jb.g) w *= jb.g[k0 + kk]; scr[kk * 33 + (lane & 31)] = w; }
    asm volatile("s_waitcnt lgkmcnt(0)" ::: "memory");
    const int c = lane & 7;
#pragma unroll
    for (int j = 0; j < 4; ++j) { const int n = (lane >> 3) + 8 * j; const LAS float* s = scr + (8 * c) * 33 + n;
        u32x4 o; o.x = pk2(s[0 * 33], s[1 * 33]); o.y = pk2(s[2 * 33], s[3 * 33]); o.z = pk2(s[4 * 33], s[5 * 33]); o.w = pk2(s[6 * 33], s[7 * 33]);
        *(u32x4*)(jb.WT + (size_t)rowmap(jb.code, n0 + n) * K + k0 + 8 * c) = o; }
    asm volatile("s_waitcnt lgkmcnt(0)" ::: "memory");
}
__device__ __forceinline__ bool common_job(const Args& a, int j, TJob& jb) {
    unsigned char* ws = a.ws;
    if (j < 14) { const int l = j / 7, k = j % 7;
        switch (k) {
            case 0: jb = TJob{a.in[I_WIN] + (size_t)l * 1024 * 6464, (bf16_t*)(ws + O_WIN + l * SZ_WIN1), a.in[I_GMIX] + l * 1024, 1024, 6464, 1}; break;
            case 1: jb = TJob{a.in[I_WBQUP] + (size_t)l * 256 * 768, (bf16_t*)(ws + O_WQUP + l * SZ_WQUP1), a.in[I_GBQ] + l * 256, 256, 768, 0}; break;
            case 2: jb = TJob{a.in[I_WBKVUP] + (size_t)l * 256 * 1024, (bf16_t*)(ws + O_WKVUP + l * SZ_WKVUP1), a.in[I_GBKV] + l * 256, 256, 1024, 2}; break;
            case 3: jb = TJob{a.in[I_WPA] + (size_t)l * 512 * 1024, (bf16_t*)(ws + O_WP + (l * 3 + 0) * SZ_WP1), nullptr, 512, 1024, 0}; break;
            case 4: jb = TJob{a.in[I_WPB] + (size_t)l * 512 * 1024, (bf16_t*)(ws + O_WP + (l * 3 + 1) * SZ_WP1), nullptr, 512, 1024, 0}; break;
            case 5: jb = TJob{a.in[I_WPC] + (size_t)l * 512 * 1024, (bf16_t*)(ws + O_WP + (l * 3 + 2) * SZ_WP1), nullptr, 512, 1024, 0}; break;
            default: jb = TJob{a.in[I_WOUT] + (size_t)l * 1024 * 1024, (bf16_t*)(ws + O_WOUT + l * SZ_WOUT1), nullptr, 1024, 1024, 0}; break;
        }
        return true; }
    if (j == 14) { jb = TJob{a.in[I_WFFG], (bf16_t*)(ws + O_WFFGU), a.in[I_GFFN], 1024, DFF, 3}; return true; }
    if (j == 15) { jb = TJob{a.in[I_WFFU], (bf16_t*)(ws + O_WFFGU), a.in[I_GFFN], 1024, DFF, 4}; return true; }
    if (j == 16) { jb = TJob{a.in[I_WFFD], (bf16_t*)(ws + O_WFFD), nullptr, DFF, 1024, 0}; return true; }
    return false;
}
__device__ __forceinline__ bool expert_job(const Args& a, int j, TJob& jb) {
    if (j >= 24) return false;
    unsigned char* ws = a.ws; const int e = j / 3, k = j % 3;
    if (k == 0) jb = TJob{a.in[I_WEG] + (size_t)e * 1024 * DFE, (bf16_t*)(ws + O_WEGU) + (size_t)e * 2 * DFE * 1024, a.in[I_GFFN] + 1024, 1024, DFE, 3};
    else if (k == 1) jb = TJob{a.in[I_WEU] + (size_t)e * 1024 * DFE, (bf16_t*)(ws + O_WEGU) + (size_t)e * 2 * DFE * 1024, a.in[I_GFFN] + 1024, 1024, DFE, 4};
    else jb = TJob{a.in[I_WED] + (size_t)e * DFE * 1024, (bf16_t*)(ws + O_WED) + (size_t)e * 1024 * DFE, nullptr, DFE, 1024, 0};
    return true;
}
template <bool EXPERTS>
__device__ __forceinline__ void run_transposes(const Args& a, LAS unsigned char* lds, int gw, int NGW, int wave, int lane) {
    LAS float* scr = (LAS float*)(lds + wave * 16384);
    TJob jb;
    for (int j = 0; EXPERTS ? expert_job(a, j, jb) : common_job(a, j, jb); ++j) {
        const int nitems = (jb.K / 64) * (jb.N / 32);
        for (int it = gw; it < nitems; it += NGW) transpose_item(jb, scr, it, lane);
    }
}
__device__ __forceinline__ void phase_prologue(const Args& a, LAS unsigned char* lds, int vcu, int G, int tid) {
    const int wave = __builtin_amdgcn_readfirstlane(tid >> 6), lane = tid & 63, gw = vcu * NWAVES + wave, NGW = G * NWAVES;
    unsigned char* ws = a.ws;
    run_transposes<false>(a, lds, gw, NGW, wave, lane);
    for (int l = 0; l < 2; ++l) { u32x4* p = (u32x4*)(ws + O_WIN + l * SZ_WIN1 + (size_t)6464 * 1024 * 2); const int n16 = 192 * 1024 * 2 / 16;
        for (int i = gw * 64 + lane; i < n16; i += NGW * 64) p[i] = (u32x4){0u, 0u, 0u, 0u}; }
    float* ta = (float*)(ws + O_TABA); float* tb = (float*)(ws + O_TABB);
    for (int i = gw * 64 + lane; i < T * 32; i += NGW * 64) { const int t = i >> 5, k = i & 31, blk = k >> 4, fi = k & 15;
        const float inv = exp2f(-(float)fi * (13.287712379549449f / 16.0f)); const float pos = (float)(blk ? (t & 63) : (t >> 6)); const float ang = pos * inv;
        ta[t * 64 + k] = cosf(ang); ta[t * 64 + 32 + k] = sinf(ang); }
    for (int i = gw * 64 + lane; i < T * 16; i += NGW * 64) { const int t = i >> 4, k = i & 15, blk = k >> 3, fi = k & 7;
        const float inv = exp2f(-(float)fi * (13.287712379549449f / 8.0f)); const float pos = (float)(blk ? (t & 63) : (t >> 6)); const float ang = pos * inv;
        tb[t * 32 + k] = cosf(ang); tb[t * 32 + 16 + k] = sinf(ang); }
    const float* x = a.in[I_X]; bf16_t* XB = (bf16_t*)(ws + O_XB); float* ssq = (float*)(ws + O_SSQ);
    for (int m = gw; m < M; m += NGW) {
        const f32x4* xr = (const f32x4*)(x + (size_t)m * D) + lane; float s = 0.f;
#pragma unroll
        for (int j = 0; j < 4; ++j) { const f32x4 v = xr[64 * j]; s += (v.x * v.x + v.y * v.y) + (v.z * v.z + v.w * v.w);
            *(u32x2*)(XB + (size_t)m * D + (lane + 64 * j) * 4) = (u32x2){pk2(v.x, v.y), pk2(v.z, v.w)}; }
        s = wave_sum(s);
        if (lane < 16) ssq[(size_t)m * 16 + lane] = lane == 0 ? s : 0.f;
    }
}

template <bool WRITE_LA>
__device__ __forceinline__ void post_item(const Args& a, int layer, int it, LAS unsigned char* lds, int tid) {
    unsigned char* ws = a.ws; const int wave = __builtin_amdgcn_readfirstlane(tid >> 6), lane = tid & 63;
    const bf16_t* P = (const bf16_t*)(ws + O_P); const float* ta = (const float*)(ws + O_TABA); const float* tb = (const float*)(ws + O_TABB);
    bf16_t* QA = (bf16_t*)(ws + O_QA); bf16_t* KA = (bf16_t*)(ws + O_KA); bf16_t* KR = (bf16_t*)(ws + O_KROPE);
    const int r0 = it * 64;
    LAS float* caf = (LAS float*)lds;
    __syncthreads();
    for (int i = tid; i < 64 * 32; i += NTHR) { const int r = i >> 5, j = i & 31; caf[i] = bf2f(P[(size_t)(r0 + r) * PW + PC_SMALL + 32 + j]); }
    const float* gaq = a.in[I_GAQ] + layer * 64; const float* gak = a.in[I_GAK] + layer * 64;
    for (int j = 0; j < 8; ++j) {
        const int row = r0 + wave * 8 + j, t = row & (T - 1);
        {
            const int seg = lane & 7; float x[8]; load8(P + (size_t)row * PW + PC_AQ + lane * 8, x);
            float ss = 0.f;
#pragma unroll
            for (int e = 0; e < 8; ++e) ss += x[e] * x[e];
            ss += __shfl_xor(ss, 1); ss += __shfl_xor(ss, 2); ss += __shfl_xor(ss, 4);
            const float rstd = rsqrtf(ss * (1.0f / 64.0f) + EPS); const int tb_ = t * 64 + (seg >> 2) * 16 + (seg & 1) * 8; float o[8];
#pragma unroll
            for (int e = 0; e < 8; ++e) { const float xn = x[e] * rstd * gaq[seg * 8 + e]; const float pr = __shfl_xor(xn, 2); const float cs = ta[tb_ + e], sn = ta[tb_ + 32 + e];
                o[e] = ((seg & 2) ? xn * cs + pr * sn : xn * cs - pr * sn) * C2A; }
            store8(QA + (size_t)row * 512 + lane * 8, o);
        }
        {
            const int l2 = lane & 15, seg = l2 & 7; float x[8]; load8(P + (size_t)row * PW + PC_AK + l2 * 8, x);
            float ss = 0.f;
#pragma unroll
            for (int e = 0; e < 8; ++e) ss += x[e] * x[e];
            ss += __shfl_xor(ss, 1); ss += __shfl_xor(ss, 2); ss += __shfl_xor(ss, 4);
            const float rstd = rsqrtf(ss * (1.0f / 64.0f) + EPS); const int tb_ = t * 64 + (seg >> 2) * 16 + (seg & 1) * 8; float o[8];
#pragma unroll
            for (int e = 0; e < 8; ++e) { const float xn = x[e] * rstd * gak[seg * 8 + e]; const float pr = __shfl_xor(xn, 2); const float cs = ta[tb_ + e], sn = ta[tb_ + 32 + e];
                o[e] = (seg & 2) ? xn * cs + pr * sn : xn * cs - pr * sn; }
            if (lane < 16) store8(KA + (size_t)row * 128 + l2 * 8, o);
        }
        {
            const int seg = lane & 3; float x[8]; load8(P + (size_t)row * PW + PC_SMALL + seg * 8, x);
            const int tb_ = t * 32 + (seg >> 1) * 8; float o[8];
#pragma unroll
            for (int e = 0; e < 8; ++e) { const float pr = __shfl_xor(x[e], 1); const float cs = tb[tb_ + e], sn = tb[tb_ + 16 + e];
                o[e] = (seg & 1) ? x[e] * cs + pr * sn : x[e] * cs - pr * sn; }
            if (lane < 4) store8(KR + (size_t)row * 32 + seg * 8, o);
        }
    }
    __syncthreads();
    const int col = tid;
    for (int dir = 0; dir < 2; ++dir) {
        const float* Wup = a.in[dir ? I_WCAB : I_WCAF] + (size_t)layer * 16 * 512; const float bias = a.in[dir ? I_BCAB : I_BCAF][layer * 512 + col];
        float w[16];
#pragma unroll
        for (int j = 0; j < 16; ++j) w[j] = Wup[j * 512 + col];
        bf16_t* QT = (bf16_t*)(ws + O_QT) + (size_t)(dir * 2) * M * 512; bf16_t* KT = QT + (size_t)M * 512;
        float* LA = (float*)(ws + O_QT) + (size_t)dir * M * 512;
        float b = 0.f;
        for (int s = 0; s < 64; ++s) {
            const int r = dir ? 63 - s : s; const LAS float* cr = caf + r * 32 + dir * 16; float z = bias;
#pragma unroll
            for (int j = 0; j < 16; ++j) z = fmaf(cr[j], w[j], z);
            const float la = (fminf(z, 0.f) - __logf(1.0f + __expf(-fabsf(z)))) * (1.0f / 16.0f);
            b += la;
            const size_t row = (size_t)(r0 + r);
            if (WRITE_LA) LA[row * 512 + col] = la;
            else { const float e = __expf(b); const float q = bf2f(P[row * PW + PC_CQ + col]), k = bf2f(P[row * PW + PC_CK + col]);
                QT[row * 512 + col] = (bf16_t)f2bf(q * e * GLA_QSCALE); KT[row * 512 + col] = (bf16_t)f2bf(k / e); }
        }
        if (!WRITE_LA) ((float*)(ws + O_DEC))[(size_t)dir * 256 * 512 + (size_t)it * 512 + col] = __expf(b);
    }
}

template <int BR>
__device__ __forceinline__ void attn_naive_unit(const Args& a, int b, int h, int qb, LAS unsigned char* lds, int tid) {
    unsigned char* ws = a.ws; constexpr int DQ = BR ? 96 : 64;
    const bf16_t* P = (const bf16_t*)(ws + O_P);
    LAS float* Ks = (LAS float*)lds;
    LAS float* Vs = Ks + 64 * 96;
    LAS float* Qs = Vs + 64 * 64;
    const int r = tid >> 1, half = tid & 1; const size_t row0 = (size_t)b * T + qb * 256; const size_t row = row0 + r;
    __syncthreads();
    for (int i = tid; i < 256 * (DQ / 8); i += NTHR) { const int rr = i / (DQ / 8), ch = i % (DQ / 8); float f[8];
        if (BR == 0) load8((const bf16_t*)(ws + O_QA) + (row0 + rr) * 512 + h * 64 + ch * 8, f); else load8((const bf16_t*)(ws + O_QB) + (row0 + rr) * 768 + h * 96 + ch * 8, f);
#pragma unroll
        for (int e = 0; e < 8; ++e) Qs[rr * 97 + ch * 8 + e] = f[e]; }
    __syncthreads();
    if (BR == 1 && tid < 256) {
        const int t = (int)((row0 + tid) & (T - 1)); const float* tb = (const float*)(ws + O_TABB) + t * 32; LAS float* q = Qs + tid * 97 + 64;
        for (int blk = 0; blk < 2; ++blk)
            for (int e = 0; e < 8; ++e) { const float cs = tb[blk * 8 + e], sn = tb[16 + blk * 8 + e]; const float x1 = q[blk * 16 + e], x2 = q[blk * 16 + 8 + e];
                q[blk * 16 + e] = x1 * cs - x2 * sn; q[blk * 16 + 8 + e] = x2 * cs + x1 * sn; } }
    float m = -1e30f, l = 0.f, o[32];
#pragma unroll
    for (int j = 0; j < 32; ++j) o[j] = 0.f;
    for (int kt = 0; kt < T / 64; ++kt) {
        __syncthreads();
        for (int i = tid; i < 64 * (DQ / 8); i += NTHR) { const int kr = i / (DQ / 8), ch = i % (DQ / 8); const size_t krow = (size_t)b * T + kt * 64 + kr; float f[8];
            if (BR == 0) load8((const bf16_t*)(ws + O_KA) + krow * 128 + (h >> 2) * 64 + ch * 8, f);
            else if (ch < 8) load8((const bf16_t*)(ws + O_KNOPE) + krow * 512 + h * 64 + ch * 8, f);
            else load8((const bf16_t*)(ws + O_KROPE) + krow * 32 + (ch - 8) * 8, f);
#pragma unroll
            for (int e = 0; e < 8; ++e) Ks[kr * 96 + ch * 8 + e] = f[e]; }
        for (int i = tid; i < 64 * 8; i += NTHR) { const int kr = i >> 3, ch = i & 7; const size_t krow = (size_t)b * T + kt * 64 + kr; float f[8];
            if (BR == 0) load8(P + krow * PW + PC_AV + (h >> 2) * 64 + ch * 8, f); else load8((const bf16_t*)(ws + O_VB) + krow * 512 + h * 64 + ch * 8, f);
#pragma unroll
            for (int e = 0; e < 8; ++e) Vs[kr * 64 + ch * 8 + e] = f[e]; }
        __syncthreads();
#pragma unroll 1
        for (int kr = 0; kr < 64; ++kr) { float s = 0.f;
#pragma unroll 8
            for (int d = 0; d < DQ; ++d) s = fmaf(Qs[r * 97 + d], Ks[kr * 96 + d], s);
            if (s > m) { const float al = exp2f(m - s); l *= al;
#pragma unroll
                for (int j = 0; j < 32; ++j) o[j] *= al;
                m = s; }
            const float p = exp2f(s - m); l += p;
#pragma unroll
            for (int j = 0; j < 32; ++j) o[j] = fmaf(p, Vs[kr * 64 + half * 32 + j], o[j]); }
    }
    const float inv = 1.0f / l; bf16_t* Y = (bf16_t*)(ws + (BR ? O_YB : O_YA)) + row * 512 + h * 64 + half * 32;
#pragma unroll
    for (int j = 0; j < 32; j += 8) { float f[8];
#pragma unroll
        for (int e = 0; e < 8; ++e) f[e] = o[j + e] * inv;
        store8(Y + j, f); }
}

__device__ __forceinline__ void gla_naive_unit(const Args& a, int layer, int b, int h, LAS unsigned char* lds, int tid) {
    unsigned char* ws = a.ws; const bf16_t* P = (const bf16_t*)(ws + O_P); bf16_t* YC = (bf16_t*)(ws + O_YC);
    LAS float* qs = (LAS float*)lds; LAS float* ks = qs + 128; LAS float* as = ks + 128; LAS float* part = as + 128; LAS float* red = part + 512;
    const int j = tid & 127, qd = tid >> 7; const float gco = a.in[I_GCOUT][layer * 128 + j];
    for (int dir = 0; dir < 2; ++dir) {
        const float* LA = (const float*)(ws + O_QT) + (size_t)dir * M * 512;
        float S[32];
#pragma unroll
        for (int i = 0; i < 32; ++i) S[i] = 0.f;
        for (int step = 0; step < T; ++step) {
            const int tok = dir ? T - 1 - step : step; const size_t row = (size_t)b * T + tok;
            __syncthreads();
            if (tid < 128) { qs[tid] = bf2f(P[row * PW + PC_CQ + h * 128 + tid]) * GLA_QSCALE; ks[tid] = bf2f(P[row * PW + PC_CK + h * 128 + tid]); as[tid] = __expf(LA[row * 512 + h * 128 + tid]); }
            const float v = bf2f(P[row * PW + PC_CV + h * 128 + j]);
            __syncthreads();
            float o = 0.f;
#pragma unroll
            for (int i = 0; i < 32; ++i) { const int dk = qd * 32 + i; S[i] = as[dk] * S[i] + ks[dk] * v; o = fmaf(qs[dk], S[i], o); }
            part[qd * 128 + j] = o;
            __syncthreads();
            float v2 = 0.f;
            if (tid < 128) {
                const float tot = (part[tid] + part[128 + tid]) + (part[256 + tid] + part[384 + tid]);
                if (dir == 0) YC[row * 512 + h * 128 + tid] = (bf16_t)f2bf(tot);
                else { v2 = tot + bf2f(YC[row * 512 + h * 128 + tid]); const float ss = wave_sum(v2 * v2); if ((tid & 63) == 0) red[tid >> 6] = ss; }
            }
            if (dir == 1) {
                __syncthreads();
                if (tid < 128) {
                    const float rstd = rsqrtf((red[0] + red[1]) * (1.0f / 128.0f) + EPS);
                    const float g = bf2f(P[row * PW + PC_CG + h * 128 + tid]);
                    YC[row * 512 + h * 128 + tid] = (bf16_t)f2bf(v2 * rstd * gco * (g * sigmoidf_(g)));
                }
            }
        }
    }
}

__device__ __forceinline__ void router_item(const Args& a, int blk, LAS unsigned char* lds, int tid) {
    unsigned char* ws = a.ws; int* mi = (int*)(ws + O_MOEI); float* mf = (float*)(ws + O_MOEI);
    const int wave = __builtin_amdgcn_readfirstlane(tid >> 6), lane = tid & 63;
    LAS float* lg = (LAS float*)lds;
    const float* x1 = a.out; const float* g = a.in[I_GFFN] + 1024; const float* wr = a.in[I_WROUTER];
    __syncthreads();
    for (int j = 0; j < 8; ++j) {
        const int tok = blk * 64 + wave * 8 + j; float acc[8], ss = 0.f;
#pragma unroll
        for (int e = 0; e < 8; ++e) acc[e] = 0.f;
#pragma unroll
        for (int jj = 0; jj < 4; ++jj) { const int idx = (lane + 64 * jj) * 4; const f32x4 v = *(const f32x4*)(x1 + (size_t)tok * D + idx), gg = *(const f32x4*)(g + idx);
            ss += (v.x * v.x + v.y * v.y) + (v.z * v.z + v.w * v.w);
            const float hv[4] = {v.x * gg.x, v.y * gg.y, v.z * gg.z, v.w * gg.w};
#pragma unroll
            for (int c = 0; c < 4; ++c) { const f32x4 w0 = *(const f32x4*)(wr + (size_t)(idx + c) * 8), w1 = *(const f32x4*)(wr + (size_t)(idx + c) * 8 + 4);
                acc[0] = fmaf(hv[c], w0.x, acc[0]); acc[1] = fmaf(hv[c], w0.y, acc[1]); acc[2] = fmaf(hv[c], w0.z, acc[2]); acc[3] = fmaf(hv[c], w0.w, acc[3]);
                acc[4] = fmaf(hv[c], w1.x, acc[4]); acc[5] = fmaf(hv[c], w1.y, acc[5]); acc[6] = fmaf(hv[c], w1.z, acc[6]); acc[7] = fmaf(hv[c], w1.w, acc[7]); } }
        ss = wave_sum(ss); const float rstd = rsqrtf(ss * (1.0f / 1024.0f) + EPS);
#pragma unroll
        for (int e = 0; e < 8; ++e) { const float s = wave_sum(acc[e]); if (lane == 0) lg[(wave * 8 + j) * 8 + e] = s * rstd; }
    }
    __syncthreads();
    if (wave == 0) {
        const int tok = blk * 64 + lane; float v[8];
#pragma unroll
        for (int e = 0; e < 8; ++e) v[e] = lg[lane * 8 + e];
        int e1 = 0; float v1 = v[0];
#pragma unroll
        for (int e = 1; e < 8; ++e) if (v[e] > v1) { v1 = v[e]; e1 = e; }
        int e2 = -1; float v2 = -3.0e38f;
#pragma unroll
        for (int e = 0; e < 8; ++e) if (e != e1 && v[e] > v2) { v2 = v[e]; e2 = e; }
        const float w1 = 1.0f / (1.0f + __expf(v2 - v1)), w2 = 1.0f - w1;
        const unsigned long long lt = (1ull << lane) - 1ull; int ra = 0, rb = 0, mycnt = 0;
#pragma unroll
        for (int e = 0; e < 8; ++e) { const unsigned long long m0 = __ballot(e1 == e), m1 = __ballot(e2 == e); const int c0 = __popcll(m0);
            if (e1 == e) ra = __popcll(m0 & lt); if (e2 == e) rb = c0 + __popcll(m1 & lt); if (lane == e) mycnt = c0 + __popcll(m1); }
        mi[MI_TOKE + tok] = e1 | (e2 << 8); mi[MI_TOKR + tok] = ra | (rb << 16); mf[MI_TOKW + tok * 2] = w1; mf[MI_TOKW + tok * 2 + 1] = w2;
        if (lane < 8) mi[MI_CNT + blk * 8 + lane] = mycnt;
    }
}
__device__ __forceinline__ void positions_phase(const Args& a, LAS unsigned char* lds, int G, int bid, int tid) {
    unsigned char* ws = a.ws; int* mi = (int*)(ws + O_MOEI); float* mf = (float*)(ws + O_MOEI);
    LAS int* cnt = (LAS int*)lds; LAS int* base = cnt + 2048;
    __syncthreads();
    for (int i = tid; i < 2048; i += NTHR) cnt[i] = mi[MI_CNT + i];
    __syncthreads();
    if (tid < 8) { int run = 0; for (int b = 0; b < 256; ++b) { const int c = cnt[b * 8 + tid]; cnt[b * 8 + tid] = run; run += c; } base[8 + tid] = run; }
    __syncthreads();
    if (tid == 0) { int off = 0; for (int e = 0; e < 8; ++e) { base[e] = off; off += (base[8 + e] + 255) & ~255; } base[16] = off >> 8; }
    __syncthreads();
    if (bid == 0) {
        const int nt = base[16];
        for (int t = tid; t < nt; t += NTHR) { int e = 0;
#pragma unroll
            for (int k = 1; k < 8; ++k) if (t * 256 >= base[k]) e = k;
            mi[MI_TILEE + t] = e; }
        if (tid == 0) mi[MI_TILEE + MAXTILES] = nt;
        for (int e = 0; e < 8; ++e) { const int lo = base[e] + base[8 + e], hi = base[e] + ((base[8 + e] + 255) & ~255);
            for (int r = lo + tid; r < hi; r += NTHR) { mi[MI_ROWTOK + r] = 0; mf[MI_ROWW + r] = 0.f; } }
    }
    for (int blk = bid; blk < 256; blk += G) if (tid < 64) {
        const int tok = blk * 64 + tid; const int ee = mi[MI_TOKE + tok], rr = mi[MI_TOKR + tok]; const int e1 = ee & 255, e2 = ee >> 8;
        const int pa = base[e1] + cnt[blk * 8 + e1] + (rr & 0xffff), pb = base[e2] + cnt[blk * 8 + e2] + (rr >> 16);
        mi[MI_ROWTOK + pa] = tok; mf[MI_ROWW + pa] = mf[MI_TOKW + tok * 2]; mi[MI_ROWTOK + pb] = tok; mf[MI_ROWW + pb] = mf[MI_TOKW + tok * 2 + 1];
        mi[MI_TOKPOS + tok * 2] = pa; mi[MI_TOKPOS + tok * 2 + 1] = pb;
    }
}
__device__ __forceinline__ void final_phase(const Args& a, int gw, int NGW, int lane) {
    unsigned char* ws = a.ws; const int* mi = (const int*)(ws + O_MOEI); const bf16_t* OUTS = (const bf16_t*)(ws + O_OUTS); const float* gf = a.in[I_GFINAL];
    for (int m = gw; m < M; m += NGW) {
        const int pa = mi[MI_TOKPOS + m * 2], pb = mi[MI_TOKPOS + m * 2 + 1]; f32x4 v[4]; float s = 0.f;
#pragma unroll
        for (int j = 0; j < 4; ++j) { const int idx = (lane + 64 * j) * 4; v[j] = *(const f32x4*)(a.out + (size_t)m * D + idx);
            const u32x2 ua = *(const u32x2*)(OUTS + (size_t)pa * 1024 + idx), ub = *(const u32x2*)(OUTS + (size_t)pb * 1024 + idx);
            v[j].x += bf2f(ua.x & 0xffffu) + bf2f(ub.x & 0xffffu); v[j].y += bf2f(ua.x >> 16) + bf2f(ub.x >> 16); v[j].z += bf2f(ua.y & 0xffffu) + bf2f(ub.y & 0xffffu); v[j].w += bf2f(ua.y >> 16) + bf2f(ub.y >> 16);
            s += (v[j].x * v[j].x + v[j].y * v[j].y) + (v[j].z * v[j].z + v[j].w * v[j].w); }
        s = wave_sum(s); const float rstd = rsqrtf(s * (1.0f / 1024.0f) + EPS);
#pragma unroll
        for (int j = 0; j < 4; ++j) { const int idx = (lane + 64 * j) * 4; const f32x4 g = *(const f32x4*)(gf + idx);
            *(f32x4*)(a.out + (size_t)m * D + idx) = (f32x4){v[j].x * rstd * g.x, v[j].y * rstd * g.y, v[j].z * rstd * g.z, v[j].w * rstd * g.w}; }
    }
}

template <class Sched, class Epi>
__device__ __forceinline__ void gemm_run(LAS unsigned char* lds, const Sched& S, const Epi& E, int K, int lda) {
    gemm_naive(S, E, K, lda);
}

__device__ __forceinline__ int launder_v(int x) { asm volatile("" : "+v"(x)); return x; }
template <class Tp> __device__ __forceinline__ Tp* launder_s(Tp* p) { asm volatile("" : "+s"(p)); return p; }
constexpr int NPHASE = 18;
__global__ void __launch_bounds__(NTHR, 2) mega_fwd(Args args) {
    extern __shared__ __attribute__((aligned(16))) unsigned char lds_raw[];
    LAS unsigned char* lds = (LAS unsigned char*)lds_raw;
    const int G = gridDim.x, bid = blockIdx.x;
    { const int tid0 = threadIdx.x; for (int u = tid0; u < (LDS_BYTES - LDS_CTL) / 4; u += NTHR) ((LAS unsigned*)(lds + LDS_CTL))[u] = 0u; }
    __syncthreads();
    XcdBarrier bar; bar.bar = (unsigned*)args.ws + CW_BAR; bar.x = 0; bar.st = nullptr;
#if N_LAUNCH_MODE == 1
    bar = xcd_barrier_post((unsigned*)args.ws + CW_BAR, (volatile LAS unsigned*)(lds + LDS_MISC) + 8);
#endif
    const int lo = args.ph_lo, hi = args.ph_hi;
#define IN(k) (lo <= (k) && (k) < hi)
#if N_LAUNCH_MODE == 1
#define SEAM(k) do { if (IN(k) && IN((k) + 1)) xcd_barrier(bar); } while (0)
#else
#define SEAM(k) do { } while (0)
#endif
#define PH_BEGIN Args A = args; A.ws = launder_s(args.ws); unsigned char* ws = A.ws; const int tid = launder_v((int)threadIdx.x); \
    const int lane = tid & 63, wave = __builtin_amdgcn_readfirstlane(tid >> 6); const int vcu = (G % 8 == 0) ? (bid % 8) * (G / 8) + bid / 8 : bid; \
    const int gw = vcu * NWAVES + wave, NGW = G * NWAVES; (void)lane; (void)gw; (void)NGW; (void)ws;

    if (IN(0)) { PH_BEGIN; phase_prologue(A, lds, vcu, G, tid); SEAM(0); }

    for (int l = 0; l < 2; ++l) {
        const int pb = l ? 8 : 1;
        if (IN(pb)) {
            PH_BEGIN;
            SchedDense S{(const bf16_t*)(ws + O_XB), (const bf16_t*)(ws + O_WIN + l * SZ_WIN1), 1024, 1024, 64, NIN / 256, G, bid};
            EpiInProj E{(bf16_t*)(ws + O_P), (bf16_t*)(ws + O_GATES), (const float*)(ws + O_SSQ), A.in[I_BGATE] + l * 3072, (float*)(ws + O_RSP)};
            gemm_run(lds, S, E, 1024, 1024);
            SEAM(pb);
        }
        if (IN(pb + 1)) {
            PH_BEGIN;
            for (int it = bid; it < 256; it += G) post_item<(NAIVE_GLA != 0)>(A, l, it, lds, tid);
            __syncthreads();
            SchedUp S{(const bf16_t*)(ws + O_P), (const bf16_t*)(ws + O_WQUP + l * SZ_WQUP1), (const bf16_t*)(ws + O_WKVUP + l * SZ_WKVUP1), G, bid};
            EpiUpProj E{(const float*)(ws + O_RSP), (bf16_t*)(ws + O_QB), (bf16_t*)(ws + O_KNOPE), (bf16_t*)(ws + O_VB)};
            gemm_run(lds, S, E, 256, PW);
            SEAM(pb + 1);
        }
        if (IN(pb + 2)) {
            PH_BEGIN;
            unsigned* qh = (unsigned*)ws + CW_Q + 64 * l; LAS unsigned* slot = (LAS unsigned*)(lds + LDS_CTL + 64);
            for (;;) {
                __syncthreads();
                if (tid == 0) *slot = __hip_atomic_fetch_add(qh, 1u, __ATOMIC_RELAXED, __HIP_MEMORY_SCOPE_AGENT);
                __syncthreads();
                const int u = (int)*slot;
                if (u >= 64 + 1024) break;
                if (u < 64) gla_naive_unit(A, l, u >> 2, u & 3, lds, tid);
                else if (u < 64 + 512) { const int v = u - 64; attn_naive_unit<1>(A, v >> 6, (v >> 3) & 7, v & 7, lds, tid); }
                else { const int v = u - 576; attn_naive_unit<0>(A, v >> 6, (v >> 3) & 7, v & 7, lds, tid); }
            }
            SEAM(pb + 2);
        }
        if (IN(pb + 3)) {
            PH_BEGIN;
            SchedMerge S{(const bf16_t*)(ws + O_YA), (const bf16_t*)(ws + O_WP + l * 3 * SZ_WP1), G, bid};
            EpiMerge E{(const bf16_t*)(ws + O_GATES), (float*)(ws + O_PART), (bf16_t*)(ws + O_MB)};
            gemm_run(lds, S, E, 512, 512);
            SEAM(pb + 3);
        }
        if (IN(pb + 4)) {
            PH_BEGIN;
            SchedDense S{(const bf16_t*)(ws + O_MB), (const bf16_t*)(ws + O_WOUT + l * SZ_WOUT1), 1024, 1024, 64, 4, G, bid};
            EpiResid E{l ? A.out : A.in[I_X], A.out, (bf16_t*)(ws + O_XB), (float*)(ws + O_SSQ)};
            gemm_run(lds, S, E, 1024, 1024);
            SEAM(pb + 4);
        }
        if (l == 0) {
            if (IN(6)) {
                PH_BEGIN;
                SchedDense S{(const bf16_t*)(ws + O_XB), (const bf16_t*)(ws + O_WFFGU), 1024, 1024, 64, 2 * DFF / 256, G, bid};
                EpiSwiGLU E{(const float*)(ws + O_SSQ), nullptr, (bf16_t*)(ws + O_HID), DFF};
                gemm_run(lds, S, E, 1024, 1024);
                SEAM(6);
            }
            if (IN(7)) {
                PH_BEGIN;
                SchedDense S{(const bf16_t*)(ws + O_HID), (const bf16_t*)(ws + O_WFFD), DFF, DFF, 64, 4, G, bid};
                EpiResid E{A.out, A.out, (bf16_t*)(ws + O_XB), (float*)(ws + O_SSQ)};
                gemm_run(lds, S, E, DFF, DFF);
                SEAM(7);
            }
        }
    }
    if (IN(13)) {
        PH_BEGIN;
        for (int blk = bid; blk < 256; blk += G) router_item(A, blk, lds, tid);
        __syncthreads();
        run_transposes<true>(A, lds, gw, NGW, wave, lane);
        SEAM(13);
    }
    if (IN(14)) { PH_BEGIN; positions_phase(A, lds, G, bid, tid); SEAM(14); }
    if (IN(15)) {
        PH_BEGIN; int* mi = (int*)(ws + O_MOEI);
        SchedMoe S{(const bf16_t*)(ws + O_XB), (const bf16_t*)(ws + O_WEGU), mi + MI_TILEE, mi + MI_ROWTOK, 1024, 1024, 2 * DFE / 256, G, bid, (size_t)2 * DFE * 1024, true};
        EpiSwiGLU E{(const float*)(ws + O_SSQ), mi + MI_ROWTOK, (bf16_t*)(ws + O_HIDS), DFE};
        gemm_run(lds, S, E, 1024, 1024);
        SEAM(15);
    }
    if (IN(16)) {
        PH_BEGIN; int* mi = (int*)(ws + O_MOEI);
        SchedMoe S{(const bf16_t*)(ws + O_HIDS), (const bf16_t*)(ws + O_WED), mi + MI_TILEE, mi + MI_ROWTOK, DFE, DFE, 4, G, bid, (size_t)1024 * DFE, false};
        EpiMoeDown E{(const float*)(ws + O_MOEI) + MI_ROWW, (bf16_t*)(ws + O_OUTS)};
        gemm_run(lds, S, E, DFE, DFE);
        SEAM(16);
    }
    if (IN(17)) { PH_BEGIN; final_phase(A, gw, NGW, lane); }
#undef IN
#undef SEAM
#undef PH_BEGIN
}

extern "C" void kernel_launch(void* const* d_in, const int* in_sizes, int n_in, void* d_out, int out_size, void* d_ws, size_t ws_size, hipStream_t stream) {
    static int grid = 0;
    if (grid == 0) {
        if (n_in != 28 || out_size != M * D || ws_size < WS_NEED) { fprintf(stderr, "kernel_launch: unexpected shapes (n_in %d out %d ws %zu need %zu)\n", n_in, out_size, ws_size, (size_t)WS_NEED); grid = -1; return; }
        int dev = 0, cus = 0;
        if (hipGetDevice(&dev) != hipSuccess || hipDeviceGetAttribute(&cus, hipDeviceAttributeMultiprocessorCount, dev) != hipSuccess) { grid = -1; return; }
        if (hipFuncSetAttribute((const void*)mega_fwd, hipFuncAttributeMaxDynamicSharedMemorySize, LDS_BYTES) != hipSuccess) { grid = -1; return; }
        int per_cu = 0;
        if (hipOccupancyMaxActiveBlocksPerMultiprocessor(&per_cu, (const void*)mega_fwd, NTHR, LDS_BYTES) != hipSuccess || per_cu < 1) { fprintf(stderr, "kernel_launch: occupancy query says %d\n", per_cu); }
        (void)hipGetLastError();
        grid = cus;
    }
    if (grid < 0) return;
    (void)hipMemsetAsync(d_ws, 0, CTL_BYTES, stream);
    Args a{};
    for (int i = 0; i < 28; ++i) a.in[i] = (const float*)d_in[i];
    a.out = (float*)d_out; a.ws = (unsigned char*)d_ws; a.li = 0; a.pad = 0;
#if N_LAUNCH_MODE == 1
    a.ph_lo = 0; a.ph_hi = NPHASE;
    hipLaunchKernelGGL(mega_fwd, dim3(grid), dim3(NTHR), LDS_BYTES, stream, a);
#else
    for (int p = 0; p < NPHASE; ++p) { a.ph_lo = p; a.ph_hi = p + 1; hipLaunchKernelGGL(mega_fwd, dim3(grid), dim3(NTHR), LDS_BYTES, stream, a); }
#endif
}
```

```cpp
#include <hip/hip_runtime.h>
#include <cstdio>
#include <cstdint>

#ifndef N_LAUNCH_MODE
#define N_LAUNCH_MODE 1
#endif
#ifndef NAIVE_GEMM
#define NAIVE_GEMM 0
#endif
#ifndef NAIVE_ATTN
#define NAIVE_ATTN 1
#endif
#ifndef NAIVE_GLA
#define NAIVE_GLA 1
#endif

#define LAS __attribute__((address_space(3)))
#define GAS __attribute__((address_space(1)))
typedef unsigned short bf16_t;
typedef short bf16x8 __attribute__((ext_vector_type(8)));
typedef float f32x4 __attribute__((ext_vector_type(4)));
typedef unsigned u32x4 __attribute__((ext_vector_type(4)));
typedef unsigned u32x2 __attribute__((ext_vector_type(2)));

constexpr int M = 16384, D = 1024, T = 2048, NBATCH = 8, NWAVES = 8, NTHR = 512;
constexpr float EPS = 1e-6f;
constexpr int PW = 3456;
constexpr int PC_AQ = 0, PC_AK = 512, PC_AV = 640, PC_BCQ = 768, PC_BCKV = 1024, PC_CQ = 1280, PC_CK = 1792, PC_CV = 2304, PC_CG = 2816, PC_SMALL = 3328;
constexpr int NIN = 6656;
constexpr int DFF = 2816, DFE = 3584, NEXP = 8;
constexpr int MAXTILES = 136, MAXROWS = MAXTILES * 256;
constexpr float LOG2E = 1.4426950408889634f;
constexpr float C2A = 0.125f * LOG2E;
constexpr float C2B = 0.10206207261596575f * LOG2E;
constexpr float GLA_QSCALE = 0.08838834764831845f;

constexpr size_t CTL_BYTES = 1u << 20;
constexpr size_t SZ_WIN1 = (size_t)NIN * 1024 * 2, SZ_WQUP1 = 768 * 256 * 2, SZ_WKVUP1 = 1024 * 256 * 2, SZ_WP1 = 1024 * 512 * 2, SZ_WOUT1 = 1024 * 1024 * 2;
constexpr size_t O_WIN = CTL_BYTES;
constexpr size_t O_WQUP = O_WIN + 2 * SZ_WIN1;
constexpr size_t O_WKVUP = O_WQUP + 2 * SZ_WQUP1;
constexpr size_t O_WP = O_WKVUP + 2 * SZ_WKVUP1;
constexpr size_t O_WOUT = O_WP + 6 * SZ_WP1;
constexpr size_t O_WFFGU = O_WOUT + 2 * SZ_WOUT1;
constexpr size_t O_WFFD = O_WFFGU + (size_t)2 * DFF * 1024 * 2;
constexpr size_t O_TABA = O_WFFD + (size_t)1024 * DFF * 2;
constexpr size_t O_TABB = O_TABA + (size_t)T * 64 * 4;
constexpr size_t O_XB = O_TABB + (size_t)T * 32 * 4;
constexpr size_t O_SSQ = O_XB + (size_t)M * 1024 * 2;
constexpr size_t O_RSP = O_SSQ + (size_t)M * 16 * 4;
constexpr size_t O_PTAB = O_RSP + (size_t)M * 32 * 4;
constexpr size_t O_MOEI = O_PTAB + 256;
constexpr size_t SZ_MOEI = 2u << 20;
constexpr size_t O_R = O_MOEI + SZ_MOEI;
constexpr size_t O_P = O_R;
constexpr size_t O_GATES = O_P + (size_t)M * PW * 2;
constexpr size_t O_QA = O_GATES + (size_t)M * 3072 * 2;
constexpr size_t O_KA = O_QA + (size_t)M * 512 * 2;
constexpr size_t O_KROPE = O_KA + (size_t)M * 128 * 2;
constexpr size_t O_QB = O_KROPE + (size_t)M * 32 * 2;
constexpr size_t O_KNOPE = O_QB + (size_t)M * 768 * 2;
constexpr size_t O_VB = O_KNOPE + (size_t)M * 512 * 2;
constexpr size_t O_QT = O_VB + (size_t)M * 512 * 2;
constexpr size_t O_DEC = O_QT + (size_t)4 * M * 512 * 2;
constexpr size_t O_YA = O_DEC + (size_t)2 * 256 * 512 * 4;
constexpr size_t O_YB = O_YA + (size_t)M * 512 * 2;
constexpr size_t O_YC = O_YB + (size_t)M * 512 * 2;
constexpr size_t O_MIX_END = O_YC + (size_t)M * 512 * 2;
constexpr size_t O_PART = O_QT;
constexpr size_t O_MB = O_P;
constexpr size_t O_HID = O_P;
constexpr size_t O_WEGU = O_R;
constexpr size_t O_WED = O_WEGU + (size_t)NEXP * 2 * DFE * 1024 * 2;
constexpr size_t O_HIDS = O_WED + (size_t)NEXP * 1024 * DFE * 2;
constexpr size_t O_MOE_END = O_HIDS + (size_t)MAXROWS * DFE * 2;
constexpr size_t O_OUTS = O_WEGU;
constexpr size_t WS_NEED = O_MIX_END > O_MOE_END ? O_MIX_END : O_MOE_END;
static_assert(WS_NEED <= 531851264ull, "workspace map exceeds the guaranteed ws_size");
static_assert((size_t)M * 1024 * 4 <= (size_t)4 * M * 512 * 2, "PART overlay");
static_assert((size_t)MAXROWS * 1024 * 2 <= (size_t)NEXP * 2 * DFE * 1024 * 2, "OUTS overlay");
constexpr int MI_CNT = 0;
constexpr int MI_TOKE = 4096;
constexpr int MI_TOKR = MI_TOKE + M;
constexpr int MI_TOKW = MI_TOKR + M;
constexpr int MI_TOKPOS = MI_TOKW + 2 * M;
constexpr int MI_ROWTOK = MI_TOKPOS + 2 * M;
constexpr int MI_ROWW = MI_ROWTOK + MAXROWS;
constexpr int MI_TILEE = MI_ROWW + MAXROWS;
constexpr int MI_END = MI_TILEE + MAXTILES + 8;
static_assert((size_t)MI_END * 4 <= SZ_MOEI, "moe lists");

constexpr int CW_TMO = 0;
constexpr int CW_Q = 1024;
constexpr int CW_BAR = 4096;

constexpr int LDS_RING = 131072, LDS_CTL = 145408, LDS_MISC = LDS_CTL + 320, LDS_BYTES = 147456;

__device__ __forceinline__ float bf2f(unsigned v) { return __uint_as_float(v << 16); }
__device__ __forceinline__ unsigned f2bf(float f) { unsigned u = __float_as_uint(f); return (u + 0x7fffu + ((u >> 16) & 1u)) >> 16; }
__device__ __forceinline__ unsigned pk2(float lo, float hi) { return f2bf(lo) | (f2bf(hi) << 16); }
__device__ __forceinline__ void unpack8(const u32x4 w, float (&f)[8]) {
    f[0] = __uint_as_float(w.x << 16); f[1] = __uint_as_float(w.x & 0xffff0000u); f[2] = __uint_as_float(w.y << 16); f[3] = __uint_as_float(w.y & 0xffff0000u);
    f[4] = __uint_as_float(w.z << 16); f[5] = __uint_as_float(w.z & 0xffff0000u); f[6] = __uint_as_float(w.w << 16); f[7] = __uint_as_float(w.w & 0xffff0000u);
}
__device__ __forceinline__ u32x4 pack8(const float (&f)[8]) { u32x4 w; w.x = pk2(f[0], f[1]); w.y = pk2(f[2], f[3]); w.z = pk2(f[4], f[5]); w.w = pk2(f[6], f[7]); return w; }
__device__ __forceinline__ void load8(const bf16_t* p, float (&f)[8]) { unpack8(*(const u32x4*)p, f); }
__device__ __forceinline__ void store8(bf16_t* p, const float (&f)[8]) { *(u32x4*)p = pack8(f); }
__device__ __forceinline__ float wave_sum(float v) {
#pragma unroll
    for (int o = 1; o < 64; o <<= 1) v += __shfl_xor(v, o);
    return v;
}
__device__ __forceinline__ float row_rstd16(const float* ssq, int row) {
    const f32x4* p = (const f32x4*)(ssq + (size_t)row * 16);
    const f32x4 a = p[0], b = p[1], c = p[2], d = p[3];
    const float s = ((a.x + a.y) + (a.z + a.w)) + ((b.x + b.y) + (b.z + b.w)) + ((c.x + c.y) + (c.z + c.w)) + ((d.x + d.y) + (d.z + d.w));
    return rsqrtf(s * (1.0f / 1024.0f) + EPS);
}
__device__ __forceinline__ float sigmoidf_(float x) { return 1.0f / (1.0f + __expf(-x)); }

#define XB_TMO      128
#define XB_XCNT(j)  (256  + 64 * (j))
#define XB_XSUB(j)  (1280 + 64 * (j))
#define XB_XGEN(j)  (2304 + 64 * (j))
#define XB_TOP      3328
#define XB_TOPGEN   3392
#define XCD_BAR_WORDS 3456
#define XB_SPIN_CAP (1u << 18)
__device__ __forceinline__ unsigned xb_ld(unsigned* p)              { return __hip_atomic_load(p, __ATOMIC_RELAXED, __HIP_MEMORY_SCOPE_AGENT); }
__device__ __forceinline__ unsigned xb_add(unsigned* p, unsigned v) { return __hip_atomic_fetch_add(p, v, __ATOMIC_RELAXED, __HIP_MEMORY_SCOPE_AGENT); }
__device__ __forceinline__ unsigned xb_xcc_id() { return (unsigned)__builtin_amdgcn_s_getreg((3 << 11) | 20) & 0xFu; }
#define XB_SPIN(cond, bar) do { unsigned _sp = 0; while (cond) { __builtin_amdgcn_s_sleep(1); \
    if ((++_sp & 255u) == 0u) { if (xb_ld(&(bar)[XB_TMO])) break; if (_sp > XB_SPIN_CAP) { atomicAdd(&(bar)[XB_TMO], 1u); break; } } } } while (0)
struct XcdBarrier { unsigned* bar; unsigned x; volatile LAS unsigned* st; };
__device__ __forceinline__ XcdBarrier xcd_barrier_post(unsigned* bar, volatile LAS unsigned* st) {
    XcdBarrier b; b.bar = bar; b.x = xb_xcc_id(); b.st = st;
    if (threadIdx.x == 0) (void)xb_add(&bar[XB_XCNT(b.x)], 1u);
    return b;
}
__device__ __forceinline__ void xcd_barrier_complete(unsigned* bar, unsigned x, unsigned& nloc, unsigned& nx) {
    const unsigned G = gridDim.x * gridDim.y * gridDim.z;
    unsigned sum, cnt, mine, sp = 0u;
    for (;;) {
        sum = 0u; cnt = 0u; mine = 0u;
#pragma unroll
        for (unsigned j = 0; j < 16; ++j) { const unsigned c = xb_ld(&bar[XB_XCNT(j)]); sum += c; cnt += (c > 0u) ? 1u : 0u; mine = (j == x) ? c : mine; }
        if (sum == G) break;
        __builtin_amdgcn_s_sleep(1);
        if ((++sp & 255u) == 0u) { if (xb_ld(&bar[XB_TMO])) break; if (sp > XB_SPIN_CAP) { atomicAdd(&bar[XB_TMO], 1u); break; } }
    }
    nloc = mine > 0u ? mine : 1u; nx = cnt > 0u ? cnt : 1u;
}
__device__ __forceinline__ void xcd_barrier(const XcdBarrier& b) {
    asm volatile("s_waitcnt vmcnt(0)" ::: "memory");
    __syncthreads();
    if (threadIdx.x == 0) {
        unsigned* bar = b.bar;
        __builtin_amdgcn_s_waitcnt(0);
        unsigned nloc = b.st[0], nx = b.st[1];
        if (nloc == 0u) { xcd_barrier_complete(bar, b.x, nloc, nx); b.st[0] = nloc; b.st[1] = nx; }
        const unsigned old = xb_add(&bar[XB_XSUB(b.x)], 1u);
        const unsigned gen = old / nloc;
        if (old + 1u == (gen + 1u) * nloc) {
            __builtin_amdgcn_fence(__ATOMIC_RELEASE, "agent");
            asm volatile("s_waitcnt vmcnt(0)" ::: "memory");
            const unsigned og = xb_add(&bar[XB_TOP], 1u);
            const unsigned tg = og / nx;
            if (og + 1u == (tg + 1u) * nx) xb_add(&bar[XB_TOPGEN], 1u);
            else XB_SPIN(xb_ld(&bar[XB_TOPGEN]) == tg, bar);
            __builtin_amdgcn_fence(__ATOMIC_ACQUIRE, "agent");
            xb_add(&bar[XB_XGEN(b.x)], 1u);
            asm volatile("s_waitcnt vmcnt(0)" ::: "memory");
        } else {
            XB_SPIN(xb_ld(&bar[XB_XGEN(b.x)]) == gen, bar);
            __builtin_amdgcn_fence(__ATOMIC_ACQUIRE, "agent");
            asm volatile("s_waitcnt vmcnt(0)" ::: "memory");
        }
    }
    __syncthreads();
}

struct Args { const float* in[28]; float* out; unsigned char* ws; int ph_lo, ph_hi, li, pad; };
struct Ctx { const float* const* in; float* out; unsigned char* ws; };
enum { I_X = 0, I_WIN, I_BGATE, I_GMIX, I_GAQ, I_GAK, I_GBQ, I_WBQUP, I_GBKV, I_WBKVUP, I_WCAF, I_BCAF, I_WCAB, I_BCAB, I_GCOUT, I_WPA, I_WPB, I_WPC, I_WOUT, I_GFFN,
       I_WFFG, I_WFFU, I_WFFD, I_WROUTER, I_WEG, I_WEU, I_WED, I_GFINAL };

struct GUnit { const bf16_t* A; const bf16_t* B; const int* rows; int pm, pn, aux; };
__device__ __forceinline__ void tile_order(int L, int nM, int nN, int& pm, int& pn) {
    const int nwg = nM * nN; int wgid = L;
    { const int q = nwg / 8, r = nwg % 8, xcd = wgid % 8, off = wgid / 8; wgid = (xcd < r ? xcd * (q + 1) : r * (q + 1) + (xcd - r) * q) + off; }
    const int nig = 8 * nN, gid = wgid / nig, fm = gid * 8, gsz = (nM - fm) < 8 ? (nM - fm) : 8;
    pm = fm + ((wgid % nig) % gsz); pn = (wgid % nig) / gsz;
}
struct SchedDense {
    const bf16_t* A; const bf16_t* B; int lda, K, nM, nN, G, c;
    __device__ __forceinline__ bool next(int i, GUnit& u) const {
        const long L = (long)i * G + c; if (L >= (long)nM * nN) return false;
        tile_order((int)L, nM, nN, u.pm, u.pn);
        u.A = A + (size_t)u.pm * 256 * lda; u.B = B + (size_t)u.pn * 256 * K; u.rows = nullptr; u.aux = 0; return true;
    }
};
struct SchedUp {
    const bf16_t* P; const bf16_t* Wq; const bf16_t* Wkv; int G, c;
    __device__ __forceinline__ bool next(int i, GUnit& u) const {
        const int L = i * G + c; if (L >= 448) return false;
        if (L < 192) { tile_order(L, 64, 3, u.pm, u.pn); u.aux = 0; u.A = P + (size_t)u.pm * 256 * PW + PC_BCQ; u.B = Wq + (size_t)u.pn * 256 * 256; }
        else { tile_order(L - 192, 64, 4, u.pm, u.pn); u.aux = 1; u.A = P + (size_t)u.pm * 256 * PW + PC_BCKV; u.B = Wkv + (size_t)u.pn * 256 * 256; }
        u.rows = nullptr; return true;
    }
};
struct SchedMerge {
    const bf16_t* Y0; const bf16_t* W; int G, c;
    __device__ __forceinline__ bool next(int i, GUnit& u) const {
        const int tile = (i / 3) * G + c, br = i % 3; if (tile >= 256) return false;
        tile_order(tile, 64, 4, u.pm, u.pn); u.aux = br;
        u.A = Y0 + (size_t)br * M * 512 + (size_t)u.pm * 256 * 512; u.B = W + (size_t)br * 1024 * 512 + (size_t)u.pn * 256 * 512; u.rows = nullptr; return true;
    }
};
struct SchedMoe {
    const bf16_t* A; const bf16_t* B; const int* tile_e; const int* rowtok; int lda, K, nN, G, c; size_t bstride; bool gather;
    __device__ __forceinline__ bool next(int i, GUnit& u) const {
        const int nM = tile_e[MAXTILES]; const long L = (long)i * G + c; if (L >= (long)nM * nN) return false;
        tile_order((int)L, nM, nN, u.pm, u.pn); const int e = tile_e[u.pm]; u.aux = e;
        u.B = B + (size_t)e * bstride + (size_t)u.pn * 256 * K;
        if (gather) { u.A = A; u.rows = rowtok + u.pm * 256; } else { u.A = A + (size_t)u.pm * 256 * lda; u.rows = nullptr; }
        return true;
    }
};

struct EpiInProj {
    bf16_t* P; bf16_t* GATES; const float* ssq; const float* bgate; float* rsp;
    static constexpr bool HAS_SSQ = false;
    __device__ __forceinline__ void half(int H, int row, int c, const float (&v)[8], float rstd) const {
        float o[8];
        if (H < 26) {
#pragma unroll
            for (int j = 0; j < 8; ++j) o[j] = v[j] * rstd;
            store8(P + (size_t)row * PW + H * 128 + c, o);
        } else if (H < 50) {
            const int gc = (H - 26) * 128 + c; const f32x4 b0 = *(const f32x4*)(bgate + gc), b1 = *(const f32x4*)(bgate + gc + 4);
            o[0] = sigmoidf_(v[0] * rstd + b0.x); o[1] = sigmoidf_(v[1] * rstd + b0.y); o[2] = sigmoidf_(v[2] * rstd + b0.z); o[3] = sigmoidf_(v[3] * rstd + b0.w);
            o[4] = sigmoidf_(v[4] * rstd + b1.x); o[5] = sigmoidf_(v[5] * rstd + b1.y); o[6] = sigmoidf_(v[6] * rstd + b1.z); o[7] = sigmoidf_(v[7] * rstd + b1.w);
            store8(GATES + (size_t)row * 3072 + gc, o);
        } else if (H == 50 && c < 64) {
#pragma unroll
            for (int j = 0; j < 8; ++j) o[j] = v[j] * rstd;
            store8(P + (size_t)row * PW + PC_SMALL + c, o);
        }
    }
    __device__ __forceinline__ float operator()(const GUnit& u, int r, int c, const float (&v0)[8], const float (&v1)[8]) const {
        const int row = u.pm * 256 + r; const float rstd = row_rstd16(ssq, row);
        half(u.pn * 2, row, c, v0, rstd); half(u.pn * 2 + 1, row, c, v1, rstd);
        if (u.pn == 3 || u.pn == 4) { float s = 0.f;
#pragma unroll
            for (int j = 0; j < 8; ++j) s += (v0[j] * v0[j] + v1[j] * v1[j]);
            rsp[(size_t)row * 32 + (u.pn - 3) * 16 + (c >> 3)] = s * rstd * rstd; }
        return 0.f;
    }
};
struct EpiUpProj {
    const float* rsp; bf16_t* QB; bf16_t* KNOPE; bf16_t* VB;
    static constexpr bool HAS_SSQ = false;
    __device__ __forceinline__ float operator()(const GUnit& u, int r, int c, const float (&v0)[8], const float (&v1)[8]) const {
        const int row = u.pm * 256 + r; const f32x4* p = (const f32x4*)(rsp + (size_t)row * 32 + u.aux * 16);
        float s = 0.f;
#pragma unroll
        for (int j = 0; j < 4; ++j) { const f32x4 a = p[j]; s += (a.x + a.y) + (a.z + a.w); }
        float rstd = rsqrtf(s * (1.0f / 256.0f) + EPS);
        float o0[8], o1[8];
        if (u.aux == 0) {
            rstd *= C2B;
#pragma unroll
            for (int j = 0; j < 8; ++j) { o0[j] = v0[j] * rstd; o1[j] = v1[j] * rstd; }
            bf16_t* q = QB + (size_t)row * 768 + u.pn * 256 + c; store8(q, o0); store8(q + 128, o1);
        } else {
#pragma unroll
            for (int j = 0; j < 8; ++j) { o0[j] = v0[j] * rstd; o1[j] = v1[j] * rstd; }
            bf16_t* q = (u.pn < 2 ? KNOPE + (size_t)row * 512 + u.pn * 256 : VB + (size_t)row * 512 + (u.pn - 2) * 256) + c; store8(q, o0); store8(q + 128, o1);
        }
        return 0.f;
    }
};
struct EpiMerge {
    const bf16_t* GATES; float* PART; bf16_t* MB;
    static constexpr bool HAS_SSQ = false;
    __device__ __forceinline__ float operator()(const GUnit& u, int r, int c, const float (&v0)[8], const float (&v1)[8]) const {
        const int row = u.pm * 256 + r, col = u.pn * 256 + c, br = u.aux;
#pragma unroll
        for (int h = 0; h < 2; ++h) {
            const int cc = col + h * 128; float g[8], o[8]; load8(GATES + (size_t)row * 3072 + br * 1024 + cc, g);
            float* pp = PART + (size_t)row * 1024 + cc;
#pragma unroll
            for (int j = 0; j < 8; ++j) o[j] = g[j] * (h ? v1[j] : v0[j]);
            if (br > 0) { const f32x4 a = *(const f32x4*)pp, b = *(const f32x4*)(pp + 4); o[0] += a.x; o[1] += a.y; o[2] += a.z; o[3] += a.w; o[4] += b.x; o[5] += b.y; o[6] += b.z; o[7] += b.w; }
            if (br < 2) { *(f32x4*)pp = (f32x4){o[0], o[1], o[2], o[3]}; *(f32x4*)(pp + 4) = (f32x4){o[4], o[5], o[6], o[7]}; }
            else store8(MB + (size_t)row * 1024 + cc, o);
        }
        return 0.f;
    }
};
struct EpiResid {
    const float* xin; float* xout; bf16_t* XB; float* ssq;
    static constexpr bool HAS_SSQ = true;
    __device__ __forceinline__ float operator()(const GUnit& u, int r, int c, const float (&v0)[8], const float (&v1)[8]) const {
        const int row = u.pm * 256 + r, col = u.pn * 256 + c; float ss = 0.f;
#pragma unroll
        for (int h = 0; h < 2; ++h) {
            const size_t off = (size_t)row * 1024 + col + h * 128; const f32x4 a = *(const f32x4*)(xin + off), b = *(const f32x4*)(xin + off + 4);
            float o[8] = {a.x, a.y, a.z, a.w, b.x, b.y, b.z, b.w};
#pragma unroll
            for (int j = 0; j < 8; ++j) { o[j] += (h ? v1[j] : v0[j]); ss += o[j] * o[j]; }
            *(f32x4*)(xout + off) = (f32x4){o[0], o[1], o[2], o[3]}; *(f32x4*)(xout + off + 4) = (f32x4){o[4], o[5], o[6], o[7]};
            store8(XB + off, o);
        }
        return ss;
    }
    __device__ __forceinline__ void put_ssq(const GUnit& u, int r, int slot, float s) const { ssq[(size_t)(u.pm * 256 + r) * 16 + u.pn * 4 + slot] = s; }
};
struct EpiSwiGLU {
    const float* ssq; const int* rowtok; bf16_t* HID; int ldh;
    static constexpr bool HAS_SSQ = false;
    __device__ __forceinline__ float operator()(const GUnit& u, int r, int c, const float (&v0)[8], const float (&v1)[8]) const {
        const int row = u.pm * 256 + r; const int tok = rowtok ? rowtok[row] : row; const float rstd = row_rstd16(ssq, tok);
        float o[8];
#pragma unroll
        for (int j = 0; j < 8; ++j) { const float g = v0[j] * rstd, up = v1[j] * rstd; o[j] = g * sigmoidf_(g) * up; }
        store8(HID + (size_t)row * ldh + u.pn * 128 + c, o); return 0.f;
    }
};
struct EpiMoeDown {
    const float* roww; bf16_t* OUTS;
    static constexpr bool HAS_SSQ = false;
    __device__ __forceinline__ float operator()(const GUnit& u, int r, int c, const float (&v0)[8], const float (&v1)[8]) const {
        const int row = u.pm * 256 + r; const float w = roww[row]; float o0[8], o1[8];
#pragma unroll
        for (int j = 0; j < 8; ++j) { o0[j] = v0[j] * w; o1[j] = v1[j] * w; }
        bf16_t* q = OUTS + (size_t)row * 1024 + u.pn * 256 + c; store8(q, o0); store8(q + 128, o1); return 0.f;
    }
};

template <class Sched, class Epi>
__device__ __forceinline__ void gemm_naive(const Sched& S, const Epi& E, int K, int lda) {
    const int tid = threadIdx.x, r = tid & 255, s = __builtin_amdgcn_readfirstlane(tid >> 8);
    GUnit u;
    for (int i = 0; S.next(i, u); ++i) {
        const bf16_t* arow = u.rows ? u.A + (size_t)u.rows[r] * lda : u.A + (size_t)r * lda;
        float ss = 0.f;
        for (int g = 0; g < 8; ++g) {
            const int c = s * 64 + g * 8;
            float a0[8], a1[8];
#pragma unroll
            for (int j = 0; j < 8; ++j) { a0[j] = 0.f; a1[j] = 0.f; }
#pragma unroll 1
            for (int k = 0; k < K; k += 8) {
                float af[8]; load8(arow + k, af);
#pragma unroll
                for (int j = 0; j < 8; ++j) {
                    float b0[8], b1[8]; load8(u.B + (size_t)(c + j) * K + k, b0); load8(u.B + (size_t)(128 + c + j) * K + k, b1);
#pragma unroll
                    for (int e = 0; e < 8; ++e) { a0[j] = fmaf(af[e], b0[e], a0[j]); a1[j] = fmaf(af[e], b1[e], a1[j]); }
                }
            }
            ss += E(u, r, c, a0, a1);
        }
        if constexpr (Epi::HAS_SSQ) { E.put_ssq(u, r, s, ss); E.put_ssq(u, r, 2 + s, 0.f); }
    }
}

__device__ __forceinline__ int launder_v(int x) { asm volatile("" : "+v"(x)); return x; }
template <class Tp> __device__ __forceinline__ Tp* launder_s(Tp* p) { asm volatile("" : "+s"(p)); return p; }
namespace pg8 {
constexpr int BK = 64, HALF = 128, HTB = HALF * BK * 2, STAGE_BYTES = 8 * HTB;
__device__ __forceinline__ int lds_byte(int r, int c) { const int st = (r >> 4) * 2 + (c >> 5), rr = r & 15, cc = c & 31, ob = rr * 64 + cc * 2; return st * 1024 + (ob ^ (((ob >> 9) & 1) << 5)); }
__device__ __forceinline__ void stage_rc(int b, int& R, int& C) { const int st = b / 1024, sb = b % 1024, swz = sb ^ (((sb >> 9) & 1) << 5); R = (st >> 1) * 16 + swz / 64; C = (st & 1) * 32 + (swz % 64) / 2; }
__device__ __forceinline__ int perm32(int rho) { const int n = rho >> 4, i = rho & 15; return 8 * (i >> 2) + 4 * n + (i & 3); }

template <bool GATHER, class Sched, class Epi>
__device__ __forceinline__ void gemm_phase(LAS unsigned char* lds, const Sched& S, const Epi& E, const int K, const int lda) {
    const int tid = launder_v((int)threadIdx.x), wid = __builtin_amdgcn_readfirstlane(tid >> 6), lane = tid & 63, wr = wid >> 2, wc = wid & 3, fr = lane & 15, fq = lane >> 4;
    const int nt = K / BK;
    int RA[2], CA[2]; unsigned voffB[2];
#pragma unroll
    for (int i = 0; i < 2; ++i) { int R, C; stage_rc(tid * 16 + i * 8192, R, C); RA[i] = R; CA[i] = C; const int Rb = (R & ~31) + perm32(R & 31); voffB[i] = (unsigned)(Rb * K + C) * 2u; }
    const size_t kstep = (size_t)(BK * 2);
    const size_t hstepB = (size_t)HALF * K * 2;
    const unsigned ldsw = (unsigned)wid * 1024u;
    const int aoff = lds_byte(wr * 64 + fr, fq * 8), boff = lds_byte(wc * 32 + fr, fq * 8);
#define PG8_SA(b, h) (((b) * 2 + (h)) * HTB)
#define PG8_SB(b, h) ((4 + (b) * 2 + (h)) * HTB)
#define PG8_STAGE2(bufoff, gbase, v0_, v1_) do { \
        __builtin_amdgcn_global_load_lds((const unsigned*)((const char*)(gbase) + (v0_)), (LAS unsigned*)(lds + (bufoff) + ldsw), 16, 0, 0); \
        __builtin_amdgcn_global_load_lds((const unsigned*)((const char*)(gbase) + (v1_)), (LAS unsigned*)(lds + (bufoff) + ldsw + 8192), 16, 0, 0); } while (0)
#define PG8_STAGEB(bufoff, gbase) PG8_STAGE2(bufoff, gbase, voffB[0], voffB[1])
#define PG8_LDA(dst, b, h) do { _Pragma("unroll") for (int m = 0; m < 4; ++m) _Pragma("unroll") for (int k = 0; k < 2; ++k) dst[m][k] = *(const LAS bf16x8*)(lds + PG8_SA(b, h) + aoff + m * 2048 + k * 1024); } while (0)
#define PG8_LDB(dst, b, h) do { _Pragma("unroll") for (int n = 0; n < 2; ++n) _Pragma("unroll") for (int k = 0; k < 2; ++k) dst[n][k] = *(const LAS bf16x8*)(lds + PG8_SB(b, h) + boff + n * 2048 + k * 1024); } while (0)
#define PG8_MMA(ai, bj, At, Bt) do { __builtin_amdgcn_s_setprio(1); _Pragma("unroll") for (int m = 0; m < 4; ++m) _Pragma("unroll") for (int n = 0; n < 2; ++n) _Pragma("unroll") for (int k = 0; k < 2; ++k) \
        acc[ai][bj][m][n] = __builtin_amdgcn_mfma_f32_16x16x32_bf16(Bt[n][k], At[m][k], acc[ai][bj][m][n], 0, 0, 0); __builtin_amdgcn_s_setprio(0); } while (0)
#define PG8_WAIT_V(n) asm volatile("s_waitcnt vmcnt(" #n ")" ::: "memory")
#define PG8_WAIT_L(n) asm volatile("s_waitcnt lgkmcnt(" #n ")" ::: "memory")
#define PG8_BAR __builtin_amdgcn_s_barrier()
#define PG8_SCHED __builtin_amdgcn_sched_barrier(0)
#define PG8_VOFFA(dst, u_) do { _Pragma("unroll") for (int h_ = 0; h_ < 2; ++h_) _Pragma("unroll") for (int i_ = 0; i_ < 2; ++i_) { \
        const unsigned row_ = GATHER ? (unsigned)(u_).rows[h_ * HALF + RA[i_]] : (unsigned)RA[i_]; dst[h_][i_] = (row_ * (unsigned)lda + (unsigned)CA[i_]) * 2u; } } while (0)
    GUnit cur, nxt; int ui = 0;
    if (!S.next(0, cur)) return;
    f32x4 acc[2][2][4][2];
#pragma unroll
    for (int a = 0; a < 2; ++a)
#pragma unroll
        for (int b = 0; b < 2; ++b)
#pragma unroll
            for (int m = 0; m < 4; ++m)
#pragma unroll
                for (int n = 0; n < 2; ++n) acc[a][b][m][n] = (f32x4){0.f, 0.f, 0.f, 0.f};
    bf16x8 At[4][2], B0[2][2], B1[2][2];
    unsigned vc[2][2], vn[2][2];
    const size_t hstepA = GATHER ? (size_t)0 : (size_t)HALF * lda * 2;
    PG8_VOFFA(vc, cur);
    const char* cA = (const char*)cur.A; const char* cB = (const char*)cur.B;
    PG8_STAGEB(PG8_SB(0, 0), cB); PG8_STAGEB(PG8_SB(0, 1), cB + hstepB); PG8_STAGE2(PG8_SA(0, 0), cA, vc[0][0], vc[0][1]); PG8_STAGE2(PG8_SA(0, 1), cA + hstepA, vc[1][0], vc[1][1]);
    if (wr == 1) PG8_BAR;
    PG8_WAIT_V(2); PG8_BAR;
    PG8_STAGEB(PG8_SB(1, 0), cB + kstep); PG8_STAGE2(PG8_SA(1, 0), cA + kstep, vc[0][0], vc[0][1]); PG8_STAGEB(PG8_SB(1, 1), cB + hstepB + kstep);
    PG8_WAIT_V(6); PG8_BAR;
    for (;;) {
        const bool has_next = S.next(ui + 1, nxt);
        const char* nA = has_next ? (const char*)nxt.A : cA; const char* nB = has_next ? (const char*)nxt.B : cB;
        if (has_next) { PG8_VOFFA(vn, nxt); } else {
#pragma unroll
            for (int h_ = 0; h_ < 2; ++h_)
#pragma unroll
                for (int i_ = 0; i_ < 2; ++i_) vn[h_][i_] = vc[h_][i_]; }
        for (int t = 0; t < nt; t += 2) {
            const bool last = (t == nt - 2);
            const char* a1 = cA + (size_t)(t + 1) * kstep;
            const char* a2 = last ? nA : cA + (size_t)(t + 2) * kstep; const char* b2 = last ? nB : cB + (size_t)(t + 2) * kstep;
            const char* a3 = a2 + kstep; const char* b3 = b2 + kstep;
            const unsigned w00 = last ? vn[0][0] : vc[0][0], w01 = last ? vn[0][1] : vc[0][1], w10 = last ? vn[1][0] : vc[1][0], w11 = last ? vn[1][1] : vc[1][1];
            PG8_LDB(B0, 0, 0); PG8_LDB(B1, 0, 1); PG8_SCHED; PG8_LDA(At, 0, 0); PG8_STAGE2(PG8_SA(1, 1), a1 + hstepA, vc[1][0], vc[1][1]);
            PG8_WAIT_V(8); PG8_WAIT_L(0); PG8_BAR; PG8_MMA(0, 0, At, B0); PG8_MMA(0, 1, At, B1); PG8_BAR; PG8_SCHED;
            PG8_LDA(At, 0, 1); PG8_STAGEB(PG8_SB(0, 0), b2); PG8_STAGEB(PG8_SB(0, 1), b2 + hstepB); PG8_STAGE2(PG8_SA(0, 0), a2, w00, w01);
            PG8_WAIT_V(8); PG8_WAIT_L(0); PG8_BAR; PG8_MMA(1, 0, At, B0); PG8_MMA(1, 1, At, B1); PG8_BAR; PG8_SCHED;
            PG8_LDB(B0, 1, 0); PG8_LDB(B1, 1, 1); PG8_SCHED; PG8_LDA(At, 1, 0); PG8_STAGE2(PG8_SA(0, 1), a2 + hstepA, w10, w11);
            PG8_WAIT_V(8); PG8_WAIT_L(0); PG8_BAR; PG8_MMA(0, 0, At, B0); PG8_MMA(0, 1, At, B1); PG8_BAR; PG8_SCHED;
            PG8_LDA(At, 1, 1); PG8_STAGEB(PG8_SB(1, 0), b3); PG8_STAGEB(PG8_SB(1, 1), b3 + hstepB); PG8_STAGE2(PG8_SA(1, 0), a3, w00, w01);
            PG8_WAIT_V(8); PG8_WAIT_L(0); PG8_BAR; PG8_MMA(1, 0, At, B0); PG8_MMA(1, 1, At, B1); PG8_BAR; PG8_SCHED;
        }
        if (wr == 0) PG8_BAR;
        const int fr2 = launder_v(fr), fq2 = launder_v(fq);
#pragma unroll
        for (int ai = 0; ai < 2; ++ai)
#pragma unroll
            for (int m = 0; m < 4; ++m) {
                const int r = ai * HALF + wr * 64 + m * 16 + fr2;
                const f32x4 p0 = acc[ai][0][m][0], p1 = acc[ai][0][m][1], q0 = acc[ai][1][m][0], q1 = acc[ai][1][m][1];
                const float v0[8] = {p0[0], p0[1], p0[2], p0[3], p1[0], p1[1], p1[2], p1[3]}, v1[8] = {q0[0], q0[1], q0[2], q0[3], q1[0], q1[1], q1[2], q1[3]};
                float ss = E(cur, r, wc * 32 + fq2 * 8, v0, v1);
                if constexpr (Epi::HAS_SSQ) { ss += __shfl_xor(ss, 16); ss += __shfl_xor(ss, 32); if (fq2 == 0) E.put_ssq(cur, r, wc, ss); }
                asm volatile("" ::: "memory");
            }
        if (!has_next) break;
#pragma unroll
        for (int a = 0; a < 2; ++a)
#pragma unroll
            for (int b = 0; b < 2; ++b)
#pragma unroll
                for (int m = 0; m < 4; ++m)
#pragma unroll
                    for (int n = 0; n < 2; ++n) acc[a][b][m][n] = (f32x4){0.f, 0.f, 0.f, 0.f};
        cur = nxt; cA = nA; cB = nB; ++ui;
#pragma unroll
        for (int h_ = 0; h_ < 2; ++h_)
#pragma unroll
            for (int i_ = 0; i_ < 2; ++i_) vc[h_][i_] = vn[h_][i_];
        if (wr == 1) PG8_BAR;
    }
    PG8_WAIT_V(0);
    PG8_BAR;
#undef PG8_SA
#undef PG8_SB
#undef PG8_STAGE2
#undef PG8_STAGEB
#undef PG8_LDA
#undef PG8_LDB
#undef PG8_MMA
#undef PG8_WAIT_V
#undef PG8_WAIT_L
#undef PG8_BAR
#undef PG8_SCHED
#undef PG8_VOFFA
}
}

__device__ __forceinline__ int rowmap(int code, int n) {
    switch (code) {
        case 1: return n < 1280 ? n : (n < 1312 ? n + 5120 : (n < 3360 ? n - 32 : (n < 3392 ? n + 3072 : n - 64)));
        case 2: { const int h = n >> 7, j = n & 127; return j < 64 ? h * 64 + j : 512 + h * 64 + (j - 64); }
        case 3: return (n >> 7) * 256 + (n & 127);
        case 4: return (n >> 7) * 256 + 128 + (n & 127);
        default: return n;
    }
}
struct TJob { const float* W; bf16_t* WT; const float* g; int K, N, code; };
__device__ __forceinline__ void transpose_item(const TJob& jb, LAS float* scr, int item, int lane) {
    const int K = jb.K, N = jb.N, nblk = N / 32, kb = item / nblk, nb = item % nblk, k0 = 64 * kb, n0 = 32 * nb;
#pragma unroll 8
    for (int i = 0; i < 32; ++i) { const int kk = 2 * i + (lane >> 5); float w = jb.W[(size_t)(k0 + kk) * N + n0 + (lane & 31)]; if (jb.g) w *= jb.g[k0 + kk]; scr[kk * 33 + (lane & 31)] = w; }
    asm volatile("s_waitcnt lgkmcnt(0)" ::: "memory");
    const int c = lane & 7;
#pragma unroll
    for (int j = 0; j < 4; ++j) { const int n = (lane >> 3) + 8 * j; const LAS float* s = scr + (8 * c) * 33 + n;
        u32x4 o; o.x = pk2(s[0 * 33], s[1 * 33]); o.y = pk2(s[2 * 33], s[3 * 33]); o.z = pk2(s[4 * 33], s[5 * 33]); o.w = pk2(s[6 * 33], s[7 * 33]);
        *(u32x4*)(jb.WT + (size_t)rowmap(jb.code, n0 + n) * K + k0 + 8 * c) = o; }
    asm volatile("s_waitcnt lgkmcnt(0)" ::: "memory");
}
__device__ __forceinline__ bool common_job(const Ctx& a, int j, TJob& jb) {
    unsigned char* ws = a.ws;
    if (j < 14) { const int l = j / 7, k = j % 7;
        switch (k) {
            case 0: jb = TJob{a.in[I_WIN] + (size_t)l * 1024 * 6464, (bf16_t*)(ws + O_WIN + l * SZ_WIN1), a.in[I_GMIX] + l * 1024, 1024, 6464, 1}; break;
            case 1: jb = TJob{a.in[I_WBQUP] + (size_t)l * 256 * 768, (bf16_t*)(ws + O_WQUP + l * SZ_WQUP1), a.in[I_GBQ] + l * 256, 256, 768, 0}; break;
            case 2: jb = TJob{a.in[I_WBKVUP] + (size_t)l * 256 * 1024, (bf16_t*)(ws + O_WKVUP + l * SZ_WKVUP1), a.in[I_GBKV] + l * 256, 256, 1024, 2}; break;
            case 3: jb = TJob{a.in[I_WPA] + (size_t)l * 512 * 1024, (bf16_t*)(ws + O_WP + (l * 3 + 0) * SZ_WP1), nullptr, 512, 1024, 0}; break;
            case 4: jb = TJob{a.in[I_WPB] + (size_t)l * 512 * 1024, (bf16_t*)(ws + O_WP + (l * 3 + 1) * SZ_WP1), nullptr, 512, 1024, 0}; break;
            case 5: jb = TJob{a.in[I_WPC] + (size_t)l * 512 * 1024, (bf16_t*)(ws + O_WP + (l * 3 + 2) * SZ_WP1), nullptr, 512, 1024, 0}; break;
            default: jb = TJob{a.in[I_WOUT] + (size_t)l * 1024 * 1024, (bf16_t*)(ws + O_WOUT + l * SZ_WOUT1), nullptr, 1024, 1024, 0}; break;
        }
        return true; }
    if (j == 14) { jb = TJob{a.in[I_WFFG], (bf16_t*)(ws + O_WFFGU), a.in[I_GFFN], 1024, DFF, 3}; return true; }
    if (j == 15) { jb = TJob{a.in[I_WFFU], (bf16_t*)(ws + O_WFFGU), a.in[I_GFFN], 1024, DFF, 4}; return true; }
    if (j == 16) { jb = TJob{a.in[I_WFFD], (bf16_t*)(ws + O_WFFD), nullptr, DFF, 1024, 0}; return true; }
    return false;
}
__device__ __forceinline__ bool expert_job(const Ctx& a, int j, TJob& jb) {
    if (j >= 24) return false;
    unsigned char* ws = a.ws; const int e = j / 3, k = j % 3;
    if (k == 0) jb = TJob{a.in[I_WEG] + (size_t)e * 1024 * DFE, (bf16_t*)(ws + O_WEGU) + (size_t)e * 2 * DFE * 1024, a.in[I_GFFN] + 1024, 1024, DFE, 3};
    else if (k == 1) jb = TJob{a.in[I_WEU] + (size_t)e * 1024 * DFE, (bf16_t*)(ws + O_WEGU) + (size_t)e * 2 * DFE * 1024, a.in[I_GFFN] + 1024, 1024, DFE, 4};
    else jb = TJob{a.in[I_WED] + (size_t)e * DFE * 1024, (bf16_t*)(ws + O_WED) + (size_t)e * 1024 * DFE, nullptr, DFE, 1024, 0};
    return true;
}
template <bool EXPERTS>
__device__ __forceinline__ void run_transposes(const Ctx& a, LAS unsigned char* lds, int gw, int NGW, int wave, int lane) {
    LAS float* scr = (LAS float*)(lds + wave * 16384);
    TJob jb;
    for (int j = 0; EXPERTS ? expert_job(a, j, jb) : common_job(a, j, jb); ++j) {
        const int nitems = (jb.K / 64) * (jb.N / 32);
        for (int it = gw; it < nitems; it += NGW) transpose_item(jb, scr, it, lane);
    }
}
__device__ __forceinline__ void phase_prologue(const Ctx& a, LAS unsigned char* lds, int vcu, int G, int tid) {
    const int wave = __builtin_amdgcn_readfirstlane(tid >> 6), lane = tid & 63, gw = vcu * NWAVES + wave, NGW = G * NWAVES;
    unsigned char* ws = a.ws;
    run_transposes<false>(a, lds, gw, NGW, wave, lane);
    for (int l = 0; l < 2; ++l) { u32x4* p = (u32x4*)(ws + O_WIN + l * SZ_WIN1 + (size_t)6464 * 1024 * 2); const int n16 = 192 * 1024 * 2 / 16;
        for (int i = gw * 64 + lane; i < n16; i += NGW * 64) p[i] = (u32x4){0u, 0u, 0u, 0u}; }
    float* ta = (float*)(ws + O_TABA); float* tb = (float*)(ws + O_TABB);
    for (int i = gw * 64 + lane; i < T * 32; i += NGW * 64) { const int t = i >> 5, k = i & 31, blk = k >> 4, fi = k & 15;
        const float inv = exp2f(-(float)fi * (13.287712379549449f / 16.0f)); const float pos = (float)(blk ? (t & 63) : (t >> 6)); const float ang = pos * inv;
        ta[t * 64 + k] = cosf(ang); ta[t * 64 + 32 + k] = sinf(ang); }
    for (int i = gw * 64 + lane; i < T * 16; i += NGW * 64) { const int t = i >> 4, k = i & 15, blk = k >> 3, fi = k & 7;
        const float inv = exp2f(-(float)fi * (13.287712379549449f / 8.0f)); const float pos = (float)(blk ? (t & 63) : (t >> 6)); const float ang = pos * inv;
        tb[t * 32 + k] = cosf(ang); tb[t * 32 + 16 + k] = sinf(ang); }
    const float* x = a.in[I_X]; bf16_t* XB = (bf16_t*)(ws + O_XB); float* ssq = (float*)(ws + O_SSQ);
    for (int m = gw; m < M; m += NGW) {
        const f32x4* xr = (const f32x4*)(x + (size_t)m * D) + lane; float s = 0.f;
#pragma unroll
        for (int j = 0; j < 4; ++j) { const f32x4 v = xr[64 * j]; s += (v.x * v.x + v.y * v.y) + (v.z * v.z + v.w * v.w);
            *(u32x2*)(XB + (size_t)m * D + (lane + 64 * j) * 4) = (u32x2){pk2(v.x, v.y), pk2(v.z, v.w)}; }
        s = wave_sum(s);
        if (lane < 16) ssq[(size_t)m * 16 + lane] = lane == 0 ? s : 0.f;
    }
}

template <bool WRITE_LA>
__device__ __forceinline__ void post_item(const Ctx& a, int layer, int it, LAS unsigned char* lds, int tid) {
    unsigned char* ws = a.ws; const int wave = __builtin_amdgcn_readfirstlane(tid >> 6), lane = tid & 63;
    const bf16_t* P = (const bf16_t*)(ws + O_P); const float* ta = (const float*)(ws + O_TABA); const float* tb = (const float*)(ws + O_TABB);
    bf16_t* QA = (bf16_t*)(ws + O_QA); bf16_t* KA = (bf16_t*)(ws + O_KA); bf16_t* KR = (bf16_t*)(ws + O_KROPE);
    const int r0 = it * 64;
    LAS float* caf = (LAS float*)lds;
    __syncthreads();
    for (int i = tid; i < 64 * 32; i += NTHR) { const int r = i >> 5, j = i & 31; caf[i] = bf2f(P[(size_t)(r0 + r) * PW + PC_SMALL + 32 + j]); }
    const float* gaq = a.in[I_GAQ] + layer * 64; const float* gak = a.in[I_GAK] + layer * 64;
    for (int j = 0; j < 8; ++j) {
        const int row = r0 + wave * 8 + j, t = row & (T - 1);
        {
            const int seg = lane & 7; float x[8]; load8(P + (size_t)row * PW + PC_AQ + lane * 8, x);
            float ss = 0.f;
#pragma unroll
            for (int e = 0; e < 8; ++e) ss += x[e] * x[e];
            ss += __shfl_xor(ss, 1); ss += __shfl_xor(ss, 2); ss += __shfl_xor(ss, 4);
            const float rstd = rsqrtf(ss * (1.0f / 64.0f) + EPS); const int tb_ = t * 64 + (seg >> 2) * 16 + (seg & 1) * 8; float o[8];
#pragma unroll
            for (int e = 0; e < 8; ++e) { const float xn = x[e] * rstd * gaq[seg * 8 + e]; const float pr = __shfl_xor(xn, 2); const float cs = ta[tb_ + e], sn = ta[tb_ + 32 + e];
                o[e] = ((seg & 2) ? xn * cs + pr * sn : xn * cs - pr * sn) * C2A; }
            store8(QA + (size_t)row * 512 + lane * 8, o);
        }
        {
            const int l2 = lane & 15, seg = l2 & 7; float x[8]; load8(P + (size_t)row * PW + PC_AK + l2 * 8, x);
            float ss = 0.f;
#pragma unroll
            for (int e = 0; e < 8; ++e) ss += x[e] * x[e];
            ss += __shfl_xor(ss, 1); ss += __shfl_xor(ss, 2); ss += __shfl_xor(ss, 4);
            const float rstd = rsqrtf(ss * (1.0f / 64.0f) + EPS); const int tb_ = t * 64 + (seg >> 2) * 16 + (seg & 1) * 8; float o[8];
#pragma unroll
            for (int e = 0; e < 8; ++e) { const float xn = x[e] * rstd * gak[seg * 8 + e]; const float pr = __shfl_xor(xn, 2); const float cs = ta[tb_ + e], sn = ta[tb_ + 32 + e];
                o[e] = (seg & 2) ? xn * cs + pr * sn : xn * cs - pr * sn; }
            if (lane < 16) store8(KA + (size_t)row * 128 + l2 * 8, o);
        }
        {
            const int seg = lane & 3; float x[8]; load8(P + (size_t)row * PW + PC_SMALL + seg * 8, x);
            const int tb_ = t * 32 + (seg >> 1) * 8; float o[8];
#pragma unroll
            for (int e = 0; e < 8; ++e) { const float pr = __shfl_xor(x[e], 1); const float cs = tb[tb_ + e], sn = tb[tb_ + 16 + e];
                o[e] = (seg & 1) ? x[e] * cs + pr * sn : x[e] * cs - pr * sn; }
            if (lane < 4) store8(KR + (size_t)row * 32 + seg * 8, o);
        }
    }
    __syncthreads();
    const int col = tid;
    for (int dir = 0; dir < 2; ++dir) {
        const float* Wup = a.in[dir ? I_WCAB : I_WCAF] + (size_t)layer * 16 * 512; const float bias = a.in[dir ? I_BCAB : I_BCAF][layer * 512 + col];
        float w[16];
#pragma unroll
        for (int j = 0; j < 16; ++j) w[j] = Wup[j * 512 + col];
        bf16_t* QT = (bf16_t*)(ws + O_QT) + (size_t)(dir * 2) * M * 512; bf16_t* KT = QT + (size_t)M * 512;
        float* LA = (float*)(ws + O_QT) + (size_t)dir * M * 512;
        float b = 0.f;
        for (int s = 0; s < 64; ++s) {
            const int r = dir ? 63 - s : s; const LAS float* cr = caf + r * 32 + dir * 16; float z = bias;
#pragma unroll
            for (int j = 0; j < 16; ++j) z = fmaf(cr[j], w[j], z);
            const float la = (fminf(z, 0.f) - __logf(1.0f + __expf(-fabsf(z)))) * (1.0f / 16.0f);
            b += la;
            const size_t row = (size_t)(r0 + r);
            if (WRITE_LA) LA[row * 512 + col] = la;
            else { const float e = __expf(b); const float q = bf2f(P[row * PW + PC_CQ + col]), k = bf2f(P[row * PW + PC_CK + col]);
                QT[row * 512 + col] = (bf16_t)f2bf(q * e * GLA_QSCALE); KT[row * 512 + col] = (bf16_t)f2bf(k / e); }
        }
        if (!WRITE_LA) ((float*)(ws + O_DEC))[(size_t)dir * 256 * 512 + (size_t)it * 512 + col] = __expf(b);
    }
}

template <int BR>
__device__ __forceinline__ void attn_naive_unit(const Ctx& a, int b, int h, int qb, LAS unsigned char* lds, int tid) {
    unsigned char* ws = a.ws; constexpr int DQ = BR ? 96 : 64;
    const bf16_t* P = (const bf16_t*)(ws + O_P);
    LAS float* Ks = (LAS float*)lds;
    LAS float* Vs = Ks + 64 * 96;
    LAS float* Qs = Vs + 64 * 64;
    const int r = tid >> 1, half = tid & 1; const size_t row0 = (size_t)b * T + qb * 256; const size_t row = row0 + r;
    __syncthreads();
    for (int i = tid; i < 256 * (DQ / 8); i += NTHR) { const int rr = i / (DQ / 8), ch = i % (DQ / 8); float f[8];
        if (BR == 0) load8((const bf16_t*)(ws + O_QA) + (row0 + rr) * 512 + h * 64 + ch * 8, f); else load8((const bf16_t*)(ws + O_QB) + (row0 + rr) * 768 + h * 96 + ch * 8, f);
#pragma unroll
        for (int e = 0; e < 8; ++e) Qs[rr * 97 + ch * 8 + e] = f[e]; }
    __syncthreads();
    if (BR == 1 && tid < 256) {
        const int t = (int)((row0 + tid) & (T - 1)); const float* tb = (const float*)(ws + O_TABB) + t * 32; LAS float* q = Qs + tid * 97 + 64;
        for (int blk = 0; blk < 2; ++blk)
            for (int e = 0; e < 8; ++e) { const float cs = tb[blk * 8 + e], sn = tb[16 + blk * 8 + e]; const float x1 = q[blk * 16 + e], x2 = q[blk * 16 + 8 + e];
                q[blk * 16 + e] = x1 * cs - x2 * sn; q[blk * 16 + 8 + e] = x2 * cs + x1 * sn; } }
    float m = -1e30f, l = 0.f, o[32];
#pragma unroll
    for (int j = 0; j < 32; ++j) o[j] = 0.f;
    for (int kt = 0; kt < T / 64; ++kt) {
        __syncthreads();
        for (int i = tid; i < 64 * (DQ / 8); i += NTHR) { const int kr = i / (DQ / 8), ch = i % (DQ / 8); const size_t krow = (size_t)b * T + kt * 64 + kr; float f[8];
            if (BR == 0) load8((const bf16_t*)(ws + O_KA) + krow * 128 + (h >> 2) * 64 + ch * 8, f);
            else if (ch < 8) load8((const bf16_t*)(ws + O_KNOPE) + krow * 512 + h * 64 + ch * 8, f);
            else load8((const bf16_t*)(ws + O_KROPE) + krow * 32 + (ch - 8) * 8, f);
#pragma unroll
            for (int e = 0; e < 8; ++e) Ks[kr * 96 + ch * 8 + e] = f[e]; }
        for (int i = tid; i < 64 * 8; i += NTHR) { const int kr = i >> 3, ch = i & 7; const size_t krow = (size_t)b * T + kt * 64 + kr; float f[8];
            if (BR == 0) load8(P + krow * PW + PC_AV + (h >> 2) * 64 + ch * 8, f); else load8((const bf16_t*)(ws + O_VB) + krow * 512 + h * 64 + ch * 8, f);
#pragma unroll
            for (int e = 0; e < 8; ++e) Vs[kr * 64 + ch * 8 + e] = f[e]; }
        __syncthreads();
#pragma unroll 1
        for (int kr = 0; kr < 64; ++kr) { float s = 0.f;
#pragma unroll 8
            for (int d = 0; d < DQ; ++d) s = fmaf(Qs[r * 97 + d], Ks[kr * 96 + d], s);
            if (s > m) { const float al = exp2f(m - s); l *= al;
#pragma unroll
                for (int j = 0; j < 32; ++j) o[j] *= al;
                m = s; }
            const float p = exp2f(s - m); l += p;
#pragma unroll
            for (int j = 0; j < 32; ++j) o[j] = fmaf(p, Vs[kr * 64 + half * 32 + j], o[j]); }
    }
    const float inv = 1.0f / l; bf16_t* Y = (bf16_t*)(ws + (BR ? O_YB : O_YA)) + row * 512 + h * 64 + half * 32;
#pragma unroll
    for (int j = 0; j < 32; j += 8) { float f[8];
#pragma unroll
        for (int e = 0; e < 8; ++e) f[e] = o[j + e] * inv;
        store8(Y + j, f); }
}

__device__ __forceinline__ void gla_naive_unit(const Ctx& a, int layer, int b, int h, LAS unsigned char* lds, int tid) {
    unsigned char* ws = a.ws; const bf16_t* P = (const bf16_t*)(ws + O_P); bf16_t* YC = (bf16_t*)(ws + O_YC);
    LAS float* qs = (LAS float*)lds; LAS float* ks = qs + 128; LAS float* as = ks + 128; LAS float* part = as + 128; LAS float* red = part + 512;
    const int j = tid & 127, qd = tid >> 7; const float gco = a.in[I_GCOUT][layer * 128 + j];
    for (int dir = 0; dir < 2; ++dir) {
        const float* LA = (const float*)(ws + O_QT) + (size_t)dir * M * 512;
        float S[32];
#pragma unroll
        for (int i = 0; i < 32; ++i) S[i] = 0.f;
        for (int step = 0; step < T; ++step) {
            const int tok = dir ? T - 1 - step : step; const size_t row = (size_t)b * T + tok;
            __syncthreads();
            if (tid < 128) { qs[tid] = bf2f(P[row * PW + PC_CQ + h * 128 + tid]) * GLA_QSCALE; ks[tid] = bf2f(P[row * PW + PC_CK + h * 128 + tid]); as[tid] = __expf(LA[row * 512 + h * 128 + tid]); }
            const float v = bf2f(P[row * PW + PC_CV + h * 128 + j]);
            __syncthreads();
            float o = 0.f;
#pragma unroll
            for (int i = 0; i < 32; ++i) { const int dk = qd * 32 + i; S[i] = as[dk] * S[i] + ks[dk] * v; o = fmaf(qs[dk], S[i], o); }
            part[qd * 128 + j] = o;
            __syncthreads();
            float v2 = 0.f;
            if (tid < 128) {
                const float tot = (part[tid] + part[128 + tid]) + (part[256 + tid] + part[384 + tid]);
                if (dir == 0) YC[row * 512 + h * 128 + tid] = (bf16_t)f2bf(tot);
                else { v2 = tot + bf2f(YC[row * 512 + h * 128 + tid]); const float ss = wave_sum(v2 * v2); if ((tid & 63) == 0) red[tid >> 6] = ss; }
            }
            if (dir == 1) {
                __syncthreads();
                if (tid < 128) {
                    const float rstd = rsqrtf((red[0] + red[1]) * (1.0f / 128.0f) + EPS);
                    const float g = bf2f(P[row * PW + PC_CG + h * 128 + tid]);
                    YC[row * 512 + h * 128 + tid] = (bf16_t)f2bf(v2 * rstd * gco * (g * sigmoidf_(g)));
                }
            }
        }
    }
}

__device__ __forceinline__ void router_item(const Ctx& a, int blk, LAS unsigned char* lds, int tid) {
    unsigned char* ws = a.ws; int* mi = (int*)(ws + O_MOEI); float* mf = (float*)(ws + O_MOEI);
    const int wave = __builtin_amdgcn_readfirstlane(tid >> 6), lane = tid & 63;
    LAS float* lg = (LAS float*)lds;
    const float* x1 = a.out; const float* g = a.in[I_GFFN] + 1024; const float* wr = a.in[I_WROUTER];
    __syncthreads();
    for (int j = 0; j < 8; ++j) {
        const int tok = blk * 64 + wave * 8 + j; float acc[8], ss = 0.f;
#pragma unroll
        for (int e = 0; e < 8; ++e) acc[e] = 0.f;
#pragma unroll
        for (int jj = 0; jj < 4; ++jj) { const int idx = (lane + 64 * jj) * 4; const f32x4 v = *(const f32x4*)(x1 + (size_t)tok * D + idx), gg = *(const f32x4*)(g + idx);
            ss += (v.x * v.x + v.y * v.y) + (v.z * v.z + v.w * v.w);
            const float hv[4] = {v.x * gg.x, v.y * gg.y, v.z * gg.z, v.w * gg.w};
#pragma unroll
            for (int c = 0; c < 4; ++c) { const f32x4 w0 = *(const f32x4*)(wr + (size_t)(idx + c) * 8), w1 = *(const f32x4*)(wr + (size_t)(idx + c) * 8 + 4);
                acc[0] = fmaf(hv[c], w0.x, acc[0]); acc[1] = fmaf(hv[c], w0.y, acc[1]); acc[2] = fmaf(hv[c], w0.z, acc[2]); acc[3] = fmaf(hv[c], w0.w, acc[3]);
                acc[4] = fmaf(hv[c], w1.x, acc[4]); acc[5] = fmaf(hv[c], w1.y, acc[5]); acc[6] = fmaf(hv[c], w1.z, acc[6]); acc[7] = fmaf(hv[c], w1.w, acc[7]); } }
        ss = wave_sum(ss); const float rstd = rsqrtf(ss * (1.0f / 1024.0f) + EPS);
#pragma unroll
        for (int e = 0; e < 8; ++e) { const float s = wave_sum(acc[e]); if (lane == 0) lg[(wave * 8 + j) * 8 + e] = s * rstd; }
    }
    __syncthreads();
    if (wave == 0) {
        const int tok = blk * 64 + lane; float v[8];
#pragma unroll
        for (int e = 0; e < 8; ++e) v[e] = lg[lane * 8 + e];
        int e1 = 0; float v1 = v[0];
#pragma unroll
        for (int e = 1; e < 8; ++e) if (v[e] > v1) { v1 = v[e]; e1 = e; }
        int e2 = -1; float v2 = -3.0e38f;
#pragma unroll
        for (int e = 0; e < 8; ++e) if (e != e1 && v[e] > v2) { v2 = v[e]; e2 = e; }
        const float w1 = 1.0f / (1.0f + __expf(v2 - v1)), w2 = 1.0f - w1;
        const unsigned long long lt = (1ull << lane) - 1ull; int ra = 0, rb = 0, mycnt = 0;
#pragma unroll
        for (int e = 0; e < 8; ++e) { const unsigned long long m0 = __ballot(e1 == e), m1 = __ballot(e2 == e); const int c0 = __popcll(m0);
            if (e1 == e) ra = __popcll(m0 & lt); if (e2 == e) rb = c0 + __popcll(m1 & lt); if (lane == e) mycnt = c0 + __popcll(m1); }
        mi[MI_TOKE + tok] = e1 | (e2 << 8); mi[MI_TOKR + tok] = ra | (rb << 16); mf[MI_TOKW + tok * 2] = w1; mf[MI_TOKW + tok * 2 + 1] = w2;
        if (lane < 8) mi[MI_CNT + blk * 8 + lane] = mycnt;
    }
}
__device__ __forceinline__ void positions_phase(const Ctx& a, LAS unsigned char* lds, int G, int bid, int tid) {
    unsigned char* ws = a.ws; int* mi = (int*)(ws + O_MOEI); float* mf = (float*)(ws + O_MOEI);
    LAS int* cnt = (LAS int*)lds; LAS int* base = cnt + 2048;
    __syncthreads();
    for (int i = tid; i < 2048; i += NTHR) cnt[i] = mi[MI_CNT + i];
    __syncthreads();
    if (tid < 8) { int run = 0; for (int b = 0; b < 256; ++b) { const int c = cnt[b * 8 + tid]; cnt[b * 8 + tid] = run; run += c; } base[8 + tid] = run; }
    __syncthreads();
    if (tid == 0) { int off = 0; for (int e = 0; e < 8; ++e) { base[e] = off; off += (base[8 + e] + 255) & ~255; } base[16] = off >> 8; }
    __syncthreads();
    if (bid == 0) {
        const int nt = base[16];
        for (int t = tid; t < nt; t += NTHR) { int e = 0;
#pragma unroll
            for (int k = 1; k < 8; ++k) if (t * 256 >= base[k]) e = k;
            mi[MI_TILEE + t] = e; }
        if (tid == 0) mi[MI_TILEE + MAXTILES] = nt;
        for (int e = 0; e < 8; ++e) { const int lo = base[e] + base[8 + e], hi = base[e] + ((base[8 + e] + 255) & ~255);
            for (int r = lo + tid; r < hi; r += NTHR) { mi[MI_ROWTOK + r] = 0; mf[MI_ROWW + r] = 0.f; } }
    }
    for (int blk = bid; blk < 256; blk += G) if (tid < 64) {
        const int tok = blk * 64 + tid; const int ee = mi[MI_TOKE + tok], rr = mi[MI_TOKR + tok]; const int e1 = ee & 255, e2 = ee >> 8;
        const int pa = base[e1] + cnt[blk * 8 + e1] + (rr & 0xffff), pb = base[e2] + cnt[blk * 8 + e2] + (rr >> 16);
        mi[MI_ROWTOK + pa] = tok; mf[MI_ROWW + pa] = mf[MI_TOKW + tok * 2]; mi[MI_ROWTOK + pb] = tok; mf[MI_ROWW + pb] = mf[MI_TOKW + tok * 2 + 1];
        mi[MI_TOKPOS + tok * 2] = pa; mi[MI_TOKPOS + tok * 2 + 1] = pb;
    }
}
__device__ __forceinline__ void final_phase(const Ctx& a, int gw, int NGW, int lane) {
    unsigned char* ws = a.ws; const int* mi = (const int*)(ws + O_MOEI); const bf16_t* OUTS = (const bf16_t*)(ws + O_OUTS); const float* gf = a.in[I_GFINAL];
    for (int m = gw; m < M; m += NGW) {
        const int pa = mi[MI_TOKPOS + m * 2], pb = mi[MI_TOKPOS + m * 2 + 1]; f32x4 v[4]; float s = 0.f;
#pragma unroll
        for (int j = 0; j < 4; ++j) { const int idx = (lane + 64 * j) * 4; v[j] = *(const f32x4*)(a.out + (size_t)m * D + idx);
            const u32x2 ua = *(const u32x2*)(OUTS + (size_t)pa * 1024 + idx), ub = *(const u32x2*)(OUTS + (size_t)pb * 1024 + idx);
            v[j].x += bf2f(ua.x & 0xffffu) + bf2f(ub.x & 0xffffu); v[j].y += bf2f(ua.x >> 16) + bf2f(ub.x >> 16); v[j].z += bf2f(ua.y & 0xffffu) + bf2f(ub.y & 0xffffu); v[j].w += bf2f(ua.y >> 16) + bf2f(ub.y >> 16);
            s += (v[j].x * v[j].x + v[j].y * v[j].y) + (v[j].z * v[j].z + v[j].w * v[j].w); }
        s = wave_sum(s); const float rstd = rsqrtf(s * (1.0f / 1024.0f) + EPS);
#pragma unroll
        for (int j = 0; j < 4; ++j) { const int idx = (lane + 64 * j) * 4; const f32x4 g = *(const f32x4*)(gf + idx);
            *(f32x4*)(a.out + (size_t)m * D + idx) = (f32x4){v[j].x * rstd * g.x, v[j].y * rstd * g.y, v[j].z * rstd * g.z, v[j].w * rstd * g.w}; }
    }
}

#ifndef FAST_MASK
#define FAST_MASK 0x1ff
#endif
template <int SITE, bool GATHER = false, class Sched, class Epi>
__device__ __forceinline__ void gemm_run(LAS unsigned char* lds, const Sched& S, const Epi& E, int K, int lda) {
    if constexpr (NAIVE_GEMM || !((FAST_MASK >> SITE) & 1)) gemm_naive(S, E, K, lda);
    else pg8::gemm_phase<GATHER>(lds, S, E, K, lda);
}

constexpr int NPHASE = 18;
__global__ void __launch_bounds__(NTHR, 2) mega_fwd(Args args) {
    extern __shared__ __attribute__((aligned(16))) unsigned char lds_raw[];
    LAS unsigned char* lds = (LAS unsigned char*)lds_raw;
    const int G = gridDim.x, bid = blockIdx.x;
    { const int tid0 = threadIdx.x; for (int u = tid0; u < (LDS_BYTES - LDS_CTL) / 4; u += NTHR) ((LAS unsigned*)(lds + LDS_CTL))[u] = 0u; }
    __syncthreads();
    XcdBarrier bar; bar.bar = (unsigned*)args.ws + CW_BAR; bar.x = 0; bar.st = nullptr;
#if N_LAUNCH_MODE == 1
    bar = xcd_barrier_post((unsigned*)args.ws + CW_BAR, (volatile LAS unsigned*)(lds + LDS_MISC) + 8);
#endif
    const int lo = args.ph_lo, hi = args.ph_hi;
#define IN(k) (lo <= (k) && (k) < hi)
#if N_LAUNCH_MODE == 1
#define SEAM(k) do { if (IN(k) && IN((k) + 1)) xcd_barrier(bar); } while (0)
#else
#define SEAM(k) do { } while (0)
#endif
#define PH_BEGIN unsigned char* ws = launder_s(args.ws); const Ctx A{(const float* const*)(ws + O_PTAB), args.out, ws}; const int tid = launder_v((int)threadIdx.x); \
    const int lane = tid & 63, wave = __builtin_amdgcn_readfirstlane(tid >> 6); const int vcu = (G % 8 == 0) ? (bid % 8) * (G / 8) + bid / 8 : bid; \
    const int gw = vcu * NWAVES + wave, NGW = G * NWAVES; (void)lane; (void)gw; (void)NGW; (void)ws;

    if (IN(0)) {
        if (threadIdx.x == 0) { const float** tab = (const float**)(args.ws + O_PTAB);
#pragma unroll
            for (int i = 0; i < 28; ++i) tab[i] = args.in[i]; }
        asm volatile("s_waitcnt vmcnt(0)" ::: "memory"); __syncthreads();
        PH_BEGIN; phase_prologue(A, lds, vcu, G, tid); SEAM(0); }

    for (int l = 0; l < 2; ++l) {
        const int pb = l ? 8 : 1;
        if (IN(pb)) {
            PH_BEGIN;
            SchedDense S{(const bf16_t*)(ws + O_XB), (const bf16_t*)(ws + O_WIN + l * SZ_WIN1), 1024, 1024, 64, NIN / 256, G, bid};
            EpiInProj E{(bf16_t*)(ws + O_P), (bf16_t*)(ws + O_GATES), (const float*)(ws + O_SSQ), A.in[I_BGATE] + l * 3072, (float*)(ws + O_RSP)};
            gemm_run<0>(lds, S, E, 1024, 1024);
            SEAM(pb);
        }
        if (IN(pb + 1)) {
            PH_BEGIN;
            for (int it = bid; it < 256; it += G) post_item<(NAIVE_GLA != 0)>(A, l, it, lds, tid);
            __syncthreads();
            SchedUp S{(const bf16_t*)(ws + O_P), (const bf16_t*)(ws + O_WQUP + l * SZ_WQUP1), (const bf16_t*)(ws + O_WKVUP + l * SZ_WKVUP1), G, bid};
            EpiUpProj E{(const float*)(ws + O_RSP), (bf16_t*)(ws + O_QB), (bf16_t*)(ws + O_KNOPE), (bf16_t*)(ws + O_VB)};
            gemm_run<1>(lds, S, E, 256, PW);
            SEAM(pb + 1);
        }
        if (IN(pb + 2)) {
            PH_BEGIN;
            unsigned* qh = (unsigned*)ws + CW_Q + 64 * l; LAS unsigned* slot = (LAS unsigned*)(lds + LDS_CTL + 64);
            for (;;) {
                __syncthreads();
                if (tid == 0) *slot = __hip_atomic_fetch_add(qh, 1u, __ATOMIC_RELAXED, __HIP_MEMORY_SCOPE_AGENT);
                __syncthreads();
                const int u = (int)*slot;
                if (u >= 64 + 1024) break;
                if (u < 64) gla_naive_unit(A, l, u >> 2, u & 3, lds, tid);
                else if (u < 64 + 512) { const int v = u - 64; attn_naive_unit<1>(A, v >> 6, (v >> 3) & 7, v & 7, lds, tid); }
                else { const int v = u - 576; attn_naive_unit<0>(A, v >> 6, (v >> 3) & 7, v & 7, lds, tid); }
            }
            SEAM(pb + 2);
        }
        if (IN(pb + 3)) {
            PH_BEGIN;
            SchedMerge S{(const bf16_t*)(ws + O_YA), (const bf16_t*)(ws + O_WP + l * 3 * SZ_WP1), G, bid};
            EpiMerge E{(const bf16_t*)(ws + O_GATES), (float*)(ws + O_PART), (bf16_t*)(ws + O_MB)};
            gemm_run<2>(lds, S, E, 512, 512);
            SEAM(pb + 3);
        }
        if (IN(pb + 4)) {
            PH_BEGIN;
            SchedDense S{(const bf16_t*)(ws + O_MB), (const bf16_t*)(ws + O_WOUT + l * SZ_WOUT1), 1024, 1024, 64, 4, G, bid};
            EpiResid E{l ? A.out : A.in[I_X], A.out, (bf16_t*)(ws + O_XB), (float*)(ws + O_SSQ)};
            gemm_run<3>(lds, S, E, 1024, 1024);
            SEAM(pb + 4);
        }
        if (l == 0) {
            if (IN(6)) {
                PH_BEGIN;
                SchedDense S{(const bf16_t*)(ws + O_XB), (const bf16_t*)(ws + O_WFFGU), 1024, 1024, 64, 2 * DFF / 256, G, bid};
                EpiSwiGLU E{(const float*)(ws + O_SSQ), nullptr, (bf16_t*)(ws + O_HID), DFF};
                gemm_run<4>(lds, S, E, 1024, 1024);
                SEAM(6);
            }
            if (IN(7)) {
                PH_BEGIN;
                SchedDense S{(const bf16_t*)(ws + O_HID), (const bf16_t*)(ws + O_WFFD), DFF, DFF, 64, 4, G, bid};
                EpiResid E{A.out, A.out, (bf16_t*)(ws + O_XB), (float*)(ws + O_SSQ)};
                gemm_run<5>(lds, S, E, DFF, DFF);
                SEAM(7);
            }
        }
    }
    if (IN(13)) {
        PH_BEGIN;
        for (int blk = bid; blk < 256; blk += G) router_item(A, blk, lds, tid);
        __syncthreads();
        run_transposes<true>(A, lds, gw, NGW, wave, lane);
        SEAM(13);
    }
    if (IN(14)) { PH_BEGIN; positions_phase(A, lds, G, bid, tid); SEAM(14); }
    if (IN(15)) {
        PH_BEGIN; int* mi = (int*)(ws + O_MOEI);
        SchedMoe S{(const bf16_t*)(ws + O_XB), (const bf16_t*)(ws + O_WEGU), mi + MI_TILEE, mi + MI_ROWTOK, 1024, 1024, 2 * DFE / 256, G, bid, (size_t)2 * DFE * 1024, true};
        EpiSwiGLU E{(const float*)(ws + O_SSQ), mi + MI_ROWTOK, (bf16_t*)(ws + O_HIDS), DFE};
        gemm_run<6, true>(lds, S, E, 1024, 1024);
        SEAM(15);
    }
    if (IN(16)) {
        PH_BEGIN; int* mi = (int*)(ws + O_MOEI);
        SchedMoe S{(const bf16_t*)(ws + O_HIDS), (const bf16_t*)(ws + O_WED), mi + MI_TILEE, mi + MI_ROWTOK, DFE, DFE, 4, G, bid, (size_t)1024 * DFE, false};
        EpiMoeDown E{(const float*)(ws + O_MOEI) + MI_ROWW, (bf16_t*)(ws + O_OUTS)};
        gemm_run<7>(lds, S, E, DFE, DFE);
        SEAM(16);
    }
    if (IN(17)) { PH_BEGIN; final_phase(A, gw, NGW, lane); }
#undef IN
#undef SEAM
#undef PH_BEGIN
}

extern "C" void kernel_launch(void* const* d_in, const int* in_sizes, int n_in, void* d_out, int out_size, void* d_ws, size_t ws_size, hipStream_t stream) {
    static int grid = 0;
    if (grid == 0) {
        if (n_in != 28 || out_size != M * D || ws_size < WS_NEED) { fprintf(stderr, "kernel_launch: unexpected shapes (n_in %d out %d ws %zu need %zu)\n", n_in, out_size, ws_size, (size_t)WS_NEED); grid = -1; return; }
        int dev = 0, cus = 0;
        if (hipGetDevice(&dev) != hipSuccess || hipDeviceGetAttribute(&cus, hipDeviceAttributeMultiprocessorCount, dev) != hipSuccess) { grid = -1; return; }
        if (hipFuncSetAttribute((const void*)mega_fwd, hipFuncAttributeMaxDynamicSharedMemorySize, LDS_BYTES) != hipSuccess) { grid = -1; return; }
        int per_cu = 0;
        if (hipOccupancyMaxActiveBlocksPerMultiprocessor(&per_cu, (const void*)mega_fwd, NTHR, LDS_BYTES) != hipSuccess || per_cu < 1) { fprintf(stderr, "kernel_launch: occupancy query says %d\n", per_cu); }
        (void)hipGetLastError();
        grid = cus;
    }
    if (grid < 0) return;
    (void)hipMemsetAsync(d_ws, 0, CTL_BYTES, stream);
    Args a{};
    for (int i = 0; i < 28; ++i) a.in[i] = (const float*)d_in[i];
    a.out = (float*)d_out; a.ws = (unsigned char*)d_ws; a.li = 0; a.pad = 0;
#if N_LAUNCH_MODE == 1
    a.ph_lo = 0; a.ph_hi = NPHASE;
    hipLaunchKernelGGL(mega_fwd, dim3(grid), dim3(NTHR), LDS_BYTES, stream, a);
#else
    for (int p = 0; p < NPHASE; ++p) { a.ph_lo = p; a.ph_hi = p + 1; hipLaunchKernelGGL(mega_fwd, dim3(grid), dim3(NTHR), LDS_BYTES, stream, a); }
#endif
}
```

```cpp
#include <hip/hip_runtime.h>
#include <cstdio>
#include <cstdint>

#ifndef N_LAUNCH_MODE
#define N_LAUNCH_MODE 1
#endif
#ifndef NAIVE_GEMM
#define NAIVE_GEMM 0
#endif
#ifndef NAIVE_ATTN
#define NAIVE_ATTN 0
#endif
#ifndef NAIVE_GLA
#define NAIVE_GLA 1
#endif

#define LAS __attribute__((address_space(3)))
#define GAS __attribute__((address_space(1)))
typedef unsigned short bf16_t;
typedef short bf16x8 __attribute__((ext_vector_type(8)));
typedef float f32x4 __attribute__((ext_vector_type(4)));
typedef unsigned u32x4 __attribute__((ext_vector_type(4)));
typedef unsigned u32x2 __attribute__((ext_vector_type(2)));

constexpr int M = 16384, D = 1024, T = 2048, NBATCH = 8, NWAVES = 8, NTHR = 512;
constexpr float EPS = 1e-6f;
constexpr int PW = 3456;
constexpr int PC_AQ = 0, PC_AK = 512, PC_AV = 640, PC_BCQ = 768, PC_BCKV = 1024, PC_CQ = 1280, PC_CK = 1792, PC_CV = 2304, PC_CG = 2816, PC_SMALL = 3328;
constexpr int NIN = 6656;
constexpr int DFF = 2816, DFE = 3584, NEXP = 8;
constexpr int MAXTILES = 136, MAXROWS = MAXTILES * 256;
constexpr float LOG2E = 1.4426950408889634f;
constexpr float C2A = 0.125f * LOG2E;
constexpr float C2B = 0.10206207261596575f * LOG2E;
constexpr float GLA_QSCALE = 0.08838834764831845f;

constexpr size_t CTL_BYTES = 1u << 20;
constexpr size_t SZ_WIN1 = (size_t)NIN * 1024 * 2, SZ_WQUP1 = 768 * 256 * 2, SZ_WKVUP1 = 1024 * 256 * 2, SZ_WP1 = 1024 * 512 * 2, SZ_WOUT1 = 1024 * 1024 * 2;
constexpr size_t O_WIN = CTL_BYTES;
constexpr size_t O_WQUP = O_WIN + 2 * SZ_WIN1;
constexpr size_t O_WKVUP = O_WQUP + 2 * SZ_WQUP1;
constexpr size_t O_WP = O_WKVUP + 2 * SZ_WKVUP1;
constexpr size_t O_WOUT = O_WP + 6 * SZ_WP1;
constexpr size_t O_WFFGU = O_WOUT + 2 * SZ_WOUT1;
constexpr size_t O_WFFD = O_WFFGU + (size_t)2 * DFF * 1024 * 2;
constexpr size_t O_TABA = O_WFFD + (size_t)1024 * DFF * 2;
constexpr size_t O_TABB = O_TABA + (size_t)T * 64 * 4;
constexpr size_t O_XB = O_TABB + (size_t)T * 32 * 4;
constexpr size_t O_SSQ = O_XB + (size_t)M * 1024 * 2;
constexpr size_t O_RSP = O_SSQ + (size_t)M * 16 * 4;
constexpr size_t O_PTAB = O_RSP + (size_t)M * 32 * 4;
constexpr size_t O_MOEI = O_PTAB + 256;
constexpr size_t SZ_MOEI = 2u << 20;
constexpr size_t O_R = O_MOEI + SZ_MOEI;
constexpr size_t O_P = O_R;
constexpr size_t O_GATES = O_P + (size_t)M * PW * 2;
constexpr size_t O_QA = O_GATES + (size_t)M * 3072 * 2;
constexpr size_t O_KA = O_QA + (size_t)M * 512 * 2;
constexpr size_t O_KROPE = O_KA + (size_t)M * 128 * 2;
constexpr size_t O_QB = O_KROPE + (size_t)M * 32 * 2;
constexpr size_t O_KNOPE = O_QB + (size_t)M * 768 * 2;
constexpr size_t O_VB = O_KNOPE + (size_t)M * 512 * 2;
constexpr size_t O_QT = O_VB + (size_t)M * 512 * 2;
constexpr size_t O_DEC = O_QT + (size_t)4 * M * 512 * 2;
constexpr size_t O_YA = O_DEC + (size_t)2 * 256 * 512 * 4;
constexpr size_t O_YB = O_YA + (size_t)M * 512 * 2;
constexpr size_t O_YC = O_YB + (size_t)M * 512 * 2;
constexpr size_t O_MIX_END = O_YC + (size_t)M * 512 * 2;
constexpr size_t O_PART = O_QT;
constexpr size_t O_MB = O_P;
constexpr size_t O_HID = O_P;
constexpr size_t O_WEGU = O_R;
constexpr size_t O_WED = O_WEGU + (size_t)NEXP * 2 * DFE * 1024 * 2;
constexpr size_t O_HIDS = O_WED + (size_t)NEXP * 1024 * DFE * 2;
constexpr size_t O_MOE_END = O_HIDS + (size_t)MAXROWS * DFE * 2;
constexpr size_t O_OUTS = O_WEGU;
constexpr size_t WS_NEED = O_MIX_END > O_MOE_END ? O_MIX_END : O_MOE_END;
static_assert(WS_NEED <= 531851264ull, "workspace map exceeds the guaranteed ws_size");
static_assert((size_t)M * 1024 * 4 <= (size_t)4 * M * 512 * 2, "PART overlay");
static_assert((size_t)MAXROWS * 1024 * 2 <= (size_t)NEXP * 2 * DFE * 1024 * 2, "OUTS overlay");
constexpr int MI_CNT = 0;
constexpr int MI_TOKE = 4096;
constexpr int MI_TOKR = MI_TOKE + M;
constexpr int MI_TOKW = MI_TOKR + M;
constexpr int MI_TOKPOS = MI_TOKW + 2 * M;
constexpr int MI_ROWTOK = MI_TOKPOS + 2 * M;
constexpr int MI_ROWW = MI_ROWTOK + MAXROWS;
constexpr int MI_TILEE = MI_ROWW + MAXROWS;
constexpr int MI_END = MI_TILEE + MAXTILES + 8;
static_assert((size_t)MI_END * 4 <= SZ_MOEI, "moe lists");

constexpr int CW_TMO = 0;
constexpr int CW_Q = 1024;
constexpr int CW_BAR = 4096;

constexpr int LDS_RING = 131072, LDS_CTL = 145408, LDS_MISC = LDS_CTL + 320, LDS_BYTES = 147456;

__device__ __forceinline__ float bf2f(unsigned v) { return __uint_as_float(v << 16); }
__device__ __forceinline__ unsigned f2bf(float f) { unsigned u = __float_as_uint(f); return (u + 0x7fffu + ((u >> 16) & 1u)) >> 16; }
__device__ __forceinline__ unsigned pk2(float lo, float hi) { return f2bf(lo) | (f2bf(hi) << 16); }
__device__ __forceinline__ void unpack8(const u32x4 w, float (&f)[8]) {
    f[0] = __uint_as_float(w.x << 16); f[1] = __uint_as_float(w.x & 0xffff0000u); f[2] = __uint_as_float(w.y << 16); f[3] = __uint_as_float(w.y & 0xffff0000u);
    f[4] = __uint_as_float(w.z << 16); f[5] = __uint_as_float(w.z & 0xffff0000u); f[6] = __uint_as_float(w.w << 16); f[7] = __uint_as_float(w.w & 0xffff0000u);
}
__device__ __forceinline__ u32x4 pack8(const float (&f)[8]) { u32x4 w; w.x = pk2(f[0], f[1]); w.y = pk2(f[2], f[3]); w.z = pk2(f[4], f[5]); w.w = pk2(f[6], f[7]); return w; }
__device__ __forceinline__ void load8(const bf16_t* p, float (&f)[8]) { unpack8(*(const u32x4*)p, f); }
__device__ __forceinline__ void store8(bf16_t* p, const float (&f)[8]) { *(u32x4*)p = pack8(f); }
__device__ __forceinline__ float wave_sum(float v) {
#pragma unroll
    for (int o = 1; o < 64; o <<= 1) v += __shfl_xor(v, o);
    return v;
}
__device__ __forceinline__ float row_rstd16(const float* ssq, int row) {
    const f32x4* p = (const f32x4*)(ssq + (size_t)row * 16);
    const f32x4 a = p[0], b = p[1], c = p[2], d = p[3];
    const float s = ((a.x + a.y) + (a.z + a.w)) + ((b.x + b.y) + (b.z + b.w)) + ((c.x + c.y) + (c.z + c.w)) + ((d.x + d.y) + (d.z + d.w));
    return rsqrtf(s * (1.0f / 1024.0f) + EPS);
}
__device__ __forceinline__ float sigmoidf_(float x) { return 1.0f / (1.0f + __expf(-x)); }

#define XB_TMO      128
#define XB_XCNT(j)  (256  + 64 * (j))
#define XB_XSUB(j)  (1280 + 64 * (j))
#define XB_XGEN(j)  (2304 + 64 * (j))
#define XB_TOP      3328
#define XB_TOPGEN   3392
#define XCD_BAR_WORDS 3456
#define XB_SPIN_CAP (1u << 18)
__device__ __forceinline__ unsigned xb_ld(unsigned* p)              { return __hip_atomic_load(p, __ATOMIC_RELAXED, __HIP_MEMORY_SCOPE_AGENT); }
__device__ __forceinline__ unsigned xb_add(unsigned* p, unsigned v) { return __hip_atomic_fetch_add(p, v, __ATOMIC_RELAXED, __HIP_MEMORY_SCOPE_AGENT); }
__device__ __forceinline__ unsigned xb_xcc_id() { return (unsigned)__builtin_amdgcn_s_getreg((3 << 11) | 20) & 0xFu; }
#define XB_SPIN(cond, bar) do { unsigned _sp = 0; while (cond) { __builtin_amdgcn_s_sleep(1); \
    if ((++_sp & 255u) == 0u) { if (xb_ld(&(bar)[XB_TMO])) break; if (_sp > XB_SPIN_CAP) { atomicAdd(&(bar)[XB_TMO], 1u); break; } } } } while (0)
struct XcdBarrier { unsigned* bar; unsigned x; volatile LAS unsigned* st; };
__device__ __forceinline__ XcdBarrier xcd_barrier_post(unsigned* bar, volatile LAS unsigned* st) {
    XcdBarrier b; b.bar = bar; b.x = xb_xcc_id(); b.st = st;
    if (threadIdx.x == 0) (void)xb_add(&bar[XB_XCNT(b.x)], 1u);
    return b;
}
__device__ __forceinline__ void xcd_barrier_complete(unsigned* bar, unsigned x, unsigned& nloc, unsigned& nx) {
    const unsigned G = gridDim.x * gridDim.y * gridDim.z;
    unsigned sum, cnt, mine, sp = 0u;
    for (;;) {
        sum = 0u; cnt = 0u; mine = 0u;
#pragma unroll
        for (unsigned j = 0; j < 16; ++j) { const unsigned c = xb_ld(&bar[XB_XCNT(j)]); sum += c; cnt += (c > 0u) ? 1u : 0u; mine = (j == x) ? c : mine; }
        if (sum == G) break;
        __builtin_amdgcn_s_sleep(1);
        if ((++sp & 255u) == 0u) { if (xb_ld(&bar[XB_TMO])) break; if (sp > XB_SPIN_CAP) { atomicAdd(&bar[XB_TMO], 1u); break; } }
    }
    nloc = mine > 0u ? mine : 1u; nx = cnt > 0u ? cnt : 1u;
}
__device__ __forceinline__ void xcd_barrier(const XcdBarrier& b) {
    asm volatile("s_waitcnt vmcnt(0)" ::: "memory");
    __syncthreads();
    if (threadIdx.x == 0) {
        unsigned* bar = b.bar;
        __builtin_amdgcn_s_waitcnt(0);
        unsigned nloc = b.st[0], nx = b.st[1];
        if (nloc == 0u) { xcd_barrier_complete(bar, b.x, nloc, nx); b.st[0] = nloc; b.st[1] = nx; }
        const unsigned old = xb_add(&bar[XB_XSUB(b.x)], 1u);
        const unsigned gen = old / nloc;
        if (old + 1u == (gen + 1u) * nloc) {
            __builtin_amdgcn_fence(__ATOMIC_RELEASE, "agent");
            asm volatile("s_waitcnt vmcnt(0)" ::: "memory");
            const unsigned og = xb_add(&bar[XB_TOP], 1u);
            const unsigned tg = og / nx;
            if (og + 1u == (tg + 1u) * nx) xb_add(&bar[XB_TOPGEN], 1u);
            else XB_SPIN(xb_ld(&bar[XB_TOPGEN]) == tg, bar);
            __builtin_amdgcn_fence(__ATOMIC_ACQUIRE, "agent");
            xb_add(&bar[XB_XGEN(b.x)], 1u);
            asm volatile("s_waitcnt vmcnt(0)" ::: "memory");
        } else {
            XB_SPIN(xb_ld(&bar[XB_XGEN(b.x)]) == gen, bar);
            __builtin_amdgcn_fence(__ATOMIC_ACQUIRE, "agent");
            asm volatile("s_waitcnt vmcnt(0)" ::: "memory");
        }
    }
    __syncthreads();
}

struct Args { const float* in[28]; float* out; unsigned char* ws; int ph_lo, ph_hi, li, pad; };
struct Ctx { const float* const* in; float* out; unsigned char* ws; };
enum { I_X = 0, I_WIN, I_BGATE, I_GMIX, I_GAQ, I_GAK, I_GBQ, I_WBQUP, I_GBKV, I_WBKVUP, I_WCAF, I_BCAF, I_WCAB, I_BCAB, I_GCOUT, I_WPA, I_WPB, I_WPC, I_WOUT, I_GFFN,
       I_WFFG, I_WFFU, I_WFFD, I_WROUTER, I_WEG, I_WEU, I_WED, I_GFINAL };

struct GUnit { const bf16_t* A; const bf16_t* B; const int* rows; int pm, pn, aux; };
__device__ __forceinline__ void tile_order(int L, int nM, int nN, int& pm, int& pn) {
    const int nwg = nM * nN; int wgid = L;
    { const int q = nwg / 8, r = nwg % 8, xcd = wgid % 8, off = wgid / 8; wgid = (xcd < r ? xcd * (q + 1) : r * (q + 1) + (xcd - r) * q) + off; }
    const int nig = 8 * nN, gid = wgid / nig, fm = gid * 8, gsz = (nM - fm) < 8 ? (nM - fm) : 8;
    pm = fm + ((wgid % nig) % gsz); pn = (wgid % nig) / gsz;
}
struct SchedDense {
    const bf16_t* A; const bf16_t* B; int lda, K, nM, nN, G, c;
    __device__ __forceinline__ bool next(int i, GUnit& u) const {
        const long L = (long)i * G + c; if (L >= (long)nM * nN) return false;
        tile_order((int)L, nM, nN, u.pm, u.pn);
        u.A = A + (size_t)u.pm * 256 * lda; u.B = B + (size_t)u.pn * 256 * K; u.rows = nullptr; u.aux = 0; return true;
    }
};
struct SchedUp {
    const bf16_t* P; const bf16_t* Wq; const bf16_t* Wkv; int G, c;
    __device__ __forceinline__ bool next(int i, GUnit& u) const {
        const int L = i * G + c; if (L >= 448) return false;
        if (L < 192) { tile_order(L, 64, 3, u.pm, u.pn); u.aux = 0; u.A = P + (size_t)u.pm * 256 * PW + PC_BCQ; u.B = Wq + (size_t)u.pn * 256 * 256; }
        else { tile_order(L - 192, 64, 4, u.pm, u.pn); u.aux = 1; u.A = P + (size_t)u.pm * 256 * PW + PC_BCKV; u.B = Wkv + (size_t)u.pn * 256 * 256; }
        u.rows = nullptr; return true;
    }
};
struct SchedMerge {
    const bf16_t* Y0; const bf16_t* W; int G, c;
    __device__ __forceinline__ bool next(int i, GUnit& u) const {
        const int tile = (i / 3) * G + c, br = i % 3; if (tile >= 256) return false;
        tile_order(tile, 64, 4, u.pm, u.pn); u.aux = br;
        u.A = Y0 + (size_t)br * M * 512 + (size_t)u.pm * 256 * 512; u.B = W + (size_t)br * 1024 * 512 + (size_t)u.pn * 256 * 512; u.rows = nullptr; return true;
    }
};
struct SchedMoe {
    const bf16_t* A; const bf16_t* B; const int* tile_e; const int* rowtok; int lda, K, nN, G, c; size_t bstride; bool gather;
    __device__ __forceinline__ bool next(int i, GUnit& u) const {
        const int nM = tile_e[MAXTILES]; const long L = (long)i * G + c; if (L >= (long)nM * nN) return false;
        tile_order((int)L, nM, nN, u.pm, u.pn); const int e = tile_e[u.pm]; u.aux = e;
        u.B = B + (size_t)e * bstride + (size_t)u.pn * 256 * K;
        if (gather) { u.A = A; u.rows = rowtok + u.pm * 256; } else { u.A = A + (size_t)u.pm * 256 * lda; u.rows = nullptr; }
        return true;
    }
};

struct EpiInProj {
    bf16_t* P; bf16_t* GATES; const float* ssq; const float* bgate; float* rsp;
    static constexpr bool HAS_SSQ = false;
    __device__ __forceinline__ void half(int H, int row, int c, const float (&v)[8], float rstd) const {
        float o[8];
        if (H < 26) {
#pragma unroll
            for (int j = 0; j < 8; ++j) o[j] = v[j] * rstd;
            store8(P + (size_t)row * PW + H * 128 + c, o);
        } else if (H < 50) {
            const int gc = (H - 26) * 128 + c; const f32x4 b0 = *(const f32x4*)(bgate + gc), b1 = *(const f32x4*)(bgate + gc + 4);
            o[0] = sigmoidf_(v[0] * rstd + b0.x); o[1] = sigmoidf_(v[1] * rstd + b0.y); o[2] = sigmoidf_(v[2] * rstd + b0.z); o[3] = sigmoidf_(v[3] * rstd + b0.w);
            o[4] = sigmoidf_(v[4] * rstd + b1.x); o[5] = sigmoidf_(v[5] * rstd + b1.y); o[6] = sigmoidf_(v[6] * rstd + b1.z); o[7] = sigmoidf_(v[7] * rstd + b1.w);
            store8(GATES + (size_t)row * 3072 + gc, o);
        } else if (H == 50 && c < 64) {
#pragma unroll
            for (int j = 0; j < 8; ++j) o[j] = v[j] * rstd;
            store8(P + (size_t)row * PW + PC_SMALL + c, o);
        }
    }
    __device__ __forceinline__ float operator()(const GUnit& u, int r, int c, const float (&v0)[8], const float (&v1)[8]) const {
        const int row = u.pm * 256 + r; const float rstd = row_rstd16(ssq, row);
        half(u.pn * 2, row, c, v0, rstd); half(u.pn * 2 + 1, row, c, v1, rstd);
        if (u.pn == 3 || u.pn == 4) { float s = 0.f;
#pragma unroll
            for (int j = 0; j < 8; ++j) s += (v0[j] * v0[j] + v1[j] * v1[j]);
            rsp[(size_t)row * 32 + (u.pn - 3) * 16 + (c >> 3)] = s * rstd * rstd; }
        return 0.f;
    }
};
struct EpiUpProj {
    const float* rsp; bf16_t* QB; bf16_t* KNOPE; bf16_t* VB;
    static constexpr bool HAS_SSQ = false;
    __device__ __forceinline__ float operator()(const GUnit& u, int r, int c, const float (&v0)[8], const float (&v1)[8]) const {
        const int row = u.pm * 256 + r; const f32x4* p = (const f32x4*)(rsp + (size_t)row * 32 + u.aux * 16);
        float s = 0.f;
#pragma unroll
        for (int j = 0; j < 4; ++j) { const f32x4 a = p[j]; s += (a.x + a.y) + (a.z + a.w); }
        float rstd = rsqrtf(s * (1.0f / 256.0f) + EPS);
        float o0[8], o1[8];
        if (u.aux == 0) {
            rstd *= C2B;
#pragma unroll
            for (int j = 0; j < 8; ++j) { o0[j] = v0[j] * rstd; o1[j] = v1[j] * rstd; }
            bf16_t* q = QB + (size_t)row * 768 + u.pn * 256 + c; store8(q, o0); store8(q + 128, o1);
        } else {
#pragma unroll
            for (int j = 0; j < 8; ++j) { o0[j] = v0[j] * rstd; o1[j] = v1[j] * rstd; }
            bf16_t* q = (u.pn < 2 ? KNOPE + (size_t)row * 512 + u.pn * 256 : VB + (size_t)row * 512 + (u.pn - 2) * 256) + c; store8(q, o0); store8(q + 128, o1);
        }
        return 0.f;
    }
};
struct EpiMerge {
    const bf16_t* GATES; float* PART; bf16_t* MB;
    static constexpr bool HAS_SSQ = false;
    __device__ __forceinline__ float operator()(const GUnit& u, int r, int c, const float (&v0)[8], const float (&v1)[8]) const {
        const int row = u.pm * 256 + r, col = u.pn * 256 + c, br = u.aux;
#pragma unroll
        for (int h = 0; h < 2; ++h) {
            const int cc = col + h * 128; float g[8], o[8]; load8(GATES + (size_t)row * 3072 + br * 1024 + cc, g);
            float* pp = PART + (size_t)row * 1024 + cc;
#pragma unroll
            for (int j = 0; j < 8; ++j) o[j] = g[j] * (h ? v1[j] : v0[j]);
            if (br > 0) { const f32x4 a = *(const f32x4*)pp, b = *(const f32x4*)(pp + 4); o[0] += a.x; o[1] += a.y; o[2] += a.z; o[3] += a.w; o[4] += b.x; o[5] += b.y; o[6] += b.z; o[7] += b.w; }
            if (br < 2) { *(f32x4*)pp = (f32x4){o[0], o[1], o[2], o[3]}; *(f32x4*)(pp + 4) = (f32x4){o[4], o[5], o[6], o[7]}; }
            else store8(MB + (size_t)row * 1024 + cc, o);
        }
        return 0.f;
    }
};
struct EpiResid {
    const float* xin; float* xout; bf16_t* XB; float* ssq;
    static constexpr bool HAS_SSQ = true;
    __device__ __forceinline__ float operator()(const GUnit& u, int r, int c, const float (&v0)[8], const float (&v1)[8]) const {
        const int row = u.pm * 256 + r, col = u.pn * 256 + c; float ss = 0.f;
#pragma unroll
        for (int h = 0; h < 2; ++h) {
            const size_t off = (size_t)row * 1024 + col + h * 128; const f32x4 a = *(const f32x4*)(xin + off), b = *(const f32x4*)(xin + off + 4);
            float o[8] = {a.x, a.y, a.z, a.w, b.x, b.y, b.z, b.w};
#pragma unroll
            for (int j = 0; j < 8; ++j) { o[j] += (h ? v1[j] : v0[j]); ss += o[j] * o[j]; }
            *(f32x4*)(xout + off) = (f32x4){o[0], o[1], o[2], o[3]}; *(f32x4*)(xout + off + 4) = (f32x4){o[4], o[5], o[6], o[7]};
            store8(XB + off, o);
        }
        return ss;
    }
    __device__ __forceinline__ void put_ssq(const GUnit& u, int r, int slot, float s) const { ssq[(size_t)(u.pm * 256 + r) * 16 + u.pn * 4 + slot] = s; }
};
struct EpiSwiGLU {
    const float* ssq; const int* rowtok; bf16_t* HID; int ldh;
    static constexpr bool HAS_SSQ = false;
    __device__ __forceinline__ float operator()(const GUnit& u, int r, int c, const float (&v0)[8], const float (&v1)[8]) const {
        const int row = u.pm * 256 + r; const int tok = rowtok ? rowtok[row] : row; const float rstd = row_rstd16(ssq, tok);
        float o[8];
#pragma unroll
        for (int j = 0; j < 8; ++j) { const float g = v0[j] * rstd, up = v1[j] * rstd; o[j] = g * sigmoidf_(g) * up; }
        store8(HID + (size_t)row * ldh + u.pn * 128 + c, o); return 0.f;
    }
};
struct EpiMoeDown {
    const float* roww; bf16_t* OUTS;
    static constexpr bool HAS_SSQ = false;
    __device__ __forceinline__ float operator()(const GUnit& u, int r, int c, const float (&v0)[8], const float (&v1)[8]) const {
        const int row = u.pm * 256 + r; const float w = roww[row]; float o0[8], o1[8];
#pragma unroll
        for (int j = 0; j < 8; ++j) { o0[j] = v0[j] * w; o1[j] = v1[j] * w; }
        bf16_t* q = OUTS + (size_t)row * 1024 + u.pn * 256 + c; store8(q, o0); store8(q + 128, o1); return 0.f;
    }
};

template <class Sched, class Epi>
__device__ __forceinline__ void gemm_naive(const Sched& S, const Epi& E, int K, int lda) {
    const int tid = threadIdx.x, r = tid & 255, s = __builtin_amdgcn_readfirstlane(tid >> 8);
    GUnit u;
    for (int i = 0; S.next(i, u); ++i) {
        const bf16_t* arow = u.rows ? u.A + (size_t)u.rows[r] * lda : u.A + (size_t)r * lda;
        float ss = 0.f;
        for (int g = 0; g < 8; ++g) {
            const int c = s * 64 + g * 8;
            float a0[8], a1[8];
#pragma unroll
            for (int j = 0; j < 8; ++j) { a0[j] = 0.f; a1[j] = 0.f; }
#pragma unroll 1
            for (int k = 0; k < K; k += 8) {
                float af[8]; load8(arow + k, af);
#pragma unroll
                for (int j = 0; j < 8; ++j) {
                    float b0[8], b1[8]; load8(u.B + (size_t)(c + j) * K + k, b0); load8(u.B + (size_t)(128 + c + j) * K + k, b1);
#pragma unroll
                    for (int e = 0; e < 8; ++e) { a0[j] = fmaf(af[e], b0[e], a0[j]); a1[j] = fmaf(af[e], b1[e], a1[j]); }
                }
            }
            ss += E(u, r, c, a0, a1);
        }
        if constexpr (Epi::HAS_SSQ) { E.put_ssq(u, r, s, ss); E.put_ssq(u, r, 2 + s, 0.f); }
    }
}

__device__ __forceinline__ int launder_v(int x) { asm volatile("" : "+v"(x)); return x; }
template <class Tp> __device__ __forceinline__ Tp* launder_s(Tp* p) { asm volatile("" : "+s"(p)); return p; }
__device__ __forceinline__ int launder_i(int x) { asm volatile("" : "+s"(x)); return x; }
__device__ __forceinline__ bool in_phase(int lo, int hi, int k) { asm volatile("" : "+s"(lo), "+s"(hi)); return lo <= k && k < hi; }
namespace pg8 {
constexpr int BK = 64, HALF = 128, HTB = HALF * BK * 2, STAGE_BYTES = 8 * HTB;
__device__ __forceinline__ int lds_byte(int r, int c) { const int st = (r >> 4) * 2 + (c >> 5), rr = r & 15, cc = c & 31, ob = rr * 64 + cc * 2; return st * 1024 + (ob ^ (((ob >> 9) & 1) << 5)); }
__device__ __forceinline__ void stage_rc(int b, int& R, int& C) { const int st = b / 1024, sb = b % 1024, swz = sb ^ (((sb >> 9) & 1) << 5); R = (st >> 1) * 16 + swz / 64; C = (st & 1) * 32 + (swz % 64) / 2; }
__device__ __forceinline__ int perm32(int rho) { const int n = rho >> 4, i = rho & 15; return 8 * (i >> 2) + 4 * n + (i & 3); }

template <bool GATHER, class Sched, class Epi>
__device__ __forceinline__ void gemm_phase(LAS unsigned char* lds, const Sched& S, const Epi& E, const int K, const int lda) {
    const int tid = launder_v((int)threadIdx.x), wid = __builtin_amdgcn_readfirstlane(tid >> 6), lane = tid & 63, wr = wid >> 2, wc = wid & 3, fr = lane & 15, fq = lane >> 4;
    const int nt = K / BK;
    int RA[2], CA[2]; unsigned voffB[2];
#pragma unroll
    for (int i = 0; i < 2; ++i) { int R, C; stage_rc(tid * 16 + i * 8192, R, C); RA[i] = R; CA[i] = C; const int Rb = (R & ~31) + perm32(R & 31); voffB[i] = (unsigned)(Rb * K + C) * 2u; }
    const size_t kstep = (size_t)(BK * 2);
    const size_t hstepB = (size_t)HALF * K * 2;
    const unsigned ldsw = (unsigned)wid * 1024u;
    const int aoff = lds_byte(wr * 64 + fr, fq * 8), boff = lds_byte(wc * 32 + fr, fq * 8);
#define PG8_SA(b, h) (((b) * 2 + (h)) * HTB)
#define PG8_SB(b, h) ((4 + (b) * 2 + (h)) * HTB)
#define PG8_STAGE2(bufoff, gbase, v0_, v1_) do { \
        __builtin_amdgcn_global_load_lds((const unsigned*)((const char*)(gbase) + (v0_)), (LAS unsigned*)(lds + (bufoff) + ldsw), 16, 0, 0); \
        __builtin_amdgcn_global_load_lds((const unsigned*)((const char*)(gbase) + (v1_)), (LAS unsigned*)(lds + (bufoff) + ldsw + 8192), 16, 0, 0); } while (0)
#define PG8_STAGEB(bufoff, gbase) PG8_STAGE2(bufoff, gbase, voffB[0], voffB[1])
#define PG8_LDA(dst, b, h) do { _Pragma("unroll") for (int m = 0; m < 4; ++m) _Pragma("unroll") for (int k = 0; k < 2; ++k) dst[m][k] = *(const LAS bf16x8*)(lds + PG8_SA(b, h) + aoff + m * 2048 + k * 1024); } while (0)
#define PG8_LDB(dst, b, h) do { _Pragma("unroll") for (int n = 0; n < 2; ++n) _Pragma("unroll") for (int k = 0; k < 2; ++k) dst[n][k] = *(const LAS bf16x8*)(lds + PG8_SB(b, h) + boff + n * 2048 + k * 1024); } while (0)
#define PG8_MMA(ai, bj, At, Bt) do { __builtin_amdgcn_s_setprio(1); _Pragma("unroll") for (int m = 0; m < 4; ++m) _Pragma("unroll") for (int n = 0; n < 2; ++n) _Pragma("unroll") for (int k = 0; k < 2; ++k) \
        acc[ai][bj][m][n] = __builtin_amdgcn_mfma_f32_16x16x32_bf16(Bt[n][k], At[m][k], acc[ai][bj][m][n], 0, 0, 0); __builtin_amdgcn_s_setprio(0); } while (0)
#define PG8_WAIT_V(n) asm volatile("s_waitcnt vmcnt(" #n ")" ::: "memory")
#define PG8_WAIT_L(n) asm volatile("s_waitcnt lgkmcnt(" #n ")" ::: "memory")
#define PG8_BAR __builtin_amdgcn_s_barrier()
#define PG8_SCHED __builtin_amdgcn_sched_barrier(0)
#define PG8_VOFFA(dst, u_) do { _Pragma("unroll") for (int h_ = 0; h_ < 2; ++h_) _Pragma("unroll") for (int i_ = 0; i_ < 2; ++i_) { \
        const unsigned row_ = GATHER ? (unsigned)(u_).rows[h_ * HALF + RA[i_]] : (unsigned)RA[i_]; dst[h_][i_] = (row_ * (unsigned)lda + (unsigned)CA[i_]) * 2u; } } while (0)
    GUnit cur, nxt; int ui = 0;
    if (!S.next(0, cur)) return;
    f32x4 acc[2][2][4][2];
#pragma unroll
    for (int a = 0; a < 2; ++a)
#pragma unroll
        for (int b = 0; b < 2; ++b)
#pragma unroll
            for (int m = 0; m < 4; ++m)
#pragma unroll
                for (int n = 0; n < 2; ++n) acc[a][b][m][n] = (f32x4){0.f, 0.f, 0.f, 0.f};
    bf16x8 At[4][2], B0[2][2], B1[2][2];
    unsigned vc[2][2], vn[2][2];
    const size_t hstepA = GATHER ? (size_t)0 : (size_t)HALF * lda * 2;
    PG8_VOFFA(vc, cur);
    const char* cA = (const char*)cur.A; const char* cB = (const char*)cur.B;
    PG8_STAGEB(PG8_SB(0, 0), cB); PG8_STAGEB(PG8_SB(0, 1), cB + hstepB); PG8_STAGE2(PG8_SA(0, 0), cA, vc[0][0], vc[0][1]); PG8_STAGE2(PG8_SA(0, 1), cA + hstepA, vc[1][0], vc[1][1]);
    if (wr == 1) PG8_BAR;
    PG8_WAIT_V(2); PG8_BAR;
    PG8_STAGEB(PG8_SB(1, 0), cB + kstep); PG8_STAGE2(PG8_SA(1, 0), cA + kstep, vc[0][0], vc[0][1]); PG8_STAGEB(PG8_SB(1, 1), cB + hstepB + kstep);
    PG8_WAIT_V(6); PG8_BAR;
    for (;;) {
        const bool has_next = S.next(ui + 1, nxt);
        const char* nA = has_next ? (const char*)nxt.A : cA; const char* nB = has_next ? (const char*)nxt.B : cB;
        if (has_next) { PG8_VOFFA(vn, nxt); } else {
#pragma unroll
            for (int h_ = 0; h_ < 2; ++h_)
#pragma unroll
                for (int i_ = 0; i_ < 2; ++i_) vn[h_][i_] = vc[h_][i_]; }
        for (int t = 0; t < nt; t += 2) {
            const bool last = (t == nt - 2);
            const char* a1 = cA + (size_t)(t + 1) * kstep;
            const char* a2 = last ? nA : cA + (size_t)(t + 2) * kstep; const char* b2 = last ? nB : cB + (size_t)(t + 2) * kstep;
            const char* a3 = a2 + kstep; const char* b3 = b2 + kstep;
            const unsigned w00 = last ? vn[0][0] : vc[0][0], w01 = last ? vn[0][1] : vc[0][1], w10 = last ? vn[1][0] : vc[1][0], w11 = last ? vn[1][1] : vc[1][1];
            PG8_LDB(B0, 0, 0); PG8_LDB(B1, 0, 1); PG8_SCHED; PG8_LDA(At, 0, 0); PG8_STAGE2(PG8_SA(1, 1), a1 + hstepA, vc[1][0], vc[1][1]);
            PG8_WAIT_V(8); PG8_WAIT_L(0); PG8_BAR; PG8_MMA(0, 0, At, B0); PG8_MMA(0, 1, At, B1); PG8_BAR; PG8_SCHED;
            PG8_LDA(At, 0, 1); PG8_STAGEB(PG8_SB(0, 0), b2); PG8_STAGEB(PG8_SB(0, 1), b2 + hstepB); PG8_STAGE2(PG8_SA(0, 0), a2, w00, w01);
            PG8_WAIT_V(8); PG8_WAIT_L(0); PG8_BAR; PG8_MMA(1, 0, At, B0); PG8_MMA(1, 1, At, B1); PG8_BAR; PG8_SCHED;
            PG8_LDB(B0, 1, 0); PG8_LDB(B1, 1, 1); PG8_SCHED; PG8_LDA(At, 1, 0); PG8_STAGE2(PG8_SA(0, 1), a2 + hstepA, w10, w11);
            PG8_WAIT_V(8); PG8_WAIT_L(0); PG8_BAR; PG8_MMA(0, 0, At, B0); PG8_MMA(0, 1, At, B1); PG8_BAR; PG8_SCHED;
            PG8_LDA(At, 1, 1); PG8_STAGEB(PG8_SB(1, 0), b3); PG8_STAGEB(PG8_SB(1, 1), b3 + hstepB); PG8_STAGE2(PG8_SA(1, 0), a3, w00, w01);
            PG8_WAIT_V(8); PG8_WAIT_L(0); PG8_BAR; PG8_MMA(1, 0, At, B0); PG8_MMA(1, 1, At, B1); PG8_BAR; PG8_SCHED;
        }
        if (wr == 0) PG8_BAR;
        const int fr2 = launder_v(fr), fq2 = launder_v(fq);
#pragma unroll
        for (int ai = 0; ai < 2; ++ai)
#pragma unroll
            for (int m = 0; m < 4; ++m) {
                const int r = ai * HALF + wr * 64 + m * 16 + fr2;
                const f32x4 p0 = acc[ai][0][m][0], p1 = acc[ai][0][m][1], q0 = acc[ai][1][m][0], q1 = acc[ai][1][m][1];
                const float v0[8] = {p0[0], p0[1], p0[2], p0[3], p1[0], p1[1], p1[2], p1[3]}, v1[8] = {q0[0], q0[1], q0[2], q0[3], q1[0], q1[1], q1[2], q1[3]};
                float ss = E(cur, r, wc * 32 + fq2 * 8, v0, v1);
                if constexpr (Epi::HAS_SSQ) { ss += __shfl_xor(ss, 16); ss += __shfl_xor(ss, 32); if (fq2 == 0) E.put_ssq(cur, r, wc, ss); }
                asm volatile("" ::: "memory");
            }
        if (!has_next) break;
#pragma unroll
        for (int a = 0; a < 2; ++a)
#pragma unroll
            for (int b = 0; b < 2; ++b)
#pragma unroll
                for (int m = 0; m < 4; ++m)
#pragma unroll
                    for (int n = 0; n < 2; ++n) acc[a][b][m][n] = (f32x4){0.f, 0.f, 0.f, 0.f};
        cur = nxt; cA = nA; cB = nB; ++ui;
#pragma unroll
        for (int h_ = 0; h_ < 2; ++h_)
#pragma unroll
            for (int i_ = 0; i_ < 2; ++i_) vc[h_][i_] = vn[h_][i_];
        if (wr == 1) PG8_BAR;
    }
    PG8_WAIT_V(0);
    PG8_BAR;
#undef PG8_SA
#undef PG8_SB
#undef PG8_STAGE2
#undef PG8_STAGEB
#undef PG8_LDA
#undef PG8_LDB
#undef PG8_MMA
#undef PG8_WAIT_V
#undef PG8_WAIT_L
#undef PG8_BAR
#undef PG8_SCHED
#undef PG8_VOFFA
}
}

__device__ __forceinline__ int rowmap(int code, int n) {
    switch (code) {
        case 1: return n < 1280 ? n : (n < 1312 ? n + 5120 : (n < 3360 ? n - 32 : (n < 3392 ? n + 3072 : n - 64)));
        case 2: { const int h = n >> 7, j = n & 127; return j < 64 ? h * 64 + j : 512 + h * 64 + (j - 64); }
        case 3: return (n >> 7) * 256 + (n & 127);
        case 4: return (n >> 7) * 256 + 128 + (n & 127);
        default: return n;
    }
}
struct TJob { const float* W; bf16_t* WT; const float* g; int K, N, code; };
__device__ __forceinline__ void transpose_item(const TJob& jb, LAS float* scr, int item, int lane) {
    const int K = jb.K, N = jb.N, nblk = N / 32, kb = item / nblk, nb = item % nblk, k0 = 64 * kb, n0 = 32 * nb;
#pragma unroll 8
    for (int i = 0; i < 32; ++i) { const int kk = 2 * i + (lane >> 5); float w = jb.W[(size_t)(k0 + kk) * N + n0 + (lane & 31)]; if (jb.g) w *= jb.g[k0 + kk]; scr[kk * 33 + (lane & 31)] = w; }
    asm volatile("s_waitcnt lgkmcnt(0)" ::: "memory");
    const int c = lane & 7;
#pragma unroll
    for (int j = 0; j < 4; ++j) { const int n = (lane >> 3) + 8 * j; const LAS float* s = scr + (8 * c) * 33 + n;
        u32x4 o; o.x = pk2(s[0 * 33], s[1 * 33]); o.y = pk2(s[2 * 33], s[3 * 33]); o.z = pk2(s[4 * 33], s[5 * 33]); o.w = pk2(s[6 * 33], s[7 * 33]);
        *(u32x4*)(jb.WT + (size_t)rowmap(jb.code, n0 + n) * K + k0 + 8 * c) = o; }
    asm volatile("s_waitcnt lgkmcnt(0)" ::: "memory");
}
__device__ __forceinline__ bool common_job(const Ctx& a, int j, TJob& jb) {
    unsigned char* ws = a.ws;
    if (j < 14) { const int l = j / 7, k = j % 7;
        switch (k) {
            case 0: jb = TJob{a.in[I_WIN] + (size_t)l * 1024 * 6464, (bf16_t*)(ws + O_WIN + l * SZ_WIN1), a.in[I_GMIX] + l * 1024, 1024, 6464, 1}; break;
            case 1: jb = TJob{a.in[I_WBQUP] + (size_t)l * 256 * 768, (bf16_t*)(ws + O_WQUP + l * SZ_WQUP1), a.in[I_GBQ] + l * 256, 256, 768, 0}; break;
            case 2: jb = TJob{a.in[I_WBKVUP] + (size_t)l * 256 * 1024, (bf16_t*)(ws + O_WKVUP + l * SZ_WKVUP1), a.in[I_GBKV] + l * 256, 256, 1024, 2}; break;
            case 3: jb = TJob{a.in[I_WPA] + (size_t)l * 512 * 1024, (bf16_t*)(ws + O_WP + (l * 3 + 0) * SZ_WP1), nullptr, 512, 1024, 0}; break;
            case 4: jb = TJob{a.in[I_WPB] + (size_t)l * 512 * 1024, (bf16_t*)(ws + O_WP + (l * 3 + 1) * SZ_WP1), nullptr, 512, 1024, 0}; break;
            case 5: jb = TJob{a.in[I_WPC] + (size_t)l * 512 * 1024, (bf16_t*)(ws + O_WP + (l * 3 + 2) * SZ_WP1), nullptr, 512, 1024, 0}; break;
            default: jb = TJob{a.in[I_WOUT] + (size_t)l * 1024 * 1024, (bf16_t*)(ws + O_WOUT + l * SZ_WOUT1), nullptr, 1024, 1024, 0}; break;
        }
        return true; }
    if (j == 14) { jb = TJob{a.in[I_WFFG], (bf16_t*)(ws + O_WFFGU), a.in[I_GFFN], 1024, DFF, 3}; return true; }
    if (j == 15) { jb = TJob{a.in[I_WFFU], (bf16_t*)(ws + O_WFFGU), a.in[I_GFFN], 1024, DFF, 4}; return true; }
    if (j == 16) { jb = TJob{a.in[I_WFFD], (bf16_t*)(ws + O_WFFD), nullptr, DFF, 1024, 0}; return true; }
    return false;
}
__device__ __forceinline__ bool expert_job(const Ctx& a, int j, TJob& jb) {
    if (j >= 24) return false;
    unsigned char* ws = a.ws; const int e = j / 3, k = j % 3;
    if (k == 0) jb = TJob{a.in[I_WEG] + (size_t)e * 1024 * DFE, (bf16_t*)(ws + O_WEGU) + (size_t)e * 2 * DFE * 1024, a.in[I_GFFN] + 1024, 1024, DFE, 3};
    else if (k == 1) jb = TJob{a.in[I_WEU] + (size_t)e * 1024 * DFE, (bf16_t*)(ws + O_WEGU) + (size_t)e * 2 * DFE * 1024, a.in[I_GFFN] + 1024, 1024, DFE, 4};
    else jb = TJob{a.in[I_WED] + (size_t)e * DFE * 1024, (bf16_t*)(ws + O_WED) + (size_t)e * 1024 * DFE, nullptr, DFE, 1024, 0};
    return true;
}
template <bool EXPERTS>
__device__ __forceinline__ void run_transposes(const Ctx& a, LAS unsigned char* lds, int gw, int NGW, int wave, int lane) {
    LAS float* scr = (LAS float*)(lds + wave * 16384);
    TJob jb;
    for (int j = 0; EXPERTS ? expert_job(a, j, jb) : common_job(a, j, jb); ++j) {
        const int nitems = (jb.K / 64) * (jb.N / 32);
        for (int it = gw; it < nitems; it += NGW) transpose_item(jb, scr, it, lane);
    }
}
__device__ __forceinline__ void phase_prologue(const Ctx& a, LAS unsigned char* lds, int vcu, int G, int tid) {
    const int wave = __builtin_amdgcn_readfirstlane(tid >> 6), lane = tid & 63, gw = vcu * NWAVES + wave, NGW = G * NWAVES;
    unsigned char* ws = a.ws;
    run_transposes<false>(a, lds, gw, NGW, wave, lane);
    for (int l = 0; l < 2; ++l) { u32x4* p = (u32x4*)(ws + O_WIN + l * SZ_WIN1 + (size_t)6464 * 1024 * 2); const int n16 = 192 * 1024 * 2 / 16;
        for (int i = gw * 64 + lane; i < n16; i += NGW * 64) p[i] = (u32x4){0u, 0u, 0u, 0u}; }
    float* ta = (float*)(ws + O_TABA); float* tb = (float*)(ws + O_TABB);
    for (int i = gw * 64 + lane; i < T * 32; i += NGW * 64) { const int t = i >> 5, k = i & 31, blk = k >> 4, fi = k & 15;
        const float inv = exp2f(-(float)fi * (13.287712379549449f / 16.0f)); const float pos = (float)(blk ? (t & 63) : (t >> 6)); const float ang = pos * inv;
        ta[t * 64 + k] = cosf(ang); ta[t * 64 + 32 + k] = sinf(ang); }
    for (int i = gw * 64 + lane; i < T * 16; i += NGW * 64) { const int t = i >> 4, k = i & 15, blk = k >> 3, fi = k & 7;
        const float inv = exp2f(-(float)fi * (13.287712379549449f / 8.0f)); const float pos = (float)(blk ? (t & 63) : (t >> 6)); const float ang = pos * inv;
        tb[t * 32 + k] = cosf(ang); tb[t * 32 + 16 + k] = sinf(ang); }
    const float* x = a.in[I_X]; bf16_t* XB = (bf16_t*)(ws + O_XB); float* ssq = (float*)(ws + O_SSQ);
    for (int m = gw; m < M; m += NGW) {
        const f32x4* xr = (const f32x4*)(x + (size_t)m * D) + lane; float s = 0.f;
#pragma unroll
        for (int j = 0; j < 4; ++j) { const f32x4 v = xr[64 * j]; s += (v.x * v.x + v.y * v.y) + (v.z * v.z + v.w * v.w);
            *(u32x2*)(XB + (size_t)m * D + (lane + 64 * j) * 4) = (u32x2){pk2(v.x, v.y), pk2(v.z, v.w)}; }
        s = wave_sum(s);
        if (lane < 16) ssq[(size_t)m * 16 + lane] = lane == 0 ? s : 0.f;
    }
}

template <bool WRITE_LA>
__device__ __forceinline__ void post_item(const Ctx& a, int layer, int it, LAS unsigned char* lds, int tid) {
    unsigned char* ws = a.ws; const int wave = __builtin_amdgcn_readfirstlane(tid >> 6), lane = tid & 63;
    const bf16_t* P = (const bf16_t*)(ws + O_P); const float* ta = (const float*)(ws + O_TABA); const float* tb = (const float*)(ws + O_TABB);
    bf16_t* QA = (bf16_t*)(ws + O_QA); bf16_t* KA = (bf16_t*)(ws + O_KA); bf16_t* KR = (bf16_t*)(ws + O_KROPE);
    const int r0 = it * 64;
    LAS float* caf = (LAS float*)lds;
    __syncthreads();
    for (int i = tid; i < 64 * 32; i += NTHR) { const int r = i >> 5, j = i & 31; caf[i] = bf2f(P[(size_t)(r0 + r) * PW + PC_SMALL + 32 + j]); }
    const float* gaq = a.in[I_GAQ] + layer * 64; const float* gak = a.in[I_GAK] + layer * 64;
    for (int j = 0; j < 8; ++j) {
        const int row = r0 + wave * 8 + j, t = row & (T - 1);
        {
            const int seg = lane & 7; float x[8]; load8(P + (size_t)row * PW + PC_AQ + lane * 8, x);
            float ss = 0.f;
#pragma unroll
            for (int e = 0; e < 8; ++e) ss += x[e] * x[e];
            ss += __shfl_xor(ss, 1); ss += __shfl_xor(ss, 2); ss += __shfl_xor(ss, 4);
            const float rstd = rsqrtf(ss * (1.0f / 64.0f) + EPS); const int tb_ = t * 64 + (seg >> 2) * 16 + (seg & 1) * 8; float o[8];
#pragma unroll
            for (int e = 0; e < 8; ++e) { const float xn = x[e] * rstd * gaq[seg * 8 + e]; const float pr = __shfl_xor(xn, 2); const float cs = ta[tb_ + e], sn = ta[tb_ + 32 + e];
                o[e] = ((seg & 2) ? xn * cs + pr * sn : xn * cs - pr * sn) * C2A; }
            store8(QA + (size_t)row * 512 + lane * 8, o);
        }
        {
            const int l2 = lane & 15, seg = l2 & 7; float x[8]; load8(P + (size_t)row * PW + PC_AK + l2 * 8, x);
            float ss = 0.f;
#pragma unroll
            for (int e = 0; e < 8; ++e) ss += x[e] * x[e];
            ss += __shfl_xor(ss, 1); ss += __shfl_xor(ss, 2); ss += __shfl_xor(ss, 4);
            const float rstd = rsqrtf(ss * (1.0f / 64.0f) + EPS); const int tb_ = t * 64 + (seg >> 2) * 16 + (seg & 1) * 8; float o[8];
#pragma unroll
            for (int e = 0; e < 8; ++e) { const float xn = x[e] * rstd * gak[seg * 8 + e]; const float pr = __shfl_xor(xn, 2); const float cs = ta[tb_ + e], sn = ta[tb_ + 32 + e];
                o[e] = (seg & 2) ? xn * cs + pr * sn : xn * cs - pr * sn; }
            if (lane < 16) store8(KA + (size_t)row * 128 + l2 * 8, o);
        }
        {
            const int seg = lane & 3; float x[8]; load8(P + (size_t)row * PW + PC_SMALL + seg * 8, x);
            const int tb_ = t * 32 + (seg >> 1) * 8; float o[8];
#pragma unroll
            for (int e = 0; e < 8; ++e) { const float pr = __shfl_xor(x[e], 1); const float cs = tb[tb_ + e], sn = tb[tb_ + 16 + e];
                o[e] = (seg & 1) ? x[e] * cs + pr * sn : x[e] * cs - pr * sn; }
            if (lane < 4) store8(KR + (size_t)row * 32 + seg * 8, o);
        }
    }
    __syncthreads();
    const int col = tid;
    for (int dir = 0; dir < 2; ++dir) {
        const float* Wup = a.in[dir ? I_WCAB : I_WCAF] + (size_t)layer * 16 * 512; const float bias = a.in[dir ? I_BCAB : I_BCAF][layer * 512 + col];
        float w[16];
#pragma unroll
        for (int j = 0; j < 16; ++j) w[j] = Wup[j * 512 + col];
        bf16_t* QT = (bf16_t*)(ws + O_QT) + (size_t)(dir * 2) * M * 512; bf16_t* KT = QT + (size_t)M * 512;
        float* LA = (float*)(ws + O_QT) + (size_t)dir * M * 512;
        float b = 0.f;
        for (int s = 0; s < 64; ++s) {
            const int r = dir ? 63 - s : s; const LAS float* cr = caf + r * 32 + dir * 16; float z = bias;
#pragma unroll
            for (int j = 0; j < 16; ++j) z = fmaf(cr[j], w[j], z);
            const float la = (fminf(z, 0.f) - __logf(1.0f + __expf(-fabsf(z)))) * (1.0f / 16.0f);
            b += la;
            const size_t row = (size_t)(r0 + r);
            if (WRITE_LA) LA[row * 512 + col] = la;
            else { const float e = __expf(b); const float q = bf2f(P[row * PW + PC_CQ + col]), k = bf2f(P[row * PW + PC_CK + col]);
                QT[row * 512 + col] = (bf16_t)f2bf(q * e * GLA_QSCALE); KT[row * 512 + col] = (bf16_t)f2bf(k / e); }
        }
        if (!WRITE_LA) ((float*)(ws + O_DEC))[(size_t)dir * 256 * 512 + (size_t)it * 512 + col] = __expf(b);
    }
}

template <int BR>
__device__ __forceinline__ void attn_naive_unit(const Ctx& a, int b, int h, int qb, LAS unsigned char* lds, int tid) {
    unsigned char* ws = a.ws; constexpr int DQ = BR ? 96 : 64;
    const bf16_t* P = (const bf16_t*)(ws + O_P);
    LAS float* Ks = (LAS float*)lds;
    LAS float* Vs = Ks + 64 * 96;
    LAS float* Qs = Vs + 64 * 64;
    const int r = tid >> 1, half = tid & 1; const size_t row0 = (size_t)b * T + qb * 256; const size_t row = row0 + r;
    __syncthreads();
    for (int i = tid; i < 256 * (DQ / 8); i += NTHR) { const int rr = i / (DQ / 8), ch = i % (DQ / 8); float f[8];
        if (BR == 0) load8((const bf16_t*)(ws + O_QA) + (row0 + rr) * 512 + h * 64 + ch * 8, f); else load8((const bf16_t*)(ws + O_QB) + (row0 + rr) * 768 + h * 96 + ch * 8, f);
#pragma unroll
        for (int e = 0; e < 8; ++e) Qs[rr * 97 + ch * 8 + e] = f[e]; }
    __syncthreads();
    if (BR == 1 && tid < 256) {
        const int t = (int)((row0 + tid) & (T - 1)); const float* tb = (const float*)(ws + O_TABB) + t * 32; LAS float* q = Qs + tid * 97 + 64;
        for (int blk = 0; blk < 2; ++blk)
            for (int e = 0; e < 8; ++e) { const float cs = tb[blk * 8 + e], sn = tb[16 + blk * 8 + e]; const float x1 = q[blk * 16 + e], x2 = q[blk * 16 + 8 + e];
                q[blk * 16 + e] = x1 * cs - x2 * sn; q[blk * 16 + 8 + e] = x2 * cs + x1 * sn; } }
    float m = -1e30f, l = 0.f, o[32];
#pragma unroll
    for (int j = 0; j < 32; ++j) o[j] = 0.f;
    for (int kt = 0; kt < T / 64; ++kt) {
        __syncthreads();
        for (int i = tid; i < 64 * (DQ / 8); i += NTHR) { const int kr = i / (DQ / 8), ch = i % (DQ / 8); const size_t krow = (size_t)b * T + kt * 64 + kr; float f[8];
            if (BR == 0) load8((const bf16_t*)(ws + O_KA) + krow * 128 + (h >> 2) * 64 + ch * 8, f);
            else if (ch < 8) load8((const bf16_t*)(ws + O_KNOPE) + krow * 512 + h * 64 + ch * 8, f);
            else load8((const bf16_t*)(ws + O_KROPE) + krow * 32 + (ch - 8) * 8, f);
#pragma unroll
            for (int e = 0; e < 8; ++e) Ks[kr * 96 + ch * 8 + e] = f[e]; }
        for (int i = tid; i < 64 * 8; i += NTHR) { const int kr = i >> 3, ch = i & 7; const size_t krow = (size_t)b * T + kt * 64 + kr; float f[8];
            if (BR == 0) load8(P + krow * PW + PC_AV + (h >> 2) * 64 + ch * 8, f); else load8((const bf16_t*)(ws + O_VB) + krow * 512 + h * 64 + ch * 8, f);
#pragma unroll
            for (int e = 0; e < 8; ++e) Vs[kr * 64 + ch * 8 + e] = f[e]; }
        __syncthreads();
#pragma unroll 1
        for (int kr = 0; kr < 64; ++kr) { float s = 0.f;
#pragma unroll 8
            for (int d = 0; d < DQ; ++d) s = fmaf(Qs[r * 97 + d], Ks[kr * 96 + d], s);
            if (s > m) { const float al = exp2f(m - s); l *= al;
#pragma unroll
                for (int j = 0; j < 32; ++j) o[j] *= al;
                m = s; }
            const float p = exp2f(s - m); l += p;
#pragma unroll
            for (int j = 0; j < 32; ++j) o[j] = fmaf(p, Vs[kr * 64 + half * 32 + j], o[j]); }
    }
    const float inv = 1.0f / l; bf16_t* Y = (bf16_t*)(ws + (BR ? O_YB : O_YA)) + row * 512 + h * 64 + half * 32;
#pragma unroll
    for (int j = 0; j < 32; j += 8) { float f[8];
#pragma unroll
        for (int e = 0; e < 8; ++e) f[e] = o[j + e] * inv;
        store8(Y + j, f); }
}

namespace att {
typedef short s16x4 __attribute__((ext_vector_type(4)));
typedef float f32x16 __attribute__((ext_vector_type(16)));
constexpr int SHM_V = 64 * 64 * 2, SHM_K = 64 * 256, OFF_K = 2 * SHM_V, OFF_WS = OFF_K + 2 * SHM_K, OFF_OST = OFF_WS + NWAVES * 64 * 4, ATT_LDS = OFF_OST + NWAVES * 4096;
constexpr float THRL = 8.0f;
#define KSWZ(row, colB) ((row) * 256 + ((colB) ^ (((row) & 7) << 4)))
#define SBAR() __builtin_amdgcn_sched_barrier(0)
__device__ __forceinline__ int crow(int r, int hi) { return (r & 3) + 8 * (r >> 2) + 4 * hi; }
__device__ __forceinline__ unsigned cvtpk(float lo, float hi) { unsigned r; asm volatile("v_cvt_pk_bf16_f32 %0, %1, %2" : "=v"(r) : "v"(lo), "v"(hi)); return r; }
__device__ __forceinline__ void partialSM(f32x16& p0, f32x16& p1, float& m_reg, float& mn, float& alpha) {
    float pmax = p0[0];
#pragma unroll
    for (int r = 1; r < 16; ++r) pmax = fmaxf(pmax, p0[r]);
#pragma unroll
    for (int r = 0; r < 16; ++r) pmax = fmaxf(pmax, p1[r]);
    { auto rr = __builtin_amdgcn_permlane32_swap(__float_as_uint(pmax), __float_as_uint(pmax), false, false); pmax = fmaxf(__uint_as_float(rr[0]), __uint_as_float(rr[1])); }
    if (__builtin_expect(__all(pmax - m_reg <= THRL), 1)) { mn = m_reg; alpha = 1.f; }
    else { mn = fmaxf(m_reg, pmax); alpha = __builtin_amdgcn_exp2f(m_reg - mn); m_reg = mn; }
#pragma unroll
    for (int r = 0; r < 16; ++r) { p0[r] -= mn; p1[r] -= mn; }
#pragma unroll
    for (int r = 0; r < 16; ++r) p0[r] = __builtin_amdgcn_exp2f(p0[r]);
}
__device__ __forceinline__ void finishSM(f32x16& p0, f32x16& p1, float alpha, float& l_reg, bf16x8& pa0, bf16x8& pa1, bf16x8& pa2, bf16x8& pa3) {
#pragma unroll
    for (int r = 0; r < 16; ++r) p1[r] = __builtin_amdgcn_exp2f(p1[r]);
    float ps = 0;
#pragma unroll
    for (int r = 0; r < 16; ++r) ps += p0[r];
#pragma unroll
    for (int r = 0; r < 16; ++r) ps += p1[r];
    { auto rr = __builtin_amdgcn_permlane32_swap(__float_as_uint(ps), __float_as_uint(ps), false, false); ps = __uint_as_float(rr[0]) + __uint_as_float(rr[1]); }
    l_reg = l_reg * alpha + ps;
#define PK4(P, BASE, OUT) do { unsigned a0 = cvtpk(P[BASE + 0], P[BASE + 1]), a1 = cvtpk(P[BASE + 2], P[BASE + 3]);   \
    unsigned b0 = cvtpk(P[BASE + 4], P[BASE + 5]), b1 = cvtpk(P[BASE + 6], P[BASE + 7]);                              \
    auto r0 = __builtin_amdgcn_permlane32_swap(a0, b0, false, false); auto r1 = __builtin_amdgcn_permlane32_swap(a1, b1, false, false); \
    u32x4 w = {r0[0], r1[0], r0[1], r1[1]}; OUT = __builtin_bit_cast(bf16x8, w); } while (0)
    PK4(p0, 0, pa0); PK4(p0, 8, pa1); PK4(p1, 0, pa2); PK4(p1, 8, pa3);
#undef PK4
}
template <int ND0>
__device__ __forceinline__ void qkt(f32x16& p0, f32x16& p1, const LAS unsigned char* Ks, const bf16x8* qr, int r32, int hi) {
    p0 = f32x16{}; p1 = f32x16{};
#pragma unroll
    for (int d0 = 0; d0 < ND0; ++d0) { const int cb = (d0 * 16 + hi * 8) * 2;
        const bf16x8 b0 = *(const LAS bf16x8*)(Ks + KSWZ(r32, cb)); const bf16x8 b1 = *(const LAS bf16x8*)(Ks + KSWZ(32 + r32, cb));
        p0 = __builtin_amdgcn_mfma_f32_32x32x16_bf16(b0, qr[d0], p0, 0, 0, 0); p1 = __builtin_amdgcn_mfma_f32_32x32x16_bf16(b1, qr[d0], p1, 0, 0, 0); }
}
__device__ __forceinline__ int v_st(int k, int c) { const int kk = (k & ~0xC) | ((k & 4) << 1) | ((k & 8) >> 1); return ((kk >> 3) * 2 + (c >> 5)) * 512 + ((kk & 7) * 32 + (c & 31)) * 2; }
__device__ __forceinline__ int v_rd_base(int lane) { return ((lane & 3) << 3) | (((lane >> 2) & 3) << 6) | (((lane >> 4) & 1) << 5) | (((lane >> 5) & 1) << 8); }
constexpr int v_rd_off(int d0, int ks, int half) { return d0 * 512 + ks * 2048 + half * 1024; }
template <int OFF> __device__ __forceinline__ s16x4 tr_read(int vb) { s16x4 r; asm volatile("ds_read_b64_tr_b16 %0, %1 offset:%2" : "=&v"(r) : "v"(vb), "i"(OFF) : "memory"); return r; }
template <int D0> __device__ __forceinline__ void pv_one(f32x16& od, int vb, bf16x8 pa0, bf16x8 pa1, bf16x8 pa2, bf16x8 pa3) {
    const s16x4 l0 = tr_read<v_rd_off(D0, 0, 0)>(vb), h0 = tr_read<v_rd_off(D0, 0, 1)>(vb), l1 = tr_read<v_rd_off(D0, 1, 0)>(vb), h1 = tr_read<v_rd_off(D0, 1, 1)>(vb);
    const s16x4 l2 = tr_read<v_rd_off(D0, 2, 0)>(vb), h2 = tr_read<v_rd_off(D0, 2, 1)>(vb), l3 = tr_read<v_rd_off(D0, 3, 0)>(vb), h3 = tr_read<v_rd_off(D0, 3, 1)>(vb);
    asm volatile("s_waitcnt lgkmcnt(0)" ::: "memory"); SBAR();
#define PK(L, H) (bf16x8){L[0], L[1], L[2], L[3], H[0], H[1], H[2], H[3]}
    od = __builtin_amdgcn_mfma_f32_32x32x16_bf16(pa0, PK(l0, h0), od, 0, 0, 0);
    od = __builtin_amdgcn_mfma_f32_32x32x16_bf16(pa1, PK(l1, h1), od, 0, 0, 0);
    od = __builtin_amdgcn_mfma_f32_32x32x16_bf16(pa2, PK(l2, h2), od, 0, 0, 0);
    od = __builtin_amdgcn_mfma_f32_32x32x16_bf16(pa3, PK(l3, h3), od, 0, 0, 0);
#undef PK
}
__device__ __forceinline__ void pv2(f32x16* o, int vb, bf16x8 pa0, bf16x8 pa1, bf16x8 pa2, bf16x8 pa3) { pv_one<0>(o[0], vb, pa0, pa1, pa2, pa3); pv_one<1>(o[1], vb, pa0, pa1, pa2, pa3); }

template <int BR>
__device__ __forceinline__ void unit(const Ctx& a, int b, int h, int qb, LAS unsigned char* lds, int tid) {
    unsigned char* ws = a.ws; constexpr int DQ = BR ? 96 : 64, ND0 = DQ / 16, NKL = BR ? 2 : 1;
    const int wid = __builtin_amdgcn_readfirstlane(tid >> 6), lane = tid & 63, r32 = lane & 31, hi = lane >> 5;
    LAS unsigned char* V_lds = lds; LAS unsigned char* K_lds = lds + OFF_K;
    LAS float* wsf = (LAS float*)(lds + OFF_WS) + wid * 64; LAS float* li_l = wsf; LAS float* al_l = wsf + 32;
    const size_t row0 = (size_t)b * T + qb * 256, krow0 = (size_t)b * T;
    float m_reg = -1e30f, l_reg = 0; f32x16 o[2]; o[0] = f32x16{}; o[1] = f32x16{}; bf16x8 qr[ND0];
    {
        const size_t qrow = row0 + wid * 32 + r32;
        const bf16_t* Qw = BR ? (const bf16_t*)(ws + O_QB) + qrow * 768 + h * 96 + hi * 8 : (const bf16_t*)(ws + O_QA) + qrow * 512 + h * 64 + hi * 8;
#pragma unroll
        for (int d0 = 0; d0 < ND0; ++d0) qr[d0] = *(const bf16x8*)(Qw + d0 * 16);
        if (BR) {
            const float* tb = (const float*)(ws + O_TABB) + (int)(qrow & (T - 1)) * 32;
#pragma unroll
            for (int blk = 0; blk < 2; ++blk) { float x[8]; unpack8(__builtin_bit_cast(u32x4, qr[4 + blk]), x); float o8[8];
#pragma unroll
                for (int e = 0; e < 8; ++e) { const float pr = __shfl_xor(x[e], 32); const float cs = tb[blk * 8 + e], sn = tb[16 + blk * 8 + e]; o8[e] = hi ? x[e] * cs + pr * sn : x[e] * cs - pr * sn; }
                qr[4 + blk] = __builtin_bit_cast(bf16x8, pack8(o8)); } }
    }
    const int vr = tid >> 3, vc = (tid & 7) * 8, vst = v_st(vr, vc);
    int kr_[NKL], kc_[NKL];
#pragma unroll
    for (int i = 0; i < NKL; ++i) { int c = tid + i * 512; if (BR) { if (c >= 768) c -= 512; kr_[i] = c / 12; kc_[i] = c % 12; } else { kr_[i] = c >> 3; kc_[i] = c & 7; } }
    const bf16_t* Vsrc = BR ? (const bf16_t*)(ws + O_VB) + (krow0 + vr) * 512 + h * 64 + vc : (const bf16_t*)(ws + O_P) + (krow0 + vr) * PW + PC_AV + (h >> 2) * 64 + vc;
    const size_t vstep = (size_t)64 * (BR ? 512 : PW);
    const bf16_t* Ksrc[NKL]; size_t kstep_[NKL];
#pragma unroll
    for (int i = 0; i < NKL; ++i) {
        if (!BR) { Ksrc[i] = (const bf16_t*)(ws + O_KA) + (krow0 + kr_[i]) * 128 + (h >> 2) * 64 + kc_[i] * 8; kstep_[i] = (size_t)64 * 128; }
        else if (kc_[i] < 8) { Ksrc[i] = (const bf16_t*)(ws + O_KNOPE) + (krow0 + kr_[i]) * 512 + h * 64 + kc_[i] * 8; kstep_[i] = (size_t)64 * 512; }
        else { Ksrc[i] = (const bf16_t*)(ws + O_KROPE) + (krow0 + kr_[i]) * 32 + (kc_[i] - 8) * 8; kstep_[i] = (size_t)64 * 32; } }
    const bool k1_valid = !BR || tid < 256;
    const int vb0 = (int)(uintptr_t)V_lds + v_rd_base(lane);
    struct { bf16x8 v, k[NKL]; } sr_[2];
#define SLOAD(i, t) do { sr_[i].v = *(const bf16x8*)(Vsrc + (size_t)(t) * vstep); _Pragma("unroll") for (int q_ = 0; q_ < NKL; ++q_) sr_[i].k[q_] = *(const bf16x8*)(Ksrc[q_] + (size_t)(t) * kstep_[q_]); } while (0)
#define SWRITE(bb, i) do { *(LAS bf16x8*)(V_lds + (bb) * SHM_V + vst) = sr_[i].v; *(LAS bf16x8*)(K_lds + (bb) * SHM_K + KSWZ(kr_[0], kc_[0] * 16)) = sr_[i].k[0]; \
        if (NKL > 1) { if (k1_valid) *(LAS bf16x8*)(K_lds + (bb) * SHM_K + KSWZ(kr_[NKL - 1], kc_[NKL - 1] * 16)) = sr_[i].k[NKL - 1]; } } while (0)
#define RESC(al) do { if (__any((al) < 1.f)) { if (hi == 0) al_l[r32] = (al); asm volatile("s_waitcnt lgkmcnt(0)" ::: "memory"); \
        _Pragma("unroll") for (int d = 0; d < 2; ++d) _Pragma("unroll") for (int r = 0; r < 16; ++r) o[d][r] *= al_l[crow(r, hi)]; } } while (0)
    f32x16 pA0, pA1, pB0, pB1; float mnA, mnB, alA, alB; bf16x8 pa0, pa1, pa2, pa3; constexpr int NT = T / 64;
    __syncthreads();
    SLOAD(0, 0); SWRITE(0, 0); __syncthreads();
    qkt<ND0>(pA0, pA1, K_lds, qr, r32, hi); partialSM(pA0, pA1, m_reg, mnA, alA);
    SLOAD(1, 1); SLOAD(0, 2);
    SWRITE(1, 1); __syncthreads();
    for (int j = 1; j + 1 < NT; j += 2) {
        SBAR(); qkt<ND0>(pB0, pB1, K_lds + SHM_K, qr, r32, hi);
        finishSM(pA0, pA1, alA, l_reg, pa0, pa1, pa2, pa3); SBAR();
        SLOAD(1, j + 2); SBAR();
        pv2(o, vb0, pa0, pa1, pa2, pa3); partialSM(pB0, pB1, m_reg, mnB, alB);
        __syncthreads(); SWRITE(0, 0);
        RESC(alB); __syncthreads();
        SBAR(); qkt<ND0>(pA0, pA1, K_lds, qr, r32, hi);
        finishSM(pB0, pB1, alB, l_reg, pa0, pa1, pa2, pa3); SBAR();
        if (j + 3 < NT) SLOAD(0, j + 3); SBAR();
        pv2(o, vb0 + SHM_V, pa0, pa1, pa2, pa3); partialSM(pA0, pA1, m_reg, mnA, alA);
        __syncthreads(); SWRITE(1, 1);
        RESC(alA); __syncthreads();
    }
    SBAR(); qkt<ND0>(pB0, pB1, K_lds + SHM_K, qr, r32, hi);
    finishSM(pA0, pA1, alA, l_reg, pa0, pa1, pa2, pa3); SBAR();
    pv2(o, vb0, pa0, pa1, pa2, pa3); partialSM(pB0, pB1, m_reg, mnB, alB);
    __syncthreads(); RESC(alB);
    finishSM(pB0, pB1, alB, l_reg, pa0, pa1, pa2, pa3); SBAR();
    pv2(o, vb0 + SHM_V, pa0, pa1, pa2, pa3);
    if (hi == 0) li_l[r32] = l_reg; asm volatile("s_waitcnt lgkmcnt(0)" ::: "memory");
    float rli[16];
#pragma unroll
    for (int r = 0; r < 16; ++r) rli[r] = __builtin_amdgcn_rcpf(li_l[crow(r, hi)]);
    LAS bf16_t* stg = (LAS bf16_t*)(lds + OFF_OST) + wid * 2048;
#pragma unroll
    for (int r = 0; r < 16; ++r) { const int orow = crow(r, hi);
#pragma unroll
        for (int d0 = 0; d0 < 2; ++d0) stg[orow * 64 + d0 * 32 + r32] = (bf16_t)f2bf(o[d0][r] * rli[r]); }
    asm volatile("s_waitcnt lgkmcnt(0)" ::: "memory");
    bf16_t* Y = (bf16_t*)(ws + (BR ? O_YB : O_YA)) + (row0 + wid * 32) * 512 + h * 64;
#pragma unroll
    for (int i = 0; i < 4; ++i) { const int row = i * 8 + (lane >> 3), ch = lane & 7; const u32x4 v = *(const LAS u32x4*)(stg + row * 64 + ch * 8); *(u32x4*)(Y + (size_t)row * 512 + ch * 8) = v; }
#undef SLOAD
#undef SWRITE
#undef RESC
}
#undef KSWZ
#undef SBAR
}

__device__ __forceinline__ void gla_naive_unit(const Ctx& a, int layer, int b, int h, LAS unsigned char* lds, int tid) {
    unsigned char* ws = a.ws; const bf16_t* P = (const bf16_t*)(ws + O_P); bf16_t* YC = (bf16_t*)(ws + O_YC);
    LAS float* qs = (LAS float*)lds; LAS float* ks = qs + 128; LAS float* as = ks + 128; LAS float* part = as + 128; LAS float* red = part + 512;
    const int j = tid & 127, qd = tid >> 7; const float gco = a.in[I_GCOUT][layer * 128 + j];
    for (int dir = 0; dir < 2; ++dir) {
        const float* LA = (const float*)(ws + O_QT) + (size_t)dir * M * 512;
        float S[32];
#pragma unroll
        for (int i = 0; i < 32; ++i) S[i] = 0.f;
        for (int step = 0; step < T; ++step) {
            const int tok = dir ? T - 1 - step : step; const size_t row = (size_t)b * T + tok;
            __syncthreads();
            if (tid < 128) { qs[tid] = bf2f(P[row * PW + PC_CQ + h * 128 + tid]) * GLA_QSCALE; ks[tid] = bf2f(P[row * PW + PC_CK + h * 128 + tid]); as[tid] = __expf(LA[row * 512 + h * 128 + tid]); }
            const float v = bf2f(P[row * PW + PC_CV + h * 128 + j]);
            __syncthreads();
            float o = 0.f;
#pragma unroll
            for (int i = 0; i < 32; ++i) { const int dk = qd * 32 + i; S[i] = as[dk] * S[i] + ks[dk] * v; o = fmaf(qs[dk], S[i], o); }
            part[qd * 128 + j] = o;
            __syncthreads();
            float v2 = 0.f;
            if (tid < 128) {
                const float tot = (part[tid] + part[128 + tid]) + (part[256 + tid] + part[384 + tid]);
                if (dir == 0) YC[row * 512 + h * 128 + tid] = (bf16_t)f2bf(tot);
                else { v2 = tot + bf2f(YC[row * 512 + h * 128 + tid]); const float ss = wave_sum(v2 * v2); if ((tid & 63) == 0) red[tid >> 6] = ss; }
            }
            if (dir == 1) {
                __syncthreads();
                if (tid < 128) {
                    const float rstd = rsqrtf((red[0] + red[1]) * (1.0f / 128.0f) + EPS);
                    const float g = bf2f(P[row * PW + PC_CG + h * 128 + tid]);
                    YC[row * 512 + h * 128 + tid] = (bf16_t)f2bf(v2 * rstd * gco * (g * sigmoidf_(g)));
                }
            }
        }
    }
}

__device__ __forceinline__ void router_item(const Ctx& a, int blk, LAS unsigned char* lds, int tid) {
    unsigned char* ws = a.ws; int* mi = (int*)(ws + O_MOEI); float* mf = (float*)(ws + O_MOEI);
    const int wave = __builtin_amdgcn_readfirstlane(tid >> 6), lane = tid & 63;
    LAS float* lg = (LAS float*)lds;
    const float* x1 = a.out; const float* g = a.in[I_GFFN] + 1024; const float* wr = a.in[I_WROUTER];
    __syncthreads();
    for (int j = 0; j < 8; ++j) {
        const int tok = blk * 64 + wave * 8 + j; float acc[8], ss = 0.f;
#pragma unroll
        for (int e = 0; e < 8; ++e) acc[e] = 0.f;
#pragma unroll
        for (int jj = 0; jj < 4; ++jj) { const int idx = (lane + 64 * jj) * 4; const f32x4 v = *(const f32x4*)(x1 + (size_t)tok * D + idx), gg = *(const f32x4*)(g + idx);
            ss += (v.x * v.x + v.y * v.y) + (v.z * v.z + v.w * v.w);
            const float hv[4] = {v.x * gg.x, v.y * gg.y, v.z * gg.z, v.w * gg.w};
#pragma unroll
            for (int c = 0; c < 4; ++c) { const f32x4 w0 = *(const f32x4*)(wr + (size_t)(idx + c) * 8), w1 = *(const f32x4*)(wr + (size_t)(idx + c) * 8 + 4);
                acc[0] = fmaf(hv[c], w0.x, acc[0]); acc[1] = fmaf(hv[c], w0.y, acc[1]); acc[2] = fmaf(hv[c], w0.z, acc[2]); acc[3] = fmaf(hv[c], w0.w, acc[3]);
                acc[4] = fmaf(hv[c], w1.x, acc[4]); acc[5] = fmaf(hv[c], w1.y, acc[5]); acc[6] = fmaf(hv[c], w1.z, acc[6]); acc[7] = fmaf(hv[c], w1.w, acc[7]); } }
        ss = wave_sum(ss); const float rstd = rsqrtf(ss * (1.0f / 1024.0f) + EPS);
#pragma unroll
        for (int e = 0; e < 8; ++e) { const float s = wave_sum(acc[e]); if (lane == 0) lg[(wave * 8 + j) * 8 + e] = s * rstd; }
    }
    __syncthreads();
    if (wave == 0) {
        const int tok = blk * 64 + lane; float v[8];
#pragma unroll
        for (int e = 0; e < 8; ++e) v[e] = lg[lane * 8 + e];
        int e1 = 0; float v1 = v[0];
#pragma unroll
        for (int e = 1; e < 8; ++e) if (v[e] > v1) { v1 = v[e]; e1 = e; }
        int e2 = -1; float v2 = -3.0e38f;
#pragma unroll
        for (int e = 0; e < 8; ++e) if (e != e1 && v[e] > v2) { v2 = v[e]; e2 = e; }
        const float w1 = 1.0f / (1.0f + __expf(v2 - v1)), w2 = 1.0f - w1;
        const unsigned long long lt = (1ull << lane) - 1ull; int ra = 0, rb = 0, mycnt = 0;
#pragma unroll
        for (int e = 0; e < 8; ++e) { const unsigned long long m0 = __ballot(e1 == e), m1 = __ballot(e2 == e); const int c0 = __popcll(m0);
            if (e1 == e) ra = __popcll(m0 & lt); if (e2 == e) rb = c0 + __popcll(m1 & lt); if (lane == e) mycnt = c0 + __popcll(m1); }
        mi[MI_TOKE + tok] = e1 | (e2 << 8); mi[MI_TOKR + tok] = ra | (rb << 16); mf[MI_TOKW + tok * 2] = w1; mf[MI_TOKW + tok * 2 + 1] = w2;
        if (lane < 8) mi[MI_CNT + blk * 8 + lane] = mycnt;
    }
}
__device__ __forceinline__ void positions_phase(const Ctx& a, LAS unsigned char* lds, int G, int bid, int tid) {
    unsigned char* ws = a.ws; int* mi = (int*)(ws + O_MOEI); float* mf = (float*)(ws + O_MOEI);
    LAS int* cnt = (LAS int*)lds; LAS int* base = cnt + 2048;
    __syncthreads();
    for (int i = tid; i < 2048; i += NTHR) cnt[i] = mi[MI_CNT + i];
    __syncthreads();
    if (tid < 8) { int run = 0; for (int b = 0; b < 256; ++b) { const int c = cnt[b * 8 + tid]; cnt[b * 8 + tid] = run; run += c; } base[8 + tid] = run; }
    __syncthreads();
    if (tid == 0) { int off = 0; for (int e = 0; e < 8; ++e) { base[e] = off; off += (base[8 + e] + 255) & ~255; } base[16] = off >> 8; }
    __syncthreads();
    if (bid == 0) {
        const int nt = base[16];
        for (int t = tid; t < nt; t += NTHR) { int e = 0;
#pragma unroll
            for (int k = 1; k < 8; ++k) if (t * 256 >= base[k]) e = k;
            mi[MI_TILEE + t] = e; }
        if (tid == 0) mi[MI_TILEE + MAXTILES] = nt;
        for (int e = 0; e < 8; ++e) { const int lo = base[e] + base[8 + e], hi = base[e] + ((base[8 + e] + 255) & ~255);
            for (int r = lo + tid; r < hi; r += NTHR) { mi[MI_ROWTOK + r] = 0; mf[MI_ROWW + r] = 0.f; } }
    }
    for (int blk = bid; blk < 256; blk += G) if (tid < 64) {
        const int tok = blk * 64 + tid; const int ee = mi[MI_TOKE + tok], rr = mi[MI_TOKR + tok]; const int e1 = ee & 255, e2 = ee >> 8;
        const int pa = base[e1] + cnt[blk * 8 + e1] + (rr & 0xffff), pb = base[e2] + cnt[blk * 8 + e2] + (rr >> 16);
        mi[MI_ROWTOK + pa] = tok; mf[MI_ROWW + pa] = mf[MI_TOKW + tok * 2]; mi[MI_ROWTOK + pb] = tok; mf[MI_ROWW + pb] = mf[MI_TOKW + tok * 2 + 1];
        mi[MI_TOKPOS + tok * 2] = pa; mi[MI_TOKPOS + tok * 2 + 1] = pb;
    }
}
__device__ __forceinline__ void final_phase(const Ctx& a, int gw, int NGW, int lane) {
    unsigned char* ws = a.ws; const int* mi = (const int*)(ws + O_MOEI); const bf16_t* OUTS = (const bf16_t*)(ws + O_OUTS); const float* gf = a.in[I_GFINAL];
    for (int m = gw; m < M; m += NGW) {
        const int pa = mi[MI_TOKPOS + m * 2], pb = mi[MI_TOKPOS + m * 2 + 1]; f32x4 v[4]; float s = 0.f;
#pragma unroll
        for (int j = 0; j < 4; ++j) { const int idx = (lane + 64 * j) * 4; v[j] = *(const f32x4*)(a.out + (size_t)m * D + idx);
            const u32x2 ua = *(const u32x2*)(OUTS + (size_t)pa * 1024 + idx), ub = *(const u32x2*)(OUTS + (size_t)pb * 1024 + idx);
            v[j].x += bf2f(ua.x & 0xffffu) + bf2f(ub.x & 0xffffu); v[j].y += bf2f(ua.x >> 16) + bf2f(ub.x >> 16); v[j].z += bf2f(ua.y & 0xffffu) + bf2f(ub.y & 0xffffu); v[j].w += bf2f(ua.y >> 16) + bf2f(ub.y >> 16);
            s += (v[j].x * v[j].x + v[j].y * v[j].y) + (v[j].z * v[j].z + v[j].w * v[j].w); }
        s = wave_sum(s); const float rstd = rsqrtf(s * (1.0f / 1024.0f) + EPS);
#pragma unroll
        for (int j = 0; j < 4; ++j) { const int idx = (lane + 64 * j) * 4; const f32x4 g = *(const f32x4*)(gf + idx);
            *(f32x4*)(a.out + (size_t)m * D + idx) = (f32x4){v[j].x * rstd * g.x, v[j].y * rstd * g.y, v[j].z * rstd * g.z, v[j].w * rstd * g.w}; }
    }
}

#ifndef FAST_MASK
#define FAST_MASK 0x1ff
#endif
template <int SITE, bool GATHER = false, class Sched, class Epi>
__device__ __forceinline__ void gemm_run(LAS unsigned char* lds, const Sched& S, const Epi& E, int K, int lda) {
    if constexpr (NAIVE_GEMM || !((FAST_MASK >> SITE) & 1)) gemm_naive(S, E, K, lda);
    else pg8::gemm_phase<GATHER>(lds, S, E, K, lda);
}

constexpr int NPHASE = 18;
__global__ void __launch_bounds__(NTHR, 2) mega_fwd(Args args) {
    extern __shared__ __attribute__((aligned(16))) unsigned char lds_raw[];
    LAS unsigned char* lds = (LAS unsigned char*)lds_raw;
    { const int tid0 = threadIdx.x; for (int u = tid0; u < (LDS_BYTES - LDS_CTL) / 4; u += NTHR) ((LAS unsigned*)(lds + LDS_CTL))[u] = 0u; }
    __syncthreads();
    XcdBarrier bar; bar.bar = (unsigned*)args.ws + CW_BAR; bar.x = 0; bar.st = nullptr;
#if N_LAUNCH_MODE == 1
    bar = xcd_barrier_post((unsigned*)args.ws + CW_BAR, (volatile LAS unsigned*)(lds + LDS_MISC) + 8);
#endif
    const int lo = args.ph_lo, hi = args.ph_hi;
#define IN(k) in_phase(lo, hi, (k))
#if N_LAUNCH_MODE == 1
#define SEAM(k) do { if (IN(k) && IN((k) + 1)) xcd_barrier(bar); } while (0)
#else
#define SEAM(k) do { } while (0)
#endif
#define PH_BEGIN unsigned char* ws = launder_s(args.ws); const Ctx A{(const float* const*)(ws + O_PTAB), args.out, ws}; const int tid = launder_v((int)threadIdx.x); \
    const int G = launder_i((int)gridDim.x), bid = launder_i((int)blockIdx.x); \
    const int lane = tid & 63, wave = __builtin_amdgcn_readfirstlane(tid >> 6); const int vcu = (G % 8 == 0) ? (bid % 8) * (G / 8) + bid / 8 : bid; \
    const int gw = vcu * NWAVES + wave, NGW = G * NWAVES; (void)lane; (void)gw; (void)NGW; (void)ws;

    if (IN(0)) {
        if (threadIdx.x == 0) { const float** tab = (const float**)(args.ws + O_PTAB);
#pragma unroll
            for (int i = 0; i < 28; ++i) tab[i] = args.in[i]; }
        asm volatile("s_waitcnt vmcnt(0)" ::: "memory"); __syncthreads();
        PH_BEGIN; phase_prologue(A, lds, vcu, G, tid); SEAM(0); }

    for (int l = 0; l < 2; ++l) {
        const int pb = l ? 8 : 1;
        if (IN(pb)) {
            PH_BEGIN;
            SchedDense S{(const bf16_t*)(ws + O_XB), (const bf16_t*)(ws + O_WIN + l * SZ_WIN1), 1024, 1024, 64, NIN / 256, G, bid};
            EpiInProj E{(bf16_t*)(ws + O_P), (bf16_t*)(ws + O_GATES), (const float*)(ws + O_SSQ), A.in[I_BGATE] + l * 3072, (float*)(ws + O_RSP)};
            gemm_run<0>(lds, S, E, 1024, 1024);
            SEAM(pb);
        }
        if (IN(pb + 1)) {
            PH_BEGIN;
            for (int it = bid; it < 256; it += G) post_item<(NAIVE_GLA != 0)>(A, l, it, lds, tid);
            __syncthreads();
            SchedUp S{(const bf16_t*)(ws + O_P), (const bf16_t*)(ws + O_WQUP + l * SZ_WQUP1), (const bf16_t*)(ws + O_WKVUP + l * SZ_WKVUP1), G, bid};
            EpiUpProj E{(const float*)(ws + O_RSP), (bf16_t*)(ws + O_QB), (bf16_t*)(ws + O_KNOPE), (bf16_t*)(ws + O_VB)};
            gemm_run<1>(lds, S, E, 256, PW);
            SEAM(pb + 1);
        }
        if (IN(pb + 2)) {
            PH_BEGIN;
            unsigned* qh = (unsigned*)ws + CW_Q + 64 * l; LAS unsigned* slot = (LAS unsigned*)(lds + LDS_CTL + 64);
            for (;;) {
                __syncthreads();
                if (tid == 0) *slot = __hip_atomic_fetch_add(qh, 1u, __ATOMIC_RELAXED, __HIP_MEMORY_SCOPE_AGENT);
                __syncthreads();
                const int u = (int)*slot;
                if (u >= 64 + 1024) break;
                if (u < 64) gla_naive_unit(A, l, u >> 2, u & 3, lds, tid);
                #if NAIVE_ATTN
                else if (u < 64 + 512) { const int v = u - 64; attn_naive_unit<1>(A, v >> 6, (v >> 3) & 7, v & 7, lds, tid); }
                else { const int v = u - 576; attn_naive_unit<0>(A, v >> 6, (v >> 3) & 7, v & 7, lds, tid); }
#else
                else if (u < 64 + 512) { const int v = u - 64; att::unit<1>(A, v >> 6, (v >> 3) & 7, v & 7, lds, tid); }
                else { const int v = u - 576; att::unit<0>(A, v >> 6, (v >> 3) & 7, v & 7, lds, tid); }
#endif
            }
            SEAM(pb + 2);
        }
        if (IN(pb + 3)) {
            PH_BEGIN;
            SchedMerge S{(const bf16_t*)(ws + O_YA), (const bf16_t*)(ws + O_WP + l * 3 * SZ_WP1), G, bid};
            EpiMerge E{(const bf16_t*)(ws + O_GATES), (float*)(ws + O_PART), (bf16_t*)(ws + O_MB)};
            gemm_run<2>(lds, S, E, 512, 512);
            SEAM(pb + 3);
        }
        if (IN(pb + 4)) {
            PH_BEGIN;
            SchedDense S{(const bf16_t*)(ws + O_MB), (const bf16_t*)(ws + O_WOUT + l * SZ_WOUT1), 1024, 1024, 64, 4, G, bid};
            EpiResid E{l ? A.out : A.in[I_X], A.out, (bf16_t*)(ws + O_XB), (float*)(ws + O_SSQ)};
            gemm_run<3>(lds, S, E, 1024, 1024);
            SEAM(pb + 4);
        }
        if (l == 0) {
            if (IN(6)) {
                PH_BEGIN;
                SchedDense S{(const bf16_t*)(ws + O_XB), (const bf16_t*)(ws + O_WFFGU), 1024, 1024, 64, 2 * DFF / 256, G, bid};
                EpiSwiGLU E{(const float*)(ws + O_SSQ), nullptr, (bf16_t*)(ws + O_HID), DFF};
                gemm_run<4>(lds, S, E, 1024, 1024);
                SEAM(6);
            }
            if (IN(7)) {
                PH_BEGIN;
                SchedDense S{(const bf16_t*)(ws + O_HID), (const bf16_t*)(ws + O_WFFD), DFF, DFF, 64, 4, G, bid};
                EpiResid E{A.out, A.out, (bf16_t*)(ws + O_XB), (float*)(ws + O_SSQ)};
                gemm_run<5>(lds, S, E, DFF, DFF);
                SEAM(7);
            }
        }
    }
    if (IN(13)) {
        PH_BEGIN;
        for (int blk = bid; blk < 256; blk += G) router_item(A, blk, lds, tid);
        __syncthreads();
        run_transposes<true>(A, lds, gw, NGW, wave, lane);
        SEAM(13);
    }
    if (IN(14)) { PH_BEGIN; positions_phase(A, lds, G, bid, tid); SEAM(14); }
    if (IN(15)) {
        PH_BEGIN; int* mi = (int*)(ws + O_MOEI);
        SchedMoe S{(const bf16_t*)(ws + O_XB), (const bf16_t*)(ws + O_WEGU), mi + MI_TILEE, mi + MI_ROWTOK, 1024, 1024, 2 * DFE / 256, G, bid, (size_t)2 * DFE * 1024, true};
        EpiSwiGLU E{(const float*)(ws + O_SSQ), mi + MI_ROWTOK, (bf16_t*)(ws + O_HIDS), DFE};
        gemm_run<6, true>(lds, S, E, 1024, 1024);
        SEAM(15);
    }
    if (IN(16)) {
        PH_BEGIN; int* mi = (int*)(ws + O_MOEI);
        SchedMoe S{(const bf16_t*)(ws + O_HIDS), (const bf16_t*)(ws + O_WED), mi + MI_TILEE, mi + MI_ROWTOK, DFE, DFE, 4, G, bid, (size_t)1024 * DFE, false};
        EpiMoeDown E{(const float*)(ws + O_MOEI) + MI_ROWW, (bf16_t*)(ws + O_OUTS)};
        gemm_run<7>(lds, S, E, DFE, DFE);
        SEAM(16);
    }
    if (IN(17)) { PH_BEGIN; final_phase(A, gw, NGW, lane); }
#undef IN
#undef SEAM
#undef PH_BEGIN
}

extern "C" void kernel_launch(void* const* d_in, const int* in_sizes, int n_in, void* d_out, int out_size, void* d_ws, size_t ws_size, hipStream_t stream) {
    static int grid = 0;
    if (grid == 0) {
        if (n_in != 28 || out_size != M * D || ws_size < WS_NEED) { fprintf(stderr, "kernel_launch: unexpected shapes (n_in %d out %d ws %zu need %zu)\n", n_in, out_size, ws_size, (size_t)WS_NEED); grid = -1; return; }
        int dev = 0, cus = 0;
        if (hipGetDevice(&dev) != hipSuccess || hipDeviceGetAttribute(&cus, hipDeviceAttributeMultiprocessorCount, dev) != hipSuccess) { grid = -1; return; }
        if (hipFuncSetAttribute((const void*)mega_fwd, hipFuncAttributeMaxDynamicSharedMemorySize, LDS_BYTES) != hipSuccess) { grid = -1; return; }
        int per_cu = 0;
        if (hipOccupancyMaxActiveBlocksPerMultiprocessor(&per_cu, (const void*)mega_fwd, NTHR, LDS_BYTES) != hipSuccess || per_cu < 1) { fprintf(stderr, "kernel_launch: occupancy query says %d\n", per_cu); }
        (void)hipGetLastError();
        grid = cus;
    }
    if (grid < 0) return;
    (void)hipMemsetAsync(d_ws, 0, CTL_BYTES, stream);
    Args a{};
    for (int i = 0; i < 28; ++i) a.in[i] = (const float*)d_in[i];
    a.out = (float*)d_out; a.ws = (unsigned char*)d_ws; a.li = 0; a.pad = 0;
#if N_LAUNCH_MODE == 1
    a.ph_lo = 0; a.ph_hi = NPHASE;
    hipLaunchKernelGGL(mega_fwd, dim3(grid), dim3(NTHR), LDS_BYTES, stream, a);
#else
    for (int p = 0; p < NPHASE; ++p) { a.ph_lo = p; a.ph_hi = p + 1; hipLaunchKernelGGL(mega_fwd, dim3(grid), dim3(NTHR), LDS_BYTES, stream, a); }
#endif
}
```

```cpp
#include <hip/hip_runtime.h>
#include <cstdio>
#include <cstdint>

#ifndef N_LAUNCH_MODE
#define N_LAUNCH_MODE 1
#endif
#ifndef NAIVE_GEMM
#define NAIVE_GEMM 0
#endif
#ifndef NAIVE_ATTN
#define NAIVE_ATTN 0
#endif
#ifndef NAIVE_GLA
#define NAIVE_GLA 0
#endif

#define LAS __attribute__((address_space(3)))
#define GAS __attribute__((address_space(1)))
typedef unsigned short bf16_t;
typedef short bf16x8 __attribute__((ext_vector_type(8)));
typedef float f32x4 __attribute__((ext_vector_type(4)));
typedef unsigned u32x4 __attribute__((ext_vector_type(4)));
typedef unsigned u32x2 __attribute__((ext_vector_type(2)));

constexpr int M = 16384, D = 1024, T = 2048, NBATCH = 8, NWAVES = 8, NTHR = 512;
constexpr float EPS = 1e-6f;
constexpr int PW = 3456;
constexpr int PC_AQ = 0, PC_AK = 512, PC_AV = 640, PC_BCQ = 768, PC_BCKV = 1024, PC_CQ = 1280, PC_CK = 1792, PC_CV = 2304, PC_CG = 2816, PC_SMALL = 3328;
constexpr int NIN = 6656;
constexpr int DFF = 2816, DFE = 3584, NEXP = 8;
constexpr int MAXTILES = 136, MAXROWS = MAXTILES * 256;
constexpr float LOG2E = 1.4426950408889634f;
constexpr float C2A = 0.125f * LOG2E;
constexpr float C2B = 0.10206207261596575f * LOG2E;
constexpr float GLA_QSCALE = 0.08838834764831845f;

constexpr size_t CTL_BYTES = 1u << 20;
constexpr size_t SZ_WIN1 = (size_t)NIN * 1024 * 2, SZ_WQUP1 = 768 * 256 * 2, SZ_WKVUP1 = 1024 * 256 * 2, SZ_WP1 = 1024 * 512 * 2, SZ_WOUT1 = 1024 * 1024 * 2;
constexpr size_t O_WIN = CTL_BYTES;
constexpr size_t O_WQUP = O_WIN + 2 * SZ_WIN1;
constexpr size_t O_WKVUP = O_WQUP + 2 * SZ_WQUP1;
constexpr size_t O_WP = O_WKVUP + 2 * SZ_WKVUP1;
constexpr size_t O_WOUT = O_WP + 6 * SZ_WP1;
constexpr size_t O_WFFGU = O_WOUT + 2 * SZ_WOUT1;
constexpr size_t O_WFFD = O_WFFGU + (size_t)2 * DFF * 1024 * 2;
constexpr size_t O_TABA = O_WFFD + (size_t)1024 * DFF * 2;
constexpr size_t O_TABB = O_TABA + (size_t)T * 64 * 4;
constexpr size_t O_XB = O_TABB + (size_t)T * 32 * 4;
constexpr size_t O_SSQ = O_XB + (size_t)M * 1024 * 2;
constexpr size_t O_RSP = O_SSQ + (size_t)M * 16 * 4;
constexpr size_t O_PTAB = O_RSP + (size_t)M * 32 * 4;
constexpr size_t O_MOEI = O_PTAB + 256;
constexpr size_t SZ_MOEI = 2u << 20;
constexpr size_t O_R = O_MOEI + SZ_MOEI;
constexpr size_t O_P = O_R;
constexpr size_t O_GATES = O_P + (size_t)M * PW * 2;
constexpr size_t O_QA = O_GATES + (size_t)M * 3072 * 2;
constexpr size_t O_KA = O_QA + (size_t)M * 512 * 2;
constexpr size_t O_KROPE = O_KA + (size_t)M * 128 * 2;
constexpr size_t O_QB = O_KROPE + (size_t)M * 32 * 2;
constexpr size_t O_KNOPE = O_QB + (size_t)M * 768 * 2;
constexpr size_t O_VB = O_KNOPE + (size_t)M * 512 * 2;
constexpr size_t O_QT = O_VB + (size_t)M * 512 * 2;
constexpr size_t O_DEC = O_QT + (size_t)4 * M * 512 * 2;
constexpr size_t O_YA = O_DEC + (size_t)2 * 256 * 512 * 4;
constexpr size_t O_YB = O_YA + (size_t)M * 512 * 2;
constexpr size_t O_YC = O_YB + (size_t)M * 512 * 2;
constexpr size_t O_OCB = O_YC + (size_t)M * 512 * 2;
constexpr size_t O_MIX_END = O_OCB + (size_t)M * 512 * 2;
constexpr size_t O_PART = O_QT;
constexpr size_t O_MB = O_P;
constexpr size_t O_HID = O_P;
constexpr size_t O_WEGU = O_R;
constexpr size_t O_WED = O_WEGU + (size_t)NEXP * 2 * DFE * 1024 * 2;
constexpr size_t O_HIDS = O_WED + (size_t)NEXP * 1024 * DFE * 2;
constexpr size_t O_MOE_END = O_HIDS + (size_t)MAXROWS * DFE * 2;
constexpr size_t O_OUTS = O_WEGU;
constexpr size_t WS_NEED = O_MIX_END > O_MOE_END ? O_MIX_END : O_MOE_END;
static_assert(WS_NEED <= 531851264ull, "workspace map exceeds the guaranteed ws_size");
static_assert((size_t)M * 1024 * 4 <= (size_t)4 * M * 512 * 2, "PART overlay");
static_assert((size_t)MAXROWS * 1024 * 2 <= (size_t)NEXP * 2 * DFE * 1024 * 2, "OUTS overlay");
constexpr int MI_CNT = 0;
constexpr int MI_TOKE = 4096;
constexpr int MI_TOKR = MI_TOKE + M;
constexpr int MI_TOKW = MI_TOKR + M;
constexpr int MI_TOKPOS = MI_TOKW + 2 * M;
constexpr int MI_ROWTOK = MI_TOKPOS + 2 * M;
constexpr int MI_ROWW = MI_ROWTOK + MAXROWS;
constexpr int MI_TILEE = MI_ROWW + MAXROWS;
constexpr int MI_END = MI_TILEE + MAXTILES + 8;
static_assert((size_t)MI_END * 4 <= SZ_MOEI, "moe lists");

constexpr int CW_TMO = 0;
constexpr int CW_Q = 1024;
constexpr int CW_BAR = 4096;

constexpr int LDS_RING = 131072, LDS_CTL = 145408, LDS_MISC = LDS_CTL + 320, LDS_BYTES = 147456;

__device__ __forceinline__ float bf2f(unsigned v) { return __uint_as_float(v << 16); }
__device__ __forceinline__ unsigned f2bf(float f) { unsigned u = __float_as_uint(f); return (u + 0x7fffu + ((u >> 16) & 1u)) >> 16; }
__device__ __forceinline__ unsigned pk2(float lo, float hi) { return f2bf(lo) | (f2bf(hi) << 16); }
__device__ __forceinline__ void unpack8(const u32x4 w, float (&f)[8]) {
    f[0] = __uint_as_float(w.x << 16); f[1] = __uint_as_float(w.x & 0xffff0000u); f[2] = __uint_as_float(w.y << 16); f[3] = __uint_as_float(w.y & 0xffff0000u);
    f[4] = __uint_as_float(w.z << 16); f[5] = __uint_as_float(w.z & 0xffff0000u); f[6] = __uint_as_float(w.w << 16); f[7] = __uint_as_float(w.w & 0xffff0000u);
}
__device__ __forceinline__ u32x4 pack8(const float (&f)[8]) { u32x4 w; w.x = pk2(f[0], f[1]); w.y = pk2(f[2], f[3]); w.z = pk2(f[4], f[5]); w.w = pk2(f[6], f[7]); return w; }
__device__ __forceinline__ void load8(const bf16_t* p, float (&f)[8]) { unpack8(*(const u32x4*)p, f); }
__device__ __forceinline__ void store8(bf16_t* p, const float (&f)[8]) { *(u32x4*)p = pack8(f); }
__device__ __forceinline__ float wave_sum(float v) {
#pragma unroll
    for (int o = 1; o < 64; o <<= 1) v += __shfl_xor(v, o);
    return v;
}
__device__ __forceinline__ float row_rstd16(const float* ssq, int row) {
    const f32x4* p = (const f32x4*)(ssq + (size_t)row * 16);
    const f32x4 a = p[0], b = p[1], c = p[2], d = p[3];
    const float s = ((a.x + a.y) + (a.z + a.w)) + ((b.x + b.y) + (b.z + b.w)) + ((c.x + c.y) + (c.z + c.w)) + ((d.x + d.y) + (d.z + d.w));
    return rsqrtf(s * (1.0f / 1024.0f) + EPS);
}
__device__ __forceinline__ float sigmoidf_(float x) { return 1.0f / (1.0f + __expf(-x)); }

#define XB_TMO      128
#define XB_XCNT(j)  (256  + 64 * (j))
#define XB_XSUB(j)  (1280 + 64 * (j))
#define XB_XGEN(j)  (2304 + 64 * (j))
#define XB_TOP      3328
#define XB_TOPGEN   3392
#define XCD_BAR_WORDS 3456
#define XB_SPIN_CAP (1u << 18)
__device__ __forceinline__ unsigned xb_ld(unsigned* p)              { return __hip_atomic_load(p, __ATOMIC_RELAXED, __HIP_MEMORY_SCOPE_AGENT); }
__device__ __forceinline__ unsigned xb_add(unsigned* p, unsigned v) { return __hip_atomic_fetch_add(p, v, __ATOMIC_RELAXED, __HIP_MEMORY_SCOPE_AGENT); }
__device__ __forceinline__ unsigned xb_xcc_id() { return (unsigned)__builtin_amdgcn_s_getreg((3 << 11) | 20) & 0xFu; }
#define XB_SPIN(cond, bar) do { unsigned _sp = 0; while (cond) { __builtin_amdgcn_s_sleep(1); \
    if ((++_sp & 255u) == 0u) { if (xb_ld(&(bar)[XB_TMO])) break; if (_sp > XB_SPIN_CAP) { atomicAdd(&(bar)[XB_TMO], 1u); break; } } } } while (0)
struct XcdBarrier { unsigned* bar; unsigned x; volatile LAS unsigned* st; };
__device__ __forceinline__ XcdBarrier xcd_barrier_post(unsigned* bar, volatile LAS unsigned* st) {
    XcdBarrier b; b.bar = bar; b.x = xb_xcc_id(); b.st = st;
    if (threadIdx.x == 0) (void)xb_add(&bar[XB_XCNT(b.x)], 1u);
    return b;
}
__device__ __forceinline__ void xcd_barrier_complete(unsigned* bar, unsigned x, unsigned& nloc, unsigned& nx) {
    const unsigned G = gridDim.x * gridDim.y * gridDim.z;
    unsigned sum, cnt, mine, sp = 0u;
    for (;;) {
        sum = 0u; cnt = 0u; mine = 0u;
#pragma unroll
        for (unsigned j = 0; j < 16; ++j) { const unsigned c = xb_ld(&bar[XB_XCNT(j)]); sum += c; cnt += (c > 0u) ? 1u : 0u; mine = (j == x) ? c : mine; }
        if (sum == G) break;
        __builtin_amdgcn_s_sleep(1);
        if ((++sp & 255u) == 0u) { if (xb_ld(&bar[XB_TMO])) break; if (sp > XB_SPIN_CAP) { atomicAdd(&bar[XB_TMO], 1u); break; } }
    }
    nloc = mine > 0u ? mine : 1u; nx = cnt > 0u ? cnt : 1u;
}
__device__ __forceinline__ void xcd_barrier(const XcdBarrier& b) {
    asm volatile("s_waitcnt vmcnt(0)" ::: "memory");
    __syncthreads();
    if (threadIdx.x == 0) {
        unsigned* bar = b.bar;
        __builtin_amdgcn_s_waitcnt(0);
        unsigned nloc = b.st[0], nx = b.st[1];
        if (nloc == 0u) { xcd_barrier_complete(bar, b.x, nloc, nx); b.st[0] = nloc; b.st[1] = nx; }
        const unsigned old = xb_add(&bar[XB_XSUB(b.x)], 1u);
        const unsigned gen = old / nloc;
        if (old + 1u == (gen + 1u) * nloc) {
            __builtin_amdgcn_fence(__ATOMIC_RELEASE, "agent");
            asm volatile("s_waitcnt vmcnt(0)" ::: "memory");
            const unsigned og = xb_add(&bar[XB_TOP], 1u);
            const unsigned tg = og / nx;
            if (og + 1u == (tg + 1u) * nx) xb_add(&bar[XB_TOPGEN], 1u);
            else XB_SPIN(xb_ld(&bar[XB_TOPGEN]) == tg, bar);
            __builtin_amdgcn_fence(__ATOMIC_ACQUIRE, "agent");
            xb_add(&bar[XB_XGEN(b.x)], 1u);
            asm volatile("s_waitcnt vmcnt(0)" ::: "memory");
        } else {
            XB_SPIN(xb_ld(&bar[XB_XGEN(b.x)]) == gen, bar);
            __builtin_amdgcn_fence(__ATOMIC_ACQUIRE, "agent");
            asm volatile("s_waitcnt vmcnt(0)" ::: "memory");
        }
    }
    __syncthreads();
}

struct Args { const float* in[28]; float* out; unsigned char* ws; int ph_lo, ph_hi, li, pad; };
struct Ctx { const float* const* in; float* out; unsigned char* ws; };
enum { I_X = 0, I_WIN, I_BGATE, I_GMIX, I_GAQ, I_GAK, I_GBQ, I_WBQUP, I_GBKV, I_WBKVUP, I_WCAF, I_BCAF, I_WCAB, I_BCAB, I_GCOUT, I_WPA, I_WPB, I_WPC, I_WOUT, I_GFFN,
       I_WFFG, I_WFFU, I_WFFD, I_WROUTER, I_WEG, I_WEU, I_WED, I_GFINAL };

struct GUnit { const bf16_t* A; const bf16_t* B; const int* rows; int pm, pn, aux; };
__device__ __forceinline__ void tile_order(int L, int nM, int nN, int& pm, int& pn) {
    const int nwg = nM * nN; int wgid = L;
    { const int q = nwg / 8, r = nwg % 8, xcd = wgid % 8, off = wgid / 8; wgid = (xcd < r ? xcd * (q + 1) : r * (q + 1) + (xcd - r) * q) + off; }
    const int nig = 8 * nN, gid = wgid / nig, fm = gid * 8, gsz = (nM - fm) < 8 ? (nM - fm) : 8;
    pm = fm + ((wgid % nig) % gsz); pn = (wgid % nig) / gsz;
}
struct SchedDense {
    const bf16_t* A; const bf16_t* B; int lda, K, nM, nN, G, c;
    __device__ __forceinline__ bool next(int i, GUnit& u) const {
        const long L = (long)i * G + c; if (L >= (long)nM * nN) return false;
        tile_order((int)L, nM, nN, u.pm, u.pn);
        u.A = A + (size_t)u.pm * 256 * lda; u.B = B + (size_t)u.pn * 256 * K; u.rows = nullptr; u.aux = 0; return true;
    }
};
struct SchedUp {
    const bf16_t* P; const bf16_t* Wq; const bf16_t* Wkv; int G, c;
    __device__ __forceinline__ bool next(int i, GUnit& u) const {
        const int L = i * G + c; if (L >= 448) return false;
        if (L < 192) { tile_order(L, 64, 3, u.pm, u.pn); u.aux = 0; u.A = P + (size_t)u.pm * 256 * PW + PC_BCQ; u.B = Wq + (size_t)u.pn * 256 * 256; }
        else { tile_order(L - 192, 64, 4, u.pm, u.pn); u.aux = 1; u.A = P + (size_t)u.pm * 256 * PW + PC_BCKV; u.B = Wkv + (size_t)u.pn * 256 * 256; }
        u.rows = nullptr; return true;
    }
};
struct SchedMerge {
    const bf16_t* Y0; const bf16_t* W; int G, c;
    __device__ __forceinline__ bool next(int i, GUnit& u) const {
        const int tile = (i / 3) * G + c, br = i % 3; if (tile >= 256) return false;
        tile_order(tile, 64, 4, u.pm, u.pn); u.aux = br;
        u.A = Y0 + (size_t)br * M * 512 + (size_t)u.pm * 256 * 512; u.B = W + (size_t)br * 1024 * 512 + (size_t)u.pn * 256 * 512; u.rows = nullptr; return true;
    }
};
struct SchedMoe {
    const bf16_t* A; const bf16_t* B; const int* tile_e; const int* rowtok; int lda, K, nN, G, c; size_t bstride; bool gather;
    __device__ __forceinline__ bool next(int i, GUnit& u) const {
        const int nM = tile_e[MAXTILES]; const long L = (long)i * G + c; if (L >= (long)nM * nN) return false;
        tile_order((int)L, nM, nN, u.pm, u.pn); const int e = tile_e[u.pm]; u.aux = e;
        u.B = B + (size_t)e * bstride + (size_t)u.pn * 256 * K;
        if (gather) { u.A = A; u.rows = rowtok + u.pm * 256; } else { u.A = A + (size_t)u.pm * 256 * lda; u.rows = nullptr; }
        return true;
    }
};

struct EpiInProj {
    bf16_t* P; bf16_t* GATES; const float* ssq; const float* bgate; float* rsp;
    static constexpr bool HAS_SSQ = false;
    __device__ __forceinline__ void half(int H, int row, int c, const float (&v)[8], float rstd) const {
        float o[8];
        if (H < 26) {
#pragma unroll
            for (int j = 0; j < 8; ++j) o[j] = v[j] * rstd;
            store8(P + (size_t)row * PW + H * 128 + c, o);
        } else if (H < 50) {
            const int gc = (H - 26) * 128 + c; const f32x4 b0 = *(const f32x4*)(bgate + gc), b1 = *(const f32x4*)(bgate + gc + 4);
            o[0] = sigmoidf_(v[0] * rstd + b0.x); o[1] = sigmoidf_(v[1] * rstd + b0.y); o[2] = sigmoidf_(v[2] * rstd + b0.z); o[3] = sigmoidf_(v[3] * rstd + b0.w);
            o[4] = sigmoidf_(v[4] * rstd + b1.x); o[5] = sigmoidf_(v[5] * rstd + b1.y); o[6] = sigmoidf_(v[6] * rstd + b1.z); o[7] = sigmoidf_(v[7] * rstd + b1.w);
            store8(GATES + (size_t)row * 3072 + gc, o);
        } else if (H == 50 && c < 64) {
#pragma unroll
            for (int j = 0; j < 8; ++j) o[j] = v[j] * rstd;
            store8(P + (size_t)row * PW + PC_SMALL + c, o);
        }
    }
    __device__ __forceinline__ float operator()(const GUnit& u, int r, int c, const float (&v0)[8], const float (&v1)[8]) const {
        const int row = u.pm * 256 + r; const float rstd = row_rstd16(ssq, row);
        half(u.pn * 2, row, c, v0, rstd); half(u.pn * 2 + 1, row, c, v1, rstd);
        if (u.pn == 3 || u.pn == 4) { float s = 0.f;
#pragma unroll
            for (int j = 0; j < 8; ++j) s += (v0[j] * v0[j] + v1[j] * v1[j]);
            rsp[(size_t)row * 32 + (u.pn - 3) * 16 + (c >> 3)] = s * rstd * rstd; }
        return 0.f;
    }
};
struct EpiUpProj {
    const float* rsp; bf16_t* QB; bf16_t* KNOPE; bf16_t* VB;
    static constexpr bool HAS_SSQ = false;
    __device__ __forceinline__ float operator()(const GUnit& u, int r, int c, const float (&v0)[8], const float (&v1)[8]) const {
        const int row = u.pm * 256 + r; const f32x4* p = (const f32x4*)(rsp + (size_t)row * 32 + u.aux * 16);
        float s = 0.f;
#pragma unroll
        for (int j = 0; j < 4; ++j) { const f32x4 a = p[j]; s += (a.x + a.y) + (a.z + a.w); }
        float rstd = rsqrtf(s * (1.0f / 256.0f) + EPS);
        float o0[8], o1[8];
        if (u.aux == 0) {
            rstd *= C2B;
#pragma unroll
            for (int j = 0; j < 8; ++j) { o0[j] = v0[j] * rstd; o1[j] = v1[j] * rstd; }
            bf16_t* q = QB + (size_t)row * 768 + u.pn * 256 + c; store8(q, o0); store8(q + 128, o1);
        } else {
#pragma unroll
            for (int j = 0; j < 8; ++j) { o0[j] = v0[j] * rstd; o1[j] = v1[j] * rstd; }
            bf16_t* q = (u.pn < 2 ? KNOPE + (size_t)row * 512 + u.pn * 256 : VB + (size_t)row * 512 + (u.pn - 2) * 256) + c; store8(q, o0); store8(q + 128, o1);
        }
        return 0.f;
    }
};
struct EpiMerge {
    const bf16_t* GATES; float* PART; bf16_t* MB;
    static constexpr bool HAS_SSQ = false;
    __device__ __forceinline__ float operator()(const GUnit& u, int r, int c, const float (&v0)[8], const float (&v1)[8]) const {
        const int row = u.pm * 256 + r, col = u.pn * 256 + c, br = u.aux;
#pragma unroll
        for (int h = 0; h < 2; ++h) {
            const int cc = col + h * 128; float g[8], o[8]; load8(GATES + (size_t)row * 3072 + br * 1024 + cc, g);
            float* pp = PART + (size_t)row * 1024 + cc;
#pragma unroll
            for (int j = 0; j < 8; ++j) o[j] = g[j] * (h ? v1[j] : v0[j]);
            if (br > 0) { const f32x4 a = *(const f32x4*)pp, b = *(const f32x4*)(pp + 4); o[0] += a.x; o[1] += a.y; o[2] += a.z; o[3] += a.w; o[4] += b.x; o[5] += b.y; o[6] += b.z; o[7] += b.w; }
            if (br < 2) { *(f32x4*)pp = (f32x4){o[0], o[1], o[2], o[3]}; *(f32x4*)(pp + 4) = (f32x4){o[4], o[5], o[6], o[7]}; }
            else store8(MB + (size_t)row * 1024 + cc, o);
        }
        return 0.f;
    }
};
struct EpiResid {
    const float* xin; float* xout; bf16_t* XB; float* ssq;
    static constexpr bool HAS_SSQ = true;
    __device__ __forceinline__ float operator()(const GUnit& u, int r, int c, const float (&v0)[8], const float (&v1)[8]) const {
        const int row = u.pm * 256 + r, col = u.pn * 256 + c; float ss = 0.f;
#pragma unroll
        for (int h = 0; h < 2; ++h) {
            const size_t off = (size_t)row * 1024 + col + h * 128; const f32x4 a = *(const f32x4*)(xin + off), b = *(const f32x4*)(xin + off + 4);
            float o[8] = {a.x, a.y, a.z, a.w, b.x, b.y, b.z, b.w};
#pragma unroll
            for (int j = 0; j < 8; ++j) { o[j] += (h ? v1[j] : v0[j]); ss += o[j] * o[j]; }
            *(f32x4*)(xout + off) = (f32x4){o[0], o[1], o[2], o[3]}; *(f32x4*)(xout + off + 4) = (f32x4){o[4], o[5], o[6], o[7]};
            store8(XB + off, o);
        }
        return ss;
    }
    __device__ __forceinline__ void put_ssq(const GUnit& u, int r, int slot, float s) const { ssq[(size_t)(u.pm * 256 + r) * 16 + u.pn * 4 + slot] = s; }
};
struct EpiSwiGLU {
    const float* ssq; const int* rowtok; bf16_t* HID; int ldh;
    static constexpr bool HAS_SSQ = false;
    __device__ __forceinline__ float operator()(const GUnit& u, int r, int c, const float (&v0)[8], const float (&v1)[8]) const {
        const int row = u.pm * 256 + r; const int tok = rowtok ? rowtok[row] : row; const float rstd = row_rstd16(ssq, tok);
        float o[8];
#pragma unroll
        for (int j = 0; j < 8; ++j) { const float g = v0[j] * rstd, up = v1[j] * rstd; o[j] = g * sigmoidf_(g) * up; }
        store8(HID + (size_t)row * ldh + u.pn * 128 + c, o); return 0.f;
    }
};
struct EpiMoeDown {
    const float* roww; bf16_t* OUTS;
    static constexpr bool HAS_SSQ = false;
    __device__ __forceinline__ float operator()(const GUnit& u, int r, int c, const float (&v0)[8], const float (&v1)[8]) const {
        const int row = u.pm * 256 + r; const float w = roww[row]; float o0[8], o1[8];
#pragma unroll
        for (int j = 0; j < 8; ++j) { o0[j] = v0[j] * w; o1[j] = v1[j] * w; }
        bf16_t* q = OUTS + (size_t)row * 1024 + u.pn * 256 + c; store8(q, o0); store8(q + 128, o1); return 0.f;
    }
};

template <class Sched, class Epi>
__device__ __forceinline__ void gemm_naive(const Sched& S, const Epi& E, int K, int lda) {
    const int tid = threadIdx.x, r = tid & 255, s = __builtin_amdgcn_readfirstlane(tid >> 8);
    GUnit u;
    for (int i = 0; S.next(i, u); ++i) {
        const bf16_t* arow = u.rows ? u.A + (size_t)u.rows[r] * lda : u.A + (size_t)r * lda;
        float ss = 0.f;
        for (int g = 0; g < 8; ++g) {
            const int c = s * 64 + g * 8;
            float a0[8], a1[8];
#pragma unroll
            for (int j = 0; j < 8; ++j) { a0[j] = 0.f; a1[j] = 0.f; }
#pragma unroll 1
            for (int k = 0; k < K; k += 8) {
                float af[8]; load8(arow + k, af);
#pragma unroll
                for (int j = 0; j < 8; ++j) {
                    float b0[8], b1[8]; load8(u.B + (size_t)(c + j) * K + k, b0); load8(u.B + (size_t)(128 + c + j) * K + k, b1);
#pragma unroll
                    for (int e = 0; e < 8; ++e) { a0[j] = fmaf(af[e], b0[e], a0[j]); a1[j] = fmaf(af[e], b1[e], a1[j]); }
                }
            }
            ss += E(u, r, c, a0, a1);
        }
        if constexpr (Epi::HAS_SSQ) { E.put_ssq(u, r, s, ss); E.put_ssq(u, r, 2 + s, 0.f); }
    }
}

__device__ __forceinline__ int launder_v(int x) { asm volatile("" : "+v"(x)); return x; }
template <class Tp> __device__ __forceinline__ Tp* launder_s(Tp* p) { asm volatile("" : "+s"(p)); return p; }
__device__ __forceinline__ int launder_i(int x) { asm volatile("" : "+s"(x)); return x; }
__device__ __forceinline__ bool in_phase(int lo, int hi, int k) { asm volatile("" : "+s"(lo), "+s"(hi)); return lo <= k && k < hi; }
namespace pg8 {
constexpr int BK = 64, HALF = 128, HTB = HALF * BK * 2, STAGE_BYTES = 8 * HTB;
__device__ __forceinline__ int lds_byte(int r, int c) { const int st = (r >> 4) * 2 + (c >> 5), rr = r & 15, cc = c & 31, ob = rr * 64 + cc * 2; return st * 1024 + (ob ^ (((ob >> 9) & 1) << 5)); }
__device__ __forceinline__ void stage_rc(int b, int& R, int& C) { const int st = b / 1024, sb = b % 1024, swz = sb ^ (((sb >> 9) & 1) << 5); R = (st >> 1) * 16 + swz / 64; C = (st & 1) * 32 + (swz % 64) / 2; }
__device__ __forceinline__ int perm32(int rho) { const int n = rho >> 4, i = rho & 15; return 8 * (i >> 2) + 4 * n + (i & 3); }

template <bool GATHER, class Sched, class Epi>
__device__ __forceinline__ void gemm_phase(LAS unsigned char* lds, const Sched& S, const Epi& E, const int K, const int lda) {
    const int tid = launder_v((int)threadIdx.x), wid = __builtin_amdgcn_readfirstlane(tid >> 6), lane = tid & 63, wr = wid >> 2, wc = wid & 3, fr = lane & 15, fq = lane >> 4;
    const int nt = K / BK;
    int RA[2], CA[2]; unsigned voffB[2];
#pragma unroll
    for (int i = 0; i < 2; ++i) { int R, C; stage_rc(tid * 16 + i * 8192, R, C); RA[i] = R; CA[i] = C; const int Rb = (R & ~31) + perm32(R & 31); voffB[i] = (unsigned)(Rb * K + C) * 2u; }
    const size_t kstep = (size_t)(BK * 2);
    const size_t hstepB = (size_t)HALF * K * 2;
    const unsigned ldsw = (unsigned)wid * 1024u;
    const int aoff = lds_byte(wr * 64 + fr, fq * 8), boff = lds_byte(wc * 32 + fr, fq * 8);
#define PG8_SA(b, h) (((b) * 2 + (h)) * HTB)
#define PG8_SB(b, h) ((4 + (b) * 2 + (h)) * HTB)
#define PG8_STAGE2(bufoff, gbase, v0_, v1_) do { \
        __builtin_amdgcn_global_load_lds((const unsigned*)((const char*)(gbase) + (v0_)), (LAS unsigned*)(lds + (bufoff) + ldsw), 16, 0, 0); \
        __builtin_amdgcn_global_load_lds((const unsigned*)((const char*)(gbase) + (v1_)), (LAS unsigned*)(lds + (bufoff) + ldsw + 8192), 16, 0, 0); } while (0)
#define PG8_STAGEB(bufoff, gbase) PG8_STAGE2(bufoff, gbase, voffB[0], voffB[1])
#define PG8_LDA(dst, b, h) do { _Pragma("unroll") for (int m = 0; m < 4; ++m) _Pragma("unroll") for (int k = 0; k < 2; ++k) dst[m][k] = *(const LAS bf16x8*)(lds + PG8_SA(b, h) + aoff + m * 2048 + k * 1024); } while (0)
#define PG8_LDB(dst, b, h) do { _Pragma("unroll") for (int n = 0; n < 2; ++n) _Pragma("unroll") for (int k = 0; k < 2; ++k) dst[n][k] = *(const LAS bf16x8*)(lds + PG8_SB(b, h) + boff + n * 2048 + k * 1024); } while (0)
#define PG8_MMA(ai, bj, At, Bt) do { __builtin_amdgcn_s_setprio(1); _Pragma("unroll") for (int m = 0; m < 4; ++m) _Pragma("unroll") for (int n = 0; n < 2; ++n) _Pragma("unroll") for (int k = 0; k < 2; ++k) \
        acc[ai][bj][m][n] = __builtin_amdgcn_mfma_f32_16x16x32_bf16(Bt[n][k], At[m][k], acc[ai][bj][m][n], 0, 0, 0); __builtin_amdgcn_s_setprio(0); } while (0)
#define PG8_WAIT_V(n) asm volatile("s_waitcnt vmcnt(" #n ")" ::: "memory")
#define PG8_WAIT_L(n) asm volatile("s_waitcnt lgkmcnt(" #n ")" ::: "memory")
#define PG8_BAR __builtin_amdgcn_s_barrier()
#define PG8_SCHED __builtin_amdgcn_sched_barrier(0)
#define PG8_VOFFA(dst, u_) do { _Pragma("unroll") for (int h_ = 0; h_ < 2; ++h_) _Pragma("unroll") for (int i_ = 0; i_ < 2; ++i_) { \
        const unsigned row_ = GATHER ? (unsigned)(u_).rows[h_ * HALF + RA[i_]] : (unsigned)RA[i_]; dst[h_][i_] = (row_ * (unsigned)lda + (unsigned)CA[i_]) * 2u; } } while (0)
    GUnit cur, nxt; int ui = 0;
    if (!S.next(0, cur)) return;
    f32x4 acc[2][2][4][2];
#pragma unroll
    for (int a = 0; a < 2; ++a)
#pragma unroll
        for (int b = 0; b < 2; ++b)
#pragma unroll
            for (int m = 0; m < 4; ++m)
#pragma unroll
                for (int n = 0; n < 2; ++n) acc[a][b][m][n] = (f32x4){0.f, 0.f, 0.f, 0.f};
    bf16x8 At[4][2], B0[2][2], B1[2][2];
    unsigned vc[2][2], vn[2][2];
    const size_t hstepA = GATHER ? (size_t)0 : (size_t)HALF * lda * 2;
    PG8_VOFFA(vc, cur);
    const char* cA = (const char*)cur.A; const char* cB = (const char*)cur.B;
    PG8_STAGEB(PG8_SB(0, 0), cB); PG8_STAGEB(PG8_SB(0, 1), cB + hstepB); PG8_STAGE2(PG8_SA(0, 0), cA, vc[0][0], vc[0][1]); PG8_STAGE2(PG8_SA(0, 1), cA + hstepA, vc[1][0], vc[1][1]);
    if (wr == 1) PG8_BAR;
    PG8_WAIT_V(2); PG8_BAR;
    PG8_STAGEB(PG8_SB(1, 0), cB + kstep); PG8_STAGE2(PG8_SA(1, 0), cA + kstep, vc[0][0], vc[0][1]); PG8_STAGEB(PG8_SB(1, 1), cB + hstepB + kstep);
    PG8_WAIT_V(6); PG8_BAR;
    for (;;) {
        const bool has_next = S.next(ui + 1, nxt);
        const char* nA = has_next ? (const char*)nxt.A : cA; const char* nB = has_next ? (const char*)nxt.B : cB;
        if (has_next) { PG8_VOFFA(vn, nxt); } else {
#pragma unroll
            for (int h_ = 0; h_ < 2; ++h_)
#pragma unroll
                for (int i_ = 0; i_ < 2; ++i_) vn[h_][i_] = vc[h_][i_]; }
        for (int t = 0; t < nt; t += 2) {
            const bool last = (t == nt - 2);
            const char* a1 = cA + (size_t)(t + 1) * kstep;
            const char* a2 = last ? nA : cA + (size_t)(t + 2) * kstep; const char* b2 = last ? nB : cB + (size_t)(t + 2) * kstep;
            const char* a3 = a2 + kstep; const char* b3 = b2 + kstep;
            const unsigned w00 = last ? vn[0][0] : vc[0][0], w01 = last ? vn[0][1] : vc[0][1], w10 = last ? vn[1][0] : vc[1][0], w11 = last ? vn[1][1] : vc[1][1];
            PG8_LDB(B0, 0, 0); PG8_LDB(B1, 0, 1); PG8_SCHED; PG8_LDA(At, 0, 0); PG8_STAGE2(PG8_SA(1, 1), a1 + hstepA, vc[1][0], vc[1][1]);
            PG8_WAIT_V(8); PG8_WAIT_L(0); PG8_BAR; PG8_MMA(0, 0, At, B0); PG8_MMA(0, 1, At, B1); PG8_BAR; PG8_SCHED;
            PG8_LDA(At, 0, 1); PG8_STAGEB(PG8_SB(0, 0), b2); PG8_STAGEB(PG8_SB(0, 1), b2 + hstepB); PG8_STAGE2(PG8_SA(0, 0), a2, w00, w01);
            PG8_WAIT_V(8); PG8_WAIT_L(0); PG8_BAR; PG8_MMA(1, 0, At, B0); PG8_MMA(1, 1, At, B1); PG8_BAR; PG8_SCHED;
            PG8_LDB(B0, 1, 0); PG8_LDB(B1, 1, 1); PG8_SCHED; PG8_LDA(At, 1, 0); PG8_STAGE2(PG8_SA(0, 1), a2 + hstepA, w10, w11);
            PG8_WAIT_V(8); PG8_WAIT_L(0); PG8_BAR; PG8_MMA(0, 0, At, B0); PG8_MMA(0, 1, At, B1); PG8_BAR; PG8_SCHED;
            PG8_LDA(At, 1, 1); PG8_STAGEB(PG8_SB(1, 0), b3); PG8_STAGEB(PG8_SB(1, 1), b3 + hstepB); PG8_STAGE2(PG8_SA(1, 0), a3, w00, w01);
            PG8_WAIT_V(8); PG8_WAIT_L(0); PG8_BAR; PG8_MMA(1, 0, At, B0); PG8_MMA(1, 1, At, B1); PG8_BAR; PG8_SCHED;
        }
        if (wr == 0) PG8_BAR;
        const int fr2 = launder_v(fr), fq2 = launder_v(fq);
#pragma unroll
        for (int ai = 0; ai < 2; ++ai)
#pragma unroll
            for (int m = 0; m < 4; ++m) {
                const int r = ai * HALF + wr * 64 + m * 16 + fr2;
                const f32x4 p0 = acc[ai][0][m][0], p1 = acc[ai][0][m][1], q0 = acc[ai][1][m][0], q1 = acc[ai][1][m][1];
                const float v0[8] = {p0[0], p0[1], p0[2], p0[3], p1[0], p1[1], p1[2], p1[3]}, v1[8] = {q0[0], q0[1], q0[2], q0[3], q1[0], q1[1], q1[2], q1[3]};
                float ss = E(cur, r, wc * 32 + fq2 * 8, v0, v1);
                if constexpr (Epi::HAS_SSQ) { ss += __shfl_xor(ss, 16); ss += __shfl_xor(ss, 32); if (fq2 == 0) E.put_ssq(cur, r, wc, ss); }
                asm volatile("" ::: "memory");
            }
        if (!has_next) break;
#pragma unroll
        for (int a = 0; a < 2; ++a)
#pragma unroll
            for (int b = 0; b < 2; ++b)
#pragma unroll
                for (int m = 0; m < 4; ++m)
#pragma unroll
                    for (int n = 0; n < 2; ++n) acc[a][b][m][n] = (f32x4){0.f, 0.f, 0.f, 0.f};
        cur = nxt; cA = nA; cB = nB; ++ui;
#pragma unroll
        for (int h_ = 0; h_ < 2; ++h_)
#pragma unroll
            for (int i_ = 0; i_ < 2; ++i_) vc[h_][i_] = vn[h_][i_];
        if (wr == 1) PG8_BAR;
    }
    PG8_WAIT_V(0);
    PG8_BAR;
#undef PG8_SA
#undef PG8_SB
#undef PG8_STAGE2
#undef PG8_STAGEB
#undef PG8_LDA
#undef PG8_LDB
#undef PG8_MMA
#undef PG8_WAIT_V
#undef PG8_WAIT_L
#undef PG8_BAR
#undef PG8_SCHED
#undef PG8_VOFFA
}
}

__device__ __forceinline__ int rowmap(int code, int n) {
    switch (code) {
        case 1: return n < 1280 ? n : (n < 1312 ? n + 5120 : (n < 3360 ? n - 32 : (n < 3392 ? n + 3072 : n - 64)));
        case 2: { const int h = n >> 7, j = n & 127; return j < 64 ? h * 64 + j : 512 + h * 64 + (j - 64); }
        case 3: return (n >> 7) * 256 + (n & 127);
        case 4: return (n >> 7) * 256 + 128 + (n & 127);
        default: return n;
    }
}
struct TJob { const float* W; bf16_t* WT; const float* g; int K, N, code; };
__device__ __forceinline__ void transpose_item(const TJob& jb, LAS float* scr, int item, int lane) {
    const int K = jb.K, N = jb.N, nblk = N / 32, kb = item / nblk, nb = item % nblk, k0 = 64 * kb, n0 = 32 * nb;
#pragma unroll 8
    for (int i = 0; i < 32; ++i) { const int kk = 2 * i + (lane >> 5); float w = jb.W[(size_t)(k0 + kk) * N + n0 + (lane & 31)]; if (jb.g) w *= jb.g[k0 + kk]; scr[kk * 33 + (lane & 31)] = w; }
    asm volatile("s_waitcnt lgkmcnt(0)" ::: "memory");
    const int c = lane & 7;
#pragma unroll
    for (int j = 0; j < 4; ++j) { const int n = (lane >> 3) + 8 * j; const LAS float* s = scr + (8 * c) * 33 + n;
        u32x4 o; o.x = pk2(s[0 * 33], s[1 * 33]); o.y = pk2(s[2 * 33], s[3 * 33]); o.z = pk2(s[4 * 33], s[5 * 33]); o.w = pk2(s[6 * 33], s[7 * 33]);
        *(u32x4*)(jb.WT + (size_t)rowmap(jb.code, n0 + n) * K + k0 + 8 * c) = o; }
    asm volatile("s_waitcnt lgkmcnt(0)" ::: "memory");
}
__device__ __forceinline__ bool common_job(const Ctx& a, int j, TJob& jb) {
    unsigned char* ws = a.ws;
    if (j < 14) { const int l = j / 7, k = j % 7;
        switch (k) {
            case 0: jb = TJob{a.in[I_WIN] + (size_t)l * 1024 * 6464, (bf16_t*)(ws + O_WIN + l * SZ_WIN1), a.in[I_GMIX] + l * 1024, 1024, 6464, 1}; break;
            case 1: jb = TJob{a.in[I_WBQUP] + (size_t)l * 256 * 768, (bf16_t*)(ws + O_WQUP + l * SZ_WQUP1), a.in[I_GBQ] + l * 256, 256, 768, 0}; break;
            case 2: jb = TJob{a.in[I_WBKVUP] + (size_t)l * 256 * 1024, (bf16_t*)(ws + O_WKVUP + l * SZ_WKVUP1), a.in[I_GBKV] + l * 256, 256, 1024, 2}; break;
            case 3: jb = TJob{a.in[I_WPA] + (size_t)l * 512 * 1024, (bf16_t*)(ws + O_WP + (l * 3 + 0) * SZ_WP1), nullptr, 512, 1024, 0}; break;
            case 4: jb = TJob{a.in[I_WPB] + (size_t)l * 512 * 1024, (bf16_t*)(ws + O_WP + (l * 3 + 1) * SZ_WP1), nullptr, 512, 1024, 0}; break;
            case 5: jb = TJob{a.in[I_WPC] + (size_t)l * 512 * 1024, (bf16_t*)(ws + O_WP + (l * 3 + 2) * SZ_WP1), nullptr, 512, 1024, 0}; break;
            default: jb = TJob{a.in[I_WOUT] + (size_t)l * 1024 * 1024, (bf16_t*)(ws + O_WOUT + l * SZ_WOUT1), nullptr, 1024, 1024, 0}; break;
        }
        return true; }
    if (j == 14) { jb = TJob{a.in[I_WFFG], (bf16_t*)(ws + O_WFFGU), a.in[I_GFFN], 1024, DFF, 3}; return true; }
    if (j == 15) { jb = TJob{a.in[I_WFFU], (bf16_t*)(ws + O_WFFGU), a.in[I_GFFN], 1024, DFF, 4}; return true; }
    if (j == 16) { jb = TJob{a.in[I_WFFD], (bf16_t*)(ws + O_WFFD), nullptr, DFF, 1024, 0}; return true; }
    return false;
}
__device__ __forceinline__ bool expert_job(const Ctx& a, int j, TJob& jb) {
    if (j >= 24) return false;
    unsigned char* ws = a.ws; const int e = j / 3, k = j % 3;
    if (k == 0) jb = TJob{a.in[I_WEG] + (size_t)e * 1024 * DFE, (bf16_t*)(ws + O_WEGU) + (size_t)e * 2 * DFE * 1024, a.in[I_GFFN] + 1024, 1024, DFE, 3};
    else if (k == 1) jb = TJob{a.in[I_WEU] + (size_t)e * 1024 * DFE, (bf16_t*)(ws + O_WEGU) + (size_t)e * 2 * DFE * 1024, a.in[I_GFFN] + 1024, 1024, DFE, 4};
    else jb = TJob{a.in[I_WED] + (size_t)e * DFE * 1024, (bf16_t*)(ws + O_WED) + (size_t)e * 1024 * DFE, nullptr, DFE, 1024, 0};
    return true;
}
template <bool EXPERTS>
__device__ __forceinline__ void run_transposes(const Ctx& a, LAS unsigned char* lds, int gw, int NGW, int wave, int lane) {
    LAS float* scr = (LAS float*)(lds + wave * 16384);
    TJob jb;
    for (int j = 0; EXPERTS ? expert_job(a, j, jb) : common_job(a, j, jb); ++j) {
        const int nitems = (jb.K / 64) * (jb.N / 32);
        for (int it = gw; it < nitems; it += NGW) transpose_item(jb, scr, it, lane);
    }
}
__device__ __forceinline__ void phase_prologue(const Ctx& a, LAS unsigned char* lds, int vcu, int G, int tid) {
    const int wave = __builtin_amdgcn_readfirstlane(tid >> 6), lane = tid & 63, gw = vcu * NWAVES + wave, NGW = G * NWAVES;
    unsigned char* ws = a.ws;
    run_transposes<false>(a, lds, gw, NGW, wave, lane);
    for (int l = 0; l < 2; ++l) { u32x4* p = (u32x4*)(ws + O_WIN + l * SZ_WIN1 + (size_t)6464 * 1024 * 2); const int n16 = 192 * 1024 * 2 / 16;
        for (int i = gw * 64 + lane; i < n16; i += NGW * 64) p[i] = (u32x4){0u, 0u, 0u, 0u}; }
    float* ta = (float*)(ws + O_TABA); float* tb = (float*)(ws + O_TABB);
    for (int i = gw * 64 + lane; i < T * 32; i += NGW * 64) { const int t = i >> 5, k = i & 31, blk = k >> 4, fi = k & 15;
        const float inv = exp2f(-(float)fi * (13.287712379549449f / 16.0f)); const float pos = (float)(blk ? (t & 63) : (t >> 6)); const float ang = pos * inv;
        ta[t * 64 + k] = cosf(ang); ta[t * 64 + 32 + k] = sinf(ang); }
    for (int i = gw * 64 + lane; i < T * 16; i += NGW * 64) { const int t = i >> 4, k = i & 15, blk = k >> 3, fi = k & 7;
        const float inv = exp2f(-(float)fi * (13.287712379549449f / 8.0f)); const float pos = (float)(blk ? (t & 63) : (t >> 6)); const float ang = pos * inv;
        tb[t * 32 + k] = cosf(ang); tb[t * 32 + 16 + k] = sinf(ang); }
    const float* x = a.in[I_X]; bf16_t* XB = (bf16_t*)(ws + O_XB); float* ssq = (float*)(ws + O_SSQ);
    for (int m = gw; m < M; m += NGW) {
        const f32x4* xr = (const f32x4*)(x + (size_t)m * D) + lane; float s = 0.f;
#pragma unroll
        for (int j = 0; j < 4; ++j) { const f32x4 v = xr[64 * j]; s += (v.x * v.x + v.y * v.y) + (v.z * v.z + v.w * v.w);
            *(u32x2*)(XB + (size_t)m * D + (lane + 64 * j) * 4) = (u32x2){pk2(v.x, v.y), pk2(v.z, v.w)}; }
        s = wave_sum(s);
        if (lane < 16) ssq[(size_t)m * 16 + lane] = lane == 0 ? s : 0.f;
    }
}

template <bool WRITE_LA>
__device__ __forceinline__ void post_item(const Ctx& a, int layer, int it, LAS unsigned char* lds, int tid) {
    unsigned char* ws = a.ws; const int wave = __builtin_amdgcn_readfirstlane(tid >> 6), lane = tid & 63;
    const bf16_t* P = (const bf16_t*)(ws + O_P); const float* ta = (const float*)(ws + O_TABA); const float* tb = (const float*)(ws + O_TABB);
    bf16_t* QA = (bf16_t*)(ws + O_QA); bf16_t* KA = (bf16_t*)(ws + O_KA); bf16_t* KR = (bf16_t*)(ws + O_KROPE);
    const int r0 = it * 64;
    LAS float* caf = (LAS float*)lds;
    __syncthreads();
    for (int i = tid; i < 64 * 32; i += NTHR) { const int r = i >> 5, j = i & 31; caf[i] = bf2f(P[(size_t)(r0 + r) * PW + PC_SMALL + 32 + j]); }
    const float* gaq = a.in[I_GAQ] + layer * 64; const float* gak = a.in[I_GAK] + layer * 64;
    for (int j = 0; j < 8; ++j) {
        const int row = r0 + wave * 8 + j, t = row & (T - 1);
        {
            const int seg = lane & 7; float x[8]; load8(P + (size_t)row * PW + PC_AQ + lane * 8, x);
            float ss = 0.f;
#pragma unroll
            for (int e = 0; e < 8; ++e) ss += x[e] * x[e];
            ss += __shfl_xor(ss, 1); ss += __shfl_xor(ss, 2); ss += __shfl_xor(ss, 4);
            const float rstd = rsqrtf(ss * (1.0f / 64.0f) + EPS); const int tb_ = t * 64 + (seg >> 2) * 16 + (seg & 1) * 8; float o[8];
#pragma unroll
            for (int e = 0; e < 8; ++e) { const float xn = x[e] * rstd * gaq[seg * 8 + e]; const float pr = __shfl_xor(xn, 2); const float cs = ta[tb_ + e], sn = ta[tb_ + 32 + e];
                o[e] = ((seg & 2) ? xn * cs + pr * sn : xn * cs - pr * sn) * C2A; }
            store8(QA + (size_t)row * 512 + lane * 8, o);
        }
        {
            const int l2 = lane & 15, seg = l2 & 7; float x[8]; load8(P + (size_t)row * PW + PC_AK + l2 * 8, x);
            float ss = 0.f;
#pragma unroll
            for (int e = 0; e < 8; ++e) ss += x[e] * x[e];
            ss += __shfl_xor(ss, 1); ss += __shfl_xor(ss, 2); ss += __shfl_xor(ss, 4);
            const float rstd = rsqrtf(ss * (1.0f / 64.0f) + EPS); const int tb_ = t * 64 + (seg >> 2) * 16 + (seg & 1) * 8; float o[8];
#pragma unroll
            for (int e = 0; e < 8; ++e) { const float xn = x[e] * rstd * gak[seg * 8 + e]; const float pr = __shfl_xor(xn, 2); const float cs = ta[tb_ + e], sn = ta[tb_ + 32 + e];
                o[e] = (seg & 2) ? xn * cs + pr * sn : xn * cs - pr * sn; }
            if (lane < 16) store8(KA + (size_t)row * 128 + l2 * 8, o);
        }
        {
            const int seg = lane & 3; float x[8]; load8(P + (size_t)row * PW + PC_SMALL + seg * 8, x);
            const int tb_ = t * 32 + (seg >> 1) * 8; float o[8];
#pragma unroll
            for (int e = 0; e < 8; ++e) { const float pr = __shfl_xor(x[e], 1); const float cs = tb[tb_ + e], sn = tb[tb_ + 16 + e];
                o[e] = (seg & 1) ? x[e] * cs + pr * sn : x[e] * cs - pr * sn; }
            if (lane < 4) store8(KR + (size_t)row * 32 + seg * 8, o);
        }
    }
    __syncthreads();
    const int col = tid;
    for (int dir = 0; dir < 2; ++dir) {
        const float* Wup = a.in[dir ? I_WCAB : I_WCAF] + (size_t)layer * 16 * 512; const float bias = a.in[dir ? I_BCAB : I_BCAF][layer * 512 + col];
        float w[16];
#pragma unroll
        for (int j = 0; j < 16; ++j) w[j] = Wup[j * 512 + col];
        bf16_t* QT = (bf16_t*)(ws + O_QT) + (size_t)(dir * 2) * M * 512; bf16_t* KT = QT + (size_t)M * 512;
        float* LA = (float*)(ws + O_QT) + (size_t)dir * M * 512;
        float b = 0.f;
        for (int s = 0; s < 64; ++s) {
            const int r = dir ? 63 - s : s; const LAS float* cr = caf + r * 32 + dir * 16; float z = bias;
#pragma unroll
            for (int j = 0; j < 16; ++j) z = fmaf(cr[j], w[j], z);
            const float la = (fminf(z, 0.f) - __logf(1.0f + __expf(-fabsf(z)))) * (1.0f / 16.0f);
            b += la;
            const size_t row = (size_t)(r0 + r);
            if (WRITE_LA) LA[row * 512 + col] = la;
            else { const float e = __expf(b); const float q = bf2f(P[row * PW + PC_CQ + col]), k = bf2f(P[row * PW + PC_CK + col]);
                QT[row * 512 + col] = (bf16_t)f2bf(q * e * GLA_QSCALE); KT[row * 512 + col] = (bf16_t)f2bf(k / e); }
        }
        if (!WRITE_LA) ((float*)(ws + O_DEC))[(size_t)dir * 256 * 512 + (size_t)it * 512 + col] = __expf(b);
    }
}

template <int BR>
__device__ __forceinline__ void attn_naive_unit(const Ctx& a, int b, int h, int qb, LAS unsigned char* lds, int tid) {
    unsigned char* ws = a.ws; constexpr int DQ = BR ? 96 : 64;
    const bf16_t* P = (const bf16_t*)(ws + O_P);
    LAS float* Ks = (LAS float*)lds;
    LAS float* Vs = Ks + 64 * 96;
    LAS float* Qs = Vs + 64 * 64;
    const int r = tid >> 1, half = tid & 1; const size_t row0 = (size_t)b * T + qb * 256; const size_t row = row0 + r;
    __syncthreads();
    for (int i = tid; i < 256 * (DQ / 8); i += NTHR) { const int rr = i / (DQ / 8), ch = i % (DQ / 8); float f[8];
        if (BR == 0) load8((const bf16_t*)(ws + O_QA) + (row0 + rr) * 512 + h * 64 + ch * 8, f); else load8((const bf16_t*)(ws + O_QB) + (row0 + rr) * 768 + h * 96 + ch * 8, f);
#pragma unroll
        for (int e = 0; e < 8; ++e) Qs[rr * 97 + ch * 8 + e] = f[e]; }
    __syncthreads();
    if (BR == 1 && tid < 256) {
        const int t = (int)((row0 + tid) & (T - 1)); const float* tb = (const float*)(ws + O_TABB) + t * 32; LAS float* q = Qs + tid * 97 + 64;
        for (int blk = 0; blk < 2; ++blk)
            for (int e = 0; e < 8; ++e) { const float cs = tb[blk * 8 + e], sn = tb[16 + blk * 8 + e]; const float x1 = q[blk * 16 + e], x2 = q[blk * 16 + 8 + e];
                q[blk * 16 + e] = x1 * cs - x2 * sn; q[blk * 16 + 8 + e] = x2 * cs + x1 * sn; } }
    float m = -1e30f, l = 0.f, o[32];
#pragma unroll
    for (int j = 0; j < 32; ++j) o[j] = 0.f;
    for (int kt = 0; kt < T / 64; ++kt) {
        __syncthreads();
        for (int i = tid; i < 64 * (DQ / 8); i += NTHR) { const int kr = i / (DQ / 8), ch = i % (DQ / 8); const size_t krow = (size_t)b * T + kt * 64 + kr; float f[8];
            if (BR == 0) load8((const bf16_t*)(ws + O_KA) + krow * 128 + (h >> 2) * 64 + ch * 8, f);
            else if (ch < 8) load8((const bf16_t*)(ws + O_KNOPE) + krow * 512 + h * 64 + ch * 8, f);
            else load8((const bf16_t*)(ws + O_KROPE) + krow * 32 + (ch - 8) * 8, f);
#pragma unroll
            for (int e = 0; e < 8; ++e) Ks[kr * 96 + ch * 8 + e] = f[e]; }
        for (int i = tid; i < 64 * 8; i += NTHR) { const int kr = i >> 3, ch = i & 7; const size_t krow = (size_t)b * T + kt * 64 + kr; float f[8];
            if (BR == 0) load8(P + krow * PW + PC_AV + (h >> 2) * 64 + ch * 8, f); else load8((const bf16_t*)(ws + O_VB) + krow * 512 + h * 64 + ch * 8, f);
#pragma unroll
            for (int e = 0; e < 8; ++e) Vs[kr * 64 + ch * 8 + e] = f[e]; }
        __syncthreads();
#pragma unroll 1
        for (int kr = 0; kr < 64; ++kr) { float s = 0.f;
#pragma unroll 8
            for (int d = 0; d < DQ; ++d) s = fmaf(Qs[r * 97 + d], Ks[kr * 96 + d], s);
            if (s > m) { const float al = exp2f(m - s); l *= al;
#pragma unroll
                for (int j = 0; j < 32; ++j) o[j] *= al;
                m = s; }
            const float p = exp2f(s - m); l += p;
#pragma unroll
            for (int j = 0; j < 32; ++j) o[j] = fmaf(p, Vs[kr * 64 + half * 32 + j], o[j]); }
    }
    const float inv = 1.0f / l; bf16_t* Y = (bf16_t*)(ws + (BR ? O_YB : O_YA)) + row * 512 + h * 64 + half * 32;
#pragma unroll
    for (int j = 0; j < 32; j += 8) { float f[8];
#pragma unroll
        for (int e = 0; e < 8; ++e) f[e] = o[j + e] * inv;
        store8(Y + j, f); }
}

namespace att {
typedef short s16x4 __attribute__((ext_vector_type(4)));
typedef float f32x16 __attribute__((ext_vector_type(16)));
constexpr int SHM_V = 64 * 64 * 2, SHM_K = 64 * 256, OFF_K = 2 * SHM_V, OFF_WS = OFF_K + 2 * SHM_K, OFF_OST = OFF_WS + NWAVES * 64 * 4, ATT_LDS = OFF_OST + NWAVES * 4096;
constexpr float THRL = 8.0f;
#define KSWZ(row, colB) ((row) * 256 + ((colB) ^ (((row) & 7) << 4)))
#define SBAR() __builtin_amdgcn_sched_barrier(0)
__device__ __forceinline__ int crow(int r, int hi) { return (r & 3) + 8 * (r >> 2) + 4 * hi; }
__device__ __forceinline__ unsigned cvtpk(float lo, float hi) { unsigned r; asm volatile("v_cvt_pk_bf16_f32 %0, %1, %2" : "=v"(r) : "v"(lo), "v"(hi)); return r; }
__device__ __forceinline__ void partialSM(f32x16& p0, f32x16& p1, float& m_reg, float& mn, float& alpha) {
    float pmax = p0[0];
#pragma unroll
    for (int r = 1; r < 16; ++r) pmax = fmaxf(pmax, p0[r]);
#pragma unroll
    for (int r = 0; r < 16; ++r) pmax = fmaxf(pmax, p1[r]);
    { auto rr = __builtin_amdgcn_permlane32_swap(__float_as_uint(pmax), __float_as_uint(pmax), false, false); pmax = fmaxf(__uint_as_float(rr[0]), __uint_as_float(rr[1])); }
    if (__builtin_expect(__all(pmax - m_reg <= THRL), 1)) { mn = m_reg; alpha = 1.f; }
    else { mn = fmaxf(m_reg, pmax); alpha = __builtin_amdgcn_exp2f(m_reg - mn); m_reg = mn; }
#pragma unroll
    for (int r = 0; r < 16; ++r) { p0[r] -= mn; p1[r] -= mn; }
#pragma unroll
    for (int r = 0; r < 16; ++r) p0[r] = __builtin_amdgcn_exp2f(p0[r]);
}
__device__ __forceinline__ void finishSM(f32x16& p0, f32x16& p1, float alpha, float& l_reg, bf16x8& pa0, bf16x8& pa1, bf16x8& pa2, bf16x8& pa3) {
#pragma unroll
    for (int r = 0; r < 16; ++r) p1[r] = __builtin_amdgcn_exp2f(p1[r]);
    float ps = 0;
#pragma unroll
    for (int r = 0; r < 16; ++r) ps += p0[r];
#pragma unroll
    for (int r = 0; r < 16; ++r) ps += p1[r];
    { auto rr = __builtin_amdgcn_permlane32_swap(__float_as_uint(ps), __float_as_uint(ps), false, false); ps = __uint_as_float(rr[0]) + __uint_as_float(rr[1]); }
    l_reg = l_reg * alpha + ps;
#define PK4(P, BASE, OUT) do { unsigned a0 = cvtpk(P[BASE + 0], P[BASE + 1]), a1 = cvtpk(P[BASE + 2], P[BASE + 3]);   \
    unsigned b0 = cvtpk(P[BASE + 4], P[BASE + 5]), b1 = cvtpk(P[BASE + 6], P[BASE + 7]);                              \
    auto r0 = __builtin_amdgcn_permlane32_swap(a0, b0, false, false); auto r1 = __builtin_amdgcn_permlane32_swap(a1, b1, false, false); \
    u32x4 w = {r0[0], r1[0], r0[1], r1[1]}; OUT = __builtin_bit_cast(bf16x8, w); } while (0)
    PK4(p0, 0, pa0); PK4(p0, 8, pa1); PK4(p1, 0, pa2); PK4(p1, 8, pa3);
#undef PK4
}
template <int ND0>
__device__ __forceinline__ void qkt(f32x16& p0, f32x16& p1, const LAS unsigned char* Ks, const bf16x8* qr, int r32, int hi) {
    p0 = f32x16{}; p1 = f32x16{};
#pragma unroll
    for (int d0 = 0; d0 < ND0; ++d0) { const int cb = (d0 * 16 + hi * 8) * 2;
        const bf16x8 b0 = *(const LAS bf16x8*)(Ks + KSWZ(r32, cb)); const bf16x8 b1 = *(const LAS bf16x8*)(Ks + KSWZ(32 + r32, cb));
        p0 = __builtin_amdgcn_mfma_f32_32x32x16_bf16(b0, qr[d0], p0, 0, 0, 0); p1 = __builtin_amdgcn_mfma_f32_32x32x16_bf16(b1, qr[d0], p1, 0, 0, 0); }
}
__device__ __forceinline__ int v_st(int k, int c) { const int kk = (k & ~0xC) | ((k & 4) << 1) | ((k & 8) >> 1); return ((kk >> 3) * 2 + (c >> 5)) * 512 + ((kk & 7) * 32 + (c & 31)) * 2; }
__device__ __forceinline__ int v_rd_base(int lane) { return ((lane & 3) << 3) | (((lane >> 2) & 3) << 6) | (((lane >> 4) & 1) << 5) | (((lane >> 5) & 1) << 8); }
constexpr int v_rd_off(int d0, int ks, int half) { return d0 * 512 + ks * 2048 + half * 1024; }
template <int OFF> __device__ __forceinline__ s16x4 tr_read(int vb) { s16x4 r; asm volatile("ds_read_b64_tr_b16 %0, %1 offset:%2" : "=&v"(r) : "v"(vb), "i"(OFF) : "memory"); return r; }
template <int D0> __device__ __forceinline__ void pv_one(f32x16& od, int vb, bf16x8 pa0, bf16x8 pa1, bf16x8 pa2, bf16x8 pa3) {
    const s16x4 l0 = tr_read<v_rd_off(D0, 0, 0)>(vb), h0 = tr_read<v_rd_off(D0, 0, 1)>(vb), l1 = tr_read<v_rd_off(D0, 1, 0)>(vb), h1 = tr_read<v_rd_off(D0, 1, 1)>(vb);
    const s16x4 l2 = tr_read<v_rd_off(D0, 2, 0)>(vb), h2 = tr_read<v_rd_off(D0, 2, 1)>(vb), l3 = tr_read<v_rd_off(D0, 3, 0)>(vb), h3 = tr_read<v_rd_off(D0, 3, 1)>(vb);
    asm volatile("s_waitcnt lgkmcnt(0)" ::: "memory"); SBAR();
#define PK(L, H) (bf16x8){L[0], L[1], L[2], L[3], H[0], H[1], H[2], H[3]}
    od = __builtin_amdgcn_mfma_f32_32x32x16_bf16(pa0, PK(l0, h0), od, 0, 0, 0);
    od = __builtin_amdgcn_mfma_f32_32x32x16_bf16(pa1, PK(l1, h1), od, 0, 0, 0);
    od = __builtin_amdgcn_mfma_f32_32x32x16_bf16(pa2, PK(l2, h2), od, 0, 0, 0);
    od = __builtin_amdgcn_mfma_f32_32x32x16_bf16(pa3, PK(l3, h3), od, 0, 0, 0);
#undef PK
}
__device__ __forceinline__ void pv2(f32x16* o, int vb, bf16x8 pa0, bf16x8 pa1, bf16x8 pa2, bf16x8 pa3) { pv_one<0>(o[0], vb, pa0, pa1, pa2, pa3); pv_one<1>(o[1], vb, pa0, pa1, pa2, pa3); }

template <int BR>
__device__ __forceinline__ void unit(const Ctx& a, int b, int h, int qb, LAS unsigned char* lds, int tid_) {
    const int tid = launder_v(tid_);
    unsigned char* ws = a.ws; constexpr int DQ = BR ? 96 : 64, ND0 = DQ / 16, NKL = BR ? 2 : 1;
    const int wid = __builtin_amdgcn_readfirstlane(tid >> 6), lane = tid & 63, r32 = lane & 31, hi = lane >> 5;
    LAS unsigned char* V_lds = lds; LAS unsigned char* K_lds = lds + OFF_K;
    LAS float* wsf = (LAS float*)(lds + OFF_WS) + wid * 64; LAS float* li_l = wsf; LAS float* al_l = wsf + 32;
    const size_t row0 = (size_t)b * T + qb * 256, krow0 = (size_t)b * T;
    float m_reg = -1e30f, l_reg = 0; f32x16 o[2]; o[0] = f32x16{}; o[1] = f32x16{}; bf16x8 qr[ND0];
    {
        const size_t qrow = row0 + wid * 32 + r32;
        const bf16_t* Qw = BR ? (const bf16_t*)(ws + O_QB) + qrow * 768 + h * 96 + hi * 8 : (const bf16_t*)(ws + O_QA) + qrow * 512 + h * 64 + hi * 8;
#pragma unroll
        for (int d0 = 0; d0 < ND0; ++d0) qr[d0] = *(const bf16x8*)(Qw + d0 * 16);
        if (BR) {
            const float* tb = (const float*)(ws + O_TABB) + (int)(qrow & (T - 1)) * 32;
#pragma unroll
            for (int blk = 0; blk < 2; ++blk) { float x[8]; unpack8(__builtin_bit_cast(u32x4, qr[4 + blk]), x); float o8[8];
#pragma unroll
                for (int e = 0; e < 8; ++e) { const float pr = __shfl_xor(x[e], 32); const float cs = tb[blk * 8 + e], sn = tb[16 + blk * 8 + e]; o8[e] = hi ? x[e] * cs + pr * sn : x[e] * cs - pr * sn; }
                qr[4 + blk] = __builtin_bit_cast(bf16x8, pack8(o8)); } }
    }
    const int vr = tid >> 3, vc = (tid & 7) * 8, vst = v_st(vr, vc);
    int kr_[NKL], kc_[NKL];
#pragma unroll
    for (int i = 0; i < NKL; ++i) { int c = tid + i * 512; if (BR) { if (c >= 768) c -= 512; kr_[i] = c / 12; kc_[i] = c % 12; } else { kr_[i] = c >> 3; kc_[i] = c & 7; } }
    const bf16_t* Vsrc = BR ? (const bf16_t*)(ws + O_VB) + (krow0 + vr) * 512 + h * 64 + vc : (const bf16_t*)(ws + O_P) + (krow0 + vr) * PW + PC_AV + (h >> 2) * 64 + vc;
    const size_t vstep = (size_t)64 * (BR ? 512 : PW);
    const bf16_t* Ksrc[NKL]; size_t kstep_[NKL];
#pragma unroll
    for (int i = 0; i < NKL; ++i) {
        if (!BR) { Ksrc[i] = (const bf16_t*)(ws + O_KA) + (krow0 + kr_[i]) * 128 + (h >> 2) * 64 + kc_[i] * 8; kstep_[i] = (size_t)64 * 128; }
        else if (kc_[i] < 8) { Ksrc[i] = (const bf16_t*)(ws + O_KNOPE) + (krow0 + kr_[i]) * 512 + h * 64 + kc_[i] * 8; kstep_[i] = (size_t)64 * 512; }
        else { Ksrc[i] = (const bf16_t*)(ws + O_KROPE) + (krow0 + kr_[i]) * 32 + (kc_[i] - 8) * 8; kstep_[i] = (size_t)64 * 32; } }
    const bool k1_valid = !BR || tid < 256;
    const int vb0 = (int)(uintptr_t)V_lds + v_rd_base(lane);
    struct { bf16x8 v, k[NKL]; } sr_[2];
#define SLOAD(i, t) do { sr_[i].v = *(const bf16x8*)(Vsrc + (size_t)(t) * vstep); _Pragma("unroll") for (int q_ = 0; q_ < NKL; ++q_) sr_[i].k[q_] = *(const bf16x8*)(Ksrc[q_] + (size_t)(t) * kstep_[q_]); } while (0)
#define SWRITE(bb, i) do { *(LAS bf16x8*)(V_lds + (bb) * SHM_V + vst) = sr_[i].v; *(LAS bf16x8*)(K_lds + (bb) * SHM_K + KSWZ(kr_[0], kc_[0] * 16)) = sr_[i].k[0]; \
        if (NKL > 1) { if (k1_valid) *(LAS bf16x8*)(K_lds + (bb) * SHM_K + KSWZ(kr_[NKL - 1], kc_[NKL - 1] * 16)) = sr_[i].k[NKL - 1]; } } while (0)
#define RESC(al) do { if (__any((al) < 1.f)) { if (hi == 0) al_l[r32] = (al); asm volatile("s_waitcnt lgkmcnt(0)" ::: "memory"); \
        _Pragma("unroll") for (int d = 0; d < 2; ++d) _Pragma("unroll") for (int r = 0; r < 16; ++r) o[d][r] *= al_l[crow(r, hi)]; } } while (0)
    f32x16 pA0, pA1, pB0, pB1; float mnA, mnB, alA, alB; bf16x8 pa0, pa1, pa2, pa3; constexpr int NT = T / 64;
    __syncthreads();
    SLOAD(0, 0); SWRITE(0, 0); __syncthreads();
    qkt<ND0>(pA0, pA1, K_lds, qr, r32, hi); partialSM(pA0, pA1, m_reg, mnA, alA);
    SLOAD(1, 1); SLOAD(0, 2);
    SWRITE(1, 1); __syncthreads();
    for (int j = 1; j + 1 < NT; j += 2) {
        SBAR(); qkt<ND0>(pB0, pB1, K_lds + SHM_K, qr, r32, hi);
        finishSM(pA0, pA1, alA, l_reg, pa0, pa1, pa2, pa3); SBAR();
        SLOAD(1, j + 2); SBAR();
        pv2(o, vb0, pa0, pa1, pa2, pa3); partialSM(pB0, pB1, m_reg, mnB, alB);
        __syncthreads(); SWRITE(0, 0);
        RESC(alB); __syncthreads();
        SBAR(); qkt<ND0>(pA0, pA1, K_lds, qr, r32, hi);
        finishSM(pB0, pB1, alB, l_reg, pa0, pa1, pa2, pa3); SBAR();
        if (j + 3 < NT) SLOAD(0, j + 3); SBAR();
        pv2(o, vb0 + SHM_V, pa0, pa1, pa2, pa3); partialSM(pA0, pA1, m_reg, mnA, alA);
        __syncthreads(); SWRITE(1, 1);
        RESC(alA); __syncthreads();
    }
    SBAR(); qkt<ND0>(pB0, pB1, K_lds + SHM_K, qr, r32, hi);
    finishSM(pA0, pA1, alA, l_reg, pa0, pa1, pa2, pa3); SBAR();
    pv2(o, vb0, pa0, pa1, pa2, pa3); partialSM(pB0, pB1, m_reg, mnB, alB);
    __syncthreads(); RESC(alB);
    finishSM(pB0, pB1, alB, l_reg, pa0, pa1, pa2, pa3); SBAR();
    pv2(o, vb0 + SHM_V, pa0, pa1, pa2, pa3);
    if (hi == 0) li_l[r32] = l_reg; asm volatile("s_waitcnt lgkmcnt(0)" ::: "memory");
    float rli[16];
#pragma unroll
    for (int r = 0; r < 16; ++r) rli[r] = __builtin_amdgcn_rcpf(li_l[crow(r, hi)]);
    LAS bf16_t* stg = (LAS bf16_t*)(lds + OFF_OST) + wid * 2048;
#pragma unroll
    for (int r = 0; r < 16; ++r) { const int orow = crow(r, hi);
#pragma unroll
        for (int d0 = 0; d0 < 2; ++d0) stg[orow * 64 + d0 * 32 + r32] = (bf16_t)f2bf(o[d0][r] * rli[r]); }
    asm volatile("s_waitcnt lgkmcnt(0)" ::: "memory");
    bf16_t* Y = (bf16_t*)(ws + (BR ? O_YB : O_YA)) + (row0 + wid * 32) * 512 + h * 64;
#pragma unroll
    for (int i = 0; i < 4; ++i) { const int row = i * 8 + (lane >> 3), ch = lane & 7; const u32x4 v = *(const LAS u32x4*)(stg + row * 64 + ch * 8); *(u32x4*)(Y + (size_t)row * 512 + ch * 8) = v; }
#undef SLOAD
#undef SWRITE
#undef RESC
}
#undef KSWZ
#undef SBAR
}

namespace gla {
constexpr int LQ = 136, LT = 72;
constexpr int O_QS = 0, O_KS = O_QS + 64 * LQ * 2, O_KST = O_KS + 64 * LQ * 2, O_VST = O_KST + 128 * LT * 2, O_PS = O_VST + 128 * LT * 2, O_SST = O_PS + 64 * LT * 2, GLA_LDS = O_SST + 128 * LQ * 2;
static_assert(GLA_LDS <= LDS_CTL, "GLA LDS");
__device__ __forceinline__ bf16x8 frag(const LAS bf16_t* base, int ld, int row0, int k0, int lane) { return *(const LAS bf16x8*)(base + (row0 + (lane & 15)) * ld + k0 + 8 * (lane >> 4)); }
__device__ __forceinline__ void unit(const Ctx& a, int b, int h, int dir, LAS unsigned char* lds, int tid_) {
    const int tid = launder_v(tid_);
    unsigned char* ws = a.ws; const int wid = __builtin_amdgcn_readfirstlane(tid >> 6), lane = tid & 63, l15 = lane & 15, q4 = (lane >> 4) * 4;
    LAS bf16_t* Qs = (LAS bf16_t*)(lds + O_QS); LAS bf16_t* Ks = (LAS bf16_t*)(lds + O_KS); LAS bf16_t* KsT = (LAS bf16_t*)(lds + O_KST);
    LAS bf16_t* VsT = (LAS bf16_t*)(lds + O_VST); LAS bf16_t* Ps = (LAS bf16_t*)(lds + O_PS); LAS bf16_t* SsT = (LAS bf16_t*)(lds + O_SST);
    const bf16_t* QT = (const bf16_t*)(ws + O_QT) + (size_t)(dir * 2) * M * 512; const bf16_t* KT = QT + (size_t)M * 512;
    const bf16_t* Pm = (const bf16_t*)(ws + O_P); const float* DEC = (const float*)(ws + O_DEC) + (size_t)dir * 256 * 512;
    bf16_t* OC = (bf16_t*)(ws + (dir ? O_OCB : O_YC));
    const int srow = tid & 63, scg = tid >> 6;
    f32x4 S[8];
#pragma unroll
    for (int i = 0; i < 8; ++i) S[i] = (f32x4){0.f, 0.f, 0.f, 0.f};
    __syncthreads();
    for (int i = tid; i < 128 * LQ / 8; i += NTHR) ((LAS u32x4*)SsT)[i] = (u32x4){0u, 0u, 0u, 0u};
    bf16x8 gq[2], gk[2], gv[2];
#define GLOAD(n_) do { const int ci_ = dir ? 31 - (n_) : (n_); const size_t r_ = (size_t)b * T + ci_ * 64 + srow; _Pragma("unroll") for (int j_ = 0; j_ < 2; ++j_) { const int c8_ = (scg + 8 * j_) * 8; \
        gq[j_] = *(const bf16x8*)(QT + r_ * 512 + h * 128 + c8_); gk[j_] = *(const bf16x8*)(KT + r_ * 512 + h * 128 + c8_); gv[j_] = *(const bf16x8*)(Pm + r_ * PW + PC_CV + h * 128 + c8_); } } while (0)
    GLOAD(0);
    for (int n = 0; n < 32; ++n) {
        const int ci = dir ? 31 - n : n; const size_t rowbase = (size_t)b * T + ci * 64;
        __syncthreads();
#pragma unroll
        for (int j = 0; j < 2; ++j) { const int c8 = (scg + 8 * j) * 8;
            *(LAS bf16x8*)(Qs + srow * LQ + c8) = gq[j]; *(LAS bf16x8*)(Ks + srow * LQ + c8) = gk[j];
#pragma unroll
            for (int e = 0; e < 8; ++e) { KsT[(c8 + e) * LT + srow] = (bf16_t)gk[j][e]; VsT[(c8 + e) * LT + srow] = (bf16_t)gv[j][e]; } }
        if (n + 1 < 32) GLOAD(n + 1);
        f32x4 dec[8];
#pragma unroll
        for (int t = 0; t < 8; ++t) dec[t] = *(const f32x4*)(DEC + (size_t)(b * 32 + ci) * 512 + h * 128 + t * 16 + q4);
        __syncthreads();
        {
            const int it = wid >> 1, st0 = (wid & 1) * 2;
#pragma unroll
            for (int ss = 0; ss < 2; ++ss) { const int st = st0 + ss; f32x4 acc = (f32x4){0.f, 0.f, 0.f, 0.f};
                const bool dead = dir ? (st < it) : (st > it);
                if (!dead) {
#pragma unroll
                    for (int kk = 0; kk < 4; ++kk) acc = __builtin_amdgcn_mfma_f32_16x16x32_bf16(frag(Ks, LQ, st * 16, kk * 32, lane), frag(Qs, LQ, it * 16, kk * 32, lane), acc, 0, 0, 0);
                    if (st == it) {
#pragma unroll
                        for (int r = 0; r < 4; ++r) { const bool keep = dir ? (q4 + r >= l15) : (q4 + r <= l15); if (!keep) acc[r] = 0.f; } }
                }
                *(LAS u32x2*)(Ps + (it * 16 + l15) * LT + st * 16 + q4) = (u32x2){pk2(acc[0], acc[1]), pk2(acc[2], acc[3])}; }
        }
        f32x4 ao[4];
#pragma unroll
        for (int it = 0; it < 4; ++it) { ao[it] = (f32x4){0.f, 0.f, 0.f, 0.f};
#pragma unroll
            for (int kk = 0; kk < 4; ++kk) ao[it] = __builtin_amdgcn_mfma_f32_16x16x32_bf16(frag(SsT, LQ, wid * 16, kk * 32, lane), frag(Qs, LQ, it * 16, kk * 32, lane), ao[it], 0, 0, 0); }
        __syncthreads();
        { const bf16x8 v0 = frag(VsT, LT, wid * 16, 0, lane), v1 = frag(VsT, LT, wid * 16, 32, lane);
#pragma unroll
          for (int it = 0; it < 4; ++it) { ao[it] = __builtin_amdgcn_mfma_f32_16x16x32_bf16(v0, frag(Ps, LT, it * 16, 0, lane), ao[it], 0, 0, 0);
              ao[it] = __builtin_amdgcn_mfma_f32_16x16x32_bf16(v1, frag(Ps, LT, it * 16, 32, lane), ao[it], 0, 0, 0); }
#pragma unroll
          for (int t = 0; t < 8; ++t) { S[t] = __builtin_amdgcn_mfma_f32_16x16x32_bf16(frag(KsT, LT, t * 16, 0, lane), v0, S[t], 0, 0, 0);
              S[t] = __builtin_amdgcn_mfma_f32_16x16x32_bf16(frag(KsT, LT, t * 16, 32, lane), v1, S[t], 0, 0, 0);
              S[t] = S[t] * dec[t];
              *(LAS u32x2*)(SsT + (wid * 16 + l15) * LQ + t * 16 + q4) = (u32x2){pk2(S[t][0], S[t][1]), pk2(S[t][2], S[t][3])}; } }
#pragma unroll
        for (int it = 0; it < 4; ++it) *(u32x2*)(OC + (rowbase + it * 16 + l15) * 512 + h * 128 + wid * 16 + q4) = (u32x2){pk2(ao[it][0], ao[it][1]), pk2(ao[it][2], ao[it][3])};
    }
#undef GLOAD
}
__device__ __forceinline__ void combine_phase(const Ctx& a, int layer, int gw, int NGW, int lane) {
    unsigned char* ws = a.ws; bf16_t* YC = (bf16_t*)(ws + O_YC); const bf16_t* OCB = (const bf16_t*)(ws + O_OCB); const bf16_t* Pm = (const bf16_t*)(ws + O_P);
    float g[8]; { const float* gp = a.in[I_GCOUT] + layer * 128 + (lane & 15) * 8; const f32x4 g0 = *(const f32x4*)gp, g1 = *(const f32x4*)(gp + 4); g[0] = g0.x; g[1] = g0.y; g[2] = g0.z; g[3] = g0.w; g[4] = g1.x; g[5] = g1.y; g[6] = g1.z; g[7] = g1.w; }
    for (int m = gw; m < M; m += NGW) {
        float f[8], bb[8], cg[8]; load8(YC + (size_t)m * 512 + lane * 8, f); load8(OCB + (size_t)m * 512 + lane * 8, bb); load8(Pm + (size_t)m * PW + PC_CG + lane * 8, cg);
        float ss = 0.f;
#pragma unroll
        for (int e = 0; e < 8; ++e) { f[e] += bb[e]; ss += f[e] * f[e]; }
        ss += __shfl_xor(ss, 1); ss += __shfl_xor(ss, 2); ss += __shfl_xor(ss, 4); ss += __shfl_xor(ss, 8);
        const float rstd = rsqrtf(ss * (1.0f / 128.0f) + EPS);
#pragma unroll
        for (int e = 0; e < 8; ++e) f[e] = f[e] * rstd * g[e] * (cg[e] * sigmoidf_(cg[e]));
        store8(YC + (size_t)m * 512 + lane * 8, f);
    }
}
}

__device__ __forceinline__ void gla_naive_unit(const Ctx& a, int layer, int b, int h, LAS unsigned char* lds, int tid) {
    unsigned char* ws = a.ws; const bf16_t* P = (const bf16_t*)(ws + O_P); bf16_t* YC = (bf16_t*)(ws + O_YC);
    LAS float* qs = (LAS float*)lds; LAS float* ks = qs + 128; LAS float* as = ks + 128; LAS float* part = as + 128; LAS float* red = part + 512;
    const int j = tid & 127, qd = tid >> 7; const float gco = a.in[I_GCOUT][layer * 128 + j];
    for (int dir = 0; dir < 2; ++dir) {
        const float* LA = (const float*)(ws + O_QT) + (size_t)dir * M * 512;
        float S[32];
#pragma unroll
        for (int i = 0; i < 32; ++i) S[i] = 0.f;
        for (int step = 0; step < T; ++step) {
            const int tok = dir ? T - 1 - step : step; const size_t row = (size_t)b * T + tok;
            __syncthreads();
            if (tid < 128) { qs[tid] = bf2f(P[row * PW + PC_CQ + h * 128 + tid]) * GLA_QSCALE; ks[tid] = bf2f(P[row * PW + PC_CK + h * 128 + tid]); as[tid] = __expf(LA[row * 512 + h * 128 + tid]); }
            const float v = bf2f(P[row * PW + PC_CV + h * 128 + j]);
            __syncthreads();
            float o = 0.f;
#pragma unroll
            for (int i = 0; i < 32; ++i) { const int dk = qd * 32 + i; S[i] = as[dk] * S[i] + ks[dk] * v; o = fmaf(qs[dk], S[i], o); }
            part[qd * 128 + j] = o;
            __syncthreads();
            float v2 = 0.f;
            if (tid < 128) {
                const float tot = (part[tid] + part[128 + tid]) + (part[256 + tid] + part[384 + tid]);
                if (dir == 0) YC[row * 512 + h * 128 + tid] = (bf16_t)f2bf(tot);
                else { v2 = tot + bf2f(YC[row * 512 + h * 128 + tid]); const float ss = wave_sum(v2 * v2); if ((tid & 63) == 0) red[tid >> 6] = ss; }
            }
            if (dir == 1) {
                __syncthreads();
                if (tid < 128) {
                    const float rstd = rsqrtf((red[0] + red[1]) * (1.0f / 128.0f) + EPS);
                    const float g = bf2f(P[row * PW + PC_CG + h * 128 + tid]);
                    YC[row * 512 + h * 128 + tid] = (bf16_t)f2bf(v2 * rstd * gco * (g * sigmoidf_(g)));
                }
            }
        }
    }
}

__device__ __forceinline__ void router_item(const Ctx& a, int blk, LAS unsigned char* lds, int tid) {
    unsigned char* ws = a.ws; int* mi = (int*)(ws + O_MOEI); float* mf = (float*)(ws + O_MOEI);
    const int wave = __builtin_amdgcn_readfirstlane(tid >> 6), lane = tid & 63;
    LAS float* lg = (LAS float*)lds;
    const float* x1 = a.out; const float* g = a.in[I_GFFN] + 1024; const float* wr = a.in[I_WROUTER];
    __syncthreads();
    for (int j = 0; j < 8; ++j) {
        const int tok = blk * 64 + wave * 8 + j; float acc[8], ss = 0.f;
#pragma unroll
        for (int e = 0; e < 8; ++e) acc[e] = 0.f;
#pragma unroll
        for (int jj = 0; jj < 4; ++jj) { const int idx = (lane + 64 * jj) * 4; const f32x4 v = *(const f32x4*)(x1 + (size_t)tok * D + idx), gg = *(const f32x4*)(g + idx);
            ss += (v.x * v.x + v.y * v.y) + (v.z * v.z + v.w * v.w);
            const float hv[4] = {v.x * gg.x, v.y * gg.y, v.z * gg.z, v.w * gg.w};
#pragma unroll
            for (int c = 0; c < 4; ++c) { const f32x4 w0 = *(const f32x4*)(wr + (size_t)(idx + c) * 8), w1 = *(const f32x4*)(wr + (size_t)(idx + c) * 8 + 4);
                acc[0] = fmaf(hv[c], w0.x, acc[0]); acc[1] = fmaf(hv[c], w0.y, acc[1]); acc[2] = fmaf(hv[c], w0.z, acc[2]); acc[3] = fmaf(hv[c], w0.w, acc[3]);
                acc[4] = fmaf(hv[c], w1.x, acc[4]); acc[5] = fmaf(hv[c], w1.y, acc[5]); acc[6] = fmaf(hv[c], w1.z, acc[6]); acc[7] = fmaf(hv[c], w1.w, acc[7]); } }
        ss = wave_sum(ss); const float rstd = rsqrtf(ss * (1.0f / 1024.0f) + EPS);
#pragma unroll
        for (int e = 0; e < 8; ++e) { const float s = wave_sum(acc[e]); if (lane == 0) lg[(wave * 8 + j) * 8 + e] = s * rstd; }
    }
    __syncthreads();
    if (wave == 0) {
        const int tok = blk * 64 + lane; float v[8];
#pragma unroll
        for (int e = 0; e < 8; ++e) v[e] = lg[lane * 8 + e];
        int e1 = 0; float v1 = v[0];
#pragma unroll
        for (int e = 1; e < 8; ++e) if (v[e] > v1) { v1 = v[e]; e1 = e; }
        int e2 = -1; float v2 = -3.0e38f;
#pragma unroll
        for (int e = 0; e < 8; ++e) if (e != e1 && v[e] > v2) { v2 = v[e]; e2 = e; }
        const float w1 = 1.0f / (1.0f + __expf(v2 - v1)), w2 = 1.0f - w1;
        const unsigned long long lt = (1ull << lane) - 1ull; int ra = 0, rb = 0, mycnt = 0;
#pragma unroll
        for (int e = 0; e < 8; ++e) { const unsigned long long m0 = __ballot(e1 == e), m1 = __ballot(e2 == e); const int c0 = __popcll(m0);
            if (e1 == e) ra = __popcll(m0 & lt); if (e2 == e) rb = c0 + __popcll(m1 & lt); if (lane == e) mycnt = c0 + __popcll(m1); }
        mi[MI_TOKE + tok] = e1 | (e2 << 8); mi[MI_TOKR + tok] = ra | (rb << 16); mf[MI_TOKW + tok * 2] = w1; mf[MI_TOKW + tok * 2 + 1] = w2;
        if (lane < 8) mi[MI_CNT + blk * 8 + lane] = mycnt;
    }
}
__device__ __forceinline__ void positions_phase(const Ctx& a, LAS unsigned char* lds, int G, int bid, int tid) {
    unsigned char* ws = a.ws; int* mi = (int*)(ws + O_MOEI); float* mf = (float*)(ws + O_MOEI);
    LAS int* cnt = (LAS int*)lds; LAS int* base = cnt + 2048;
    __syncthreads();
    for (int i = tid; i < 2048; i += NTHR) cnt[i] = mi[MI_CNT + i];
    __syncthreads();
    if (tid < 8) { int run = 0; for (int b = 0; b < 256; ++b) { const int c = cnt[b * 8 + tid]; cnt[b * 8 + tid] = run; run += c; } base[8 + tid] = run; }
    __syncthreads();
    if (tid == 0) { int off = 0; for (int e = 0; e < 8; ++e) { base[e] = off; off += (base[8 + e] + 255) & ~255; } base[16] = off >> 8; }
    __syncthreads();
    if (bid == 0) {
        const int nt = base[16];
        for (int t = tid; t < nt; t += NTHR) { int e = 0;
#pragma unroll
            for (int k = 1; k < 8; ++k) if (t * 256 >= base[k]) e = k;
            mi[MI_TILEE + t] = e; }
        if (tid == 0) mi[MI_TILEE + MAXTILES] = nt;
        for (int e = 0; e < 8; ++e) { const int lo = base[e] + base[8 + e], hi = base[e] + ((base[8 + e] + 255) & ~255);
            for (int r = lo + tid; r < hi; r += NTHR) { mi[MI_ROWTOK + r] = 0; mf[MI_ROWW + r] = 0.f; } }
    }
    for (int blk = bid; blk < 256; blk += G) if (tid < 64) {
        const int tok = blk * 64 + tid; const int ee = mi[MI_TOKE + tok], rr = mi[MI_TOKR + tok]; const int e1 = ee & 255, e2 = ee >> 8;
        const int pa = base[e1] + cnt[blk * 8 + e1] + (rr & 0xffff), pb = base[e2] + cnt[blk * 8 + e2] + (rr >> 16);
        mi[MI_ROWTOK + pa] = tok; mf[MI_ROWW + pa] = mf[MI_TOKW + tok * 2]; mi[MI_ROWTOK + pb] = tok; mf[MI_ROWW + pb] = mf[MI_TOKW + tok * 2 + 1];
        mi[MI_TOKPOS + tok * 2] = pa; mi[MI_TOKPOS + tok * 2 + 1] = pb;
    }
}
__device__ __forceinline__ void final_phase(const Ctx& a, int gw, int NGW, int lane) {
    unsigned char* ws = a.ws; const int* mi = (const int*)(ws + O_MOEI); const bf16_t* OUTS = (const bf16_t*)(ws + O_OUTS); const float* gf = a.in[I_GFINAL];
    for (int m = gw; m < M; m += NGW) {
        const int pa = mi[MI_TOKPOS + m * 2], pb = mi[MI_TOKPOS + m * 2 + 1]; f32x4 v[4]; float s = 0.f;
#pragma unroll
        for (int j = 0; j < 4; ++j) { const int idx = (lane + 64 * j) * 4; v[j] = *(const f32x4*)(a.out + (size_t)m * D + idx);
            const u32x2 ua = *(const u32x2*)(OUTS + (size_t)pa * 1024 + idx), ub = *(const u32x2*)(OUTS + (size_t)pb * 1024 + idx);
            v[j].x += bf2f(ua.x & 0xffffu) + bf2f(ub.x & 0xffffu); v[j].y += bf2f(ua.x >> 16) + bf2f(ub.x >> 16); v[j].z += bf2f(ua.y & 0xffffu) + bf2f(ub.y & 0xffffu); v[j].w += bf2f(ua.y >> 16) + bf2f(ub.y >> 16);
            s += (v[j].x * v[j].x + v[j].y * v[j].y) + (v[j].z * v[j].z + v[j].w * v[j].w); }
        s = wave_sum(s); const float rstd = rsqrtf(s * (1.0f / 1024.0f) + EPS);
#pragma unroll
        for (int j = 0; j < 4; ++j) { const int idx = (lane + 64 * j) * 4; const f32x4 g = *(const f32x4*)(gf + idx);
            *(f32x4*)(a.out + (size_t)m * D + idx) = (f32x4){v[j].x * rstd * g.x, v[j].y * rstd * g.y, v[j].z * rstd * g.z, v[j].w * rstd * g.w}; }
    }
}

#ifndef FAST_MASK
#define FAST_MASK 0x1ff
#endif
template <int SITE, bool GATHER = false, class Sched, class Epi>
__device__ __forceinline__ void gemm_run(LAS unsigned char* lds, const Sched& S, const Epi& E, int K, int lda) {
    if constexpr (NAIVE_GEMM || !((FAST_MASK >> SITE) & 1)) gemm_naive(S, E, K, lda);
    else pg8::gemm_phase<GATHER>(lds, S, E, K, lda);
}

constexpr int NPHASE = 20;
__global__ void __launch_bounds__(NTHR, 2) mega_fwd(Args args) {
    extern __shared__ __attribute__((aligned(16))) unsigned char lds_raw[];
    LAS unsigned char* lds = (LAS unsigned char*)lds_raw;
    { const int tid0 = threadIdx.x; for (int u = tid0; u < (LDS_BYTES - LDS_CTL) / 4; u += NTHR) ((LAS unsigned*)(lds + LDS_CTL))[u] = 0u; }
    __syncthreads();
    XcdBarrier bar; bar.bar = (unsigned*)args.ws + CW_BAR; bar.x = 0; bar.st = nullptr;
#if N_LAUNCH_MODE == 1
    bar = xcd_barrier_post((unsigned*)args.ws + CW_BAR, (volatile LAS unsigned*)(lds + LDS_MISC) + 8);
#endif
    const int lo = args.ph_lo, hi = args.ph_hi;
#define IN(k) in_phase(lo, hi, (k))
#if N_LAUNCH_MODE == 1
#define SEAM(k) do { if (IN(k) && IN((k) + 1)) xcd_barrier(bar); } while (0)
#else
#define SEAM(k) do { } while (0)
#endif
#define PH_BEGIN unsigned char* ws = launder_s(args.ws); const Ctx A{(const float* const*)(ws + O_PTAB), args.out, ws}; const int tid = launder_v((int)threadIdx.x); \
    const int G = launder_i((int)gridDim.x), bid = launder_i((int)blockIdx.x); \
    const int lane = tid & 63, wave = __builtin_amdgcn_readfirstlane(tid >> 6); const int vcu = (G % 8 == 0) ? (bid % 8) * (G / 8) + bid / 8 : bid; \
    const int gw = vcu * NWAVES + wave, NGW = G * NWAVES; (void)lane; (void)gw; (void)NGW; (void)ws;

    if (IN(0)) {
        if (threadIdx.x == 0) { const float** tab = (const float**)(args.ws + O_PTAB);
#pragma unroll
            for (int i = 0; i < 28; ++i) tab[i] = args.in[i]; }
        asm volatile("s_waitcnt vmcnt(0)" ::: "memory"); __syncthreads();
        PH_BEGIN; phase_prologue(A, lds, vcu, G, tid); SEAM(0); }

    for (int l = 0; l < 2; ++l) {
        const int pb = l ? 9 : 1;
        if (IN(pb)) {
            PH_BEGIN;
            SchedDense S{(const bf16_t*)(ws + O_XB), (const bf16_t*)(ws + O_WIN + l * SZ_WIN1), 1024, 1024, 64, NIN / 256, G, bid};
            EpiInProj E{(bf16_t*)(ws + O_P), (bf16_t*)(ws + O_GATES), (const float*)(ws + O_SSQ), A.in[I_BGATE] + l * 3072, (float*)(ws + O_RSP)};
            gemm_run<0>(lds, S, E, 1024, 1024);
            SEAM(pb);
        }
        if (IN(pb + 1)) {
            PH_BEGIN;
            for (int it = bid; it < 256; it += G) post_item<(NAIVE_GLA != 0)>(A, l, it, lds, tid);
            __syncthreads();
            SchedUp S{(const bf16_t*)(ws + O_P), (const bf16_t*)(ws + O_WQUP + l * SZ_WQUP1), (const bf16_t*)(ws + O_WKVUP + l * SZ_WKVUP1), G, bid};
            EpiUpProj E{(const float*)(ws + O_RSP), (bf16_t*)(ws + O_QB), (bf16_t*)(ws + O_KNOPE), (bf16_t*)(ws + O_VB)};
            gemm_run<1>(lds, S, E, 256, PW);
            SEAM(pb + 1);
        }
        if (IN(pb + 2)) {
            PH_BEGIN;
            unsigned* qh = (unsigned*)ws + CW_Q + 64 * l; LAS unsigned* slot = (LAS unsigned*)(lds + LDS_CTL + 64);
            constexpr int NGLA = NAIVE_GLA ? 32 : 64;
            for (;;) {
                __syncthreads();
                if (tid == 0) *slot = __hip_atomic_fetch_add(qh, 1u, __ATOMIC_RELAXED, __HIP_MEMORY_SCOPE_AGENT);
                __syncthreads();
                const int u = (int)*slot;
                if (u >= NGLA + 1024) break;
#if NAIVE_GLA
                if (u < NGLA) gla_naive_unit(A, l, u >> 2, u & 3, lds, tid);
#else
                if (u < NGLA) gla::unit(A, u >> 3, (u >> 1) & 3, u & 1, lds, tid);
#endif
#if NAIVE_ATTN
                else if (u < NGLA + 512) { const int v = u - NGLA; attn_naive_unit<1>(A, v >> 6, (v >> 3) & 7, v & 7, lds, tid); }
                else { const int v = u - NGLA - 512; attn_naive_unit<0>(A, v >> 6, (v >> 3) & 7, v & 7, lds, tid); }
#else
                else if (u < NGLA + 512) { const int v = u - NGLA; att::unit<1>(A, v >> 6, (v >> 3) & 7, v & 7, lds, tid); }
                else { const int v = u - NGLA - 512; att::unit<0>(A, v >> 6, (v >> 3) & 7, v & 7, lds, tid); }
#endif
            }
            SEAM(pb + 2);
        }
        if (IN(pb + 3)) {
            PH_BEGIN;
#if !NAIVE_GLA
            gla::combine_phase(A, l, gw, NGW, lane);
#endif
            SEAM(pb + 3);
        }
        if (IN(pb + 4)) {
            PH_BEGIN;
            SchedMerge S{(const bf16_t*)(ws + O_YA), (const bf16_t*)(ws + O_WP + l * 3 * SZ_WP1), G, bid};
            EpiMerge E{(const bf16_t*)(ws + O_GATES), (float*)(ws + O_PART), (bf16_t*)(ws + O_MB)};
            gemm_run<2>(lds, S, E, 512, 512);
            SEAM(pb + 4);
        }
        if (IN(pb + 5)) {
            PH_BEGIN;
            SchedDense S{(const bf16_t*)(ws + O_MB), (const bf16_t*)(ws + O_WOUT + l * SZ_WOUT1), 1024, 1024, 64, 4, G, bid};
            EpiResid E{l ? A.out : A.in[I_X], A.out, (bf16_t*)(ws + O_XB), (float*)(ws + O_SSQ)};
            gemm_run<3>(lds, S, E, 1024, 1024);
            SEAM(pb + 5);
        }
        if (l == 0) {
            if (IN(7)) {
                PH_BEGIN;
                SchedDense S{(const bf16_t*)(ws + O_XB), (const bf16_t*)(ws + O_WFFGU), 1024, 1024, 64, 2 * DFF / 256, G, bid};
                EpiSwiGLU E{(const float*)(ws + O_SSQ), nullptr, (bf16_t*)(ws + O_HID), DFF};
                gemm_run<4>(lds, S, E, 1024, 1024);
                SEAM(7);
            }
            if (IN(8)) {
                PH_BEGIN;
                SchedDense S{(const bf16_t*)(ws + O_HID), (const bf16_t*)(ws + O_WFFD), DFF, DFF, 64, 4, G, bid};
                EpiResid E{A.out, A.out, (bf16_t*)(ws + O_XB), (float*)(ws + O_SSQ)};
                gemm_run<5>(lds, S, E, DFF, DFF);
                SEAM(8);
            }
        }
    }
    if (IN(15)) {
        PH_BEGIN;
        for (int blk = bid; blk < 256; blk += G) router_item(A, blk, lds, tid);
        __syncthreads();
        run_transposes<true>(A, lds, gw, NGW, wave, lane);
        SEAM(15);
    }
    if (IN(16)) { PH_BEGIN; positions_phase(A, lds, G, bid, tid); SEAM(16); }
    if (IN(17)) {
        PH_BEGIN; int* mi = (int*)(ws + O_MOEI);
        SchedMoe S{(const bf16_t*)(ws + O_XB), (const bf16_t*)(ws + O_WEGU), mi + MI_TILEE, mi + MI_ROWTOK, 1024, 1024, 2 * DFE / 256, G, bid, (size_t)2 * DFE * 1024, true};
        EpiSwiGLU E{(const float*)(ws + O_SSQ), mi + MI_ROWTOK, (bf16_t*)(ws + O_HIDS), DFE};
        gemm_run<6, true>(lds, S, E, 1024, 1024);
        SEAM(17);
    }
    if (IN(18)) {
        PH_BEGIN; int* mi = (int*)(ws + O_MOEI);
        SchedMoe S{(const bf16_t*)(ws + O_HIDS), (const bf16_t*)(ws + O_WED), mi + MI_TILEE, mi + MI_ROWTOK, DFE, DFE, 4, G, bid, (size_t)1024 * DFE, false};
        EpiMoeDown E{(const float*)(ws + O_MOEI) + MI_ROWW, (bf16_t*)(ws + O_OUTS)};
        gemm_run<7>(lds, S, E, DFE, DFE);
        SEAM(18);
    }
    if (IN(19)) { PH_BEGIN; final_phase(A, gw, NGW, lane); }
#undef IN
#undef SEAM
#undef PH_BEGIN
}

extern "C" void kernel_launch(void* const* d_in, const int* in_sizes, int n_in, void* d_out, int out_size, void* d_ws, size_t ws_size, hipStream_t stream) {
    static int grid = 0;
    if (grid == 0) {
        if (n_in != 28 || out_size != M * D || ws_size < WS_NEED) { fprintf(stderr, "kernel_launch: unexpected shapes (n_in %d out %d ws %zu need %zu)\n", n_in, out_size, ws_size, (size_t)WS_NEED); grid = -1; return; }
        int dev = 0, cus = 0;
        if (hipGetDevice(&dev) != hipSuccess || hipDeviceGetAttribute(&cus, hipDeviceAttributeMultiprocessorCount, dev) != hipSuccess) { grid = -1; return; }
        if (hipFuncSetAttribute((const void*)mega_fwd, hipFuncAttributeMaxDynamicSharedMemorySize, LDS_BYTES) != hipSuccess) { grid = -1; return; }
        int per_cu = 0;
        if (hipOccupancyMaxActiveBlocksPerMultiprocessor(&per_cu, (const void*)mega_fwd, NTHR, LDS_BYTES) != hipSuccess || per_cu < 1) { fprintf(stderr, "kernel_launch: occupancy query says %d\n", per_cu); }
        (void)hipGetLastError();
        grid = cus;
    }
    if (grid < 0) return;
    (void)hipMemsetAsync(d_ws, 0, CTL_BYTES, stream);
    Args a{};
    for (int i = 0; i < 28; ++i) a.in[i] = (const float*)d_in[i];
    a.out = (float*)d_out; a.ws = (unsigned char*)d_ws; a.li = 0; a.pad = 0;
#if N_LAUNCH_MODE == 1
    a.ph_lo = 0; a.ph_hi = NPHASE;
    hipLaunchKernelGGL(mega_fwd, dim3(grid), dim3(NTHR), LDS_BYTES, stream, a);
#else
    for (int p = 0; p < NPHASE; ++p) { a.ph_lo = p; a.ph_hi = p + 1; hipLaunchKernelGGL(mega_fwd, dim3(grid), dim3(NTHR), LDS_BYTES, stream, a); }
#endif
}
```

```cpp
#include <hip/hip_runtime.h>
#include <cstdio>
#include <cstdint>

#ifndef N_LAUNCH_MODE
#define N_LAUNCH_MODE 1
#endif
#ifndef PROBE_MASK
#define PROBE_MASK 0
#endif
#ifndef NAIVE_GEMM
#define NAIVE_GEMM 0
#endif
#ifndef NAIVE_ATTN
#define NAIVE_ATTN 0
#endif
#ifndef NAIVE_GLA
#define NAIVE_GLA 0
#endif

#define LAS __attribute__((address_space(3)))
#define GAS __attribute__((address_space(1)))
typedef unsigned short bf16_t;
typedef short bf16x8 __attribute__((ext_vector_type(8)));
typedef float f32x4 __attribute__((ext_vector_type(4)));
typedef unsigned u32x4 __attribute__((ext_vector_type(4)));
typedef unsigned u32x2 __attribute__((ext_vector_type(2)));

constexpr int M = 16384, D = 1024, T = 2048, NBATCH = 8, NWAVES = 8, NTHR = 512;
constexpr float EPS = 1e-6f;
constexpr int PW = 2304;
constexpr int PC_AQ = 0, PC_AK = 512, PC_SMALL = 640, PC_BCQ = 768, PC_BCKV = 1024, PC_CQ = 1280, PC_CK = 1792;
constexpr int NIN = 6656;
constexpr int DFF = 2816, DFE = 3584, NEXP = 8;
constexpr int MAXTILES = 136, MAXROWS = MAXTILES * 256;
constexpr float LOG2E = 1.4426950408889634f;
constexpr float C2A = 0.125f * LOG2E;
constexpr float C2B = 0.10206207261596575f * LOG2E;
constexpr float GLA_QSCALE = 0.08838834764831845f;

constexpr size_t CTL_BYTES = 1u << 20;
constexpr size_t SZ_WIN1 = (size_t)NIN * 1024 * 2, SZ_WQUP1 = 768 * 256 * 2, SZ_WKVUP1 = 1024 * 256 * 2, SZ_WP1 = 1024 * 512 * 2, SZ_WOUT1 = 1024 * 1024 * 2;
constexpr size_t O_WIN = CTL_BYTES;
constexpr size_t O_WQUP = O_WIN + 2 * SZ_WIN1;
constexpr size_t O_WKVUP = O_WQUP + 2 * SZ_WQUP1;
constexpr size_t O_WP = O_WKVUP + 2 * SZ_WKVUP1;
constexpr size_t O_WOUT = O_WP + 6 * SZ_WP1;
constexpr size_t O_WFFGU = O_WOUT + 2 * SZ_WOUT1;
constexpr size_t O_WFFD = O_WFFGU + (size_t)2 * DFF * 1024 * 2;
constexpr size_t O_TABA = O_WFFD + (size_t)1024 * DFF * 2;
constexpr size_t O_TABB = O_TABA + (size_t)T * 64 * 4;
constexpr size_t O_XB = O_TABB + (size_t)T * 32 * 4;
constexpr size_t O_SSQ = O_XB + (size_t)M * 1024 * 2;
constexpr size_t O_RSP = O_SSQ + (size_t)M * 16 * 4;
constexpr size_t O_PTAB = O_RSP + (size_t)M * 32 * 4;
constexpr size_t O_MOEI = O_PTAB + 256;
constexpr size_t SZ_MOEI = 2u << 20;
constexpr size_t O_R = O_MOEI + SZ_MOEI;
constexpr size_t O_P = O_R;
constexpr size_t O_VA = O_P + (size_t)M * PW * 2;
constexpr size_t O_VG = O_VA + (size_t)M * 128 * 2;
constexpr size_t O_GATES = O_VG + (size_t)M * 1024 * 2;
constexpr size_t O_QA = O_GATES + (size_t)M * 3072 * 2;
constexpr size_t O_KA = O_QA + (size_t)M * 512 * 2;
constexpr size_t O_KROPE = O_KA + (size_t)M * 128 * 2;
constexpr size_t O_QB = O_KROPE + (size_t)M * 32 * 2;
constexpr size_t O_KNOPE = O_QB + (size_t)M * 768 * 2;
constexpr size_t O_VB = O_KNOPE + (size_t)M * 512 * 2;
constexpr size_t O_QT = O_VB + (size_t)M * 512 * 2;
constexpr size_t O_DEC = O_QT + (size_t)4 * M * 512 * 2;
constexpr size_t O_YA = O_DEC + (size_t)2 * 256 * 512 * 4;
constexpr size_t O_YB = O_YA + (size_t)M * 512 * 2;
constexpr size_t O_YC = O_YB + (size_t)M * 512 * 2;
constexpr size_t O_OCB = O_YC + (size_t)M * 512 * 2;
constexpr size_t O_MIX_END = O_OCB + (size_t)M * 512 * 2;
constexpr size_t O_PART = O_QT;
constexpr size_t O_MB = O_QT;
constexpr size_t O_HID = O_P;
constexpr size_t O_WEGU = O_R;
constexpr size_t O_WED = O_WEGU + (size_t)NEXP * 2 * DFE * 1024 * 2;
constexpr size_t O_HIDS = O_WED + (size_t)NEXP * 1024 * DFE * 2;
constexpr size_t O_MOE_END = O_HIDS + (size_t)MAXROWS * DFE * 2;
constexpr size_t O_OUTS = O_WEGU;
constexpr int KSPLIT = 4, MAXSPLIT = 32;
constexpr size_t O_SLAB = O_OUTS + (size_t)MAXROWS * 1024 * 2;
static_assert(O_SLAB + (size_t)MAXSPLIT * KSPLIT * 65536 * 4 <= O_WED, "slabs overlay");
constexpr size_t WS_NEED = O_MIX_END > O_MOE_END ? O_MIX_END : O_MOE_END;
static_assert(WS_NEED <= 531851264ull, "workspace map exceeds the guaranteed ws_size");
static_assert((size_t)M * 1024 * 4 <= (size_t)4 * M * 512 * 2, "PART overlay");
static_assert((size_t)MAXROWS * 1024 * 2 <= (size_t)NEXP * 2 * DFE * 1024 * 2, "OUTS overlay");
constexpr int MI_CNT = 0;
constexpr int MI_TOKE = 4096;
constexpr int MI_TOKR = MI_TOKE + M;
constexpr int MI_TOKW = MI_TOKR + M;
constexpr int MI_TOKPOS = MI_TOKW + 2 * M;
constexpr int MI_ROWTOK = MI_TOKPOS + 2 * M;
constexpr int MI_ROWW = MI_ROWTOK + MAXROWS;
constexpr int MI_TILEE = MI_ROWW + MAXROWS;
constexpr int MI_ROWSC = MI_TILEE + MAXTILES + 8;
constexpr int MI_SPLIT = MI_ROWSC + MAXROWS;
constexpr int MI_END = MI_SPLIT + MAXTILES * 4 + 8;
static_assert((size_t)MI_END * 4 <= SZ_MOEI, "moe lists");

constexpr int CW_TMO = 0;
constexpr int CW_Q = 1024;
constexpr int CW_BAR = 4096;

constexpr int LDS_RING = 131072, LDS_CTL = 145408, LDS_MISC = LDS_CTL + 320, LDS_BYTES = 147456;

__device__ __forceinline__ float bf2f(unsigned v) { return __uint_as_float(v << 16); }
__device__ __forceinline__ unsigned f2bf(float f) { typedef float f2_ __attribute__((ext_vector_type(2))); typedef __bf16 b2_ __attribute__((ext_vector_type(2))); f2_ v = {f, 0.f}; b2_ b = __builtin_convertvector(v, b2_); return __builtin_bit_cast(unsigned, b) & 0xffffu; }
typedef float f32x2_t __attribute__((ext_vector_type(2))); typedef __bf16 bf16x2_t __attribute__((ext_vector_type(2)));
__device__ __forceinline__ unsigned pk2(float lo, float hi) { f32x2_t v = {lo, hi}; bf16x2_t b = __builtin_convertvector(v, bf16x2_t); return __builtin_bit_cast(unsigned, b); }
__device__ __forceinline__ void unpack8(const u32x4 w, float (&f)[8]) {
    f[0] = __uint_as_float(w.x << 16); f[1] = __uint_as_float(w.x & 0xffff0000u); f[2] = __uint_as_float(w.y << 16); f[3] = __uint_as_float(w.y & 0xffff0000u);
    f[4] = __uint_as_float(w.z << 16); f[5] = __uint_as_float(w.z & 0xffff0000u); f[6] = __uint_as_float(w.w << 16); f[7] = __uint_as_float(w.w & 0xffff0000u);
}
__device__ __forceinline__ u32x4 pack8(const float (&f)[8]) { u32x4 w; w.x = pk2(f[0], f[1]); w.y = pk2(f[2], f[3]); w.z = pk2(f[4], f[5]); w.w = pk2(f[6], f[7]); return w; }
__device__ __forceinline__ void load8(const bf16_t* p, float (&f)[8]) { unpack8(*(const u32x4*)p, f); }
__device__ __forceinline__ void store8(bf16_t* p, const float (&f)[8]) { *(u32x4*)p = pack8(f); }
__device__ __forceinline__ void ld8f(const float* p, float (&f)[8]) { const f32x4 a = *(const f32x4*)p, b = *(const f32x4*)(p + 4); f[0] = a.x; f[1] = a.y; f[2] = a.z; f[3] = a.w; f[4] = b.x; f[5] = b.y; f[6] = b.z; f[7] = b.w; }
template <int MASK> __device__ __forceinline__ float shx(float v) { static_assert(MASK > 0 && MASK < 32, "shx: 1..31"); return __int_as_float(__builtin_amdgcn_ds_swizzle(__float_as_int(v), 0x1f | (MASK << 10))); }
__device__ __forceinline__ float sum_halves(float v) { auto r = __builtin_amdgcn_permlane32_swap(__float_as_uint(v), __float_as_uint(v), false, false); return __uint_as_float(r[0]) + __uint_as_float(r[1]); }
__device__ __forceinline__ float other_half(float v, int hi) { auto r = __builtin_amdgcn_permlane32_swap(__float_as_uint(v), __float_as_uint(v), false, false); return __uint_as_float(hi ? r[0] : r[1]); }
__device__ __forceinline__ float wave_sum(float v) { v += shx<1>(v); v += shx<2>(v); v += shx<4>(v); v += shx<8>(v); v += shx<16>(v); return sum_halves(v); }
__device__ __forceinline__ float row_rstd16(const float* ssq, int row) {
    const f32x4* p = (const f32x4*)(ssq + (size_t)row * 16);
    const f32x4 a = p[0], b = p[1], c = p[2], d = p[3];
    const float s = ((a.x + a.y) + (a.z + a.w)) + ((b.x + b.y) + (b.z + b.w)) + ((c.x + c.y) + (c.z + c.w)) + ((d.x + d.y) + (d.z + d.w));
    return rsqrtf(s * (1.0f / 1024.0f) + EPS);
}
__device__ __forceinline__ float sigmoidf_(float x) { return __builtin_amdgcn_rcpf(1.0f + __builtin_amdgcn_exp2f(x * -LOG2E)); }

#define XB_TMO      128
#define XB_XCNT(j)  (256  + 64 * (j))
#define XB_XSUB(j)  (1280 + 64 * (j))
#define XB_XGEN(j)  (2304 + 64 * (j))
#define XB_TOP      3328
#define XB_TOPGEN   3392
#define XCD_BAR_WORDS 3456
#define XB_SPIN_CAP (1u << 18)
__device__ __forceinline__ unsigned xb_ld(unsigned* p)              { return __hip_atomic_load(p, __ATOMIC_RELAXED, __HIP_MEMORY_SCOPE_AGENT); }
__device__ __forceinline__ unsigned xb_add(unsigned* p, unsigned v) { return __hip_atomic_fetch_add(p, v, __ATOMIC_RELAXED, __HIP_MEMORY_SCOPE_AGENT); }
__device__ __forceinline__ unsigned xb_xcc_id() { return (unsigned)__builtin_amdgcn_s_getreg((3 << 11) | 20) & 0xFu; }
#define XB_SPIN(cond, bar) do { unsigned _sp = 0; while (cond) { __builtin_amdgcn_s_sleep(1); \
    if ((++_sp & 255u) == 0u) { if (xb_ld(&(bar)[XB_TMO])) break; if (_sp > XB_SPIN_CAP) { atomicAdd(&(bar)[XB_TMO], 1u); break; } } } } while (0)
struct XcdBarrier { unsigned* bar; unsigned x; volatile LAS unsigned* st; int wave; };
__device__ __forceinline__ bool xb_thread0(int wave) { unsigned z = 0u; asm volatile("" : "+v"(z)); return wave == 0 && __builtin_amdgcn_mbcnt_hi(~0u, __builtin_amdgcn_mbcnt_lo(~0u, z)) == 0u; }
__device__ __forceinline__ XcdBarrier xcd_barrier_post(unsigned* bar, volatile LAS unsigned* st, int wave) {
    XcdBarrier b; b.bar = bar; b.x = xb_xcc_id(); b.st = st; b.wave = wave;
    if (xb_thread0(wave)) (void)xb_add(&bar[XB_XCNT(b.x)], 1u);
    return b;
}
__device__ __forceinline__ void xcd_barrier_complete(unsigned* bar, unsigned x, unsigned& nloc, unsigned& nx) {
    const unsigned G = gridDim.x * gridDim.y * gridDim.z;
    unsigned sum, cnt, mine, sp = 0u;
    for (;;) {
        sum = 0u; cnt = 0u; mine = 0u;
#pragma unroll
        for (unsigned j = 0; j < 16; ++j) { const unsigned c = xb_ld(&bar[XB_XCNT(j)]); sum += c; cnt += (c > 0u) ? 1u : 0u; mine = (j == x) ? c : mine; }
        if (sum == G) break;
        __builtin_amdgcn_s_sleep(1);
        if ((++sp & 255u) == 0u) { if (xb_ld(&bar[XB_TMO])) break; if (sp > XB_SPIN_CAP) { atomicAdd(&bar[XB_TMO], 1u); break; } }
    }
    nloc = mine > 0u ? mine : 1u; nx = cnt > 0u ? cnt : 1u;
}
__device__ __forceinline__ void xcd_barrier(const XcdBarrier& b) {
    asm volatile("s_waitcnt vmcnt(0)" ::: "memory");
    __syncthreads();
    if (xb_thread0(b.wave)) {
        unsigned* bar = b.bar;
        __builtin_amdgcn_s_waitcnt(0);
        unsigned nloc = b.st[0], nx = b.st[1];
        if (nloc == 0u) { xcd_barrier_complete(bar, b.x, nloc, nx); b.st[0] = nloc; b.st[1] = nx; }
        const unsigned old = xb_add(&bar[XB_XSUB(b.x)], 1u);
        const unsigned gen = old / nloc;
        if (old + 1u == (gen + 1u) * nloc) {
            __builtin_amdgcn_fence(__ATOMIC_RELEASE, "agent");
            asm volatile("s_waitcnt vmcnt(0)" ::: "memory");
            const unsigned og = xb_add(&bar[XB_TOP], 1u);
            const unsigned tg = og / nx;
            if (og + 1u == (tg + 1u) * nx) xb_add(&bar[XB_TOPGEN], 1u);
            else XB_SPIN(xb_ld(&bar[XB_TOPGEN]) == tg, bar);
            __builtin_amdgcn_fence(__ATOMIC_ACQUIRE, "agent");
            xb_add(&bar[XB_XGEN(b.x)], 1u);
            asm volatile("s_waitcnt vmcnt(0)" ::: "memory");
        } else {
            XB_SPIN(xb_ld(&bar[XB_XGEN(b.x)]) == gen, bar);
            __builtin_amdgcn_fence(__ATOMIC_ACQUIRE, "agent");
            asm volatile("s_waitcnt vmcnt(0)" ::: "memory");
        }
    }
    __syncthreads();
}

struct Args { const float* in[28]; float* out; unsigned char* ws; int ph_lo, ph_hi, li, pad; };
struct InTab { const float* const* t; __device__ __forceinline__ const float* operator[](int i) const { return (const float*)(const GAS float*)(uintptr_t)(((const GAS unsigned long long*)t)[i]); } };
struct Ctx { InTab in; float* out; unsigned char* ws; };
enum { I_X = 0, I_WIN, I_BGATE, I_GMIX, I_GAQ, I_GAK, I_GBQ, I_WBQUP, I_GBKV, I_WBKVUP, I_WCAF, I_BCAF, I_WCAB, I_BCAB, I_GCOUT, I_WPA, I_WPB, I_WPC, I_WOUT, I_GFFN,
       I_WFFG, I_WFFU, I_WFFD, I_WROUTER, I_WEG, I_WEU, I_WED, I_GFINAL };

struct GUnit { const bf16_t* A; const bf16_t* B; const int* rows; int pm, pn, aux; };
__device__ __forceinline__ void tile_order(int L, int nM, int nN, int& pm, int& pn) {
    const int nwg = nM * nN; int wgid = L;
    { const int q = nwg / 8, r = nwg % 8, xcd = wgid % 8, off = wgid / 8; wgid = (xcd < r ? xcd * (q + 1) : r * (q + 1) + (xcd - r) * q) + off; }
    const int nig = 8 * nN, gid = wgid / nig, fm = gid * 8, gsz = (nM - fm) < 8 ? (nM - fm) : 8;
    pm = fm + ((wgid % nig) % gsz); pn = (wgid % nig) / gsz;
}
struct SchedDense {
    const bf16_t* A; const bf16_t* B; int lda, K, nM, nN, G, c; int lim = 0;
    __device__ __forceinline__ bool next(int i, GUnit& u) const {
        const long L = (long)i * G + c; if (L >= (long)nM * nN || (lim && L >= lim)) return false;
        tile_order((int)L, nM, nN, u.pm, u.pn);
        u.A = A + (size_t)u.pm * 256 * lda; u.B = B + (size_t)u.pn * 256 * K; u.rows = nullptr; u.aux = 0; return true;
    }
};
struct SchedInTail {
    const bf16_t* A; const bf16_t* B; int G, c;
    __device__ __forceinline__ bool next(int i, GUnit& u) const {
        const int s = i * G + c; if (s >= 192) return false;
        u.pm = s & 63; u.pn = 48 + (s >> 6); u.aux = 0; u.A = A + (size_t)u.pm * 256 * 1024; u.B = B + (size_t)u.pn * 128 * 1024; u.rows = nullptr; return true;
    }
};
struct SchedUp {
    const bf16_t* P; const bf16_t* Wq; const bf16_t* Wkv; int G, c;
    __device__ __forceinline__ bool next(int i, GUnit& u) const {
        const int L = i * G + c; if (L >= 448) return false;
        if (L < 192) { tile_order(L, 64, 3, u.pm, u.pn); u.aux = 0; u.A = P + (size_t)u.pm * 256 * PW + PC_BCQ; u.B = Wq + (size_t)u.pn * 256 * 256; }
        else { tile_order(L - 192, 64, 4, u.pm, u.pn); u.aux = 1; u.A = P + (size_t)u.pm * 256 * PW + PC_BCKV; u.B = Wkv + (size_t)u.pn * 256 * 256; }
        u.rows = nullptr; return true;
    }
};
struct SchedMerge {
    const bf16_t* Y0; const bf16_t* W; int G, c;
    __device__ __forceinline__ bool next(int i, GUnit& u) const {
        const int tile = (i / 3) * G + c, br = i % 3; if (tile >= 256) return false;
        tile_order(tile, 64, 4, u.pm, u.pn); u.aux = br;
        u.A = Y0 + (size_t)br * M * 512 + (size_t)u.pm * 256 * 512; u.B = W + (size_t)br * 1024 * 512 + (size_t)u.pn * 256 * 512; u.rows = nullptr; return true;
    }
};
struct SchedMergeH {
    const bf16_t* Y0; const bf16_t* W; int G, c;
    __device__ __forceinline__ bool next(int i, GUnit& u) const {
        const int tile = (i / 3) * G + c, br = i % 3; if (tile >= 512) return false;
        tile_order(tile, 64, 8, u.pm, u.pn); u.aux = br;
        u.A = Y0 + (size_t)br * M * 512 + (size_t)u.pm * 256 * 512; u.B = W + (size_t)br * 1024 * 512 + (size_t)u.pn * 128 * 512; u.rows = nullptr; return true;
    }
};
struct SchedMoeSlice {
    const bf16_t* A; const bf16_t* B; const LAS int* tile_e; int nM, nmain, nsplit; int G, c;
    __device__ __forceinline__ bool next(int i, GUnit& u) const {
        const int s = i * G + c; if (s >= nsplit * KSPLIT) return false;
        tile_order(nmain + s / KSPLIT, nM, 4, u.pm, u.pn); const int e = tile_e[u.pm], j = s % KSPLIT; u.aux = s;
        const size_t koff = (size_t)j * (DFE / KSPLIT / 64) * 256 * 64;
        u.A = A + (size_t)u.pm * 256 * DFE + koff; u.B = B + (size_t)e * 1024 * DFE + (size_t)u.pn * 256 * DFE + koff; u.rows = nullptr; return true;
    }
};
struct SchedMoe {
    const bf16_t* A; const bf16_t* B; const LAS int* tile_e; const int* rowtok; int lda, K, nN, G, c; size_t bstride; bool gather; int nM, lim;
    __device__ __forceinline__ bool next(int i, GUnit& u) const {
        const long L = (long)i * G + c; if (L >= (long)nM * nN || (lim && L >= lim)) return false;
        tile_order((int)L, nM, nN, u.pm, u.pn); const int e = tile_e[u.pm]; u.aux = e;
        u.B = B + (size_t)e * bstride + (size_t)u.pn * 256 * K;
        if (gather) { u.A = A; u.rows = rowtok + u.pm * 256; } else { u.A = A + (size_t)u.pm * 256 * lda; u.rows = nullptr; }
        return true;
    }
};

struct NoPre {};
struct EpiInProj {
    bf16_t* P; bf16_t* GATES; const float* ssq; const float* bgate; float* rsp;
    static constexpr bool CARRY = false; static constexpr bool HAS_SSQ = false, HAS_SCALE = true; typedef NoPre Pre;
    __device__ __forceinline__ float row_scale(const GUnit& u, int r) const { return row_rstd16(ssq, u.pm * 256 + r); }
    __device__ __forceinline__ Pre load(const GUnit&, int, int) const { return Pre{}; }
    __device__ __forceinline__ void half(int H, int row, int c, const float (&v)[8], float rstd) const {
        float o[8];
        if (H >= 26 && H < 50) {
            const int gc = (H - 26) * 128 + c; const f32x4 b0 = *(const f32x4*)(bgate + gc), b1 = *(const f32x4*)(bgate + gc + 4);
            o[0] = sigmoidf_(v[0] * rstd + b0.x); o[1] = sigmoidf_(v[1] * rstd + b0.y); o[2] = sigmoidf_(v[2] * rstd + b0.z); o[3] = sigmoidf_(v[3] * rstd + b0.w);
            o[4] = sigmoidf_(v[4] * rstd + b1.x); o[5] = sigmoidf_(v[5] * rstd + b1.y); o[6] = sigmoidf_(v[6] * rstd + b1.z); o[7] = sigmoidf_(v[7] * rstd + b1.w);
            store8(GATES + (size_t)row * 3072 + gc, o);
        } else if (H < 51) {
#pragma unroll
            for (int j = 0; j < 8; ++j) o[j] = v[j] * rstd;
            const bool inP = H < 18, inG = H < 26;
            bf16_t* base = inP ? P + H * 128 : (inG ? (bf16_t*)((unsigned char*)P + (O_VG - O_P)) + (H - 18) * 128 : (bf16_t*)((unsigned char*)P + (O_VA - O_P)));
            const int pitch = inP ? PW : (inG ? 1024 : 128);
            store8(base + (size_t)row * pitch + c, o);
        }
    }
    __device__ __forceinline__ float apply(const GUnit& u, int r, int c, const float (&v0)[8], const float (&v1)[8], float rstd, const Pre&) const {
        const int row = u.pm * 256 + r;
        half(u.pn * 2, row, c, v0, rstd); half(u.pn * 2 + 1, row, c, v1, rstd);
        if (u.pn == 3 || u.pn == 4) { float s = 0.f;
#pragma unroll
            for (int j = 0; j < 8; ++j) s += (v0[j] * v0[j] + v1[j] * v1[j]);
            rsp[(size_t)row * 32 + (u.pn - 3) * 16 + (c >> 3)] = s * rstd * rstd; }
        return 0.f;
    }
};
struct EpiInProjH {
    EpiInProj e;
    static constexpr bool CARRY = false, HAS_SSQ = false, HAS_SCALE = true; typedef NoPre Pre;
    __device__ __forceinline__ float row_scale(const GUnit& u, int r) const { return e.row_scale(u, r); }
    __device__ __forceinline__ Pre load(const GUnit&, int, int) const { return Pre{}; }
    __device__ __forceinline__ float apply(const GUnit& u, int r, int c, const float (&v0)[8], const float (&)[8], float rstd, const Pre&) const { e.half(u.pn, u.pm * 256 + r, c, v0, rstd); return 0.f; }
};
struct EpiUpProj {
    const float* rsp; bf16_t* QB; bf16_t* KNOPE; bf16_t* VB;
    static constexpr bool CARRY = false; static constexpr bool HAS_SSQ = false, HAS_SCALE = true; typedef NoPre Pre;
    __device__ __forceinline__ float row_scale(const GUnit& u, int r) const {
        const f32x4* p = (const f32x4*)(rsp + (size_t)(u.pm * 256 + r) * 32 + u.aux * 16); float s = 0.f;
#pragma unroll
        for (int j = 0; j < 4; ++j) { const f32x4 a = p[j]; s += (a.x + a.y) + (a.z + a.w); }
        const float rstd = rsqrtf(s * (1.0f / 256.0f) + EPS); return u.aux == 0 ? rstd * C2B : rstd;
    }
    __device__ __forceinline__ Pre load(const GUnit&, int, int) const { return Pre{}; }
    __device__ __forceinline__ float apply(const GUnit& u, int r, int c, const float (&v0)[8], const float (&v1)[8], float rstd, const Pre&) const {
        const int row = u.pm * 256 + r; float o0[8], o1[8];
#pragma unroll
        for (int j = 0; j < 8; ++j) { o0[j] = v0[j] * rstd; o1[j] = v1[j] * rstd; }
        bf16_t* q = (u.aux == 0 ? QB + (size_t)row * 768 + u.pn * 256 : (u.pn < 2 ? KNOPE + (size_t)row * 512 + u.pn * 256 : VB + (size_t)row * 512 + (u.pn - 2) * 256)) + c;
        store8(q, o0); store8(q + 128, o1);
        return 0.f;
    }
};
struct EpiMerge {
    const bf16_t* GATES; bf16_t* PART; bf16_t* MB;
    static constexpr bool CARRY = false; static constexpr bool HAS_SSQ = false, HAS_SCALE = false;
    struct Pre { u32x4 g0, g1, p0, p1; };
    __device__ __forceinline__ float row_scale(const GUnit&, int) const { return 0.f; }
    __device__ __forceinline__ Pre load(const GUnit& u, int r, int c) const {
        const int row = u.pm * 256 + r, col = u.pn * 256 + c; Pre p;
        const bf16_t* g = GATES + (size_t)row * 3072 + u.aux * 1024 + col; p.g0 = *(const u32x4*)g; p.g1 = *(const u32x4*)(g + 128);
        if (u.aux > 0) { const bf16_t* pp = PART + (size_t)row * 1024 + col; p.p0 = *(const u32x4*)pp; p.p1 = *(const u32x4*)(pp + 128); } else { p.p0 = (u32x4){0u, 0u, 0u, 0u}; p.p1 = p.p0; }
        return p;
    }
    __device__ __forceinline__ float apply(const GUnit& u, int r, int c, const float (&v0)[8], const float (&v1)[8], float, const Pre& pre) const {
        const int row = u.pm * 256 + r, col = u.pn * 256 + c, br = u.aux;
        float g[8], p[8], o[8];
        unpack8(pre.g0, g); unpack8(pre.p0, p);
#pragma unroll
        for (int j = 0; j < 8; ++j) o[j] = g[j] * v0[j] + p[j];
        store8((br < 2 ? PART : MB) + (size_t)row * 1024 + col, o);
        unpack8(pre.g1, g); unpack8(pre.p1, p);
#pragma unroll
        for (int j = 0; j < 8; ++j) o[j] = g[j] * v1[j] + p[j];
        store8((br < 2 ? PART : MB) + (size_t)row * 1024 + col + 128, o);
        return 0.f;
    }
};
struct EpiMergeH {
    const bf16_t* GATES; bf16_t* MB;
    static constexpr bool CARRY = true, HAS_SSQ = false, HAS_SCALE = false;
    struct Pre { u32x4 g; };
    __device__ __forceinline__ float row_scale(const GUnit&, int) const { return 0.f; }
    __device__ __forceinline__ Pre load(const GUnit& u, int r, int c) const { Pre p; p.g = *(const u32x4*)(GATES + (size_t)(u.pm * 256 + r) * 3072 + u.aux * 1024 + u.pn * 128 + c); return p; }
    __device__ __forceinline__ float apply_carry(const GUnit& u, int r, int c, const float (&v0)[8], f32x4& c0, f32x4& c1, const Pre& pre) const {
        float g[8]; unpack8(pre.g, g);
        const f32x4 t0 = (f32x4){g[0] * v0[0], g[1] * v0[1], g[2] * v0[2], g[3] * v0[3]}, t1 = (f32x4){g[4] * v0[4], g[5] * v0[5], g[6] * v0[6], g[7] * v0[7]};
        if (u.aux == 0) { c0 = t0; c1 = t1; }
        else { c0 += t0; c1 += t1; }
        if (u.aux == 2) { const float o[8] = {c0[0], c0[1], c0[2], c0[3], c1[0], c1[1], c1[2], c1[3]}; store8(MB + (size_t)(u.pm * 256 + r) * 1024 + u.pn * 128 + c, o); }
        return 0.f;
    }
    __device__ __forceinline__ float apply(const GUnit&, int, int, const float (&)[8], const float (&)[8], float, const Pre&) const { return 0.f; }
};
struct EpiMergeR {
    const bf16_t* GATES; bf16_t* MB;
    static constexpr bool CARRY = false, HAS_SSQ = false, HAS_SCALE = false, RATIO = true;
    struct Pre { u32x4 a0, a1, b0, b1; };
    __device__ __forceinline__ float row_scale(const GUnit&, int) const { return 0.f; }
    __device__ __forceinline__ Pre load(const GUnit& u, int r, int c) const {
        const bf16_t* g = GATES + (size_t)(u.pm * 256 + r) * 3072 + u.aux * 1024 + u.pn * 256 + c; Pre p;
        p.a0 = *(const u32x4*)g; p.a1 = *(const u32x4*)(g + 128);
        if (u.aux < 2) { p.b0 = *(const u32x4*)(g + 1024); p.b1 = *(const u32x4*)(g + 1024 + 128); } else { p.b0 = p.a0; p.b1 = p.a1; }
        return p;
    }
    __device__ __forceinline__ void scale(const GUnit&, int, int, f32x4& p0, f32x4& p1, f32x4& q0, f32x4& q1, const Pre& pre) const {
        float a[8], b[8], t[8];
        unpack8(pre.a0, a); unpack8(pre.b0, b);
#pragma unroll
        for (int j = 0; j < 8; ++j) t[j] = fmaxf(a[j], 1e-30f) * __builtin_amdgcn_rcpf(fmaxf(b[j], 1e-30f));
        p0 = (f32x4){p0[0] * t[0], p0[1] * t[1], p0[2] * t[2], p0[3] * t[3]}; p1 = (f32x4){p1[0] * t[4], p1[1] * t[5], p1[2] * t[6], p1[3] * t[7]};
        unpack8(pre.a1, a); unpack8(pre.b1, b);
#pragma unroll
        for (int j = 0; j < 8; ++j) t[j] = fmaxf(a[j], 1e-30f) * __builtin_amdgcn_rcpf(fmaxf(b[j], 1e-30f));
        q0 = (f32x4){q0[0] * t[0], q0[1] * t[1], q0[2] * t[2], q0[3] * t[3]}; q1 = (f32x4){q1[0] * t[4], q1[1] * t[5], q1[2] * t[6], q1[3] * t[7]};
    }
    __device__ __forceinline__ float apply(const GUnit& u, int r, int c, const float (&v0)[8], const float (&v1)[8], float, const Pre& pre) const {
        bf16_t* d = MB + (size_t)(u.pm * 256 + r) * 1024 + u.pn * 256 + c; float g[8], o[8];
        unpack8(pre.a0, g);
#pragma unroll
        for (int j = 0; j < 8; ++j) o[j] = fmaxf(g[j], 1e-30f) * v0[j];
        store8(d, o);
        unpack8(pre.a1, g);
#pragma unroll
        for (int j = 0; j < 8; ++j) o[j] = fmaxf(g[j], 1e-30f) * v1[j];
        store8(d + 128, o);
        return 0.f;
    }
};
template <class T, class = void> struct epi_is_ratio { static constexpr bool value = false; };
template <class T> struct epi_is_ratio<T, decltype((void)T::RATIO)> { static constexpr bool value = T::RATIO; };
struct EpiResid {
    bf16_t* XB; float* ssq;
    static constexpr bool CARRY = false; static constexpr bool HAS_SSQ = true, HAS_SCALE = false;
    struct Pre { u32x4 a, b; };
    __device__ __forceinline__ float row_scale(const GUnit&, int) const { return 0.f; }
    __device__ __forceinline__ Pre load(const GUnit& u, int r, int c) const {
        const size_t off = (size_t)(u.pm * 256 + r) * 1024 + u.pn * 256 + c; Pre p; p.a = *(const u32x4*)(XB + off); p.b = *(const u32x4*)(XB + off + 128); return p;
    }
    __device__ __forceinline__ float apply(const GUnit& u, int r, int c, const float (&v0)[8], const float (&v1)[8], float, const Pre& pre) const {
        const size_t off = (size_t)(u.pm * 256 + r) * 1024 + u.pn * 256 + c; float ss = 0.f, o[8], w[8];
        unpack8(pre.a, o); unpack8(pre.b, w);
#pragma unroll
        for (int j = 0; j < 8; ++j) { o[j] += v0[j]; w[j] += v1[j]; }
        const u32x4 po = pack8(o), pw = pack8(w);
        *(u32x4*)(XB + off) = po; *(u32x4*)(XB + off + 128) = pw;
        unpack8(po, o); unpack8(pw, w);
#pragma unroll
        for (int j = 0; j < 8; ++j) ss += o[j] * o[j] + w[j] * w[j];
        return ss;
    }
    __device__ __forceinline__ void put_ssq(const GUnit& u, int r, int slot, float s) const { ssq[(size_t)(u.pm * 256 + r) * 16 + u.pn * 4 + slot] = s; }
};
struct EpiSwiGLU {
    const float* ssq; const int* rowtok; bf16_t* HID; int ldh;
    static constexpr bool CARRY = false; static constexpr bool HAS_SSQ = false, HAS_SCALE = true; typedef NoPre Pre;
    __device__ __forceinline__ float row_scale(const GUnit& u, int r) const { const int row = u.pm * 256 + r; return rowtok ? ((const float*)rowtok)[row] : row_rstd16(ssq, row); }
    __device__ __forceinline__ Pre load(const GUnit&, int, int) const { return Pre{}; }
    __device__ __forceinline__ float apply(const GUnit& u, int r, int c, const float (&v0)[8], const float (&v1)[8], float rstd, const Pre&) const {
        const int row = u.pm * 256 + r; float o[8];
#pragma unroll
        for (int j = 0; j < 8; ++j) { const float g = v0[j] * rstd, up = v1[j] * rstd; o[j] = g * sigmoidf_(g) * up; }
        const int col = u.pn * 128 + c;
        store8(HID + ((size_t)(u.pm * (ldh >> 6) + (col >> 6)) * 256 + r) * 64 + (col & 63), o); return 0.f;
    }
};
struct EpiSlab {
    float* SL;
    static constexpr bool CARRY = false; static constexpr bool HAS_SSQ = false, HAS_SCALE = false; typedef NoPre Pre;
    __device__ __forceinline__ float row_scale(const GUnit&, int) const { return 0.f; }
    __device__ __forceinline__ Pre load(const GUnit&, int, int) const { return Pre{}; }
    __device__ __forceinline__ float apply(const GUnit& u, int r, int c, const float (&v0)[8], const float (&v1)[8], float, const Pre&) const {
        float* q = SL + (size_t)u.aux * 65536 + r * 256 + c;
        *(f32x4*)q = (f32x4){v0[0], v0[1], v0[2], v0[3]}; *(f32x4*)(q + 4) = (f32x4){v0[4], v0[5], v0[6], v0[7]};
        *(f32x4*)(q + 128) = (f32x4){v1[0], v1[1], v1[2], v1[3]}; *(f32x4*)(q + 132) = (f32x4){v1[4], v1[5], v1[6], v1[7]}; return 0.f;
    }
};
struct EpiMoeDown {
    const float* roww; bf16_t* OUTS;
    static constexpr bool CARRY = false; static constexpr bool HAS_SSQ = false, HAS_SCALE = true; typedef NoPre Pre;
    __device__ __forceinline__ float row_scale(const GUnit& u, int r) const { return roww[u.pm * 256 + r]; }
    __device__ __forceinline__ Pre load(const GUnit&, int, int) const { return Pre{}; }
    __device__ __forceinline__ float apply(const GUnit& u, int r, int c, const float (&v0)[8], const float (&v1)[8], float w, const Pre&) const {
        const int row = u.pm * 256 + r; float o0[8], o1[8];
#pragma unroll
        for (int j = 0; j < 8; ++j) { o0[j] = v0[j] * w; o1[j] = v1[j] * w; }
        bf16_t* q = OUTS + (size_t)row * 1024 + u.pn * 256 + c; store8(q, o0); store8(q + 128, o1); return 0.f;
    }
};

template <class Sched, class Epi>
__device__ __forceinline__ void gemm_naive(const Sched& S, const Epi& E, int K, int lda) {
    const int tid = threadIdx.x, r = tid & 255, s = __builtin_amdgcn_readfirstlane(tid >> 8);
    GUnit u;
    for (int i = 0; S.next(i, u); ++i) {
        const bf16_t* arow = u.rows ? u.A + (size_t)u.rows[r] * lda : u.A + (size_t)r * lda;
        float ss = 0.f;
        for (int g = 0; g < 8; ++g) {
            const int c = s * 64 + g * 8;
            float a0[8], a1[8];
#pragma unroll
            for (int j = 0; j < 8; ++j) { a0[j] = 0.f; a1[j] = 0.f; }
#pragma unroll 1
            for (int k = 0; k < K; k += 8) {
                float af[8]; load8(arow + k, af);
#pragma unroll
                for (int j = 0; j < 8; ++j) {
                    float b0[8], b1[8]; load8(u.B + (size_t)(c + j) * K + k, b0); load8(u.B + (size_t)(128 + c + j) * K + k, b1);
#pragma unroll
                    for (int e = 0; e < 8; ++e) { a0[j] = fmaf(af[e], b0[e], a0[j]); a1[j] = fmaf(af[e], b1[e], a1[j]); }
                }
            }
            ss += E.apply(u, r, c, a0, a1, E.row_scale(u, r), E.load(u, r, c));
        }
        if constexpr (Epi::HAS_SSQ) { E.put_ssq(u, r, s, ss); E.put_ssq(u, r, 2 + s, 0.f); }
    }
}

__device__ __forceinline__ int launder_v(int x) { asm volatile("" : "+v"(x)); return x; }
template <class Tp> __device__ __forceinline__ Tp* launder_s(Tp* p) { GAS Tp* g = (GAS Tp*)p; asm volatile("" : "+s"(g)); return (Tp*)g; }
__device__ __forceinline__ int launder_i(int x) { asm volatile("" : "+s"(x)); return x; }
__device__ __forceinline__ bool in_phase(int lo, int hi, int k) { asm volatile("" : "+s"(lo), "+s"(hi)); return lo <= k && k < hi; }
namespace pg8 {
constexpr int BK = 64, HALF = 128, HTB = HALF * BK * 2, STAGE_BYTES = 8 * HTB;
__device__ __forceinline__ int lds_byte(int r, int c) { const int st = (r >> 4) * 2 + (c >> 5), rr = r & 15, cc = c & 31, ob = rr * 64 + cc * 2; return st * 1024 + (ob ^ (((ob >> 9) & 1) << 5)); }
__device__ __forceinline__ void stage_rc(int b, int& R, int& C) { const int st = b / 1024, sb = b % 1024, swz = sb ^ (((sb >> 9) & 1) << 5); R = (st >> 1) * 16 + swz / 64; C = (st & 1) * 32 + (swz % 64) / 2; }
__device__ __forceinline__ int perm32(int rho) { const int n = rho >> 4, i = rho & 15; return 8 * (i >> 2) + 4 * n + (i & 3); }

template <bool GATHER, bool HALFN = false, class Sched, class Epi>
__device__ __forceinline__ void gemm_phase(LAS unsigned char* lds, const Sched& S, const Epi& E, const int K, const int lda, const int tid_, const int ldb_ = 0, const bool tiled = false) {
    const int ldb = ldb_ ? ldb_ : K;
    const int tid = launder_v(tid_), wid = __builtin_amdgcn_readfirstlane(tid >> 6), lane = tid & 63, wr = wid >> 2, wc = wid & 3, fr = lane & 15, fq = lane >> 4;
    const int nt = K / BK;
    int RA[2], CA[2]; unsigned voffB[2];
#pragma unroll
    for (int i = 0; i < 2; ++i) { int R, C; stage_rc(tid * 16 + i * 8192, R, C); RA[i] = R; CA[i] = C; const int Rb = (R & ~31) + perm32(R & 31); voffB[i] = (unsigned)(Rb * ldb + C) * 2u; }
    const size_t kstep = tiled ? (size_t)(256 * BK * 2) : (size_t)(BK * 2);
    const size_t hstepB = (size_t)HALF * ldb * 2;
    const unsigned ldsw = (unsigned)wid * 1024u;
    const int aoff = lds_byte(wr * 64 + fr, fq * 8), boff = lds_byte(wc * 32 + fr, fq * 8);
#define PG8_SA(b, h) (((b) * 2 + (h)) * HTB)
#define PG8_SB(b, h) ((4 + (b) * 2 + (h)) * HTB)
#define PG8_STAGE2(bufoff, gbase, v0_, v1_) do { \
        __builtin_amdgcn_global_load_lds((const unsigned*)((const char*)(gbase) + (v0_)), (LAS unsigned*)(lds + (bufoff) + ldsw), 16, 0, 0); \
        __builtin_amdgcn_global_load_lds((const unsigned*)((const char*)(gbase) + (v1_)), (LAS unsigned*)(lds + (bufoff) + ldsw + 8192), 16, 0, 0); } while (0)
#define PG8_STAGEB(bufoff, gbase) PG8_STAGE2(bufoff, gbase, voffB[0], voffB[1])
#define PG8_LDA(dst, b, h) do { _Pragma("unroll") for (int m = 0; m < 4; ++m) _Pragma("unroll") for (int k = 0; k < 2; ++k) dst[m][k] = *(const LAS bf16x8*)(lds + PG8_SA(b, h) + aoff + m * 2048 + k * 1024); } while (0)
#define PG8_LDB(dst, b, h) do { _Pragma("unroll") for (int n = 0; n < 2; ++n) _Pragma("unroll") for (int k = 0; k < 2; ++k) dst[n][k] = *(const LAS bf16x8*)(lds + PG8_SB(b, h) + boff + n * 2048 + k * 1024); } while (0)
#define PG8_MMA(ai, bj, At, Bt) do { __builtin_amdgcn_s_setprio(1); _Pragma("unroll") for (int m = 0; m < 4; ++m) _Pragma("unroll") for (int n = 0; n < 2; ++n) _Pragma("unroll") for (int k = 0; k < 2; ++k) \
        acc[ai][bj][m][n] = __builtin_amdgcn_mfma_f32_16x16x32_bf16(Bt[n][k], At[m][k], acc[ai][bj][m][n], 0, 0, 0); __builtin_amdgcn_s_setprio(0); } while (0)
#define PG8_WAIT_V(n) asm volatile("s_waitcnt vmcnt(" #n ")" ::: "memory")
#define PG8_WAIT_L(n) asm volatile("s_waitcnt lgkmcnt(" #n ")" ::: "memory")
#define PG8_BAR __builtin_amdgcn_s_barrier()
#define PG8_SCHED __builtin_amdgcn_sched_barrier(0)
#define PG8_VOFFA(dst, u_) do { _Pragma("unroll") for (int h_ = 0; h_ < 2; ++h_) _Pragma("unroll") for (int i_ = 0; i_ < 2; ++i_) { \
        const unsigned row_ = GATHER ? (unsigned)(u_).rows[h_ * HALF + RA[i_]] : (unsigned)RA[i_]; dst[h_][i_] = (row_ * (unsigned)lda + (unsigned)CA[i_]) * 2u; } } while (0)
    GUnit cur, nxt; int ui = 0;
    if (!S.next(0, cur)) return;
    f32x4 acc[2][2][4][2];
#pragma unroll
    for (int a = 0; a < 2; ++a)
#pragma unroll
        for (int b = 0; b < 2; ++b)
#pragma unroll
            for (int m = 0; m < 4; ++m)
#pragma unroll
                for (int n = 0; n < 2; ++n) acc[a][b][m][n] = (f32x4){0.f, 0.f, 0.f, 0.f};
    bf16x8 At[4][2], B0[2][2], B1[2][2];
    f32x4 car[2][4][2];
    unsigned vc[2][2], vn[2][2];
    const size_t hstepA = GATHER ? (size_t)0 : (size_t)HALF * lda * 2;
    PG8_VOFFA(vc, cur);
    const char* cA = (const char*)cur.A; const char* cB = (const char*)cur.B;
    if constexpr (Epi::HAS_SCALE) { if (tid < 256) ((LAS float*)(lds + LDS_RING))[tid] = E.row_scale(cur, tid); }
    if constexpr (HALFN) {
        PG8_STAGEB(PG8_SB(0, 0), cB); PG8_STAGE2(PG8_SA(0, 0), cA, vc[0][0], vc[0][1]); PG8_STAGE2(PG8_SA(0, 1), cA + hstepA, vc[1][0], vc[1][1]);
        if (wr == 1) PG8_BAR;
        PG8_WAIT_V(2); PG8_BAR;
        PG8_STAGEB(PG8_SB(1, 0), cB + kstep); PG8_STAGE2(PG8_SA(1, 0), cA + kstep, vc[0][0], vc[0][1]);
        PG8_WAIT_V(4); PG8_BAR;
    } else {
    PG8_STAGEB(PG8_SB(0, 0), cB); PG8_STAGEB(PG8_SB(0, 1), cB + hstepB); PG8_STAGE2(PG8_SA(0, 0), cA, vc[0][0], vc[0][1]); PG8_STAGE2(PG8_SA(0, 1), cA + hstepA, vc[1][0], vc[1][1]);
    if (wr == 1) PG8_BAR;
    PG8_WAIT_V(2); PG8_BAR;
    PG8_STAGEB(PG8_SB(1, 0), cB + kstep); PG8_STAGE2(PG8_SA(1, 0), cA + kstep, vc[0][0], vc[0][1]); PG8_STAGEB(PG8_SB(1, 1), cB + hstepB + kstep);
    PG8_WAIT_V(6); PG8_BAR;
    }
    for (;;) {
        const bool has_next = S.next(ui + 1, nxt);
        const char* nA = has_next ? (const char*)nxt.A : cA; const char* nB = has_next ? (const char*)nxt.B : cB;
        if constexpr (Epi::HAS_SCALE) { if (has_next && tid < 256) ((LAS float*)(lds + LDS_RING))[((ui + 1) % 3) * 256 + tid] = E.row_scale(nxt, tid); }
        if (has_next) { PG8_VOFFA(vn, nxt); } else {
#pragma unroll
            for (int h_ = 0; h_ < 2; ++h_)
#pragma unroll
                for (int i_ = 0; i_ < 2; ++i_) vn[h_][i_] = vc[h_][i_]; }
        for (int t = 0; t < nt; t += 2) {
            const bool last = (t == nt - 2);
            const char* a1 = cA + (size_t)(t + 1) * kstep;
            const char* a2 = last ? nA : cA + (size_t)(t + 2) * kstep; const char* b2 = last ? nB : cB + (size_t)(t + 2) * kstep;
            const char* a3 = a2 + kstep; const char* b3 = b2 + kstep;
            const unsigned w00 = last ? vn[0][0] : vc[0][0], w01 = last ? vn[0][1] : vc[0][1], w10 = last ? vn[1][0] : vc[1][0], w11 = last ? vn[1][1] : vc[1][1];
            if constexpr (HALFN) {
            PG8_LDB(B0, 0, 0); PG8_SCHED; PG8_LDA(At, 0, 0); PG8_STAGE2(PG8_SA(1, 1), a1 + hstepA, vc[1][0], vc[1][1]);
            PG8_WAIT_V(6); PG8_WAIT_L(0); PG8_BAR; PG8_MMA(0, 0, At, B0); PG8_BAR; PG8_SCHED;
            PG8_LDA(At, 0, 1); PG8_STAGEB(PG8_SB(0, 0), b2); PG8_STAGE2(PG8_SA(0, 0), a2, w00, w01);
            PG8_WAIT_V(6); PG8_WAIT_L(0); PG8_BAR; PG8_MMA(1, 0, At, B0); PG8_BAR; PG8_SCHED;
            PG8_LDB(B0, 1, 0); PG8_SCHED; PG8_LDA(At, 1, 0); PG8_STAGE2(PG8_SA(0, 1), a2 + hstepA, w10, w11);
            PG8_WAIT_V(6); PG8_WAIT_L(0); PG8_BAR; PG8_MMA(0, 0, At, B0); PG8_BAR; PG8_SCHED;
            PG8_LDA(At, 1, 1); PG8_STAGEB(PG8_SB(1, 0), b3); PG8_STAGE2(PG8_SA(1, 0), a3, w00, w01);
            PG8_WAIT_V(6); PG8_WAIT_L(0); PG8_BAR; PG8_MMA(1, 0, At, B0); PG8_BAR; PG8_SCHED;
            } else {
            PG8_LDB(B0, 0, 0); PG8_LDB(B1, 0, 1); PG8_SCHED; PG8_LDA(At, 0, 0); PG8_STAGE2(PG8_SA(1, 1), a1 + hstepA, vc[1][0], vc[1][1]);
            PG8_WAIT_V(8); PG8_WAIT_L(0); PG8_BAR; PG8_MMA(0, 0, At, B0); PG8_MMA(0, 1, At, B1); PG8_BAR; PG8_SCHED;
            PG8_LDA(At, 0, 1); PG8_STAGEB(PG8_SB(0, 0), b2); PG8_STAGEB(PG8_SB(0, 1), b2 + hstepB); PG8_STAGE2(PG8_SA(0, 0), a2, w00, w01);
            PG8_WAIT_V(8); PG8_WAIT_L(0); PG8_BAR; PG8_MMA(1, 0, At, B0); PG8_MMA(1, 1, At, B1); PG8_BAR; PG8_SCHED;
            PG8_LDB(B0, 1, 0); PG8_LDB(B1, 1, 1); PG8_SCHED; PG8_LDA(At, 1, 0); PG8_STAGE2(PG8_SA(0, 1), a2 + hstepA, w10, w11);
            PG8_WAIT_V(8); PG8_WAIT_L(0); PG8_BAR; PG8_MMA(0, 0, At, B0); PG8_MMA(0, 1, At, B1); PG8_BAR; PG8_SCHED;
            PG8_LDA(At, 1, 1); PG8_STAGEB(PG8_SB(1, 0), b3); PG8_STAGEB(PG8_SB(1, 1), b3 + hstepB); PG8_STAGE2(PG8_SA(1, 0), a3, w00, w01);
            PG8_WAIT_V(8); PG8_WAIT_L(0); PG8_BAR; PG8_MMA(1, 0, At, B0); PG8_MMA(1, 1, At, B1); PG8_BAR; PG8_SCHED;
            }
        }
        if (wr == 0) PG8_BAR;
        {
            const int fr2 = launder_v(fr), fq2 = launder_v(fq);
            const int c = wc * 32 + fq2 * 8, rb = wr * 64 + fr2;
            const LAS float* sct = (const LAS float*)(lds + LDS_RING) + (ui % 3) * 256;
            float sc[8];
            if constexpr (Epi::HAS_SCALE) {
#pragma unroll
                for (int i = 0; i < 8; ++i) sc[i] = sct[(i >> 2) * HALF + (i & 3) * 16 + rb];
            }
            typename Epi::Pre pre = E.load(cur, rb, c);
#pragma unroll
            for (int i = 0; i < 8; ++i) {
                const int ai = i >> 2, m = i & 3, r = ai * HALF + m * 16 + rb;
                typename Epi::Pre nx = pre;
                if (i < 7) nx = E.load(cur, ((i + 1) >> 2) * HALF + ((i + 1) & 3) * 16 + rb, c);
                asm volatile("" ::: "memory");
                const f32x4 p0 = acc[ai][0][m][0], p1 = acc[ai][0][m][1], q0 = acc[ai][1][m][0], q1 = acc[ai][1][m][1];
                const float v0[8] = {p0[0], p0[1], p0[2], p0[3], p1[0], p1[1], p1[2], p1[3]}, v1[8] = {q0[0], q0[1], q0[2], q0[3], q1[0], q1[1], q1[2], q1[3]};
                float ss;
                if constexpr (Epi::CARRY) ss = E.apply_carry(cur, r, c, v0, car[ai][m][0], car[ai][m][1], pre);
                else if constexpr (epi_is_ratio<Epi>::value) {
                    if (cur.aux < 2) { E.scale(cur, r, c, acc[ai][0][m][0], acc[ai][0][m][1], acc[ai][1][m][0], acc[ai][1][m][1], pre); ss = 0.f; }
                    else ss = E.apply(cur, r, c, v0, v1, 0.f, pre);
                }
                else ss = E.apply(cur, r, c, v0, v1, Epi::HAS_SCALE ? sc[i] : 0.f, pre);
                if constexpr (Epi::HAS_SSQ) { ss += shx<16>(ss); ss = sum_halves(ss); if (fq2 == 0) E.put_ssq(cur, r, wc, ss); }
                asm volatile("" ::: "memory");
                pre = nx;
            }
        }
        if (!has_next) break;
        if (!epi_is_ratio<Epi>::value || cur.aux >= 2) {
#pragma unroll
        for (int a = 0; a < 2; ++a)
#pragma unroll
            for (int b = 0; b < 2; ++b)
#pragma unroll
                for (int m = 0; m < 4; ++m)
#pragma unroll
                    for (int n = 0; n < 2; ++n) acc[a][b][m][n] = (f32x4){0.f, 0.f, 0.f, 0.f};
        }
        cur = nxt; cA = nA; cB = nB; ++ui;
#pragma unroll
        for (int h_ = 0; h_ < 2; ++h_)
#pragma unroll
            for (int i_ = 0; i_ < 2; ++i_) vc[h_][i_] = vn[h_][i_];
        if (wr == 1) PG8_BAR;
    }
    PG8_WAIT_V(0);
    PG8_BAR;
#undef PG8_SA
#undef PG8_SB
#undef PG8_STAGE2
#undef PG8_STAGEB
#undef PG8_LDA
#undef PG8_LDB
#undef PG8_MMA
#undef PG8_WAIT_V
#undef PG8_WAIT_L
#undef PG8_BAR
#undef PG8_SCHED
#undef PG8_VOFFA
}
}

__device__ __forceinline__ int rowmap(int code, int n) {
    switch (code) {
        case 1: return n < 640 ? n : (n < 768 ? n + 5760 : (n < 1280 ? n : (n < 1312 ? n - 640 : (n < 3360 ? n - 32 : (n < 3392 ? n - 2688 : n - 64)))));
        case 2: { const int h = n >> 7, j = n & 127; return j < 64 ? h * 64 + j : 512 + h * 64 + (j - 64); }
        case 3: return (n >> 7) * 256 + (n & 127);
        case 4: return (n >> 7) * 256 + 128 + (n & 127);
        default: return n;
    }
}
struct TJob { const float* W; bf16_t* WT; const float* g; int K, N, code; bool tiled; };
__device__ __forceinline__ void transpose_item(const TJob& jb, LAS float* scr, int item, int lane) {
    const int K = jb.K, N = jb.N, nblk = N / 64, kb = item / nblk, nb = item % nblk, k0 = 64 * kb, n0 = 64 * nb;
    const float* src = jb.W + (size_t)k0 * N + n0 + lane;
    float v[64];
#pragma unroll
    for (int i = 0; i < 64; ++i) v[i] = __builtin_nontemporal_load(src + (size_t)i * N);
    if (jb.g) {
#pragma unroll
        for (int i = 0; i < 64; ++i) v[i] *= jb.g[k0 + i];
    }
    LAS unsigned char* sb = (LAS unsigned char*)scr;
#pragma unroll
    for (int c = 0; c < 8; ++c) { u32x4 o; o.x = pk2(v[8 * c], v[8 * c + 1]); o.y = pk2(v[8 * c + 2], v[8 * c + 3]); o.z = pk2(v[8 * c + 4], v[8 * c + 5]); o.w = pk2(v[8 * c + 6], v[8 * c + 7]);
        *(LAS u32x4*)(sb + lane * 144 + c * 16) = o; }
    asm volatile("s_waitcnt lgkmcnt(0)" ::: "memory");
#pragma unroll
    for (int j = 0; j < 8; ++j) { const int n = (lane >> 3) + 8 * j, c = lane & 7; const u32x4 o = *(const LAS u32x4*)(sb + n * 144 + c * 16);
        const int rr = rowmap(jb.code, n0 + n);
        bf16_t* d = jb.tiled ? jb.WT + ((size_t)((rr >> 8) * (K >> 6) + kb) * 256 + (rr & 255)) * 64 + 8 * c : jb.WT + (size_t)rr * K + k0 + 8 * c;
        *(u32x4*)d = o; }
    asm volatile("s_waitcnt lgkmcnt(0)" ::: "memory");
}
__device__ __forceinline__ bool common_job(const Ctx& a, int j, TJob& jb) {
    unsigned char* ws = a.ws;
    if (j < 14) { const int l = j / 7, k = j % 7;
        switch (k) {
            case 0: jb = TJob{a.in[I_WIN] + (size_t)l * 1024 * 6464, (bf16_t*)(ws + O_WIN + l * SZ_WIN1), a.in[I_GMIX] + l * 1024, 1024, 6464, 1, false}; break;
            case 1: jb = TJob{a.in[I_WBQUP] + (size_t)l * 256 * 768, (bf16_t*)(ws + O_WQUP + l * SZ_WQUP1), a.in[I_GBQ] + l * 256, 256, 768, 0, false}; break;
            case 2: jb = TJob{a.in[I_WBKVUP] + (size_t)l * 256 * 1024, (bf16_t*)(ws + O_WKVUP + l * SZ_WKVUP1), a.in[I_GBKV] + l * 256, 256, 1024, 2, false}; break;
            case 3: jb = TJob{a.in[I_WPA] + (size_t)l * 512 * 1024, (bf16_t*)(ws + O_WP + (l * 3 + 0) * SZ_WP1), nullptr, 512, 1024, 0, false}; break;
            case 4: jb = TJob{a.in[I_WPB] + (size_t)l * 512 * 1024, (bf16_t*)(ws + O_WP + (l * 3 + 1) * SZ_WP1), nullptr, 512, 1024, 0, false}; break;
            case 5: jb = TJob{a.in[I_WPC] + (size_t)l * 512 * 1024, (bf16_t*)(ws + O_WP + (l * 3 + 2) * SZ_WP1), nullptr, 512, 1024, 0, false}; break;
            default: jb = TJob{a.in[I_WOUT] + (size_t)l * 1024 * 1024, (bf16_t*)(ws + O_WOUT + l * SZ_WOUT1), nullptr, 1024, 1024, 0, false}; break;
        }
        return true; }
    if (j == 14) { jb = TJob{a.in[I_WFFG], (bf16_t*)(ws + O_WFFGU), a.in[I_GFFN], 1024, DFF, 3, false}; return true; }
    if (j == 15) { jb = TJob{a.in[I_WFFU], (bf16_t*)(ws + O_WFFGU), a.in[I_GFFN], 1024, DFF, 4, false}; return true; }
    if (j == 16) { jb = TJob{a.in[I_WFFD], (bf16_t*)(ws + O_WFFD), nullptr, DFF, 1024, 0, true}; return true; }
    return false;
}
__device__ __forceinline__ bool expert_job(const Ctx& a, int j, TJob& jb) {
    if (j >= 24) return false;
    unsigned char* ws = a.ws; const int e = j / 3, k = j % 3;
    if (k == 0) jb = TJob{a.in[I_WEG] + (size_t)e * 1024 * DFE, (bf16_t*)(ws + O_WEGU) + (size_t)e * 2 * DFE * 1024, a.in[I_GFFN] + 1024, 1024, DFE, 3, false};
    else if (k == 1) jb = TJob{a.in[I_WEU] + (size_t)e * 1024 * DFE, (bf16_t*)(ws + O_WEGU) + (size_t)e * 2 * DFE * 1024, a.in[I_GFFN] + 1024, 1024, DFE, 4, false};
    else jb = TJob{a.in[I_WED] + (size_t)e * DFE * 1024, (bf16_t*)(ws + O_WED) + (size_t)e * 1024 * DFE, nullptr, DFE, 1024, 0, true};
    return true;
}
__device__ __forceinline__ void common_find(int set, int it, int& j, int& r) {
    if (set == 0) { if (it < 1616) { j = 0; r = it; } else if (it < 1664) { j = 1; r = it - 1616; } else { j = 2; r = it - 1664; } return; }
    if (it < 640) { if (it < 384) { j = 3 + (it >> 7); r = it & 127; } else { j = 6; r = it - 384; } }
    else if (it < 3008) { r = it - 640;
        if (r < 1616) j = 7; else if ((r -= 1616) < 48) j = 8; else if ((r -= 48) < 64) j = 9; else if ((r -= 64) < 384) { j = 10 + (r >> 7); r &= 127; } else { r -= 384; j = 13; } }
    else { r = it - 3008; j = 14 + r / 704; r = r % 704; }
}
constexpr int CONV0_ITEMS = 5120, CONV_PER_UNIT = 32;
constexpr int NEXP_EARLY = 5;
constexpr int CONV1_ITEMS = NEXP_EARLY * 2 * 896;
static_assert((size_t)NEXP_EARLY * 2 * DFE * 1024 * 2 <= (size_t)M * PW * 2, "early expert copies must stay inside P");
template <bool EXPERTS>
__device__ __forceinline__ void run_transposes(const Ctx& a, LAS unsigned char* lds, int gw, int NGW, int wave, int lane) {
    LAS float* scr = (LAS float*)(lds + wave * 16384);
    TJob jb;
    if (EXPERTS) {
        constexpr int PER = (1024 / 64) * (DFE / 64), NGU = (NEXP - NEXP_EARLY) * 2 * PER;
        for (int it = gw; it < NGU + NEXP * PER; it += NGW) {
            const int j = it < NGU ? NEXP_EARLY * 3 + (it / (2 * PER)) * 3 + (it / PER) % 2 : ((it - NGU) / PER) * 3 + 2;
            expert_job(a, j, jb); transpose_item(jb, scr, it % PER, lane); }
    } else {
        for (int it = gw; it < 1728; it += NGW) { int j, r; common_find(0, it, j, r); common_job(a, j, jb); transpose_item(jb, scr, r, lane); }
    }
}
__device__ __forceinline__ void conv_unit0(const Ctx& a, LAS unsigned char* lds, int layer, int cu, int wave, int lane) {
    LAS float* scr = (LAS float*)(lds + wave * 16384);
    TJob jb;
    for (int i = 0; i < CONV_PER_UNIT / NWAVES; ++i) { const int it = cu * CONV_PER_UNIT + i * NWAVES + wave;
        if (layer == 0) { if (it < CONV0_ITEMS) { int j, r; common_find(1, it, j, r); common_job(a, j, jb); transpose_item(jb, scr, r, lane); } }
        else if (it < CONV1_ITEMS) { expert_job(a, (it / 1792) * 3 + (it / 896) % 2, jb); transpose_item(jb, scr, it % 896, lane); } }
}
__device__ __forceinline__ void phase_prologue(const Ctx& a, LAS unsigned char* lds, int vcu, int G, int tid) {
    const int wave = __builtin_amdgcn_readfirstlane(tid >> 6), lane = tid & 63, gw = vcu * NWAVES + wave, NGW = G * NWAVES;
    unsigned char* ws = a.ws;
    run_transposes<false>(a, lds, gw, NGW, wave, lane);
    for (int l = 0; l < 2; ++l) { u32x4* p = (u32x4*)(ws + O_WIN + l * SZ_WIN1 + (size_t)6528 * 1024 * 2); const int n16 = 128 * 1024 * 2 / 16;
        for (int i = gw * 64 + lane; i < n16; i += NGW * 64) p[i] = (u32x4){0u, 0u, 0u, 0u};
        u32x4* p2 = (u32x4*)(ws + O_WIN + l * SZ_WIN1 + (size_t)704 * 1024 * 2); const int m16 = 64 * 1024 * 2 / 16;
        for (int i = gw * 64 + lane; i < m16; i += NGW * 64) p2[i] = (u32x4){0u, 0u, 0u, 0u}; }
    float* ta = (float*)(ws + O_TABA); float* tb = (float*)(ws + O_TABB);
    for (int i = gw * 64 + lane; i < T * 32; i += NGW * 64) { const int t = i >> 5, k = i & 31, blk = k >> 4, fi = k & 15;
        const float inv = exp2f(-(float)fi * (13.287712379549449f / 16.0f)); const float pos = (float)(blk ? (t & 63) : (t >> 6)); const float ang = pos * inv;
        ta[t * 64 + k] = cosf(ang); ta[t * 64 + 32 + k] = sinf(ang); }
    for (int i = gw * 64 + lane; i < T * 16; i += NGW * 64) { const int t = i >> 4, k = i & 15, blk = k >> 3, fi = k & 7;
        const float inv = exp2f(-(float)fi * (13.287712379549449f / 8.0f)); const float pos = (float)(blk ? (t & 63) : (t >> 6)); const float ang = pos * inv;
        tb[t * 32 + k] = cosf(ang); tb[t * 32 + 16 + k] = sinf(ang); }
    const float* x = a.in[I_X]; bf16_t* XB = (bf16_t*)(ws + O_XB); float* ssq = (float*)(ws + O_SSQ);
    for (int m0 = gw; m0 < M; m0 += 4 * NGW) {
        f32x4 v[4][4];
#pragma unroll
        for (int q = 0; q < 4; ++q) { const int m = m0 + q * NGW; const f32x4* xr = (const f32x4*)(x + (size_t)(m < M ? m : gw) * D) + lane;
#pragma unroll
            for (int j = 0; j < 4; ++j) v[q][j] = __builtin_nontemporal_load(xr + 64 * j); }
#pragma unroll
        for (int q = 0; q < 4; ++q) { const int m = m0 + q * NGW; float s = 0.f;
#pragma unroll
            for (int j = 0; j < 4; ++j) s += (v[q][j].x * v[q][j].x + v[q][j].y * v[q][j].y) + (v[q][j].z * v[q][j].z + v[q][j].w * v[q][j].w);
            s = wave_sum(s);
            if (m < M) {
#pragma unroll
                for (int j = 0; j < 4; ++j) *(u32x2*)(XB + (size_t)m * D + (lane + 64 * j) * 4) = (u32x2){pk2(v[q][j].x, v[q][j].y), pk2(v[q][j].z, v[q][j].w)};
                if (lane < 16) ssq[(size_t)m * 16 + lane] = lane == 0 ? s : 0.f; } }
    }
}

template <bool WRITE_LA>
__device__ __forceinline__ void post_item(const Ctx& a, int layer, int it, LAS unsigned char* lds, int tid) {
    unsigned char* ws = a.ws; const int wave = __builtin_amdgcn_readfirstlane(tid >> 6), lane = tid & 63;
    const bf16_t* P = (const bf16_t*)(ws + O_P); const float* ta = (const float*)(ws + O_TABA); const float* tb = (const float*)(ws + O_TABB);
    bf16_t* QA = (bf16_t*)(ws + O_QA); bf16_t* KA = (bf16_t*)(ws + O_KA); bf16_t* KR = (bf16_t*)(ws + O_KROPE);
    const int r0 = it * 64;
    LAS float* caf = (LAS float*)lds;
    LAS bf16_t* qk = (LAS bf16_t*)(lds + 8192);
    __syncthreads();
    for (int i = tid; i < 64 * 32; i += NTHR) { const int r = i >> 5, j = i & 31; caf[i] = bf2f(P[(size_t)(r0 + r) * PW + PC_SMALL + 32 + j]); }
#pragma unroll
    for (int i = 0; i < 16; ++i) { const int idx = wave * 16 + i, r = idx >> 1, hf = idx & 1;
        __builtin_amdgcn_global_load_lds((const unsigned*)(P + (size_t)(r0 + r) * PW + PC_CQ + hf * 512 + lane * 8), (LAS unsigned*)(lds + 8192 + r * 2048 + hf * 1024), 16, 0, 0); }
    {
        const int seg = lane & 7; float gq[8], gk[8]; ld8f(a.in[I_GAQ] + layer * 64 + seg * 8, gq); ld8f(a.in[I_GAK] + layer * 64 + seg * 8, gk);
#pragma unroll
        for (int jb = 0; jb < 8; jb += 4) {
            u32x4 rq[4]; float cs[4][8], sn[4][8];
#pragma unroll
            for (int q = 0; q < 4; ++q) { const int row = r0 + wave * 8 + jb + q, t = row & (T - 1); const int tb_ = t * 64 + (seg >> 2) * 16 + (seg & 1) * 8;
                rq[q] = *(const u32x4*)(P + (size_t)row * PW + PC_AQ + lane * 8); ld8f(ta + tb_, cs[q]); ld8f(ta + tb_ + 32, sn[q]); }
#pragma unroll
            for (int q = 0; q < 4; ++q) { const int row = r0 + wave * 8 + jb + q; float x[8], o[8]; unpack8(rq[q], x);
                float ss = 0.f;
#pragma unroll
                for (int e = 0; e < 8; ++e) ss += x[e] * x[e];
                ss += shx<1>(ss); ss += shx<2>(ss); ss += shx<4>(ss);
                const float rstd = rsqrtf(ss * (1.0f / 64.0f) + EPS);
#pragma unroll
                for (int e = 0; e < 8; ++e) { const float xn = x[e] * rstd * gq[e]; const float pr = shx<2>(xn);
                    o[e] = ((seg & 2) ? xn * cs[q][e] + pr * sn[q][e] : xn * cs[q][e] - pr * sn[q][e]) * C2A; }
                store8(QA + (size_t)row * 512 + lane * 8, o); }
        }
        {
            u32x4 rk[2]; float cs[2][8], sn[2][8]; const int l2 = lane & 15;
#pragma unroll
            for (int q = 0; q < 2; ++q) { const int row = r0 + wave * 8 + q * 4 + (lane >> 4), t = row & (T - 1); const int tb_ = t * 64 + (seg >> 2) * 16 + (seg & 1) * 8;
                rk[q] = *(const u32x4*)(P + (size_t)row * PW + PC_AK + l2 * 8); ld8f(ta + tb_, cs[q]); ld8f(ta + tb_ + 32, sn[q]); }
#pragma unroll
            for (int q = 0; q < 2; ++q) { const int row = r0 + wave * 8 + q * 4 + (lane >> 4); float x[8], o[8]; unpack8(rk[q], x);
                float ss = 0.f;
#pragma unroll
                for (int e = 0; e < 8; ++e) ss += x[e] * x[e];
                ss += shx<1>(ss); ss += shx<2>(ss); ss += shx<4>(ss);
                const float rstd = rsqrtf(ss * (1.0f / 64.0f) + EPS);
#pragma unroll
                for (int e = 0; e < 8; ++e) { const float xn = x[e] * rstd * gk[e]; const float pr = shx<2>(xn);
                    o[e] = (seg & 2) ? xn * cs[q][e] + pr * sn[q][e] : xn * cs[q][e] - pr * sn[q][e]; }
                store8(KA + (size_t)row * 128 + l2 * 8, o); }
        }
        {
            const int sg = lane & 3, row = r0 + wave * 8 + ((lane >> 2) & 7), t = row & (T - 1); float x[8], o[8], cs[8], sn[8];
            load8(P + (size_t)row * PW + PC_SMALL + sg * 8, x); const int tb_ = t * 32 + (sg >> 1) * 8; ld8f(tb + tb_, cs); ld8f(tb + tb_ + 16, sn);
#pragma unroll
            for (int e = 0; e < 8; ++e) { const float pr = shx<1>(x[e]); o[e] = (sg & 1) ? x[e] * cs[e] + pr * sn[e] : x[e] * cs[e] - pr * sn[e]; }
            if (lane < 32) store8(KR + (size_t)row * 32 + sg * 8, o);
        }
    }
    __syncthreads();
    const int col = tid;
    for (int dir = 0; dir < 2; ++dir) {
        const float* Wup = a.in[dir ? I_WCAB : I_WCAF] + (size_t)layer * 16 * 512; const float bias = a.in[dir ? I_BCAB : I_BCAF][layer * 512 + col];
        float w[16];
#pragma unroll
        for (int j = 0; j < 16; ++j) w[j] = Wup[j * 512 + col];
        bf16_t* QT = (bf16_t*)(ws + O_QT) + (size_t)(dir * 2) * M * 512; bf16_t* KT = QT + (size_t)M * 512;
        float* LA = (float*)(ws + O_QT) + (size_t)dir * M * 512;
        float b = 0.f;
        for (int s0 = 0; s0 < 64; s0 += 8) {
            float z[8], la[8];
#pragma unroll
            for (int u = 0; u < 8; ++u) { const int r = dir ? 63 - (s0 + u) : s0 + u; const LAS float* cr = caf + r * 32 + dir * 16; f32x2_t zz = {bias, 0.f};
#pragma unroll
                for (int j = 0; j < 16; j += 2) zz = __builtin_elementwise_fma((f32x2_t){cr[j], cr[j + 1]}, (f32x2_t){w[j], w[j + 1]}, zz);
                z[u] = zz.x + zz.y; }
#pragma unroll
            for (int u = 0; u < 8; ++u) la[u] = (fminf(z[u], 0.f) - 0.6931471805599453f * __builtin_amdgcn_logf(1.0f + __builtin_amdgcn_exp2f(-LOG2E * fabsf(z[u])))) * (1.0f / 16.0f);
#pragma unroll
            for (int u = 0; u < 8; ++u) { b += la[u]; z[u] = b; }
#pragma unroll
            for (int u = 0; u < 8; ++u) { const int r = dir ? 63 - (s0 + u) : s0 + u; const size_t row = (size_t)(r0 + r);
                if (WRITE_LA) LA[row * 512 + col] = la[u];
                else { const float e = __builtin_amdgcn_exp2f(LOG2E * z[u]), ei = __builtin_amdgcn_exp2f(-LOG2E * z[u]); const float q = bf2f(qk[r * 1024 + col]), k = bf2f(qk[r * 1024 + 512 + col]);
                    QT[row * 512 + col] = (bf16_t)f2bf(q * e * GLA_QSCALE); KT[row * 512 + col] = (bf16_t)f2bf(k * ei); } }
        }
        if (!WRITE_LA) ((float*)(ws + O_DEC))[(size_t)dir * 256 * 512 + (size_t)it * 512 + col] = __expf(b);
    }
}

template <int BR>
__device__ __forceinline__ void attn_naive_unit(const Ctx& a, int b, int h, int qb, LAS unsigned char* lds, int tid) {
    unsigned char* ws = a.ws; constexpr int DQ = BR ? 96 : 64;
    const bf16_t* P = (const bf16_t*)(ws + O_P);
    LAS float* Ks = (LAS float*)lds;
    LAS float* Vs = Ks + 64 * 96;
    LAS float* Qs = Vs + 64 * 64;
    const int r = tid >> 1, half = tid & 1; const size_t row0 = (size_t)b * T + qb * 256; const size_t row = row0 + r;
    __syncthreads();
    for (int i = tid; i < 256 * (DQ / 8); i += NTHR) { const int rr = i / (DQ / 8), ch = i % (DQ / 8); float f[8];
        if (BR == 0) load8((const bf16_t*)(ws + O_QA) + (row0 + rr) * 512 + h * 64 + ch * 8, f); else load8((const bf16_t*)(ws + O_QB) + (row0 + rr) * 768 + h * 96 + ch * 8, f);
#pragma unroll
        for (int e = 0; e < 8; ++e) Qs[rr * 97 + ch * 8 + e] = f[e]; }
    __syncthreads();
    if (BR == 1 && tid < 256) {
        const int t = (int)((row0 + tid) & (T - 1)); const float* tb = (const float*)(ws + O_TABB) + t * 32; LAS float* q = Qs + tid * 97 + 64;
        for (int blk = 0; blk < 2; ++blk)
            for (int e = 0; e < 8; ++e) { const float cs = tb[blk * 8 + e], sn = tb[16 + blk * 8 + e]; const float x1 = q[blk * 16 + e], x2 = q[blk * 16 + 8 + e];
                q[blk * 16 + e] = x1 * cs - x2 * sn; q[blk * 16 + 8 + e] = x2 * cs + x1 * sn; } }
    float m = -1e30f, l = 0.f, o[32];
#pragma unroll
    for (int j = 0; j < 32; ++j) o[j] = 0.f;
    for (int kt = 0; kt < T / 64; ++kt) {
        __syncthreads();
        for (int i = tid; i < 64 * (DQ / 8); i += NTHR) { const int kr = i / (DQ / 8), ch = i % (DQ / 8); const size_t krow = (size_t)b * T + kt * 64 + kr; float f[8];
            if (BR == 0) load8((const bf16_t*)(ws + O_KA) + krow * 128 + (h >> 2) * 64 + ch * 8, f);
            else if (ch < 8) load8((const bf16_t*)(ws + O_KNOPE) + krow * 512 + h * 64 + ch * 8, f);
            else load8((const bf16_t*)(ws + O_KROPE) + krow * 32 + (ch - 8) * 8, f);
#pragma unroll
            for (int e = 0; e < 8; ++e) Ks[kr * 96 + ch * 8 + e] = f[e]; }
        for (int i = tid; i < 64 * 8; i += NTHR) { const int kr = i >> 3, ch = i & 7; const size_t krow = (size_t)b * T + kt * 64 + kr; float f[8];
            if (BR == 0) load8((const bf16_t*)(ws + O_VA) + krow * 128 + (h >> 2) * 64 + ch * 8, f); else load8((const bf16_t*)(ws + O_VB) + krow * 512 + h * 64 + ch * 8, f);
#pragma unroll
            for (int e = 0; e < 8; ++e) Vs[kr * 64 + ch * 8 + e] = f[e]; }
        __syncthreads();
#pragma unroll 1
        for (int kr = 0; kr < 64; ++kr) { float s = 0.f;
#pragma unroll 8
            for (int d = 0; d < DQ; ++d) s = fmaf(Qs[r * 97 + d], Ks[kr * 96 + d], s);
            if (s > m) { const float al = exp2f(m - s); l *= al;
#pragma unroll
                for (int j = 0; j < 32; ++j) o[j] *= al;
                m = s; }
            const float p = exp2f(s - m); l += p;
#pragma unroll
            for (int j = 0; j < 32; ++j) o[j] = fmaf(p, Vs[kr * 64 + half * 32 + j], o[j]); }
    }
    const float inv = 1.0f / l; bf16_t* Y = (bf16_t*)(ws + (BR ? O_YB : O_YA)) + row * 512 + h * 64 + half * 32;
#pragma unroll
    for (int j = 0; j < 32; j += 8) { float f[8];
#pragma unroll
        for (int e = 0; e < 8; ++e) f[e] = o[j + e] * inv;
        store8(Y + j, f); }
}

namespace att {
typedef short s16x4 __attribute__((ext_vector_type(4)));
typedef float f32x16 __attribute__((ext_vector_type(16)));
constexpr int SHM_V = 64 * 64 * 2, SHM_K = 64 * 256, OFF_K = 2 * SHM_V, OFF_WS = OFF_K + 2 * SHM_K, OFF_OST = OFF_WS + NWAVES * 64 * 4, ATT_LDS = OFF_OST + NWAVES * 4096;
constexpr float THRL = 8.0f;
#define KSWZ(row, colB) ((row) * 256 + ((colB) ^ (((row) & 7) << 4)))
#define SBAR() __builtin_amdgcn_sched_barrier(0)
__device__ __forceinline__ int crow(int r, int hi) { return (r & 3) + 8 * (r >> 2) + 4 * hi; }
__device__ __forceinline__ unsigned cvtpk(float lo, float hi) { unsigned r; asm volatile("v_cvt_pk_bf16_f32 %0, %1, %2" : "=v"(r) : "v"(lo), "v"(hi)); return r; }
__device__ __forceinline__ void partialSM(f32x16& p0, f32x16& p1, float& m_reg, float& mn, float& alpha) {
    float pmax = p0[0];
#pragma unroll
    for (int r = 1; r < 16; ++r) pmax = fmaxf(pmax, p0[r]);
#pragma unroll
    for (int r = 0; r < 16; ++r) pmax = fmaxf(pmax, p1[r]);
    { auto rr = __builtin_amdgcn_permlane32_swap(__float_as_uint(pmax), __float_as_uint(pmax), false, false); pmax = fmaxf(__uint_as_float(rr[0]), __uint_as_float(rr[1])); }
    if (__builtin_expect(__all(pmax - m_reg <= THRL), 1)) { mn = m_reg; alpha = 1.f; }
    else { mn = fmaxf(m_reg, pmax); alpha = __builtin_amdgcn_exp2f(m_reg - mn); m_reg = mn; }
#pragma unroll
    for (int r = 0; r < 16; ++r) { p0[r] -= mn; p1[r] -= mn; }
#pragma unroll
    for (int r = 0; r < 16; ++r) p0[r] = __builtin_amdgcn_exp2f(p0[r]);
}
__device__ __forceinline__ void finishSM(f32x16& p0, f32x16& p1, float alpha, float& l_reg, bf16x8& pa0, bf16x8& pa1, bf16x8& pa2, bf16x8& pa3) {
#pragma unroll
    for (int r = 0; r < 16; ++r) p1[r] = __builtin_amdgcn_exp2f(p1[r]);
    float ps = 0;
#pragma unroll
    for (int r = 0; r < 16; ++r) ps += p0[r];
#pragma unroll
    for (int r = 0; r < 16; ++r) ps += p1[r];
    { auto rr = __builtin_amdgcn_permlane32_swap(__float_as_uint(ps), __float_as_uint(ps), false, false); ps = __uint_as_float(rr[0]) + __uint_as_float(rr[1]); }
    l_reg = l_reg * alpha + ps;
#define PK4(P, BASE, OUT) do { unsigned a0 = cvtpk(P[BASE + 0], P[BASE + 1]), a1 = cvtpk(P[BASE + 2], P[BASE + 3]);   \
    unsigned b0 = cvtpk(P[BASE + 4], P[BASE + 5]), b1 = cvtpk(P[BASE + 6], P[BASE + 7]);                              \
    auto r0 = __builtin_amdgcn_permlane32_swap(a0, b0, false, false); auto r1 = __builtin_amdgcn_permlane32_swap(a1, b1, false, false); \
    u32x4 w = {r0[0], r1[0], r0[1], r1[1]}; OUT = __builtin_bit_cast(bf16x8, w); } while (0)
    PK4(p0, 0, pa0); PK4(p0, 8, pa1); PK4(p1, 0, pa2); PK4(p1, 8, pa3);
#undef PK4
}
template <int ND0>
__device__ __forceinline__ void qkt(f32x16& p0, f32x16& p1, const LAS unsigned char* Ks, const bf16x8* qr, int r32, int hi) {
    p0 = f32x16{}; p1 = f32x16{};
#pragma unroll
    for (int d0 = 0; d0 < ND0; ++d0) { const int cb = (d0 * 16 + hi * 8) * 2;
        const bf16x8 b0 = *(const LAS bf16x8*)(Ks + KSWZ(r32, cb)); const bf16x8 b1 = *(const LAS bf16x8*)(Ks + KSWZ(32 + r32, cb));
        p0 = __builtin_amdgcn_mfma_f32_32x32x16_bf16(b0, qr[d0], p0, 0, 0, 0); p1 = __builtin_amdgcn_mfma_f32_32x32x16_bf16(b1, qr[d0], p1, 0, 0, 0); }
}
__device__ __forceinline__ int v_st(int k, int c) { const int kk = (k & ~0xC) | ((k & 4) << 1) | ((k & 8) >> 1); return ((kk >> 3) * 2 + (c >> 5)) * 512 + ((kk & 7) * 32 + (c & 31)) * 2; }
__device__ __forceinline__ int v_rd_base(int lane) { return ((lane & 3) << 3) | (((lane >> 2) & 3) << 6) | (((lane >> 4) & 1) << 5) | (((lane >> 5) & 1) << 8); }
constexpr int v_rd_off(int d0, int ks, int half) { return d0 * 512 + ks * 2048 + half * 1024; }
template <int OFF> __device__ __forceinline__ s16x4 tr_read(int vb) { s16x4 r; asm volatile("ds_read_b64_tr_b16 %0, %1 offset:%2" : "=&v"(r) : "v"(vb), "i"(OFF) : "memory"); return r; }
template <int D0> __device__ __forceinline__ void pv_one(f32x16& od, int vb, bf16x8 pa0, bf16x8 pa1, bf16x8 pa2, bf16x8 pa3) {
    const s16x4 l0 = tr_read<v_rd_off(D0, 0, 0)>(vb), h0 = tr_read<v_rd_off(D0, 0, 1)>(vb), l1 = tr_read<v_rd_off(D0, 1, 0)>(vb), h1 = tr_read<v_rd_off(D0, 1, 1)>(vb);
    const s16x4 l2 = tr_read<v_rd_off(D0, 2, 0)>(vb), h2 = tr_read<v_rd_off(D0, 2, 1)>(vb), l3 = tr_read<v_rd_off(D0, 3, 0)>(vb), h3 = tr_read<v_rd_off(D0, 3, 1)>(vb);
    asm volatile("s_waitcnt lgkmcnt(0)" ::: "memory"); SBAR();
#define PK(L, H) (bf16x8){L[0], L[1], L[2], L[3], H[0], H[1], H[2], H[3]}
    od = __builtin_amdgcn_mfma_f32_32x32x16_bf16(pa0, PK(l0, h0), od, 0, 0, 0);
    od = __builtin_amdgcn_mfma_f32_32x32x16_bf16(pa1, PK(l1, h1), od, 0, 0, 0);
    od = __builtin_amdgcn_mfma_f32_32x32x16_bf16(pa2, PK(l2, h2), od, 0, 0, 0);
    od = __builtin_amdgcn_mfma_f32_32x32x16_bf16(pa3, PK(l3, h3), od, 0, 0, 0);
#undef PK
}
__device__ __forceinline__ void pv2(f32x16* o, int vb, bf16x8 pa0, bf16x8 pa1, bf16x8 pa2, bf16x8 pa3) { pv_one<0>(o[0], vb, pa0, pa1, pa2, pa3); pv_one<1>(o[1], vb, pa0, pa1, pa2, pa3); }

template <int BR>
__device__ __forceinline__ void unit(const Ctx& a, int b, int h, int qb, LAS unsigned char* lds, int tid_) {
    const int tid = launder_v(tid_);
    unsigned char* ws = a.ws; constexpr int DQ = BR ? 96 : 64, ND0 = DQ / 16, NKL = BR ? 2 : 1;
    const int wid = __builtin_amdgcn_readfirstlane(tid >> 6), lane = tid & 63, r32 = lane & 31, hi = lane >> 5;
    LAS unsigned char* V_lds = lds; LAS unsigned char* K_lds = lds + OFF_K;
    LAS float* wsf = (LAS float*)(lds + OFF_WS) + wid * 64; LAS float* li_l = wsf; LAS float* al_l = wsf + 32;
    const size_t row0 = (size_t)b * T + qb * 256, krow0 = (size_t)b * T;
    float m_reg = -1e30f, l_reg = 0; f32x16 o[2]; o[0] = f32x16{}; o[1] = f32x16{}; bf16x8 qr[ND0];
    {
        const size_t qrow = row0 + wid * 32 + r32;
        const bf16_t* Qw = BR ? (const bf16_t*)(ws + O_QB) + qrow * 768 + h * 96 + hi * 8 : (const bf16_t*)(ws + O_QA) + qrow * 512 + h * 64 + hi * 8;
#pragma unroll
        for (int d0 = 0; d0 < ND0; ++d0) qr[d0] = *(const bf16x8*)(Qw + d0 * 16);
        if (BR) {
            const float* tb = (const float*)(ws + O_TABB) + (int)(qrow & (T - 1)) * 32;
#pragma unroll
            for (int blk = 0; blk < 2; ++blk) { float x[8]; unpack8(__builtin_bit_cast(u32x4, qr[4 + blk]), x); float o8[8];
#pragma unroll
                for (int e = 0; e < 8; ++e) { const float pr = other_half(x[e], hi); const float cs = tb[blk * 8 + e], sn = tb[16 + blk * 8 + e]; o8[e] = hi ? x[e] * cs + pr * sn : x[e] * cs - pr * sn; }
                qr[4 + blk] = __builtin_bit_cast(bf16x8, pack8(o8)); } }
    }
    const int vr = tid >> 3, vc = (tid & 7) * 8, vst = v_st(vr, vc);
    int kr_[NKL], kc_[NKL];
#pragma unroll
    for (int i = 0; i < NKL; ++i) { int c = tid + i * 512; if (BR) { if (c >= 768) c -= 512; kr_[i] = c / 12; kc_[i] = c % 12; } else { kr_[i] = c >> 3; kc_[i] = c & 7; } }
    const bf16_t* Vsrc = BR ? (const bf16_t*)(ws + O_VB) + (krow0 + vr) * 512 + h * 64 + vc : (const bf16_t*)(ws + O_VA) + (krow0 + vr) * 128 + (h >> 2) * 64 + vc;
    const size_t vstep = (size_t)64 * (BR ? 512 : 128);
    const bf16_t* Ksrc[NKL]; size_t kstep_[NKL];
#pragma unroll
    for (int i = 0; i < NKL; ++i) {
        if (!BR) { Ksrc[i] = (const bf16_t*)(ws + O_KA) + (krow0 + kr_[i]) * 128 + (h >> 2) * 64 + kc_[i] * 8; kstep_[i] = (size_t)64 * 128; }
        else if (kc_[i] < 8) { Ksrc[i] = (const bf16_t*)(ws + O_KNOPE) + (krow0 + kr_[i]) * 512 + h * 64 + kc_[i] * 8; kstep_[i] = (size_t)64 * 512; }
        else { Ksrc[i] = (const bf16_t*)(ws + O_KROPE) + (krow0 + kr_[i]) * 32 + (kc_[i] - 8) * 8; kstep_[i] = (size_t)64 * 32; } }
    const bool k1_valid = !BR || tid < 256;
    const int vb0 = (int)(uintptr_t)V_lds + v_rd_base(lane);
    struct { bf16x8 v, k[NKL]; } sr_[2];
#define SLOAD(i, t) do { sr_[i].v = *(const bf16x8*)(Vsrc + (size_t)(t) * vstep); _Pragma("unroll") for (int q_ = 0; q_ < NKL; ++q_) sr_[i].k[q_] = *(const bf16x8*)(Ksrc[q_] + (size_t)(t) * kstep_[q_]); } while (0)
#define SWRITE(bb, i) do { *(LAS bf16x8*)(V_lds + (bb) * SHM_V + vst) = sr_[i].v; *(LAS bf16x8*)(K_lds + (bb) * SHM_K + KSWZ(kr_[0], kc_[0] * 16)) = sr_[i].k[0]; \
        if (NKL > 1) { if (k1_valid) *(LAS bf16x8*)(K_lds + (bb) * SHM_K + KSWZ(kr_[NKL - 1], kc_[NKL - 1] * 16)) = sr_[i].k[NKL - 1]; } } while (0)
#define RESC(al) do { if (__any((al) < 1.f)) { if (hi == 0) al_l[r32] = (al); asm volatile("s_waitcnt lgkmcnt(0)" ::: "memory"); \
        _Pragma("unroll") for (int d = 0; d < 2; ++d) _Pragma("unroll") for (int r = 0; r < 16; ++r) o[d][r] *= al_l[crow(r, hi)]; } } while (0)
    f32x16 pA0, pA1, pB0, pB1; float mnA, mnB, alA, alB; bf16x8 pa0, pa1, pa2, pa3; constexpr int NT = T / 64;
    __syncthreads();
    SLOAD(0, 0); SWRITE(0, 0); __syncthreads();
    qkt<ND0>(pA0, pA1, K_lds, qr, r32, hi); partialSM(pA0, pA1, m_reg, mnA, alA);
    SLOAD(1, 1); SLOAD(0, 2);
    SWRITE(1, 1); __syncthreads();
    for (int j = 1; j + 1 < NT; j += 2) {
        SBAR(); qkt<ND0>(pB0, pB1, K_lds + SHM_K, qr, r32, hi);
        finishSM(pA0, pA1, alA, l_reg, pa0, pa1, pa2, pa3); SBAR();
        SLOAD(1, j + 2); SBAR();
        pv2(o, vb0, pa0, pa1, pa2, pa3); partialSM(pB0, pB1, m_reg, mnB, alB);
        __syncthreads(); SWRITE(0, 0);
        RESC(alB); __syncthreads();
        SBAR(); qkt<ND0>(pA0, pA1, K_lds, qr, r32, hi);
        finishSM(pB0, pB1, alB, l_reg, pa0, pa1, pa2, pa3); SBAR();
        if (j + 3 < NT) SLOAD(0, j + 3); SBAR();
        pv2(o, vb0 + SHM_V, pa0, pa1, pa2, pa3); partialSM(pA0, pA1, m_reg, mnA, alA);
        __syncthreads(); SWRITE(1, 1);
        RESC(alA); __syncthreads();
    }
    SBAR(); qkt<ND0>(pB0, pB1, K_lds + SHM_K, qr, r32, hi);
    finishSM(pA0, pA1, alA, l_reg, pa0, pa1, pa2, pa3); SBAR();
    pv2(o, vb0, pa0, pa1, pa2, pa3); partialSM(pB0, pB1, m_reg, mnB, alB);
    __syncthreads(); RESC(alB);
    finishSM(pB0, pB1, alB, l_reg, pa0, pa1, pa2, pa3); SBAR();
    pv2(o, vb0 + SHM_V, pa0, pa1, pa2, pa3);
    if (hi == 0) li_l[r32] = l_reg; asm volatile("s_waitcnt lgkmcnt(0)" ::: "memory");
    float rli[16];
#pragma unroll
    for (int r = 0; r < 16; ++r) rli[r] = __builtin_amdgcn_rcpf(li_l[crow(r, hi)]);
    LAS bf16_t* stg = (LAS bf16_t*)(lds + OFF_OST) + wid * 2048;
#pragma unroll
    for (int r = 0; r < 16; ++r) { const int orow = crow(r, hi);
#pragma unroll
        for (int d0 = 0; d0 < 2; ++d0) stg[orow * 64 + d0 * 32 + r32] = (bf16_t)f2bf(o[d0][r] * rli[r]); }
    asm volatile("s_waitcnt lgkmcnt(0)" ::: "memory");
    bf16_t* Y = (bf16_t*)(ws + (BR ? O_YB : O_YA)) + (row0 + wid * 32) * 512 + h * 64;
#pragma unroll
    for (int i = 0; i < 4; ++i) { const int row = i * 8 + (lane >> 3), ch = lane & 7; const u32x4 v = *(const LAS u32x4*)(stg + row * 64 + ch * 8); *(u32x4*)(Y + (size_t)row * 512 + ch * 8) = v; }
#undef SLOAD
#undef SWRITE
#undef RESC
}
#undef KSWZ
#undef SBAR
}

namespace att64 {
typedef unsigned short bf16;
using s16x4=__attribute__((ext_vector_type(4)))short;
using f32x16=__attribute__((ext_vector_type(16)))float;
constexpr int SEQ=2048,D=64,QP=512,KP=128,VP=128,OP=512;
constexpr int NW=8,QBLK=32,QB=QBLK*NW,KVBLK=64,NQB=SEQ/QB;
__device__ __forceinline__ int crow(int r,int hi){return (r&3)+8*(r>>2)+4*hi;}
#define SBAR() __builtin_amdgcn_sched_barrier(0)
constexpr int NSLOT=3, SLOTB=8192;
constexpr int LDS_K=0, LDS_V=NSLOT*SLOTB, LDS_WS=2*NSLOT*SLOTB, LDS_OST=LDS_WS+NW*64*4, LDS_BYTES=LDS_OST+NW*4096;
constexpr float C2=0.125f*1.4426950408889634f;
__device__ __forceinline__ void glds16(const void*gsrc,unsigned lds_dst){unsigned keep;
  asm volatile("s_mov_b32 %0, m0\n\ts_mov_b32 m0, %2\n\ts_nop 0\n\tglobal_load_lds_dwordx4 %1, off\n\ts_mov_b32 m0, %0":"=&s"(keep):"v"(gsrc),"s"(lds_dst):"memory");}
__device__ __forceinline__ float max3f(float a,float b,float c){float r;asm("v_max3_f32 %0, %1, %2, %3":"=v"(r):"v"(a),"v"(b),"v"(c));return r;}
__device__ __forceinline__ float max2f(float a,float b){float r;asm("v_max_f32_e32 %0, %1, %2":"=v"(r):"v"(a),"v"(b));return r;}
__device__ __forceinline__ float fadd_s(float a,float b){float r;asm("v_add_f32_e32 %0, %1, %2":"=v"(r):"v"(a),"v"(b));return r;}
__device__ __forceinline__ float fsub_s(float a,float b){float r;asm("v_sub_f32_e32 %0, %1, %2":"=v"(r):"v"(a),"v"(b));return r;}
typedef float f32x2_t __attribute__((ext_vector_type(2))); typedef __bf16 bf16x2_t __attribute__((ext_vector_type(2)));
__device__ __forceinline__ unsigned cvtpk_s(float lo,float hi){f32x2_t v={lo,hi};bf16x2_t b=__builtin_convertvector(v,bf16x2_t);return __builtin_bit_cast(unsigned,b);}
#define WAIT_BAR(N) asm volatile("s_waitcnt vmcnt(" #N ") lgkmcnt(0)\n\ts_barrier":::"memory")

__device__ __forceinline__ void qkt(f32x16&p0,f32x16&p1,const char*Kslot,const bf16x8*qr,const f32x16&negm,int r32,int hi){
  const char*kb=Kslot+hi*1024+r32*16;
  #pragma unroll
  for(int d0=0;d0<4;++d0){
    const bf16x8 b0=*reinterpret_cast<const bf16x8*>(kb+d0*2048);
    const bf16x8 b1=*reinterpret_cast<const bf16x8*>(kb+d0*2048+512);
    if(d0==0){p0=__builtin_amdgcn_mfma_f32_32x32x16_bf16(b0,qr[0],negm,0,0,0);p1=__builtin_amdgcn_mfma_f32_32x32x16_bf16(b1,qr[0],negm,0,0,0);}
    else{p0=__builtin_amdgcn_mfma_f32_32x32x16_bf16(b0,qr[d0],p0,0,0,0);p1=__builtin_amdgcn_mfma_f32_32x32x16_bf16(b1,qr[d0],p1,0,0,0);}}
}
typedef __attribute__((address_space(3))) const char* lds_cptr;
typedef short v4i16_t __attribute__((ext_vector_type(4)));
__device__ __forceinline__ void kload8(bf16x8*kf,lds_cptr kp){
  kf[0]=*(const __attribute__((address_space(3))) bf16x8*)(kp);      kf[1]=*(const __attribute__((address_space(3))) bf16x8*)(kp+512);
  kf[2]=*(const __attribute__((address_space(3))) bf16x8*)(kp+2048); kf[3]=*(const __attribute__((address_space(3))) bf16x8*)(kp+2560);
  kf[4]=*(const __attribute__((address_space(3))) bf16x8*)(kp+4096); kf[5]=*(const __attribute__((address_space(3))) bf16x8*)(kp+4608);
  kf[6]=*(const __attribute__((address_space(3))) bf16x8*)(kp+6144); kf[7]=*(const __attribute__((address_space(3))) bf16x8*)(kp+6656);
}
__device__ __forceinline__ void kload2(bf16x8*kf,lds_cptr kp,int j){ kf[2*j]=*(const __attribute__((address_space(3))) bf16x8*)(kp+j*2048); kf[2*j+1]=*(const __attribute__((address_space(3))) bf16x8*)(kp+j*2048+512); }
__device__ __forceinline__ s16x4 vtr(lds_cptr p){ return __builtin_bit_cast(s16x4,__builtin_amdgcn_ds_read_tr16_b64_v4i16((__attribute__((address_space(3))) v4i16_t*)p)); }
__device__ __forceinline__ float rowmax(const f32x16&p0,const f32x16&p1){
  float a=max3f(p0[0],p0[1],p1[0]),b=max3f(p0[2],p0[3],p1[1]);a=max3f(a,p1[2],p1[3]);
  #pragma unroll
  for(int r=4;r<16;r+=4){a=max3f(a,p0[r],p0[r+1]);b=max3f(b,p0[r+2],p0[r+3]);a=max3f(a,p1[r],p1[r+1]);b=max3f(b,p1[r+2],p1[r+3]);}
  const float m=max2f(a,b);
  auto rr=__builtin_amdgcn_permlane32_swap(__float_as_uint(m),__float_as_uint(m),false,false);
  return max2f(__uint_as_float(rr[0]),__uint_as_float(rr[1]));
}
__device__ __forceinline__ void pv(f32x16*o,int vb,bf16x8 pa0,bf16x8 pa1,bf16x8 pa2,bf16x8 pa3){
  #pragma unroll
  for(int d0=0;d0<2;++d0){s16x4 lo[4],hi[4];
    #pragma unroll
    for(int ks=0;ks<4;++ks){
      asm volatile("ds_read_b64_tr_b16 %0,%1 offset:%c2":"=&v"(lo[ks]):"v"(vb),"i"(d0*4096+ks*1024):"memory");
      asm volatile("ds_read_b64_tr_b16 %0,%1 offset:%c2":"=&v"(hi[ks]):"v"(vb),"i"(d0*4096+ks*1024+512):"memory");}
    asm volatile("s_waitcnt lgkmcnt(0)":::"memory");SBAR();
    #define PK(k) (bf16x8){lo[k][0],lo[k][1],lo[k][2],lo[k][3],hi[k][0],hi[k][1],hi[k][2],hi[k][3]}
    o[d0]=__builtin_amdgcn_mfma_f32_32x32x16_bf16(pa0,PK(0),o[d0],0,0,0);
    o[d0]=__builtin_amdgcn_mfma_f32_32x32x16_bf16(pa1,PK(1),o[d0],0,0,0);
    o[d0]=__builtin_amdgcn_mfma_f32_32x32x16_bf16(pa2,PK(2),o[d0],0,0,0);
    o[d0]=__builtin_amdgcn_mfma_f32_32x32x16_bf16(pa3,PK(3),o[d0],0,0,0);
    #undef PK
  }
}

#ifndef ATTN_STORE16
#define ATTN_STORE16(p,v) (*(u32x4*)(p)=(v))
#endif
template<int THRL> __device__ __forceinline__ void attn_unit(int b,int h,int qb,const bf16*Q,const bf16*__restrict__ K,const bf16*__restrict__ V,bf16*O,char*shm,int tid_){
  const int tid=launder_v(tid_),lane=tid&63,r32=lane&31,hi=lane>>5; const int wid=__builtin_amdgcn_readfirstlane(tid>>6);
  const long rowbase=(long)b*SEQ; const int q0=qb*QB;
  const bf16*Qw=Q+(rowbase+q0+wid*QBLK)*QP+h*D;
  const bf16*Kh=K+rowbase*KP,*Vh=V+rowbase*VP;
  const unsigned lds0=(unsigned)(uintptr_t)shm;
  float*wsf=(float*)(shm+LDS_WS)+wid*64;
  const bf16*ksrc=Kh+(long)lane*KP+wid*8;
  const bf16*vsrc=Vh+(long)(16*(wid&3)+(lane>>2))*VP+(wid>>2)*32+(lane&3)*8;
  const unsigned kdst=lds0+LDS_K+wid*1024, vdst=lds0+LDS_V+wid*1024;
  #define DMA_K(t,slot) glds16(ksrc+(long)(t)*KVBLK*KP,(unsigned)__builtin_amdgcn_readfirstlane(kdst+(slot)))
  #define DMA_V(t,slot) glds16(vsrc+(long)(t)*KVBLK*VP,(unsigned)__builtin_amdgcn_readfirstlane(vdst+(slot)))
  const int vb0=(int)(lds0+LDS_V)+((lane>>4)&1)*32+(lane&3)*8+(4*hi+((lane&15)>>2))*64;
  const char*Kbase=shm+LDS_K; bf16x8 kf[8];
  const lds_cptr shm3=(lds_cptr)shm; const lds_cptr kp0=shm3+LDS_K+hi*1024+r32*16; const lds_cptr vp0=shm3+LDS_V+((lane>>4)&1)*32+(lane&3)*8+(4*hi+((lane&15)>>2))*64;
  constexpr int NT=SEQ/KVBLK;
  DMA_K(0,0);DMA_V(0,0);DMA_K(1,SLOTB);
  bf16x8 qr[4];
  #pragma unroll
  for(int d0=0;d0<4;++d0)qr[d0]=*reinterpret_cast<const bf16x8*>(&Qw[(long)r32*QP+d0*16+hi*8]);
  float mhat=0.f,l_reg=0.f;f32x16 o[2];o[0]=f32x16{};o[1]=f32x16{};f32x16 negm=f32x16{};asm volatile("":"+v"(negm));
  #define CMASK(P0,P1,t) do{}while(0)
  bool resc=false;
  #define START(P0,P1) do{ const float rm=rowmax(P0,P1); resc=false; \
    { const float dl=rm; mhat=fadd_s(mhat,dl); \
      _Pragma("unroll") for(int r=0;r<16;++r){P0[r]=fsub_s(P0[r],dl);P1[r]=fsub_s(P1[r],dl);} \
      _Pragma("unroll") for(int r=0;r<16;++r)negm[r]=-mhat; asm volatile("":"+v"(negm)); } \
    _Pragma("unroll") for(int r=0;r<16;++r)P0[r]=__builtin_amdgcn_exp2f(P0[r]); }while(0)
  #define RESC() do{ if(resc){ asm volatile("s_waitcnt lgkmcnt(0)":::"memory"); \
      _Pragma("unroll") for(int d_=0;d_<2;++d_) _Pragma("unroll") for(int r=0;r<16;++r)o[d_][r]*=wsf[crow(r,hi)]; } }while(0)
  f32x16 pA0,pA1,pB0,pB1;
  int sl_prev=0,sl_cur=0,sl_next=SLOTB;
  #define ROT() do{sl_prev=sl_cur;sl_cur=sl_next;sl_next=(sl_next==(NSLOT-1)*SLOTB)?0:sl_next+SLOTB;}while(0)
  DMA_K(2,2*SLOTB);
  WAIT_BAR(3);
  qkt(pA0,pA1,Kbase,qr,negm,r32,hi);asm volatile("s_nop 15\n\ts_nop 7":"+v"(pA0),"+v"(pA1));CMASK(pA0,pA1,0);
  START(pA0,pA1);
  _Pragma("unroll") for(int r=0;r<16;++r)pA1[r]=__builtin_amdgcn_exp2f(pA1[r]);
  WAIT_BAR(0);
  DMA_K(3,0);DMA_V(1,SLOTB);
  ROT();
  kload8(kf,kp0+sl_cur);
  WAIT_BAR(2);
  s16x4 vlo[8],vhi[8]; u32x4 pw0,pw1,pw2,pw3;
  #define PKW(P,B) cvtpk_s(P[B],P[B+1])
  #define PAF(k) __builtin_bit_cast(bf16x8,pw##k)
  #define VFR(i) (bf16x8){vlo[i][0],vlo[i][1],vlo[i][2],vlo[i][3],vhi[i][0],vhi[i][1],vhi[i][2],vhi[i][3]}
  #define PIN(x) asm volatile("":"+v"(x))
  #define MX3(a,b,c) __builtin_fmaxf(__builtin_fmaxf((a),(b)),(c))
  #define GAPA(MF,A0,A1,A2,A3,W0,W1,PW) do{ MF; sacc+=A0; sacc+=A1; sacc+=A2; sacc+=A3; PIN(sacc); W0; W1; PIN(PW); SBAR(); }while(0)
  #define EX(v) __builtin_amdgcn_exp2f(v)
  #define GAPB(MF,X,B) do{ MF; X[B]=EX(X[B]); X[B+1]=EX(X[B+1]); X[B+2]=EX(X[B+2]); X[B+3]=EX(X[B+3]); PIN(X); SBAR(); }while(0)
  #define VRD(i) do{ vlo[i]=vtr(vp_+(((i)>>2)*4096+((i)&3)*1024)); vhi[i]=vtr(vp_+(((i)>>2)*4096+((i)&3)*1024+512)); }while(0)
  #define KRD(G,j) do{ if(G){ kload2(kf,kp0+sl_next,j); SBAR(); } }while(0)
  #define STEP(C0,C1,P0,P1,t,GK,GV,GL) do{ SBAR(); \
    const lds_cptr vp_=vp0+sl_prev; \
    VRD(0); SBAR(); float sacc=(P0[0]+P0[1]); \
    GAPA(C0=__builtin_amdgcn_mfma_f32_32x32x16_bf16(kf[0],qr[0],negm,0,0,0), P0[2],P0[3],P0[4],P0[5],     pw0[0]=PKW(P0,0), pw0[1]=PKW(P0,2), pw0); \
    VRD(4); SBAR(); GAPA(C1=__builtin_amdgcn_mfma_f32_32x32x16_bf16(kf[1],qr[0],negm,0,0,0), P0[6],P0[7],P0[8],P0[9],     pw0[2]=PKW(P0,4), pw0[3]=PKW(P0,6), pw0); \
    VRD(1); SBAR(); GAPA(C0=__builtin_amdgcn_mfma_f32_32x32x16_bf16(kf[2],qr[1],C0,0,0,0),   P0[10],P0[11],P0[12],P0[13], pw1[0]=PKW(P0,8), pw1[1]=PKW(P0,10), pw1); \
    VRD(5); SBAR(); GAPA(C1=__builtin_amdgcn_mfma_f32_32x32x16_bf16(kf[3],qr[1],C1,0,0,0),   P0[14],P0[15],P1[0],P1[1],   pw1[2]=PKW(P0,12),pw1[3]=PKW(P0,14), pw1); \
    VRD(2); SBAR(); GAPA(C0=__builtin_amdgcn_mfma_f32_32x32x16_bf16(kf[4],qr[2],C0,0,0,0),   P1[2],P1[3],P1[4],P1[5],     pw2[0]=PKW(P1,0), pw2[1]=PKW(P1,2), pw2); \
    VRD(6); SBAR(); GAPA(C1=__builtin_amdgcn_mfma_f32_32x32x16_bf16(kf[5],qr[2],C1,0,0,0),   P1[6],P1[7],P1[8],P1[9],     pw2[2]=PKW(P1,4), pw2[3]=PKW(P1,6), pw2); \
    VRD(3); SBAR(); GAPA(C0=__builtin_amdgcn_mfma_f32_32x32x16_bf16(kf[6],qr[3],C0,0,0,0),   P1[10],P1[11],P1[12],P1[13], pw3[0]=PKW(P1,8), pw3[1]=PKW(P1,10), pw3); \
    VRD(7); SBAR(); GAPA(C1=__builtin_amdgcn_mfma_f32_32x32x16_bf16(kf[7],qr[3],C1,0,0,0),   P1[14],P1[15],0.f,0.f,       pw3[2]=PKW(P1,12),pw3[3]=PKW(P1,14), pw3); \
    l_reg+=sacc; \
    if(GK){DMA_K((t)+3,sl_cur);} if(GV){DMA_V((t)+1,sl_next);} \
    CMASK(C0,C1,t); \
    { float a=MX3(C0[0],C0[1],C1[0]),b=MX3(C0[2],C0[3],C1[1]); a=MX3(a,C1[2],C1[3]); \
      _Pragma("unroll") for(int r=4;r<16;r+=4){a=MX3(a,C0[r],C0[r+1]);b=MX3(b,C0[r+2],C0[r+3]);a=MX3(a,C1[r],C1[r+1]);b=MX3(b,C1[r+2],C1[r+3]);} \
      float rm=__builtin_fmaxf(a,b); { auto rr=__builtin_amdgcn_permlane32_swap(__float_as_uint(rm),__float_as_uint(rm),false,false); rm=__builtin_fmaxf(__uint_as_float(rr[0]),__uint_as_float(rr[1])); } \
      resc=false; \
      if(__builtin_expect(__any(rm>(float)THRL),0)){ const float dl=__builtin_fmaxf(rm,0.f); mhat+=dl; \
        _Pragma("unroll") for(int r=0;r<16;++r){C0[r]-=dl;C1[r]-=dl;} \
        _Pragma("unroll") for(int r=0;r<16;++r)negm[r]=-mhat; asm volatile("":"+v"(negm)); \
        const float f=__builtin_amdgcn_exp2f(-dl); l_reg*=f; if(hi==0)wsf[r32]=f; resc=true; } } \
    SBAR(); \
    GAPB(o[0]=__builtin_amdgcn_mfma_f32_32x32x16_bf16(PAF(0),VFR(0),o[0],0,0,0), C0,0); \
    GAPB(o[1]=__builtin_amdgcn_mfma_f32_32x32x16_bf16(PAF(0),VFR(4),o[1],0,0,0), C0,4); \
    KRD(GL,0); GAPB(o[0]=__builtin_amdgcn_mfma_f32_32x32x16_bf16(PAF(1),VFR(1),o[0],0,0,0), C0,8); \
    KRD(GL,1); GAPB(o[1]=__builtin_amdgcn_mfma_f32_32x32x16_bf16(PAF(1),VFR(5),o[1],0,0,0), C0,12); \
    KRD(GL,2); GAPB(o[0]=__builtin_amdgcn_mfma_f32_32x32x16_bf16(PAF(2),VFR(2),o[0],0,0,0), C1,0); \
    KRD(GL,3); GAPB(o[1]=__builtin_amdgcn_mfma_f32_32x32x16_bf16(PAF(2),VFR(6),o[1],0,0,0), C1,4); \
    GAPB(o[0]=__builtin_amdgcn_mfma_f32_32x32x16_bf16(PAF(3),VFR(3),o[0],0,0,0), C1,8); \
    GAPB(o[1]=__builtin_amdgcn_mfma_f32_32x32x16_bf16(PAF(3),VFR(7),o[1],0,0,0), C1,12); \
    }while(0)
  int t=1;
  for(;t+5<NT;t+=2){
    STEP(pB0,pB1,pA0,pA1,t,true,true,true);     WAIT_BAR(2); RESC(); ROT();
    STEP(pA0,pA1,pB0,pB1,t+1,true,true,true);   WAIT_BAR(2); RESC(); ROT();
  }
  #define ENDW(tt) do{ if((tt)+3<NT){WAIT_BAR(2);} else if((tt)+2<NT){WAIT_BAR(1);} else {WAIT_BAR(0);} }while(0)
  for(;t+1<NT;t+=2){
    STEP(pB0,pB1,pA0,pA1,t,(t+3<NT),(t+1<NT),(t+1<NT));       ENDW(t);   RESC(); ROT();
    STEP(pA0,pA1,pB0,pB1,t+1,(t+4<NT),(t+2<NT),(t+2<NT));     ENDW(t+1); RESC(); ROT();
  }
  STEP(pB0,pB1,pA0,pA1,NT-1,false,false,false); RESC();
  { float sacc=pB0[0]+pB0[1]; _Pragma("unroll") for(int r=2;r<16;++r)sacc+=pB0[r]; _Pragma("unroll") for(int r=0;r<16;++r)sacc+=pB1[r]; l_reg+=sacc;
    pw0=(u32x4){PKW(pB0,0),PKW(pB0,2),PKW(pB0,4),PKW(pB0,6)};pw1=(u32x4){PKW(pB0,8),PKW(pB0,10),PKW(pB0,12),PKW(pB0,14)};pw2=(u32x4){PKW(pB1,0),PKW(pB1,2),PKW(pB1,4),PKW(pB1,6)};pw3=(u32x4){PKW(pB1,8),PKW(pB1,10),PKW(pB1,12),PKW(pB1,14)};
    SBAR(); pv(o,vb0+sl_cur,PAF(0),PAF(1),PAF(2),PAF(3)); }
  #undef PKW
  #undef PAF
  #undef VFR
  #undef PIN
  #undef MX3
  #undef GAPA
  #undef GAPB
  #undef EX
  #undef VRD
  #undef KRD
  #undef STEP
  #undef ENDW
  {auto rr=__builtin_amdgcn_permlane32_swap(__float_as_uint(l_reg),__float_as_uint(l_reg),false,false);l_reg=__uint_as_float(rr[0])+__uint_as_float(rr[1]);}
  if(hi==0)wsf[32+r32]=l_reg;asm volatile("s_waitcnt lgkmcnt(0)":::"memory");
  float rli[16];
  #pragma unroll
  for(int r=0;r<16;++r)rli[r]=__builtin_amdgcn_rcpf(wsf[32+crow(r,hi)]);
  bf16*Ow=O+(rowbase+q0+wid*QBLK)*OP+h*D;
  { bf16*stg=(bf16*)(shm+LDS_OST)+wid*2048;
    #pragma unroll
    for(int r=0;r<16;++r){const int orow=crow(r,hi);
      #pragma unroll
      for(int d0=0;d0<2;++d0)stg[orow*64+d0*32+r32]=(bf16)f2bf(o[d0][r]*rli[r]);}
    asm volatile("s_waitcnt lgkmcnt(0)":::"memory");
    #pragma unroll
    for(int i=0;i<4;++i){const int row=i*8+(lane>>3),ch=lane&7; const u32x4 v=*(const u32x4*)(stg+row*64+ch*8); ATTN_STORE16(Ow+(long)row*OP+ch*8,v);} }
  asm volatile("s_waitcnt lgkmcnt(0)\n\ts_barrier":::"memory");
  #undef DMA_K
  #undef DMA_V
  #undef CMASK
  #undef START
  #undef RESC
  #undef ROT
}
constexpr int ATTN_LDS_BYTES=LDS_BYTES;
#undef SBAR
#undef WAIT_BAR
}

namespace att96 {
typedef unsigned short bf16;
using s16x4=__attribute__((ext_vector_type(4)))short;
using f32x16=__attribute__((ext_vector_type(16)))float;
constexpr int SEQ=2048,D=64,DQ=96,QP=768,KP=512,RP=32,VP=512,OP=512;
constexpr int NW=8,QBLK=32,QB=QBLK*NW,KVBLK=64,NQB=SEQ/QB;
__device__ __forceinline__ int crow(int r,int hi){return (r&3)+8*(r>>2)+4*hi;}
#define SBAR() __builtin_amdgcn_sched_barrier(0)
constexpr int NSLOT=3, SLOTB=8192;
constexpr int LDS_K=0, LDS_V=NSLOT*2*SLOTB, LDS_WS=LDS_V+NSLOT*SLOTB, LDS_OST=LDS_WS+NW*64*4, LDS_BYTES=LDS_OST+NW*4096;
constexpr float C2=0.125f*1.4426950408889634f;
__device__ __forceinline__ void glds16(const void*gsrc,unsigned lds_dst){unsigned keep;
  asm volatile("s_mov_b32 %0, m0\n\ts_mov_b32 m0, %2\n\ts_nop 0\n\tglobal_load_lds_dwordx4 %1, off\n\ts_mov_b32 m0, %0":"=&s"(keep):"v"(gsrc),"s"(lds_dst):"memory");}
__device__ __forceinline__ float max3f(float a,float b,float c){float r;asm("v_max3_f32 %0, %1, %2, %3":"=v"(r):"v"(a),"v"(b),"v"(c));return r;}
__device__ __forceinline__ float max2f(float a,float b){float r;asm("v_max_f32_e32 %0, %1, %2":"=v"(r):"v"(a),"v"(b));return r;}
__device__ __forceinline__ float fadd_s(float a,float b){float r;asm("v_add_f32_e32 %0, %1, %2":"=v"(r):"v"(a),"v"(b));return r;}
__device__ __forceinline__ float fsub_s(float a,float b){float r;asm("v_sub_f32_e32 %0, %1, %2":"=v"(r):"v"(a),"v"(b));return r;}
typedef float f32x2_t __attribute__((ext_vector_type(2))); typedef __bf16 bf16x2_t __attribute__((ext_vector_type(2)));
__device__ __forceinline__ unsigned cvtpk_s(float lo,float hi){f32x2_t v={lo,hi};bf16x2_t b=__builtin_convertvector(v,bf16x2_t);return __builtin_bit_cast(unsigned,b);}
#define WAIT_BAR(N) asm volatile("s_waitcnt vmcnt(" #N ") lgkmcnt(0)\n\ts_barrier":::"memory")

__device__ __forceinline__ void qkt(f32x16&p0,f32x16&p1,const char*Kslot,const bf16x8*qr,int r32,int hi){
  const char*kb=Kslot+hi*1024+r32*16;
  #pragma unroll
  for(int d0=0;d0<6;++d0){
    const bf16x8 b0=*reinterpret_cast<const bf16x8*>(kb+d0*2048);
    const bf16x8 b1=*reinterpret_cast<const bf16x8*>(kb+d0*2048+512);
    if(d0==0){p0=__builtin_amdgcn_mfma_f32_32x32x16_bf16(b0,qr[0],f32x16{},0,0,0);p1=__builtin_amdgcn_mfma_f32_32x32x16_bf16(b1,qr[0],f32x16{},0,0,0);}
    else{p0=__builtin_amdgcn_mfma_f32_32x32x16_bf16(b0,qr[d0],p0,0,0,0);p1=__builtin_amdgcn_mfma_f32_32x32x16_bf16(b1,qr[d0],p1,0,0,0);}}
}
typedef __attribute__((address_space(3))) const char* lds_cptr;
typedef short v4i16_t __attribute__((ext_vector_type(4)));
__device__ __forceinline__ void kload8(bf16x8*kf,lds_cptr kp){
  kf[0]=*(const __attribute__((address_space(3))) bf16x8*)(kp);      kf[1]=*(const __attribute__((address_space(3))) bf16x8*)(kp+512);
  kf[2]=*(const __attribute__((address_space(3))) bf16x8*)(kp+2048); kf[3]=*(const __attribute__((address_space(3))) bf16x8*)(kp+2560);
  kf[4]=*(const __attribute__((address_space(3))) bf16x8*)(kp+4096); kf[5]=*(const __attribute__((address_space(3))) bf16x8*)(kp+4608);
  kf[6]=*(const __attribute__((address_space(3))) bf16x8*)(kp+6144); kf[7]=*(const __attribute__((address_space(3))) bf16x8*)(kp+6656);
  kf[8]=*(const __attribute__((address_space(3))) bf16x8*)(kp+8192); kf[9]=*(const __attribute__((address_space(3))) bf16x8*)(kp+8704);
  kf[10]=*(const __attribute__((address_space(3))) bf16x8*)(kp+10240); kf[11]=*(const __attribute__((address_space(3))) bf16x8*)(kp+10752);
}
__device__ __forceinline__ void kload2(bf16x8*kf,lds_cptr kp,int j){ kf[2*j]=*(const __attribute__((address_space(3))) bf16x8*)(kp+j*2048); kf[2*j+1]=*(const __attribute__((address_space(3))) bf16x8*)(kp+j*2048+512); }
__device__ __forceinline__ s16x4 vtr(lds_cptr p){ return __builtin_bit_cast(s16x4,__builtin_amdgcn_ds_read_tr16_b64_v4i16((__attribute__((address_space(3))) v4i16_t*)p)); }
__device__ __forceinline__ float rowmax(const f32x16&p0,const f32x16&p1){
  float a=max3f(p0[0],p0[1],p1[0]),b=max3f(p0[2],p0[3],p1[1]);a=max3f(a,p1[2],p1[3]);
  #pragma unroll
  for(int r=4;r<16;r+=4){a=max3f(a,p0[r],p0[r+1]);b=max3f(b,p0[r+2],p0[r+3]);a=max3f(a,p1[r],p1[r+1]);b=max3f(b,p1[r+2],p1[r+3]);}
  const float m=max2f(a,b);
  auto rr=__builtin_amdgcn_permlane32_swap(__float_as_uint(m),__float_as_uint(m),false,false);
  return max2f(__uint_as_float(rr[0]),__uint_as_float(rr[1]));
}
__device__ __forceinline__ void pv(f32x16*o,int vb,bf16x8 pa0,bf16x8 pa1,bf16x8 pa2,bf16x8 pa3){
  #pragma unroll
  for(int d0=0;d0<2;++d0){s16x4 lo[4],hi[4];
    #pragma unroll
    for(int ks=0;ks<4;++ks){
      asm volatile("ds_read_b64_tr_b16 %0,%1 offset:%c2":"=&v"(lo[ks]):"v"(vb),"i"(d0*4096+ks*1024):"memory");
      asm volatile("ds_read_b64_tr_b16 %0,%1 offset:%c2":"=&v"(hi[ks]):"v"(vb),"i"(d0*4096+ks*1024+512):"memory");}
    asm volatile("s_waitcnt lgkmcnt(0)":::"memory");SBAR();
    #define PK(k) (bf16x8){lo[k][0],lo[k][1],lo[k][2],lo[k][3],hi[k][0],hi[k][1],hi[k][2],hi[k][3]}
    o[d0]=__builtin_amdgcn_mfma_f32_32x32x16_bf16(pa0,PK(0),o[d0],0,0,0);
    o[d0]=__builtin_amdgcn_mfma_f32_32x32x16_bf16(pa1,PK(1),o[d0],0,0,0);
    o[d0]=__builtin_amdgcn_mfma_f32_32x32x16_bf16(pa2,PK(2),o[d0],0,0,0);
    o[d0]=__builtin_amdgcn_mfma_f32_32x32x16_bf16(pa3,PK(3),o[d0],0,0,0);
    #undef PK
  }
}

#ifndef ATTN_STORE16
#define ATTN_STORE16(p,v) (*(u32x4*)(p)=(v))
#endif
template<int THRL> __device__ __forceinline__ void attn_unit(int b,int h,int qb,const bf16*Q,const bf16*__restrict__ K,const bf16*__restrict__ KR,const bf16*__restrict__ V,bf16*O,const float*tabb,char*shm,int tid_){
  const int tid=launder_v(tid_),lane=tid&63,r32=lane&31,hi=lane>>5; const int wid=__builtin_amdgcn_readfirstlane(tid>>6);
  const long rowbase=(long)b*SEQ; const int q0=qb*QB;
  const bf16*Qw=Q+(rowbase+q0+wid*QBLK)*QP+h*DQ;
  const bf16*Kh=K+rowbase*KP,*KRh=KR+rowbase*RP,*Vh=V+rowbase*VP;
  const unsigned lds0=(unsigned)(uintptr_t)shm;
  float*wsf=(float*)(shm+LDS_WS)+wid*64;
  const bf16*ksrc=Kh+(long)lane*KP+wid*8;
  const bf16*ksrc2=KRh+(long)lane*RP+(wid&3)*8;
  const bf16*vsrc=Vh+(long)(16*(wid&3)+(lane>>2))*VP+(wid>>2)*32+(lane&3)*8;
  const unsigned kdst=lds0+LDS_K+wid*1024, vdst=lds0+LDS_V+wid*1024;
  #define DMA_K(t,slot) do{ glds16(ksrc+(long)(t)*KVBLK*KP,(unsigned)__builtin_amdgcn_readfirstlane(kdst+2*(slot))); glds16(ksrc2+(long)(t)*KVBLK*RP,(unsigned)__builtin_amdgcn_readfirstlane(kdst+8192+2*(slot))); }while(0)
  #define DMA_V(t,slot) glds16(vsrc+(long)(t)*KVBLK*VP,(unsigned)__builtin_amdgcn_readfirstlane(vdst+(slot)))
  const int vb0=(int)(lds0+LDS_V)+((lane>>4)&1)*32+(lane&3)*8+(4*hi+((lane&15)>>2))*64;
  const char*Kbase=shm+LDS_K; bf16x8 kf[12];
  const lds_cptr shm3=(lds_cptr)shm; const lds_cptr kp0=shm3+LDS_K+hi*1024+r32*16; const lds_cptr vp0=shm3+LDS_V+((lane>>4)&1)*32+(lane&3)*8+(4*hi+((lane&15)>>2))*64;
  constexpr int NT=SEQ/KVBLK;
  DMA_K(0,0);DMA_V(0,0);DMA_K(1,SLOTB);
  bf16x8 qr[6];
  #pragma unroll
  for(int d0=0;d0<6;++d0)qr[d0]=*reinterpret_cast<const bf16x8*>(&Qw[(long)r32*QP+d0*16+hi*8]);
  { const float*tb=tabb+(int)((rowbase+q0+wid*QBLK+r32)&(SEQ-1))*32;
    #pragma unroll
    for(int blk=0;blk<2;++blk){ float x[8],o8[8]; unpack8(__builtin_bit_cast(u32x4,qr[4+blk]),x);
      #pragma unroll
      for(int e=0;e<8;++e){ const float pr=other_half(x[e],hi); const float cs=tb[blk*8+e],sn=tb[16+blk*8+e]; o8[e]=hi?x[e]*cs+pr*sn:x[e]*cs-pr*sn; }
      qr[4+blk]=__builtin_bit_cast(bf16x8,pack8(o8)); } }
  __attribute__((address_space(3))) bf16x8* const qpark=(__attribute__((address_space(3))) bf16x8*)((lds_cptr)shm+LDS_OST+wid*4096)+lane*2;
  qpark[0]=qr[4]; qpark[1]=qr[5];
  float mhat=0.f,l_reg=0.f;f32x16 o[2];o[0]=f32x16{};o[1]=f32x16{};
  #define CMASK(P0,P1,t) do{}while(0)
  bool resc=false;
  #define START(P0,P1) do{ const float rm=rowmax(P0,P1); resc=false; \
    { const float dl=rm; mhat=fadd_s(mhat,dl); \
      _Pragma("unroll") for(int r=0;r<16;++r){P0[r]=fsub_s(P0[r],dl);P1[r]=fsub_s(P1[r],dl);} } \
    _Pragma("unroll") for(int r=0;r<16;++r)P0[r]=__builtin_amdgcn_exp2f(P0[r]); }while(0)
  #define RESC() do{ if(resc){ asm volatile("s_waitcnt lgkmcnt(0)":::"memory"); \
      _Pragma("unroll") for(int d_=0;d_<2;++d_) _Pragma("unroll") for(int r=0;r<16;++r)o[d_][r]*=wsf[crow(r,hi)]; } }while(0)
  f32x16 pA0,pA1,pB0,pB1;
  int sl_prev=0,sl_cur=0,sl_next=SLOTB;
  #define ROT() do{sl_prev=sl_cur;sl_cur=sl_next;sl_next=(sl_next==(NSLOT-1)*SLOTB)?0:sl_next+SLOTB;}while(0)
  DMA_K(2,2*SLOTB);
  WAIT_BAR(5);
  qkt(pA0,pA1,Kbase,qr,r32,hi);asm volatile("s_nop 15\n\ts_nop 7":"+v"(pA0),"+v"(pA1));CMASK(pA0,pA1,0);
  START(pA0,pA1);
  _Pragma("unroll") for(int r=0;r<16;++r)pA1[r]=__builtin_amdgcn_exp2f(pA1[r]);
  WAIT_BAR(0);
  DMA_K(3,0);DMA_V(1,SLOTB);
  ROT();
  kload8(kf,kp0+2*sl_cur);
  WAIT_BAR(3);
  s16x4 vlo[8],vhi[8]; u32x4 pw0,pw1,pw2,pw3;
  #define PKW(P,B) cvtpk_s(P[B],P[B+1])
  #define PAF(k) __builtin_bit_cast(bf16x8,pw##k)
  #define VFR(i) (bf16x8){vlo[i][0],vlo[i][1],vlo[i][2],vlo[i][3],vhi[i][0],vhi[i][1],vhi[i][2],vhi[i][3]}
  #define PIN(x) asm volatile("":"+v"(x))
  #define MX3(a,b,c) __builtin_fmaxf(__builtin_fmaxf((a),(b)),(c))
  #define GAPA(MF,A0,A1,A2,A3,W0,W1,PW) do{ MF; sacc+=A0; sacc+=A1; sacc+=A2; sacc+=A3; PIN(sacc); W0; W1; PIN(PW); SBAR(); }while(0)
  #define EX(v) __builtin_amdgcn_exp2f(v)
  #define GAPB(MF,X,B) do{ MF; X[B]=EX(X[B]); X[B+1]=EX(X[B+1]); X[B+2]=EX(X[B+2]); X[B+3]=EX(X[B+3]); PIN(X); SBAR(); }while(0)
  #define VRD(i) do{ vlo[i]=vtr(vp_+(((i)>>2)*4096+((i)&3)*1024)); vhi[i]=vtr(vp_+(((i)>>2)*4096+((i)&3)*1024+512)); }while(0)
  #define KRD(G,j) do{ if(G){ kload2(kf,kp0+2*sl_next,j); SBAR(); } }while(0)
  #define STEP(C0,C1,P0,P1,t,GK,GV,GL) do{ SBAR(); \
    const lds_cptr vp_=vp0+sl_prev; \
    VRD(0); SBAR(); float sacc=(P0[0]+P0[1]); \
    GAPA(C0=__builtin_amdgcn_mfma_f32_32x32x16_bf16(kf[0],qr[0],f32x16{},0,0,0), P0[2],P0[3],P0[4],P0[5],     pw0[0]=PKW(P0,0), pw0[1]=PKW(P0,2), pw0); \
    VRD(4); SBAR(); GAPA(C1=__builtin_amdgcn_mfma_f32_32x32x16_bf16(kf[1],qr[0],f32x16{},0,0,0), P0[6],P0[7],P0[8],P0[9],     pw0[2]=PKW(P0,4), pw0[3]=PKW(P0,6), pw0); \
    VRD(1); SBAR(); GAPA(C0=__builtin_amdgcn_mfma_f32_32x32x16_bf16(kf[2],qr[1],C0,0,0,0),   P0[10],P0[11],P0[12],P0[13], pw1[0]=PKW(P0,8), pw1[1]=PKW(P0,10), pw1); \
    VRD(5); SBAR(); GAPA(C1=__builtin_amdgcn_mfma_f32_32x32x16_bf16(kf[3],qr[1],C1,0,0,0),   P0[14],P0[15],P1[0],P1[1],   pw1[2]=PKW(P0,12),pw1[3]=PKW(P0,14), pw1); \
    VRD(2); SBAR(); GAPA(C0=__builtin_amdgcn_mfma_f32_32x32x16_bf16(kf[4],qr[2],C0,0,0,0),   P1[2],P1[3],P1[4],P1[5],     pw2[0]=PKW(P1,0), pw2[1]=PKW(P1,2), pw2); \
    VRD(6); SBAR(); GAPA(C1=__builtin_amdgcn_mfma_f32_32x32x16_bf16(kf[5],qr[2],C1,0,0,0),   P1[6],P1[7],P1[8],P1[9],     pw2[2]=PKW(P1,4), pw2[3]=PKW(P1,6), pw2); \
    VRD(3); SBAR(); GAPA(C0=__builtin_amdgcn_mfma_f32_32x32x16_bf16(kf[6],qr[3],C0,0,0,0),   P1[10],P1[11],P1[12],P1[13], pw3[0]=PKW(P1,8), pw3[1]=PKW(P1,10), pw3); \
    VRD(7); SBAR(); GAPA(C1=__builtin_amdgcn_mfma_f32_32x32x16_bf16(kf[7],qr[3],C1,0,0,0),   P1[14],P1[15],0.f,0.f,       pw3[2]=PKW(P1,12),pw3[3]=PKW(P1,14), pw3); \
    l_reg+=sacc; \
    { const bf16x8 q4_=qpark[0], q5_=qpark[1]; SBAR(); \
      C0=__builtin_amdgcn_mfma_f32_32x32x16_bf16(kf[8],q4_,C0,0,0,0); C1=__builtin_amdgcn_mfma_f32_32x32x16_bf16(kf[9],q4_,C1,0,0,0); \
      C0=__builtin_amdgcn_mfma_f32_32x32x16_bf16(kf[10],q5_,C0,0,0,0); C1=__builtin_amdgcn_mfma_f32_32x32x16_bf16(kf[11],q5_,C1,0,0,0); SBAR(); } \
    if(GK){DMA_K((t)+3,sl_cur);} if(GV){DMA_V((t)+1,sl_next);} \
    { const float nm_=-mhat; _Pragma("unroll") for(int r=0;r<16;++r){C0[r]+=nm_;C1[r]+=nm_;} } \
    CMASK(C0,C1,t); \
    { float a=MX3(C0[0],C0[1],C1[0]),b=MX3(C0[2],C0[3],C1[1]); a=MX3(a,C1[2],C1[3]); \
      _Pragma("unroll") for(int r=4;r<16;r+=4){a=MX3(a,C0[r],C0[r+1]);b=MX3(b,C0[r+2],C0[r+3]);a=MX3(a,C1[r],C1[r+1]);b=MX3(b,C1[r+2],C1[r+3]);} \
      float rm=__builtin_fmaxf(a,b); { auto rr=__builtin_amdgcn_permlane32_swap(__float_as_uint(rm),__float_as_uint(rm),false,false); rm=__builtin_fmaxf(__uint_as_float(rr[0]),__uint_as_float(rr[1])); } \
      resc=false; \
      if(__builtin_expect(__any(rm>(float)THRL),0)){ const float dl=__builtin_fmaxf(rm,0.f); mhat+=dl; \
        _Pragma("unroll") for(int r=0;r<16;++r){C0[r]-=dl;C1[r]-=dl;} \
        const float f=__builtin_amdgcn_exp2f(-dl); l_reg*=f; if(hi==0)wsf[r32]=f; resc=true; } } \
    SBAR(); \
    GAPB(o[0]=__builtin_amdgcn_mfma_f32_32x32x16_bf16(PAF(0),VFR(0),o[0],0,0,0), C0,0); \
    GAPB(o[1]=__builtin_amdgcn_mfma_f32_32x32x16_bf16(PAF(0),VFR(4),o[1],0,0,0), C0,4); \
    KRD(GL,0); GAPB(o[0]=__builtin_amdgcn_mfma_f32_32x32x16_bf16(PAF(1),VFR(1),o[0],0,0,0), C0,8); \
    KRD(GL,1); GAPB(o[1]=__builtin_amdgcn_mfma_f32_32x32x16_bf16(PAF(1),VFR(5),o[1],0,0,0), C0,12); \
    KRD(GL,2); GAPB(o[0]=__builtin_amdgcn_mfma_f32_32x32x16_bf16(PAF(2),VFR(2),o[0],0,0,0), C1,0); \
    KRD(GL,3); GAPB(o[1]=__builtin_amdgcn_mfma_f32_32x32x16_bf16(PAF(2),VFR(6),o[1],0,0,0), C1,4); \
    KRD(GL,4); GAPB(o[0]=__builtin_amdgcn_mfma_f32_32x32x16_bf16(PAF(3),VFR(3),o[0],0,0,0), C1,8); \
    KRD(GL,5); GAPB(o[1]=__builtin_amdgcn_mfma_f32_32x32x16_bf16(PAF(3),VFR(7),o[1],0,0,0), C1,12); \
    }while(0)
  int t=1;
  for(;t+5<NT;t+=2){
    STEP(pB0,pB1,pA0,pA1,t,true,true,true);     WAIT_BAR(3); RESC(); ROT();
    STEP(pA0,pA1,pB0,pB1,t+1,true,true,true);   WAIT_BAR(3); RESC(); ROT();
  }
  #define ENDW(tt) do{ if((tt)+3<NT){WAIT_BAR(3);} else if((tt)+2<NT){WAIT_BAR(1);} else {WAIT_BAR(0);} }while(0)
  for(;t+1<NT;t+=2){
    STEP(pB0,pB1,pA0,pA1,t,(t+3<NT),(t+1<NT),(t+1<NT));       ENDW(t);   RESC(); ROT();
    STEP(pA0,pA1,pB0,pB1,t+1,(t+4<NT),(t+2<NT),(t+2<NT));     ENDW(t+1); RESC(); ROT();
  }
  STEP(pB0,pB1,pA0,pA1,NT-1,false,false,false); RESC();
  { float sacc=pB0[0]+pB0[1]; _Pragma("unroll") for(int r=2;r<16;++r)sacc+=pB0[r]; _Pragma("unroll") for(int r=0;r<16;++r)sacc+=pB1[r]; l_reg+=sacc;
    pw0=(u32x4){PKW(pB0,0),PKW(pB0,2),PKW(pB0,4),PKW(pB0,6)};pw1=(u32x4){PKW(pB0,8),PKW(pB0,10),PKW(pB0,12),PKW(pB0,14)};pw2=(u32x4){PKW(pB1,0),PKW(pB1,2),PKW(pB1,4),PKW(pB1,6)};pw3=(u32x4){PKW(pB1,8),PKW(pB1,10),PKW(pB1,12),PKW(pB1,14)};
    SBAR(); pv(o,vb0+sl_cur,PAF(0),PAF(1),PAF(2),PAF(3)); }
  #undef PKW
  #undef PAF
  #undef VFR
  #undef PIN
  #undef MX3
  #undef GAPA
  #undef GAPB
  #undef EX
  #undef VRD
  #undef KRD
  #undef STEP
  #undef ENDW
  {auto rr=__builtin_amdgcn_permlane32_swap(__float_as_uint(l_reg),__float_as_uint(l_reg),false,false);l_reg=__uint_as_float(rr[0])+__uint_as_float(rr[1]);}
  if(hi==0)wsf[32+r32]=l_reg;asm volatile("s_waitcnt lgkmcnt(0)":::"memory");
  float rli[16];
  #pragma unroll
  for(int r=0;r<16;++r)rli[r]=__builtin_amdgcn_rcpf(wsf[32+crow(r,hi)]);
  bf16*Ow=O+(rowbase+q0+wid*QBLK)*OP+h*D;
  { bf16*stg=(bf16*)(shm+LDS_OST)+wid*2048;
    #pragma unroll
    for(int r=0;r<16;++r){const int orow=crow(r,hi);
      #pragma unroll
      for(int d0=0;d0<2;++d0)stg[orow*64+d0*32+r32]=(bf16)f2bf(o[d0][r]*rli[r]);}
    asm volatile("s_waitcnt lgkmcnt(0)":::"memory");
    #pragma unroll
    for(int i=0;i<4;++i){const int row=i*8+(lane>>3),ch=lane&7; const u32x4 v=*(const u32x4*)(stg+row*64+ch*8); ATTN_STORE16(Ow+(long)row*OP+ch*8,v);} }
  asm volatile("s_waitcnt lgkmcnt(0)\n\ts_barrier":::"memory");
  #undef DMA_K
  #undef DMA_V
  #undef CMASK
  #undef START
  #undef RESC
  #undef ROT
}
constexpr int ATTN_LDS_BYTES=LDS_BYTES;
#undef SBAR
#undef WAIT_BAR
}

namespace gla {
constexpr int LQ = 136, LT = 72;
constexpr int O_QS = 0, O_KS = O_QS + 64 * LQ * 2, O_KST = O_KS + 64 * LQ * 2, O_VST = O_KST + 128 * LT * 2, O_PS = O_VST + 128 * LT * 2, O_SST = O_PS + 64 * LT * 2, O_DECS = O_SST + 128 * LQ * 2, GLA_LDS = O_DECS + 32 * 128 * 4;
static_assert(GLA_LDS <= LDS_CTL, "GLA LDS");
__device__ __forceinline__ bf16x8 frag(const LAS bf16_t* base, int ld, int row0, int k0, int lane) { return *(const LAS bf16x8*)(base + (row0 + (lane & 15)) * ld + k0 + 8 * (lane >> 4)); }
__device__ __forceinline__ void unit(const Ctx& a, int b, int h, int dir, LAS unsigned char* lds, int tid_) {
    const int tid = launder_v(tid_);
    unsigned char* ws = a.ws; const int wid = __builtin_amdgcn_readfirstlane(tid >> 6), lane = tid & 63, l15 = lane & 15, q4 = (lane >> 4) * 4;
    LAS bf16_t* Qs = (LAS bf16_t*)(lds + O_QS); LAS bf16_t* Ks = (LAS bf16_t*)(lds + O_KS); LAS bf16_t* KsT = (LAS bf16_t*)(lds + O_KST);
    LAS bf16_t* VsT = (LAS bf16_t*)(lds + O_VST); LAS bf16_t* Ps = (LAS bf16_t*)(lds + O_PS); LAS bf16_t* SsT = (LAS bf16_t*)(lds + O_SST);
    const bf16_t* QT = (const bf16_t*)(ws + O_QT) + (size_t)(dir * 2) * M * 512; const bf16_t* KT = QT + (size_t)M * 512;
    const bf16_t* Pm = (const bf16_t*)(ws + O_VG); const float* DEC = (const float*)(ws + O_DEC) + (size_t)dir * 256 * 512;
    bf16_t* OC = (bf16_t*)(ws + (dir ? O_OCB : O_YC));
    const int srow = tid >> 3, scg = tid & 7;
    const int spc = (((srow >> 3) ^ scg) << 3) + (srow & 7);
    int aoff[4];
#pragma unroll
    for (int c = 0; c < 4; ++c) aoff[c] = l15 * LT + ((((lane >> 4) ^ (l15 >> 3)) ^ (2 * c)) << 3);
    const int voff0 = (wid * 16 + l15) * LT + ((((lane >> 4) ^ (l15 >> 3)) ^ ((2 * wid) & 7)) << 3), voff1 = (wid * 16 + l15) * LT + ((((lane >> 4) ^ (l15 >> 3)) ^ (4 ^ ((2 * wid) & 7))) << 3);
#define LDS_BAR() asm volatile("s_waitcnt lgkmcnt(0)\n\ts_barrier" ::: "memory")
#define SCHED_FENCE() __builtin_amdgcn_sched_barrier(0)
    f32x4 S[8];
#pragma unroll
    for (int i = 0; i < 8; ++i) S[i] = (f32x4){0.f, 0.f, 0.f, 0.f};
    __syncthreads();
    { const unsigned z = (unsigned)launder_v(0);
      for (int i = tid; i < 128 * LQ / 8; i += NTHR) ((LAS u32x4*)SsT)[i] = (u32x4){z, z, z, z}; }
    { LAS float* decs = (LAS float*)(lds + O_DECS);
#pragma unroll
      for (int i = 0; i < 2; ++i) { const int e4 = (tid + i * NTHR) * 4, c = e4 >> 7, k = e4 & 127; *(LAS f32x4*)(decs + e4) = *(const f32x4*)(DEC + (size_t)(b * 32 + c) * 512 + h * 128 + k); } }
    bf16x8 gq[2][2], gk[2][2], gv[2][2];
#define GLD(dst_, ptr_) asm volatile("global_load_dwordx4 %0, %1, off" : "=&v"(dst_) : "v"(ptr_) : "memory")
#define GLOAD(n_, s_) do { const int ci_ = dir ? 31 - (n_) : (n_); const size_t r_ = (size_t)b * T + ci_ * 64 + srow; _Pragma("unroll") for (int j_ = 0; j_ < 2; ++j_) { const int c8_ = (scg + 8 * j_) * 8; \
        GLD(gq[s_][j_], QT + r_ * 512 + h * 128 + c8_); GLD(gk[s_][j_], KT + r_ * 512 + h * 128 + c8_); GLD(gv[s_][j_], Pm + r_ * 1024 + h * 128 + c8_); } } while (0)
    GLOAD(0, 0); GLOAD(1, 1);
    for (int n2 = 0; n2 < 32; n2 += 2) {
#pragma unroll
      for (int hs = 0; hs < 2; ++hs) {
        const int n = n2 + hs;
        const int ci = dir ? 31 - n : n;
        LDS_BAR();
        f32x4 dec[8];
        u32x4 ost[2];
        if (n > 0) {
#pragma unroll
            for (int j = 0; j < 2; ++j) ost[j] = *(const LAS u32x4*)(Qs + srow * LQ + (scg + 8 * j) * 8); }
        if (n2 == 0) asm volatile("s_waitcnt vmcnt(6)" ::: "memory"); else if (n == 31) asm volatile("s_waitcnt vmcnt(2)" ::: "memory"); else asm volatile("s_waitcnt vmcnt(8)" ::: "memory");
        asm volatile("" : "+v"(gq[hs][0]), "+v"(gq[hs][1]), "+v"(gk[hs][0]), "+v"(gk[hs][1]), "+v"(gv[hs][0]), "+v"(gv[hs][1]));
#pragma unroll
        for (int j = 0; j < 2; ++j) { const int c8 = (scg + 8 * j) * 8;
            *(LAS bf16x8*)(Qs + srow * LQ + c8) = gq[hs][j]; *(LAS bf16x8*)(Ks + srow * LQ + c8) = gk[hs][j];
#pragma unroll
            for (int e = 0; e < 8; ++e) { KsT[(c8 + e) * LT + spc] = (bf16_t)gk[hs][j][e]; VsT[(c8 + e) * LT + spc] = (bf16_t)gv[hs][j][e]; } }
        LDS_BAR();
        if (n > 0) { const size_t rowprev = (size_t)b * T + (dir ? ci + 1 : ci - 1) * 64;
#pragma unroll
            for (int j = 0; j < 2; ++j) *(u32x4*)(OC + (rowprev + srow) * 512 + h * 128 + (scg + 8 * j) * 8) = ost[j]; }
        if (n + 2 < 32) GLOAD(n + 2, hs);
        SCHED_FENCE();
        const int it = wid >> 1, st0 = (wid & 1) * 2;
        bf16x8 qf[4], kf[2][4], sf[4], kt[8][2], q2[4][4];
#pragma unroll
        for (int kk = 0; kk < 4; ++kk) qf[kk] = frag(Qs, LQ, it * 16, kk * 32, lane);
#pragma unroll
        for (int ss = 0; ss < 2; ++ss) {
#pragma unroll
            for (int kk = 0; kk < 4; ++kk) kf[ss][kk] = frag(Ks, LQ, (st0 + ss) * 16, kk * 32, lane); }
#pragma unroll
        for (int kk = 0; kk < 4; ++kk) sf[kk] = frag(SsT, LQ, wid * 16, kk * 32, lane);
        const bf16x8 v0 = *(const LAS bf16x8*)(VsT + voff0), v1 = *(const LAS bf16x8*)(VsT + voff1);
#pragma unroll
        for (int t = 0; t < 4; ++t) { kt[t][0] = *(const LAS bf16x8*)(KsT + t * 16 * LT + aoff[((2 * t) & 7) >> 1]); kt[t][1] = *(const LAS bf16x8*)(KsT + t * 16 * LT + aoff[(4 ^ ((2 * t) & 7)) >> 1]); dec[t] = *(const LAS f32x4*)((LAS float*)(lds + O_DECS) + ci * 128 + t * 16 + q4); }
        SCHED_FENCE();
        {
#pragma unroll
            for (int ss = 0; ss < 2; ++ss) { const int st = st0 + ss; f32x4 acc = (f32x4){0.f, 0.f, 0.f, 0.f};
                const bool dead = dir ? (st < it) : (st > it);
                if (!dead) {
#pragma unroll
                    for (int kk = 0; kk < 4; ++kk) acc = __builtin_amdgcn_mfma_f32_16x16x32_bf16(kf[ss][kk], qf[kk], acc, 0, 0, 0);
                    if (st == it) {
#pragma unroll
                        for (int r = 0; r < 4; ++r) { const bool keep = dir ? (q4 + r >= l15) : (q4 + r <= l15); if (!keep) acc[r] = 0.f; } }
                }
                *(LAS u32x2*)(Ps + (it * 16 + l15) * LT + st * 16 + q4) = (u32x2){pk2(acc[0], acc[1]), pk2(acc[2], acc[3])}; }
        }
        SCHED_FENCE();
#pragma unroll
        for (int t = 4; t < 8; ++t) { kt[t][0] = *(const LAS bf16x8*)(KsT + t * 16 * LT + aoff[((2 * t) & 7) >> 1]); kt[t][1] = *(const LAS bf16x8*)(KsT + t * 16 * LT + aoff[(4 ^ ((2 * t) & 7)) >> 1]); dec[t] = *(const LAS f32x4*)((LAS float*)(lds + O_DECS) + ci * 128 + t * 16 + q4); }
        SCHED_FENCE();
#pragma unroll
        for (int t = 0; t < 4; ++t) { S[t] = __builtin_amdgcn_mfma_f32_16x16x32_bf16(kt[t][0], v0, S[t], 0, 0, 0); S[t] = __builtin_amdgcn_mfma_f32_16x16x32_bf16(kt[t][1], v1, S[t], 0, 0, 0);
            S[t] = S[t] * dec[t];
            *(LAS u32x2*)(SsT + (wid * 16 + l15) * LQ + t * 16 + q4) = (u32x2){pk2(S[t][0], S[t][1]), pk2(S[t][2], S[t][3])}; }
        SCHED_FENCE();
#pragma unroll
        for (int i2 = 0; i2 < 2; ++i2) {
#pragma unroll
            for (int kk = 0; kk < 4; ++kk) q2[i2][kk] = frag(Qs, LQ, i2 * 16, kk * 32, lane); }
        SCHED_FENCE();
#pragma unroll
        for (int t = 4; t < 8; ++t) { S[t] = __builtin_amdgcn_mfma_f32_16x16x32_bf16(kt[t][0], v0, S[t], 0, 0, 0); S[t] = __builtin_amdgcn_mfma_f32_16x16x32_bf16(kt[t][1], v1, S[t], 0, 0, 0);
            S[t] = S[t] * dec[t];
            *(LAS u32x2*)(SsT + (wid * 16 + l15) * LQ + t * 16 + q4) = (u32x2){pk2(S[t][0], S[t][1]), pk2(S[t][2], S[t][3])}; }
        SCHED_FENCE();
#pragma unroll
        for (int i2 = 2; i2 < 4; ++i2) {
#pragma unroll
            for (int kk = 0; kk < 4; ++kk) q2[i2][kk] = frag(Qs, LQ, i2 * 16, kk * 32, lane); }
        SCHED_FENCE();
        f32x4 ao[4];
#pragma unroll
        for (int i2 = 0; i2 < 4; ++i2) { ao[i2] = (f32x4){0.f, 0.f, 0.f, 0.f};
#pragma unroll
            for (int kk = 0; kk < 4; ++kk) ao[i2] = __builtin_amdgcn_mfma_f32_16x16x32_bf16(sf[kk], q2[i2][kk], ao[i2], 0, 0, 0);
            if (i2 == 1) SCHED_FENCE(); }
        LDS_BAR();
        { bf16x8 pf[4][2];
#pragma unroll
          for (int i2 = 0; i2 < 4; ++i2) { pf[i2][0] = frag(Ps, LT, i2 * 16, 0, lane); pf[i2][1] = frag(Ps, LT, i2 * 16, 32, lane); }
          SCHED_FENCE();
#pragma unroll
          for (int i2 = 0; i2 < 4; ++i2) { ao[i2] = __builtin_amdgcn_mfma_f32_16x16x32_bf16(v0, pf[i2][0], ao[i2], 0, 0, 0); ao[i2] = __builtin_amdgcn_mfma_f32_16x16x32_bf16(v1, pf[i2][1], ao[i2], 0, 0, 0); } }
#pragma unroll
        for (int i2 = 0; i2 < 4; ++i2) *(LAS u32x2*)(Qs + (i2 * 16 + l15) * LQ + wid * 16 + q4) = (u32x2){pk2(ao[i2][0], ao[i2][1]), pk2(ao[i2][2], ao[i2][3])};
      }
    }
    LDS_BAR();
    { const int ci = dir ? 0 : 31; const size_t rowbase = (size_t)b * T + ci * 64;
#pragma unroll
      for (int j = 0; j < 2; ++j) *(u32x4*)(OC + (rowbase + srow) * 512 + h * 128 + (scg + 8 * j) * 8) = *(const LAS u32x4*)(Qs + srow * LQ + (scg + 8 * j) * 8); }
#undef GLOAD
#undef GLD
#undef LDS_BAR
#undef SCHED_FENCE
}
__device__ __forceinline__ void combine_phase(const Ctx& a, int layer, int gw, int NGW, int lane) {
    unsigned char* ws = a.ws; bf16_t* YC = (bf16_t*)(ws + O_YC); const bf16_t* OCB = (const bf16_t*)(ws + O_OCB); const bf16_t* Pm = (const bf16_t*)(ws + O_VG);
    float g[8]; { const float* gp = a.in[I_GCOUT] + layer * 128 + (lane & 15) * 8; const f32x4 g0 = *(const f32x4*)gp, g1 = *(const f32x4*)(gp + 4); g[0] = g0.x; g[1] = g0.y; g[2] = g0.z; g[3] = g0.w; g[4] = g1.x; g[5] = g1.y; g[6] = g1.z; g[7] = g1.w; }
    for (int m0 = gw; m0 < M; m0 += 4 * NGW) {
        u32x4 rf[4], rb[4], rc[4];
#pragma unroll
        for (int q = 0; q < 4; ++q) { const int m_ = m0 + q * NGW, m = m_ < M ? m_ : gw;
            rf[q] = *(const u32x4*)(YC + (size_t)m * 512 + lane * 8); rb[q] = *(const u32x4*)(OCB + (size_t)m * 512 + lane * 8); rc[q] = *(const u32x4*)(Pm + (size_t)m * 1024 + 512 + lane * 8); }
#pragma unroll
        for (int q = 0; q < 4; ++q) { const int m = m0 + q * NGW;
            float f[8], bb[8], cg[8]; unpack8(rf[q], f); unpack8(rb[q], bb); unpack8(rc[q], cg);
            float ss = 0.f;
#pragma unroll
            for (int e = 0; e < 8; ++e) { f[e] += bb[e]; ss += f[e] * f[e]; }
            ss += shx<1>(ss); ss += shx<2>(ss); ss += shx<4>(ss); ss += shx<8>(ss);
            const float rstd = rsqrtf(ss * (1.0f / 128.0f) + EPS);
#pragma unroll
            for (int e = 0; e < 8; ++e) f[e] = f[e] * rstd * g[e] * (cg[e] * sigmoidf_(cg[e]));
            if (m < M) store8(YC + (size_t)m * 512 + lane * 8, f); }
    }
}
}

__device__ __forceinline__ void gla_naive_unit(const Ctx& a, int layer, int b, int h, LAS unsigned char* lds, int tid) {
    unsigned char* ws = a.ws; const bf16_t* P = (const bf16_t*)(ws + O_P); bf16_t* YC = (bf16_t*)(ws + O_YC);
    LAS float* qs = (LAS float*)lds; LAS float* ks = qs + 128; LAS float* as = ks + 128; LAS float* part = as + 128; LAS float* red = part + 512;
    const int j = tid & 127, qd = tid >> 7; const float gco = a.in[I_GCOUT][layer * 128 + j];
    for (int dir = 0; dir < 2; ++dir) {
        const float* LA = (const float*)(ws + O_QT) + (size_t)dir * M * 512;
        float S[32];
#pragma unroll
        for (int i = 0; i < 32; ++i) S[i] = 0.f;
        for (int step = 0; step < T; ++step) {
            const int tok = dir ? T - 1 - step : step; const size_t row = (size_t)b * T + tok;
            __syncthreads();
            if (tid < 128) { qs[tid] = bf2f(P[row * PW + PC_CQ + h * 128 + tid]) * GLA_QSCALE; ks[tid] = bf2f(P[row * PW + PC_CK + h * 128 + tid]); as[tid] = __expf(LA[row * 512 + h * 128 + tid]); }
            const float v = bf2f(((const bf16_t*)(ws + O_VG))[row * 1024 + h * 128 + j]);
            __syncthreads();
            float o = 0.f;
#pragma unroll
            for (int i = 0; i < 32; ++i) { const int dk = qd * 32 + i; S[i] = as[dk] * S[i] + ks[dk] * v; o = fmaf(qs[dk], S[i], o); }
            part[qd * 128 + j] = o;
            __syncthreads();
            float v2 = 0.f;
            if (tid < 128) {
                const float tot = (part[tid] + part[128 + tid]) + (part[256 + tid] + part[384 + tid]);
                if (dir == 0) YC[row * 512 + h * 128 + tid] = (bf16_t)f2bf(tot);
                else { v2 = tot + bf2f(YC[row * 512 + h * 128 + tid]); const float ss = wave_sum(v2 * v2); if ((tid & 63) == 0) red[tid >> 6] = ss; }
            }
            if (dir == 1) {
                __syncthreads();
                if (tid < 128) {
                    const float rstd = rsqrtf((red[0] + red[1]) * (1.0f / 128.0f) + EPS);
                    const float g = bf2f(((const bf16_t*)(ws + O_VG))[row * 1024 + 512 + h * 128 + tid]);
                    YC[row * 512 + h * 128 + tid] = (bf16_t)f2bf(v2 * rstd * gco * (g * sigmoidf_(g)));
                }
            }
        }
    }
}

__device__ __forceinline__ void router_item(const Ctx& a, int blk, LAS unsigned char* lds, int tid) {
    unsigned char* ws = a.ws; int* mi = (int*)(ws + O_MOEI); float* mf = (float*)(ws + O_MOEI);
    const int wave = __builtin_amdgcn_readfirstlane(tid >> 6), lane = tid & 63;
    LAS float* lg = (LAS float*)lds;
    const bf16_t* x1 = (const bf16_t*)(ws + O_XB); const float* g = a.in[I_GFFN] + 1024; const float* wr = a.in[I_WROUTER];
    __syncthreads();
    {
        u32x2 rx[8][4]; f32x4 gg[4];
#pragma unroll
        for (int jj = 0; jj < 4; ++jj) gg[jj] = *(const f32x4*)(g + (lane + 64 * jj) * 4);
#pragma unroll
        for (int j = 0; j < 8; ++j)
#pragma unroll
            for (int jj = 0; jj < 4; ++jj) rx[j][jj] = *(const u32x2*)(x1 + (size_t)(blk * 64 + wave * 8 + j) * D + (lane + 64 * jj) * 4);
#pragma unroll
        for (int j = 0; j < 8; ++j) {
            float acc[8], ss = 0.f;
#pragma unroll
            for (int e = 0; e < 8; ++e) acc[e] = 0.f;
#pragma unroll
            for (int jj = 0; jj < 4; ++jj) { const int idx = (lane + 64 * jj) * 4; const u32x2 xr = rx[j][jj];
                const f32x4 v = (f32x4){bf2f(xr.x & 0xffffu), bf2f(xr.x >> 16), bf2f(xr.y & 0xffffu), bf2f(xr.y >> 16)};
                ss += (v.x * v.x + v.y * v.y) + (v.z * v.z + v.w * v.w);
                const float hv[4] = {v.x * gg[jj].x, v.y * gg[jj].y, v.z * gg[jj].z, v.w * gg[jj].w};
#pragma unroll
                for (int c = 0; c < 4; ++c) { const f32x4 w0 = *(const f32x4*)(wr + (size_t)(idx + c) * 8), w1 = *(const f32x4*)(wr + (size_t)(idx + c) * 8 + 4);
                    acc[0] = fmaf(hv[c], w0.x, acc[0]); acc[1] = fmaf(hv[c], w0.y, acc[1]); acc[2] = fmaf(hv[c], w0.z, acc[2]); acc[3] = fmaf(hv[c], w0.w, acc[3]);
                    acc[4] = fmaf(hv[c], w1.x, acc[4]); acc[5] = fmaf(hv[c], w1.y, acc[5]); acc[6] = fmaf(hv[c], w1.z, acc[6]); acc[7] = fmaf(hv[c], w1.w, acc[7]); } }
            ss = wave_sum(ss); const float rstd = rsqrtf(ss * (1.0f / 1024.0f) + EPS);
#pragma unroll
            for (int e = 0; e < 8; ++e) { const float s = wave_sum(acc[e]); if (lane == 0) lg[(wave * 8 + j) * 8 + e] = s * rstd; }
        }
    }
    __syncthreads();
    if (wave == 0) {
        const int tok = blk * 64 + lane; float v[8];
#pragma unroll
        for (int e = 0; e < 8; ++e) v[e] = lg[lane * 8 + e];
        int e1 = 0; float v1 = v[0];
#pragma unroll
        for (int e = 1; e < 8; ++e) if (v[e] > v1) { v1 = v[e]; e1 = e; }
        int e2 = -1; float v2 = -3.0e38f;
#pragma unroll
        for (int e = 0; e < 8; ++e) if (e != e1 && v[e] > v2) { v2 = v[e]; e2 = e; }
        const float w1 = 1.0f / (1.0f + __expf(v2 - v1)), w2 = 1.0f - w1;
        const unsigned long long lt = (1ull << lane) - 1ull; int ra = 0, rb = 0, mycnt = 0;
#pragma unroll
        for (int e = 0; e < 8; ++e) { const unsigned long long m0 = __ballot(e1 == e), m1 = __ballot(e2 == e); const int c0 = __popcll(m0);
            if (e1 == e) ra = __popcll(m0 & lt); if (e2 == e) rb = c0 + __popcll(m1 & lt); if (lane == e) mycnt = c0 + __popcll(m1); }
        mi[MI_TOKE + tok] = e1 | (e2 << 8); mi[MI_TOKR + tok] = ra | (rb << 16); mf[MI_TOKW + tok * 2] = w1; mf[MI_TOKW + tok * 2 + 1] = w2;
        if (lane < 8) mi[MI_CNT + blk * 8 + lane] = mycnt;
    }
}
__device__ __forceinline__ void positions_phase(const Ctx& a, LAS unsigned char* lds, int G, int bid, int tid) {
    unsigned char* ws = a.ws; int* mi = (int*)(ws + O_MOEI); float* mf = (float*)(ws + O_MOEI);
    LAS int* cnt = (LAS int*)lds; LAS int* base = cnt + 2048;
    __syncthreads();
    for (int i = tid; i < 2048; i += NTHR) cnt[i] = mi[MI_CNT + i];
    __syncthreads();
    {
        LAS int* segs = base + 32; const int e = tid & 7, seg = tid >> 3; int c4[4], loc = 0;
#pragma unroll
        for (int k = 0; k < 4; ++k) { c4[k] = cnt[(seg * 4 + k) * 8 + e]; loc += c4[k]; }
        segs[seg * 8 + e] = loc;
        __syncthreads();
        int run = 0; for (int s = 0; s < seg; ++s) run += segs[s * 8 + e];
        if (seg == 63) base[8 + e] = run + loc;
#pragma unroll
        for (int k = 0; k < 4; ++k) { cnt[(seg * 4 + k) * 8 + e] = run; run += c4[k]; }
    }
    __syncthreads();
    if (tid == 0) { int off = 0; for (int e = 0; e < 8; ++e) { base[e] = off; off += (base[8 + e] + 255) & ~255; } base[16] = off >> 8; }
    __syncthreads();
    if (bid == 0) {
        const int nt = base[16];
        for (int t = tid; t < nt; t += NTHR) { int e = 0;
#pragma unroll
            for (int k = 1; k < 8; ++k) if (t * 256 >= base[k]) e = k;
            mi[MI_TILEE + t] = e; }
        if (tid == 0) mi[MI_TILEE + MAXTILES] = nt;
        {
            const int nunits = nt * 4, rem = nunits % G; const bool split = rem > 0 && rem <= MAXSPLIT; const int nmain = split ? nunits - rem : nunits, nsplit = split ? rem : 0;
            for (int i = tid; i < MAXTILES * 4; i += NTHR) mi[MI_SPLIT + i] = -1;
            __syncthreads();
            for (int i = tid; i < nsplit; i += NTHR) { int pm, pn; tile_order(nmain + i, nt, 4, pm, pn); mi[MI_SPLIT + pm * 4 + pn] = i; }
            if (tid == 0) { mi[MI_SPLIT + MAXTILES * 4] = nmain; mi[MI_SPLIT + MAXTILES * 4 + 1] = nsplit; }
        }
        for (int e = 0; e < 8; ++e) { const int lo = base[e] + base[8 + e], hi = base[e] + ((base[8 + e] + 255) & ~255);
            for (int r = lo + tid; r < hi; r += NTHR) { mi[MI_ROWTOK + r] = 0; mf[MI_ROWW + r] = 0.f; mf[MI_ROWSC + r] = 0.f; } }
    }
    for (int blk = bid; blk < 256; blk += G) if (tid < 64) {
        const int tok = blk * 64 + tid; const int ee = mi[MI_TOKE + tok], rr = mi[MI_TOKR + tok]; const int e1 = ee & 255, e2 = ee >> 8;
        const int pa = base[e1] + cnt[blk * 8 + e1] + (rr & 0xffff), pb = base[e2] + cnt[blk * 8 + e2] + (rr >> 16);
        mi[MI_ROWTOK + pa] = tok; mf[MI_ROWW + pa] = mf[MI_TOKW + tok * 2]; mi[MI_ROWTOK + pb] = tok; mf[MI_ROWW + pb] = mf[MI_TOKW + tok * 2 + 1];
        mi[MI_TOKPOS + tok * 2] = pa; mi[MI_TOKPOS + tok * 2 + 1] = pb;
        const float rs = row_rstd16((const float*)(ws + O_SSQ), tok); mf[MI_ROWSC + pa] = rs; mf[MI_ROWSC + pb] = rs;
    }
}
__device__ __forceinline__ void final_phase(const Ctx& a, int gw, int NGW, int lane) {
    unsigned char* ws = a.ws; const int* mi = (const int*)(ws + O_MOEI); const float* mf = (const float*)(ws + O_MOEI); const bf16_t* OUTS = (const bf16_t*)(ws + O_OUTS); const float* gf = a.in[I_GFINAL];
    const bf16_t* XBf = (const bf16_t*)(ws + O_XB); const float* SL = (const float*)(ws + O_SLAB);
    f32x4 g[4];
#pragma unroll
    for (int j = 0; j < 4; ++j) g[j] = *(const f32x4*)(gf + (lane + 64 * j) * 4);
    for (int m0 = gw; m0 < M; m0 += 2 * NGW) {
        int pos[2][2];
#pragma unroll
        for (int q = 0; q < 2; ++q) { const int m_ = m0 + q * NGW, m = m_ < M ? m_ : gw; pos[q][0] = mi[MI_TOKPOS + m * 2]; pos[q][1] = mi[MI_TOKPOS + m * 2 + 1]; }
        u32x2 rx[2][4], ro[2][2][4];
#pragma unroll
        for (int q = 0; q < 2; ++q) { const int m_ = m0 + q * NGW, m = m_ < M ? m_ : gw;
#pragma unroll
            for (int j = 0; j < 4; ++j) { const int idx = (lane + 64 * j) * 4; rx[q][j] = *(const u32x2*)(XBf + (size_t)m * D + idx);
                ro[q][0][j] = *(const u32x2*)(OUTS + (size_t)pos[q][0] * 1024 + idx); ro[q][1][j] = *(const u32x2*)(OUTS + (size_t)pos[q][1] * 1024 + idx); } }
#pragma unroll
        for (int q = 0; q < 2; ++q) { const int m = m0 + q * NGW; f32x4 v[4]; float s = 0.f;
#pragma unroll
            for (int j = 0; j < 4; ++j) {
                v[j] = (f32x4){bf2f(rx[q][j].x & 0xffffu), bf2f(rx[q][j].x >> 16), bf2f(rx[q][j].y & 0xffffu), bf2f(rx[q][j].y >> 16)};
#pragma unroll
                for (int e = 0; e < 2; ++e) { const int ps = pos[q][e]; const int sp = mi[MI_SPLIT + (ps >> 8) * 4 + j];
                    if (sp < 0) { const u32x2 ua = ro[q][e][j]; v[j].x += bf2f(ua.x & 0xffffu); v[j].y += bf2f(ua.x >> 16); v[j].z += bf2f(ua.y & 0xffffu); v[j].w += bf2f(ua.y >> 16); }
                    else { const float w = mf[MI_ROWW + ps]; f32x4 acc = (f32x4){0.f, 0.f, 0.f, 0.f};
#pragma unroll
                        for (int k = 0; k < KSPLIT; ++k) acc += *(const f32x4*)(SL + (size_t)(sp * KSPLIT + k) * 65536 + (ps & 255) * 256 + lane * 4);
                        v[j] += acc * w; } }
                s += (v[j].x * v[j].x + v[j].y * v[j].y) + (v[j].z * v[j].z + v[j].w * v[j].w); }
            s = wave_sum(s); const float rstd = rsqrtf(s * (1.0f / 1024.0f) + EPS);
            if (m < M) {
#pragma unroll
                for (int j = 0; j < 4; ++j) *(f32x4*)(a.out + (size_t)m * D + (lane + 64 * j) * 4) = (f32x4){v[j].x * rstd * g[j].x, v[j].y * rstd * g[j].y, v[j].z * rstd * g[j].z, v[j].w * rstd * g[j].w}; } }
    }
}

#ifndef FAST_MASK
#define FAST_MASK 0xfff
#endif
template <int SITE, bool GATHER = false, bool HALFN = false, class Sched, class Epi>
__device__ __forceinline__ void gemm_run(LAS unsigned char* lds, const Sched& S, const Epi& E, int K, int lda, int tid, int ldb = 0, bool tiled = false) {
    if constexpr ((NAIVE_GEMM || !((FAST_MASK >> SITE) & 1)) && !HALFN) gemm_naive(S, E, K, lda);
    else pg8::gemm_phase<GATHER, HALFN>(lds, S, E, K, lda, tid, ldb, tiled);
}

constexpr int NPHASE = 20;
__global__ void __launch_bounds__(NTHR, 2) mega_fwd(Args args) {
    extern __shared__ __attribute__((aligned(16))) unsigned char lds_raw[];
    LAS unsigned char* lds = (LAS unsigned char*)lds_raw;
    const int wave_s = __builtin_amdgcn_readfirstlane((int)threadIdx.x >> 6);
    { const int tid0 = threadIdx.x; for (int u = tid0; u < (LDS_BYTES - LDS_CTL) / 4; u += NTHR) ((LAS unsigned*)(lds + LDS_CTL))[u] = 0u; }
    __syncthreads();
    XcdBarrier bar; bar.bar = (unsigned*)args.ws + CW_BAR; bar.x = 0; bar.st = nullptr; bar.wave = wave_s;
#if N_LAUNCH_MODE == 1
    bar = xcd_barrier_post((unsigned*)args.ws + CW_BAR, (volatile LAS unsigned*)(lds + LDS_MISC) + 8, wave_s);
#endif
    const int lo = args.ph_lo, hi = args.ph_hi;
#define IN(k) in_phase(lo, hi, (k))
#define PROBE_SPIN(k) do { if ((PROBE_MASK >> (k)) & 1) { const unsigned long long t1_ = __builtin_amdgcn_s_memrealtime(), dt_ = t1_ - ph_t0; \
        while (__builtin_amdgcn_s_memrealtime() - t1_ < dt_) __builtin_amdgcn_s_sleep(8); } } while (0)
#if N_LAUNCH_MODE == 1
#define SEAM(k) do { PROBE_SPIN(k); if (IN(k) && IN((k) + 1)) { xcd_barrier(bar); if ((PROBE_MASK >> 20) & 1) xcd_barrier(bar); } } while (0)
#else
#define SEAM(k) do { } while (0)
#endif
#define PH_BEGIN unsigned char* ws = launder_s(args.ws); const Ctx A{InTab{(const float* const*)(ws + O_PTAB)}, (float*)(GAS float*)args.out, ws}; const int tid = (launder_i(wave_s) << 6) | (int)__builtin_amdgcn_mbcnt_hi(~0u, __builtin_amdgcn_mbcnt_lo(~0u, (unsigned)launder_v(0))); \
    const int G = launder_i((int)gridDim.x), bid = launder_i((int)blockIdx.x); \
    const int lane = tid & 63, wave = __builtin_amdgcn_readfirstlane(tid >> 6); const int vcu = (G % 8 == 0) ? (bid % 8) * (G / 8) + bid / 8 : bid; \
    const int gw = vcu * NWAVES + wave, NGW = G * NWAVES; (void)lane; (void)gw; (void)NGW; (void)ws; \
    const unsigned long long ph_t0 = PROBE_MASK ? __builtin_amdgcn_s_memrealtime() : 0ull; (void)ph_t0;

    if (IN(0)) {
        if (xb_thread0(wave_s)) { const float** tab = (const float**)(args.ws + O_PTAB);
#pragma unroll
            for (int i = 0; i < 28; ++i) tab[i] = args.in[i]; }
        asm volatile("s_waitcnt vmcnt(0)" ::: "memory"); __syncthreads();
        PH_BEGIN; phase_prologue(A, lds, vcu, G, tid); SEAM(0); }

    for (int l = 0; l < 2; ++l) {
        const int pb = l ? 9 : 1;
        if (IN(pb)) {
            PH_BEGIN;
            const bool tail = (G == 256), tail_first = tail && bid < 192 && ((bid >> 3) & 1) == 0;
            SchedDense S{(const bf16_t*)(ws + O_XB), (const bf16_t*)(ws + O_WIN + l * SZ_WIN1), 1024, 1024, 64, NIN / 256, G, bid, tail ? 6 * 256 : 0};
            EpiInProj E{(bf16_t*)(ws + O_P), (bf16_t*)(ws + O_GATES), (const float*)(ws + O_SSQ), A.in[I_BGATE] + l * 3072, (float*)(ws + O_RSP)};
            SchedInTail S2{(const bf16_t*)(ws + O_XB), (const bf16_t*)(ws + O_WIN + l * SZ_WIN1), G, bid}; EpiInProjH E2{E};
            if (tail_first) gemm_run<9, false, true>(lds, S2, E2, 1024, 1024, tid);
            gemm_run<0>(lds, S, E, 1024, 1024, tid);
            if (tail && !tail_first) gemm_run<10, false, true>(lds, S2, E2, 1024, 1024, tid);
            SEAM(pb);
        }
        if (IN(pb + 1)) {
            PH_BEGIN;
            for (int it = bid; it < 256; it += G) post_item<(NAIVE_GLA != 0)>(A, l, it, lds, tid);
            __syncthreads();
            SchedUp S{(const bf16_t*)(ws + O_P), (const bf16_t*)(ws + O_WQUP + l * SZ_WQUP1), (const bf16_t*)(ws + O_WKVUP + l * SZ_WKVUP1), G, bid};
            EpiUpProj E{(const float*)(ws + O_RSP), (bf16_t*)(ws + O_QB), (bf16_t*)(ws + O_KNOPE), (bf16_t*)(ws + O_VB)};
            gemm_run<1>(lds, S, E, 256, PW, tid);
            SEAM(pb + 1);
        }
        if (IN(pb + 2)) {
            PH_BEGIN;
            unsigned* qh = (unsigned*)ws + CW_Q + 64 * l; LAS unsigned* slot = (LAS unsigned*)(lds + LDS_CTL + 64);
            constexpr int NGLA = NAIVE_GLA ? 32 : 64;
            for (;;) {
                __syncthreads();
                if (tid == 0) *slot = __hip_atomic_fetch_add(qh, 1u, __ATOMIC_RELAXED, __HIP_MEMORY_SCOPE_AGENT);
                __syncthreads();
                const int u = (int)*slot;
                const int NCI = l == 0 ? 80 : 140, NCT = l == 0 ? 80 : 140;
                if (u >= NGLA + 1024 + NCI + NCT) break;
                int v = u - NGLA, ci = -1;
                if (v >= 1024 + NCI) ci = v - 1024;
                else if (v >= 0 && NCI > 0) { const int c0 = (v * NCI) / (1024 + NCI), c1 = ((v + 1) * NCI) / (1024 + NCI); if (c1 > c0) ci = c0; else v -= c0; }
                if (ci >= 0) { conv_unit0(A, lds, l, ci, wave, lane); continue; }
#if NAIVE_GLA
                if (u < NGLA) gla_naive_unit(A, l, u >> 2, u & 3, lds, tid);
#else
                if (u < NGLA) gla::unit(A, u >> 3, (u >> 1) & 3, u & 1, lds, tid);
#endif
#if NAIVE_ATTN
                else if (v < 512) { attn_naive_unit<1>(A, v >> 6, (v >> 3) & 7, v & 7, lds, tid); }
                else { v -= 512; attn_naive_unit<0>(A, v >> 6, (v >> 3) & 7, v & 7, lds, tid); }
#else
                else if (v < 512) { const int b_ = v >> 6, h_ = (v >> 3) & 7, qb_ = v & 7;
                    att96::attn_unit<8>(b_, h_, qb_, (const att96::bf16*)(ws + O_QB), (const att96::bf16*)(ws + O_KNOPE) + h_ * 64, (const att96::bf16*)(ws + O_KROPE), (const att96::bf16*)(ws + O_VB) + h_ * 64,
                                        (att96::bf16*)(ws + O_YB), (const float*)(ws + O_TABB), (char*)lds, tid); }
                else { v -= 512; const int b_ = v >> 6, h_ = (v >> 3) & 7, qb_ = v & 7;
                    att64::attn_unit<8>(b_, h_, qb_, (const att64::bf16*)(ws + O_QA), (const att64::bf16*)(ws + O_KA) + (h_ >> 2) * 64, (const att64::bf16*)(ws + O_VA) + (h_ >> 2) * 64,
                                        (att64::bf16*)(ws + O_YA), (char*)lds, tid); }
#endif
            }
            SEAM(pb + 2);
        }
        if (IN(pb + 3)) {
            PH_BEGIN;
#if !NAIVE_GLA
            gla::combine_phase(A, l, gw, NGW, lane);
#endif
            SEAM(pb + 3);
        }
        if (IN(pb + 4)) {
            PH_BEGIN;
            SchedMerge S{(const bf16_t*)(ws + O_YA), (const bf16_t*)(ws + O_WP + l * 3 * SZ_WP1), G, bid};
            EpiMergeR E{(const bf16_t*)(ws + O_GATES), (bf16_t*)(ws + O_MB)};
            gemm_run<2>(lds, S, E, 512, 512, tid);
            SEAM(pb + 4);
        }
        if (IN(pb + 5)) {
            PH_BEGIN;
            SchedDense S{(const bf16_t*)(ws + O_MB), (const bf16_t*)(ws + O_WOUT + l * SZ_WOUT1), 1024, 1024, 64, 4, G, bid};
            EpiResid E{(bf16_t*)(ws + O_XB), (float*)(ws + O_SSQ)};
            gemm_run<3>(lds, S, E, 1024, 1024, tid);
            SEAM(pb + 5);
        }
        if (l == 0) {
            if (IN(7)) {
                PH_BEGIN;
                SchedDense S{(const bf16_t*)(ws + O_XB), (const bf16_t*)(ws + O_WFFGU), 1024, 1024, 64, 2 * DFF / 256, G, bid};
                EpiSwiGLU E{(const float*)(ws + O_SSQ), nullptr, (bf16_t*)(ws + O_HID), DFF};
                gemm_run<4>(lds, S, E, 1024, 1024, tid);
                SEAM(7);
            }
            if (IN(8)) {
                PH_BEGIN;
                SchedDense S{(const bf16_t*)(ws + O_HID), (const bf16_t*)(ws + O_WFFD), DFF, DFF, 64, 4, G, bid};
                EpiResid E{(bf16_t*)(ws + O_XB), (float*)(ws + O_SSQ)};
                gemm_run<5>(lds, S, E, DFF, 64, tid, 64, true);
                SEAM(8);
            }
        }
    }
    if (IN(15)) {
        PH_BEGIN;
        for (int blk = bid; blk < 256; blk += G) router_item(A, blk, lds, tid);
        __syncthreads();
        run_transposes<true>(A, lds, gw, NGW, wave, lane);
        SEAM(15);
    }
    if (IN(16)) { PH_BEGIN; positions_phase(A, lds, G, bid, tid); SEAM(16); }
    if (IN(17)) {
        PH_BEGIN; int* mi = (int*)(ws + O_MOEI);
        LAS int* te = (LAS int*)(lds + LDS_RING + 4096);
        __syncthreads(); if (tid < MAXTILES + 8) te[tid] = mi[MI_TILEE + tid]; __syncthreads();
        SchedMoe S{(const bf16_t*)(ws + O_XB), (const bf16_t*)(ws + O_WEGU), te, mi + MI_ROWTOK, 1024, 1024, 2 * DFE / 256, G, bid, (size_t)2 * DFE * 1024, true, te[MAXTILES], 0};
        EpiSwiGLU E{(const float*)(ws + O_SSQ), mi + MI_ROWSC, (bf16_t*)(ws + O_HIDS), DFE};
        gemm_run<6, true>(lds, S, E, 1024, 1024, tid);
        SEAM(17);
    }
    if (IN(18)) {
        PH_BEGIN; int* mi = (int*)(ws + O_MOEI);
        LAS int* te = (LAS int*)(lds + LDS_RING + 4096);
        __syncthreads(); if (tid < MAXTILES + 8) te[tid] = mi[MI_TILEE + tid]; if (tid >= 256 && tid < 258) te[MAXTILES + 8 + (tid - 256)] = mi[MI_SPLIT + MAXTILES * 4 + (tid - 256)]; __syncthreads();
        const int nmain_ = te[MAXTILES + 8], nsplit_ = te[MAXTILES + 9];
        SchedMoe S{(const bf16_t*)(ws + O_HIDS), (const bf16_t*)(ws + O_WED), te, mi + MI_ROWTOK, DFE, DFE, 4, G, bid, (size_t)1024 * DFE, false, te[MAXTILES], nmain_};
        EpiMoeDown E{(const float*)(ws + O_MOEI) + MI_ROWW, (bf16_t*)(ws + O_OUTS)};
        gemm_run<7>(lds, S, E, DFE, 64, tid, 64, true);
        {
            SchedMoeSlice S2{(const bf16_t*)(ws + O_HIDS), (const bf16_t*)(ws + O_WED), te, te[MAXTILES], nmain_, nsplit_, G, bid};
            EpiSlab E2{(float*)(ws + O_SLAB)};
            gemm_run<8>(lds, S2, E2, DFE / KSPLIT, 64, tid, 64, true);
        }
        SEAM(18);
    }
    if (IN(19)) { PH_BEGIN; final_phase(A, gw, NGW, lane); PROBE_SPIN(19); }
#undef IN
#undef SEAM
#undef PH_BEGIN
}

extern "C" void kernel_launch(void* const* d_in, const int* in_sizes, int n_in, void* d_out, int out_size, void* d_ws, size_t ws_size, hipStream_t stream) {
    static int grid = 0;
    if (grid == 0) {
        if (n_in != 28 || out_size != M * D || ws_size < WS_NEED) { fprintf(stderr, "kernel_launch: unexpected shapes (n_in %d out %d ws %zu need %zu)\n", n_in, out_size, ws_size, (size_t)WS_NEED); grid = -1; return; }
        int dev = 0, cus = 0;
        if (hipGetDevice(&dev) != hipSuccess || hipDeviceGetAttribute(&cus, hipDeviceAttributeMultiprocessorCount, dev) != hipSuccess) { grid = -1; return; }
        if (hipFuncSetAttribute((const void*)mega_fwd, hipFuncAttributeMaxDynamicSharedMemorySize, LDS_BYTES) != hipSuccess) { grid = -1; return; }
        int per_cu = 0;
        if (hipOccupancyMaxActiveBlocksPerMultiprocessor(&per_cu, (const void*)mega_fwd, NTHR, LDS_BYTES) != hipSuccess || per_cu < 1) { fprintf(stderr, "kernel_launch: occupancy query says %d\n", per_cu); }
        (void)hipGetLastError();
        grid = cus;
    }
    if (grid < 0) return;
    (void)hipMemsetAsync(d_ws, 0, CTL_BYTES, stream);
    Args a{};
    for (int i = 0; i < 28; ++i) a.in[i] = (const float*)d_in[i];
    a.out = (float*)d_out; a.ws = (unsigned char*)d_ws; a.li = 0; a.pad = 0;
#if N_LAUNCH_MODE == 1
    a.ph_lo = 0; a.ph_hi = NPHASE;
    hipLaunchKernelGGL(mega_fwd, dim3(grid), dim3(NTHR), LDS_BYTES, stream, a);
#else
    for (int p = 0; p < NPHASE; ++p) { a.ph_lo = p; a.ph_hi = p + 1; hipLaunchKernelGGL(mega_fwd, dim3(grid), dim3(NTHR), LDS_BYTES, stream, a); }
#endif
}
```

```cpp
#include <hip/hip_runtime.h>
#include <cstdio>
#include <cstdint>

#ifndef N_LAUNCH_MODE
#define N_LAUNCH_MODE 1
#endif
#ifndef PROBE_MASK
#define PROBE_MASK 0
#endif
#ifndef NAIVE_GEMM
#define NAIVE_GEMM 0
#endif
#ifndef NAIVE_ATTN
#define NAIVE_ATTN 0
#endif
#ifndef NAIVE_GLA
#define NAIVE_GLA 0
#endif

#define LAS __attribute__((address_space(3)))
#define GAS __attribute__((address_space(1)))
typedef unsigned short bf16_t;
typedef short bf16x8 __attribute__((ext_vector_type(8)));
typedef float f32x4 __attribute__((ext_vector_type(4)));
typedef unsigned u32x4 __attribute__((ext_vector_type(4)));
typedef unsigned u32x2 __attribute__((ext_vector_type(2)));

constexpr int M = 16384, D = 1024, T = 2048, NBATCH = 8, NWAVES = 8, NTHR = 512;
constexpr float EPS = 1e-6f;
constexpr int PW = 2304;
constexpr int PC_AQ = 0, PC_AK = 512, PC_SMALL = 640, PC_BCQ = 768, PC_BCKV = 1024, PC_CQ = 1280, PC_CK = 1792;
constexpr int NIN = 6656;
constexpr int DFF = 2816, DFE = 3584, NEXP = 8;
constexpr int MAXTILES = 136, MAXROWS = MAXTILES * 256;
constexpr float LOG2E = 1.4426950408889634f;
constexpr float C2A = 0.125f * LOG2E;
constexpr float C2B = 0.10206207261596575f * LOG2E;
constexpr float GLA_QSCALE = 0.08838834764831845f;

constexpr size_t CTL_BYTES = 1u << 20;
constexpr size_t SZ_WIN1 = (size_t)NIN * 1024 * 2, SZ_WQUP1 = 768 * 256 * 2, SZ_WKVUP1 = 1024 * 256 * 2, SZ_WP1 = 1024 * 512 * 2, SZ_WOUT1 = 1024 * 1024 * 2;
constexpr size_t O_WIN = CTL_BYTES;
constexpr size_t O_WQUP = O_WIN + 2 * SZ_WIN1;
constexpr size_t O_WKVUP = O_WQUP + 2 * SZ_WQUP1;
constexpr size_t O_WP = O_WKVUP + 2 * SZ_WKVUP1;
constexpr size_t O_WOUT = O_WP + 6 * SZ_WP1;
constexpr size_t O_WFFGU = O_WOUT + 2 * SZ_WOUT1;
constexpr size_t O_WFFD = O_WFFGU + (size_t)2 * DFF * 1024 * 2;
constexpr size_t O_TABA = O_WFFD + (size_t)1024 * DFF * 2;
constexpr size_t O_TABB = O_TABA + (size_t)T * 64 * 4;
constexpr size_t O_XB = O_TABB + (size_t)T * 32 * 4;
constexpr size_t O_SSQ = O_XB + (size_t)M * 1024 * 2;
constexpr size_t O_RSP = O_SSQ + (size_t)M * 16 * 4;
constexpr size_t O_PTAB = O_RSP + (size_t)M * 32 * 4;
constexpr size_t O_MOEI = O_PTAB + 256;
constexpr size_t SZ_MOEI = 2u << 20;
constexpr size_t O_R = O_MOEI + SZ_MOEI;
constexpr size_t O_P = O_R;
constexpr size_t O_VA = O_P + (size_t)M * PW * 2;
constexpr size_t O_VG = O_VA + (size_t)M * 128 * 2;
constexpr size_t O_GATES = O_VG + (size_t)M * 1024 * 2;
constexpr size_t O_QA = O_GATES + (size_t)M * 3072 * 2;
constexpr size_t O_KA = O_QA + (size_t)M * 512 * 2;
constexpr size_t O_KROPE = O_KA + (size_t)M * 128 * 2;
constexpr size_t O_QB = O_KROPE + (size_t)M * 32 * 2;
constexpr size_t O_KNOPE = O_QB + (size_t)M * 768 * 2;
constexpr size_t O_VB = O_KNOPE + (size_t)M * 512 * 2;
constexpr size_t O_QT = O_VB + (size_t)M * 512 * 2;
constexpr size_t O_DEC = O_QT + (size_t)4 * M * 512 * 2;
constexpr size_t O_YA = O_DEC + (size_t)2 * 256 * 512 * 4;
constexpr size_t O_YB = O_YA + (size_t)M * 512 * 2;
constexpr size_t O_YC = O_YB + (size_t)M * 512 * 2;
constexpr size_t O_OCB = O_YC + (size_t)M * 512 * 2;
constexpr size_t O_MIX_END = O_OCB + (size_t)M * 512 * 2;
constexpr size_t O_PART = O_QT;
constexpr size_t O_MB = O_QT;
constexpr size_t O_HID = O_P;
constexpr size_t O_WEGU = O_R;
constexpr size_t O_WED = O_WEGU + (size_t)NEXP * 2 * DFE * 1024 * 2;
constexpr size_t O_HIDS = O_WED + (size_t)NEXP * 1024 * DFE * 2;
constexpr size_t O_MOE_END = O_HIDS + (size_t)MAXROWS * DFE * 2;
constexpr size_t O_OUTS = O_WEGU;
constexpr int KSPLIT = 4, MAXSPLIT = 32;
constexpr size_t O_SLAB = O_OUTS + (size_t)MAXROWS * 1024 * 2;
static_assert(O_SLAB + (size_t)MAXSPLIT * KSPLIT * 65536 * 4 <= O_WED, "slabs overlay");
constexpr size_t WS_NEED = O_MIX_END > O_MOE_END ? O_MIX_END : O_MOE_END;
static_assert(WS_NEED <= 531851264ull, "workspace map exceeds the guaranteed ws_size");
static_assert((size_t)M * 1024 * 4 <= (size_t)4 * M * 512 * 2, "PART overlay");
static_assert((size_t)MAXROWS * 1024 * 2 <= (size_t)NEXP * 2 * DFE * 1024 * 2, "OUTS overlay");
constexpr int MI_CNT = 0;
constexpr int MI_TOKE = 4096;
constexpr int MI_TOKR = MI_TOKE + M;
constexpr int MI_TOKW = MI_TOKR + M;
constexpr int MI_TOKPOS = MI_TOKW + 2 * M;
constexpr int MI_ROWTOK = MI_TOKPOS + 2 * M;
constexpr int MI_ROWW = MI_ROWTOK + MAXROWS;
constexpr int MI_TILEE = MI_ROWW + MAXROWS;
constexpr int MI_ROWSC = MI_TILEE + MAXTILES + 8;
constexpr int MI_SPLIT = MI_ROWSC + MAXROWS;
constexpr int MI_END = MI_SPLIT + MAXTILES * 4 + 8;
static_assert((size_t)MI_END * 4 <= SZ_MOEI, "moe lists");

constexpr int CW_TMO = 0;
constexpr int CW_Q = 1024;
constexpr int CW_BAR = 4096;

constexpr int LDS_RING = 131072, LDS_CTL = 145408, LDS_MISC = LDS_CTL + 320, LDS_BYTES = 147456;

__device__ __forceinline__ float bf2f(unsigned v) { return __uint_as_float(v << 16); }
__device__ __forceinline__ unsigned f2bf(float f) { typedef float f2_ __attribute__((ext_vector_type(2))); typedef __bf16 b2_ __attribute__((ext_vector_type(2))); f2_ v = {f, 0.f}; b2_ b = __builtin_convertvector(v, b2_); return __builtin_bit_cast(unsigned, b) & 0xffffu; }
typedef float f32x2_t __attribute__((ext_vector_type(2))); typedef __bf16 bf16x2_t __attribute__((ext_vector_type(2)));
__device__ __forceinline__ unsigned pk2(float lo, float hi) { f32x2_t v = {lo, hi}; bf16x2_t b = __builtin_convertvector(v, bf16x2_t); return __builtin_bit_cast(unsigned, b); }
__device__ __forceinline__ void unpack8(const u32x4 w, float (&f)[8]) {
    f[0] = __uint_as_float(w.x << 16); f[1] = __uint_as_float(w.x & 0xffff0000u); f[2] = __uint_as_float(w.y << 16); f[3] = __uint_as_float(w.y & 0xffff0000u);
    f[4] = __uint_as_float(w.z << 16); f[5] = __uint_as_float(w.z & 0xffff0000u); f[6] = __uint_as_float(w.w << 16); f[7] = __uint_as_float(w.w & 0xffff0000u);
}
__device__ __forceinline__ u32x4 pack8(const float (&f)[8]) { u32x4 w; w.x = pk2(f[0], f[1]); w.y = pk2(f[2], f[3]); w.z = pk2(f[4], f[5]); w.w = pk2(f[6], f[7]); return w; }
__device__ __forceinline__ void load8(const bf16_t* p, float (&f)[8]) { unpack8(*(const u32x4*)p, f); }
__device__ __forceinline__ void store8(bf16_t* p, const float (&f)[8]) { *(u32x4*)p = pack8(f); }
__device__ __forceinline__ void ld8f(const float* p, float (&f)[8]) { const f32x4 a = *(const f32x4*)p, b = *(const f32x4*)(p + 4); f[0] = a.x; f[1] = a.y; f[2] = a.z; f[3] = a.w; f[4] = b.x; f[5] = b.y; f[6] = b.z; f[7] = b.w; }
template <int MASK> __device__ __forceinline__ float shx(float v) { static_assert(MASK > 0 && MASK < 32, "shx: 1..31"); return __int_as_float(__builtin_amdgcn_ds_swizzle(__float_as_int(v), 0x1f | (MASK << 10))); }
__device__ __forceinline__ float sum_halves(float v) { auto r = __builtin_amdgcn_permlane32_swap(__float_as_uint(v), __float_as_uint(v), false, false); return __uint_as_float(r[0]) + __uint_as_float(r[1]); }
__device__ __forceinline__ float other_half(float v, int hi) { auto r = __builtin_amdgcn_permlane32_swap(__float_as_uint(v), __float_as_uint(v), false, false); return __uint_as_float(hi ? r[0] : r[1]); }
__device__ __forceinline__ float wave_sum(float v) { v += shx<1>(v); v += shx<2>(v); v += shx<4>(v); v += shx<8>(v); v += shx<16>(v); return sum_halves(v); }
__device__ __forceinline__ float row_rstd16(const float* ssq, int row) {
    const f32x4* p = (const f32x4*)(ssq + (size_t)row * 16);
    const f32x4 a = p[0], b = p[1], c = p[2], d = p[3];
    const float s = ((a.x + a.y) + (a.z + a.w)) + ((b.x + b.y) + (b.z + b.w)) + ((c.x + c.y) + (c.z + c.w)) + ((d.x + d.y) + (d.z + d.w));
    return rsqrtf(s * (1.0f / 1024.0f) + EPS);
}
__device__ __forceinline__ float sigmoidf_(float x) { return __builtin_amdgcn_rcpf(1.0f + __builtin_amdgcn_exp2f(x * -LOG2E)); }

#define XB_TMO      128
#define XB_XCNT(j)  (256  + 64 * (j))
#define XB_XSUB(j)  (1280 + 64 * (j))
#define XB_XGEN(j)  (2304 + 64 * (j))
#define XB_TOP      3328
#define XB_TOPGEN   3392
#define XCD_BAR_WORDS 3456
#define XB_SPIN_CAP (1u << 18)
__device__ __forceinline__ unsigned xb_ld(unsigned* p)              { return __hip_atomic_load(p, __ATOMIC_RELAXED, __HIP_MEMORY_SCOPE_AGENT); }
__device__ __forceinline__ unsigned xb_add(unsigned* p, unsigned v) { return __hip_atomic_fetch_add(p, v, __ATOMIC_RELAXED, __HIP_MEMORY_SCOPE_AGENT); }
__device__ __forceinline__ unsigned xb_xcc_id() { return (unsigned)__builtin_amdgcn_s_getreg((3 << 11) | 20) & 0xFu; }
#define XB_SPIN(cond, bar) do { unsigned _sp = 0; while (cond) { __builtin_amdgcn_s_sleep(1); \
    if ((++_sp & 255u) == 0u) { if (xb_ld(&(bar)[XB_TMO])) break; if (_sp > XB_SPIN_CAP) { atomicAdd(&(bar)[XB_TMO], 1u); break; } } } } while (0)
struct XcdBarrier { unsigned* bar; unsigned x; volatile LAS unsigned* st; int wave; };
__device__ __forceinline__ bool xb_thread0(int wave) { unsigned z = 0u; asm volatile("" : "+v"(z)); return wave == 0 && __builtin_amdgcn_mbcnt_hi(~0u, __builtin_amdgcn_mbcnt_lo(~0u, z)) == 0u; }
__device__ __forceinline__ XcdBarrier xcd_barrier_post(unsigned* bar, volatile LAS unsigned* st, int wave) {
    XcdBarrier b; b.bar = bar; b.x = xb_xcc_id(); b.st = st; b.wave = wave;
    if (xb_thread0(wave)) (void)xb_add(&bar[XB_XCNT(b.x)], 1u);
    return b;
}
__device__ __forceinline__ void xcd_barrier_complete(unsigned* bar, unsigned x, unsigned& nloc, unsigned& nx) {
    const unsigned G = gridDim.x * gridDim.y * gridDim.z;
    unsigned sum, cnt, mine, sp = 0u;
    for (;;) {
        sum = 0u; cnt = 0u; mine = 0u;
#pragma unroll
        for (unsigned j = 0; j < 16; ++j) { const unsigned c = xb_ld(&bar[XB_XCNT(j)]); sum += c; cnt += (c > 0u) ? 1u : 0u; mine = (j == x) ? c : mine; }
        if (sum == G) break;
        __builtin_amdgcn_s_sleep(1);
        if ((++sp & 255u) == 0u) { if (xb_ld(&bar[XB_TMO])) break; if (sp > XB_SPIN_CAP) { atomicAdd(&bar[XB_TMO], 1u); break; } }
    }
    nloc = mine > 0u ? mine : 1u; nx = cnt > 0u ? cnt : 1u;
}
__device__ __forceinline__ void xcd_barrier(const XcdBarrier& b) {
    asm volatile("s_waitcnt vmcnt(0)" ::: "memory");
    __syncthreads();
    if (xb_thread0(b.wave)) {
        unsigned* bar = b.bar;
        __builtin_amdgcn_s_waitcnt(0);
        unsigned nloc = b.st[0], nx = b.st[1];
        if (nloc == 0u) { xcd_barrier_complete(bar, b.x, nloc, nx); b.st[0] = nloc; b.st[1] = nx; }
        const unsigned old = xb_add(&bar[XB_XSUB(b.x)], 1u);
        const unsigned gen = old / nloc;
        if (old + 1u == (gen + 1u) * nloc) {
            __builtin_amdgcn_fence(__ATOMIC_RELEASE, "agent");
            asm volatile("s_waitcnt vmcnt(0)" ::: "memory");
            const unsigned og = xb_add(&bar[XB_TOP], 1u);
            const unsigned tg = og / nx;
            if (og + 1u == (tg + 1u) * nx) xb_add(&bar[XB_TOPGEN], 1u);
            else XB_SPIN(xb_ld(&bar[XB_TOPGEN]) == tg, bar);
            __builtin_amdgcn_fence(__ATOMIC_ACQUIRE, "agent");
            xb_add(&bar[XB_XGEN(b.x)], 1u);
            asm volatile("s_waitcnt vmcnt(0)" ::: "memory");
        } else {
            XB_SPIN(xb_ld(&bar[XB_XGEN(b.x)]) == gen, bar);
            __builtin_amdgcn_fence(__ATOMIC_ACQUIRE, "agent");
            asm volatile("s_waitcnt vmcnt(0)" ::: "memory");
        }
    }
    __syncthreads();
}

struct Args { const float* in[28]; float* out; unsigned char* ws; int ph_lo, ph_hi, li, pad; };
struct InTab { const float* const* t; __device__ __forceinline__ const float* operator[](int i) const { return (const float*)(const GAS float*)(uintptr_t)(((const GAS unsigned long long*)t)[i]); } };
struct Ctx { InTab in; float* out; unsigned char* ws; };
enum { I_X = 0, I_WIN, I_BGATE, I_GMIX, I_GAQ, I_GAK, I_GBQ, I_WBQUP, I_GBKV, I_WBKVUP, I_WCAF, I_BCAF, I_WCAB, I_BCAB, I_GCOUT, I_WPA, I_WPB, I_WPC, I_WOUT, I_GFFN,
       I_WFFG, I_WFFU, I_WFFD, I_WROUTER, I_WEG, I_WEU, I_WED, I_GFINAL };

struct GUnit { const bf16_t* A; const bf16_t* B; const int* rows; int pm, pn, aux; };
__device__ __forceinline__ void tile_order(int L, int nM, int nN, int& pm, int& pn) {
    const int nwg = nM * nN; int wgid = L;
    { const int q = nwg / 8, r = nwg % 8, xcd = wgid % 8, off = wgid / 8; wgid = (xcd < r ? xcd * (q + 1) : r * (q + 1) + (xcd - r) * q) + off; }
    const int nig = 8 * nN, gid = wgid / nig, fm = gid * 8, gsz = (nM - fm) < 8 ? (nM - fm) : 8;
    pm = fm + ((wgid % nig) % gsz); pn = (wgid % nig) / gsz;
}
struct SchedDense {
    const bf16_t* A; const bf16_t* B; int lda, K, nM, nN, G, c; int lim = 0;
    __device__ __forceinline__ bool next(int i, GUnit& u) const {
        const long L = (long)i * G + c; if (L >= (long)nM * nN || (lim && L >= lim)) return false;
        tile_order((int)L, nM, nN, u.pm, u.pn);
        u.A = A + (size_t)u.pm * 256 * lda; u.B = B + (size_t)u.pn * 256 * K; u.rows = nullptr; u.aux = 0; return true;
    }
};
struct SchedInTail {
    const bf16_t* A; const bf16_t* B; int G, c;
    __device__ __forceinline__ bool next(int i, GUnit& u) const {
        const int s = i * G + c; if (s >= 192) return false;
        u.pm = s & 63; u.pn = 48 + (s >> 6); u.aux = 0; u.A = A + (size_t)u.pm * 256 * 1024; u.B = B + (size_t)u.pn * 128 * 1024; u.rows = nullptr; return true;
    }
};
struct SchedUp {
    const bf16_t* P; const bf16_t* Wq; const bf16_t* Wkv; int G, c;
    __device__ __forceinline__ bool next(int i, GUnit& u) const {
        const int L = i * G + c; if (L >= 448) return false;
        if (L < 192) { tile_order(L, 64, 3, u.pm, u.pn); u.aux = 0; u.A = P + (size_t)u.pm * 256 * PW + PC_BCQ; u.B = Wq + (size_t)u.pn * 256 * 256; }
        else { tile_order(L - 192, 64, 4, u.pm, u.pn); u.aux = 1; u.A = P + (size_t)u.pm * 256 * PW + PC_BCKV; u.B = Wkv + (size_t)u.pn * 256 * 256; }
        u.rows = nullptr; return true;
    }
};
struct SchedMerge {
    const bf16_t* Y0; const bf16_t* W; int G, c;
    __device__ __forceinline__ bool next(int i, GUnit& u) const {
        const int tile = (i / 3) * G + c, br = i % 3; if (tile >= 256) return false;
        tile_order(tile, 64, 4, u.pm, u.pn); u.aux = br;
        u.A = Y0 + (size_t)br * M * 512 + (size_t)u.pm * 256 * 512; u.B = W + (size_t)br * 1024 * 512 + (size_t)u.pn * 256 * 512; u.rows = nullptr; return true;
    }
};
struct SchedMergeH {
    const bf16_t* Y0; const bf16_t* W; int G, c;
    __device__ __forceinline__ bool next(int i, GUnit& u) const {
        const int tile = (i / 3) * G + c, br = i % 3; if (tile >= 512) return false;
        tile_order(tile, 64, 8, u.pm, u.pn); u.aux = br;
        u.A = Y0 + (size_t)br * M * 512 + (size_t)u.pm * 256 * 512; u.B = W + (size_t)br * 1024 * 512 + (size_t)u.pn * 128 * 512; u.rows = nullptr; return true;
    }
};
struct SchedMoeSlice {
    const bf16_t* A; const bf16_t* B; const LAS int* tile_e; int nM, nmain, nsplit; int G, c;
    __device__ __forceinline__ bool next(int i, GUnit& u) const {
        const int s = i * G + c; if (s >= nsplit * KSPLIT) return false;
        tile_order(nmain + s / KSPLIT, nM, 4, u.pm, u.pn); const int e = tile_e[u.pm], j = s % KSPLIT; u.aux = s;
        const size_t koff = (size_t)j * (DFE / KSPLIT / 64) * 256 * 64;
        u.A = A + (size_t)u.pm * 256 * DFE + koff; u.B = B + (size_t)e * 1024 * DFE + (size_t)u.pn * 256 * DFE + koff; u.rows = nullptr; return true;
    }
};
struct SchedMoe {
    const bf16_t* A; const bf16_t* B; const LAS int* tile_e; const int* rowtok; int lda, K, nN, G, c; size_t bstride; bool gather; int nM, lim;
    __device__ __forceinline__ bool next(int i, GUnit& u) const {
        const long L = (long)i * G + c; if (L >= (long)nM * nN || (lim && L >= lim)) return false;
        tile_order((int)L, nM, nN, u.pm, u.pn); const int e = tile_e[u.pm]; u.aux = e;
        u.B = B + (size_t)e * bstride + (size_t)u.pn * 256 * K;
        if (gather) { u.A = A; u.rows = rowtok + u.pm * 256; } else { u.A = A + (size_t)u.pm * 256 * lda; u.rows = nullptr; }
        return true;
    }
};

struct NoPre {};
constexpr int INPROJ_PERM_TILES = 24;
struct EpiInProj {
    bf16_t* P; bf16_t* GATES; const float* ssq; const float* bgate; float* rsp;
    static constexpr bool CARRY = false; static constexpr bool HAS_SSQ = false, HAS_SCALE = true; typedef NoPre Pre;
    __device__ __forceinline__ float row_scale(const GUnit& u, int r) const { return row_rstd16(ssq, u.pm * 256 + r); }
    __device__ __forceinline__ Pre load(const GUnit&, int, int) const { return Pre{}; }
    __device__ __forceinline__ void half(int H, int row, int c, const float (&v)[8], float rstd) const {
        float o[8];
        if (H >= 26 && H < 50) {
            const int gc = (H - 26) * 128 + c; const f32x4 b0 = *(const f32x4*)(bgate + gc), b1 = *(const f32x4*)(bgate + gc + 4);
            o[0] = sigmoidf_(v[0] * rstd + b0.x); o[1] = sigmoidf_(v[1] * rstd + b0.y); o[2] = sigmoidf_(v[2] * rstd + b0.z); o[3] = sigmoidf_(v[3] * rstd + b0.w);
            o[4] = sigmoidf_(v[4] * rstd + b1.x); o[5] = sigmoidf_(v[5] * rstd + b1.y); o[6] = sigmoidf_(v[6] * rstd + b1.z); o[7] = sigmoidf_(v[7] * rstd + b1.w);
            store8(GATES + (size_t)row * 3072 + gc, o);
        } else if (H < 51) {
#pragma unroll
            for (int j = 0; j < 8; ++j) o[j] = v[j] * rstd;
            const bool inP = H < 18, inG = H < 26;
            bf16_t* base = inP ? P + H * 128 : (inG ? (bf16_t*)((unsigned char*)P + (O_VG - O_P)) + (H - 18) * 128 : (bf16_t*)((unsigned char*)P + (O_VA - O_P)));
            const int pitch = inP ? PW : (inG ? 1024 : 128);
            store8(base + (size_t)row * pitch + c, o);
        }
    }
    __device__ __forceinline__ u32x4 val(int H, int c, const float (&v)[8], float rstd) const {
        float o[8];
        if (H >= 26) {
            const int gc = (H - 26) * 128 + c; const f32x4 b0 = *(const f32x4*)(bgate + gc), b1 = *(const f32x4*)(bgate + gc + 4);
            o[0] = sigmoidf_(v[0] * rstd + b0.x); o[1] = sigmoidf_(v[1] * rstd + b0.y); o[2] = sigmoidf_(v[2] * rstd + b0.z); o[3] = sigmoidf_(v[3] * rstd + b0.w);
            o[4] = sigmoidf_(v[4] * rstd + b1.x); o[5] = sigmoidf_(v[5] * rstd + b1.y); o[6] = sigmoidf_(v[6] * rstd + b1.z); o[7] = sigmoidf_(v[7] * rstd + b1.w);
        } else {
#pragma unroll
            for (int j = 0; j < 8; ++j) o[j] = v[j] * rstd;
        }
        return pack8(o);
    }
    __device__ __forceinline__ float apply(const GUnit& u, int r, int c, const float (&v0)[8], const float (&v1)[8], float rstd, const Pre&) const {
        const int row = u.pm * 256 + r;
        if (u.pn < INPROJ_PERM_TILES) {
            const int wc = c >> 5, ch = (wc & 1) * 64 + (c & 31), H = u.pn * 2 + (wc >> 1);
            const u32x4 pk0 = val(H, ch, v0, rstd), pk1 = val(H, ch + 32, v1, rstd);
            const bool odd = (r & 1) != 0;
            const u32x4 snd = odd ? pk0 : pk1; u32x4 rcv;
            rcv.x = (unsigned)__builtin_amdgcn_mov_dpp((int)snd.x, 0xB1, 0xF, 0xF, true); rcv.y = (unsigned)__builtin_amdgcn_mov_dpp((int)snd.y, 0xB1, 0xF, 0xF, true);
            rcv.z = (unsigned)__builtin_amdgcn_mov_dpp((int)snd.z, 0xB1, 0xF, 0xF, true); rcv.w = (unsigned)__builtin_amdgcn_mov_dpp((int)snd.w, 0xB1, 0xF, 0xF, true);
            const u32x4 da = odd ? rcv : pk0, db = odd ? pk1 : rcv;
            const int col = ch + (odd ? 32 : 0);
            bf16_t* d; int pitch;
            if (H >= 26) { d = GATES + (H - 26) * 128 + col; pitch = 3072; }
            else { const bool inP = H < 18; d = (inP ? P + H * 128 : (bf16_t*)((unsigned char*)P + (O_VG - O_P)) + (H - 18) * 128) + col; pitch = inP ? PW : 1024; }
            *(u32x4*)(d + (size_t)(row & ~1) * pitch) = da; *(u32x4*)(d + (size_t)(row | 1) * pitch) = db;
        } else { half(u.pn * 2, row, c, v0, rstd); half(u.pn * 2 + 1, row, c, v1, rstd); }
        if (u.pn == 3 || u.pn == 4) { float s = 0.f;
#pragma unroll
            for (int j = 0; j < 8; ++j) s += (v0[j] * v0[j] + v1[j] * v1[j]);
            rsp[(size_t)row * 32 + (u.pn - 3) * 16 + (c >> 3)] = s * rstd * rstd; }
        return 0.f;
    }
};
struct EpiInProjH {
    EpiInProj e;
    static constexpr bool CARRY = false, HAS_SSQ = false, HAS_SCALE = true; typedef NoPre Pre;
    __device__ __forceinline__ float row_scale(const GUnit& u, int r) const { return e.row_scale(u, r); }
    __device__ __forceinline__ Pre load(const GUnit&, int, int) const { return Pre{}; }
    __device__ __forceinline__ float apply(const GUnit& u, int r, int c, const float (&v0)[8], const float (&)[8], float rstd, const Pre&) const { e.half(u.pn, u.pm * 256 + r, c, v0, rstd); return 0.f; }
};
struct EpiUpProj {
    const float* rsp; bf16_t* QB; bf16_t* KNOPE; bf16_t* VB;
    static constexpr bool CARRY = false; static constexpr bool HAS_SSQ = false, HAS_SCALE = true; typedef NoPre Pre;
    __device__ __forceinline__ float row_scale(const GUnit& u, int r) const {
        const f32x4* p = (const f32x4*)(rsp + (size_t)(u.pm * 256 + r) * 32 + u.aux * 16); float s = 0.f;
#pragma unroll
        for (int j = 0; j < 4; ++j) { const f32x4 a = p[j]; s += (a.x + a.y) + (a.z + a.w); }
        const float rstd = rsqrtf(s * (1.0f / 256.0f) + EPS); return u.aux == 0 ? rstd * C2B : rstd;
    }
    __device__ __forceinline__ Pre load(const GUnit&, int, int) const { return Pre{}; }
    __device__ __forceinline__ float apply(const GUnit& u, int r, int c, const float (&v0)[8], const float (&v1)[8], float rstd, const Pre&) const {
        const int row = u.pm * 256 + r; float o0[8], o1[8];
#pragma unroll
        for (int j = 0; j < 8; ++j) { o0[j] = v0[j] * rstd; o1[j] = v1[j] * rstd; }
        bf16_t* q = (u.aux == 0 ? QB + (size_t)row * 768 + u.pn * 256 : (u.pn < 2 ? KNOPE + (size_t)row * 512 + u.pn * 256 : VB + (size_t)row * 512 + (u.pn - 2) * 256)) + c;
        store8(q, o0); store8(q + 128, o1);
        return 0.f;
    }
};
struct EpiMerge {
    const bf16_t* GATES; bf16_t* PART; bf16_t* MB;
    static constexpr bool CARRY = false; static constexpr bool HAS_SSQ = false, HAS_SCALE = false;
    struct Pre { u32x4 g0, g1, p0, p1; };
    __device__ __forceinline__ float row_scale(const GUnit&, int) const { return 0.f; }
    __device__ __forceinline__ Pre load(const GUnit& u, int r, int c) const {
        const int row = u.pm * 256 + r, col = u.pn * 256 + c; Pre p;
        const bf16_t* g = GATES + (size_t)row * 3072 + u.aux * 1024 + col; p.g0 = *(const u32x4*)g; p.g1 = *(const u32x4*)(g + 128);
        if (u.aux > 0) { const bf16_t* pp = PART + (size_t)row * 1024 + col; p.p0 = *(const u32x4*)pp; p.p1 = *(const u32x4*)(pp + 128); } else { p.p0 = (u32x4){0u, 0u, 0u, 0u}; p.p1 = p.p0; }
        return p;
    }
    __device__ __forceinline__ float apply(const GUnit& u, int r, int c, const float (&v0)[8], const float (&v1)[8], float, const Pre& pre) const {
        const int row = u.pm * 256 + r, col = u.pn * 256 + c, br = u.aux;
        float g[8], p[8], o[8];
        unpack8(pre.g0, g); unpack8(pre.p0, p);
#pragma unroll
        for (int j = 0; j < 8; ++j) o[j] = g[j] * v0[j] + p[j];
        store8((br < 2 ? PART : MB) + (size_t)row * 1024 + col, o);
        unpack8(pre.g1, g); unpack8(pre.p1, p);
#pragma unroll
        for (int j = 0; j < 8; ++j) o[j] = g[j] * v1[j] + p[j];
        store8((br < 2 ? PART : MB) + (size_t)row * 1024 + col + 128, o);
        return 0.f;
    }
};
struct EpiMergeH {
    const bf16_t* GATES; bf16_t* MB;
    static constexpr bool CARRY = true, HAS_SSQ = false, HAS_SCALE = false;
    struct Pre { u32x4 g; };
    __device__ __forceinline__ float row_scale(const GUnit&, int) const { return 0.f; }
    __device__ __forceinline__ Pre load(const GUnit& u, int r, int c) const { Pre p; p.g = *(const u32x4*)(GATES + (size_t)(u.pm * 256 + r) * 3072 + u.aux * 1024 + u.pn * 128 + c); return p; }
    __device__ __forceinline__ float apply_carry(const GUnit& u, int r, int c, const float (&v0)[8], f32x4& c0, f32x4& c1, const Pre& pre) const {
        float g[8]; unpack8(pre.g, g);
        const f32x4 t0 = (f32x4){g[0] * v0[0], g[1] * v0[1], g[2] * v0[2], g[3] * v0[3]}, t1 = (f32x4){g[4] * v0[4], g[5] * v0[5], g[6] * v0[6], g[7] * v0[7]};
        if (u.aux == 0) { c0 = t0; c1 = t1; }
        else { c0 += t0; c1 += t1; }
        if (u.aux == 2) { const float o[8] = {c0[0], c0[1], c0[2], c0[3], c1[0], c1[1], c1[2], c1[3]}; store8(MB + (size_t)(u.pm * 256 + r) * 1024 + u.pn * 128 + c, o); }
        return 0.f;
    }
    __device__ __forceinline__ float apply(const GUnit&, int, int, const float (&)[8], const float (&)[8], float, const Pre&) const { return 0.f; }
};
struct EpiMergeR {
    const bf16_t* GATES; bf16_t* MB;
    static constexpr bool CARRY = false, HAS_SSQ = false, HAS_SCALE = false, RATIO = true;
    struct Pre { u32x4 a0, a1, b0, b1; };
    __device__ __forceinline__ float row_scale(const GUnit&, int) const { return 0.f; }
    __device__ __forceinline__ Pre load(const GUnit& u, int r, int c) const {
        const bf16_t* g = GATES + (size_t)(u.pm * 256 + r) * 3072 + u.aux * 1024 + u.pn * 256 + c; Pre p;
        p.a0 = *(const u32x4*)g; p.a1 = *(const u32x4*)(g + 128);
        if (u.aux < 2) { p.b0 = *(const u32x4*)(g + 1024); p.b1 = *(const u32x4*)(g + 1024 + 128); } else { p.b0 = p.a0; p.b1 = p.a1; }
        return p;
    }
    __device__ __forceinline__ void scale(const GUnit&, int, int, f32x4& p0, f32x4& p1, f32x4& q0, f32x4& q1, const Pre& pre) const {
        float a[8], b[8], t[8];
        unpack8(pre.a0, a); unpack8(pre.b0, b);
#pragma unroll
        for (int j = 0; j < 8; ++j) t[j] = fmaxf(a[j], 1e-30f) * __builtin_amdgcn_rcpf(fmaxf(b[j], 1e-30f));
        p0 = (f32x4){p0[0] * t[0], p0[1] * t[1], p0[2] * t[2], p0[3] * t[3]}; p1 = (f32x4){p1[0] * t[4], p1[1] * t[5], p1[2] * t[6], p1[3] * t[7]};
        unpack8(pre.a1, a); unpack8(pre.b1, b);
#pragma unroll
        for (int j = 0; j < 8; ++j) t[j] = fmaxf(a[j], 1e-30f) * __builtin_amdgcn_rcpf(fmaxf(b[j], 1e-30f));
        q0 = (f32x4){q0[0] * t[0], q0[1] * t[1], q0[2] * t[2], q0[3] * t[3]}; q1 = (f32x4){q1[0] * t[4], q1[1] * t[5], q1[2] * t[6], q1[3] * t[7]};
    }
    __device__ __forceinline__ float apply(const GUnit& u, int r, int c, const float (&v0)[8], const float (&v1)[8], float, const Pre& pre) const {
        bf16_t* d = MB + (size_t)(u.pm * 256 + r) * 1024 + u.pn * 256 + c; float g[8], o[8];
        unpack8(pre.a0, g);
#pragma unroll
        for (int j = 0; j < 8; ++j) o[j] = fmaxf(g[j], 1e-30f) * v0[j];
        store8(d, o);
        unpack8(pre.a1, g);
#pragma unroll
        for (int j = 0; j < 8; ++j) o[j] = fmaxf(g[j], 1e-30f) * v1[j];
        store8(d + 128, o);
        return 0.f;
    }
};
template <class T, class = void> struct epi_is_ratio { static constexpr bool value = false; };
template <class T> struct epi_is_ratio<T, decltype((void)T::RATIO)> { static constexpr bool value = T::RATIO; };
struct EpiResid {
    bf16_t* XB; float* ssq;
    static constexpr bool CARRY = false; static constexpr bool HAS_SSQ = true, HAS_SCALE = false;
    struct Pre { u32x4 a, b; };
    __device__ __forceinline__ float row_scale(const GUnit&, int) const { return 0.f; }
    __device__ __forceinline__ Pre load(const GUnit& u, int r, int c) const {
        const size_t off = (size_t)(u.pm * 256 + r) * 1024 + u.pn * 256 + c; Pre p; p.a = *(const u32x4*)(XB + off); p.b = *(const u32x4*)(XB + off + 128); return p;
    }
    __device__ __forceinline__ float apply(const GUnit& u, int r, int c, const float (&v0)[8], const float (&v1)[8], float, const Pre& pre) const {
        const size_t off = (size_t)(u.pm * 256 + r) * 1024 + u.pn * 256 + c; float ss = 0.f, o[8], w[8];
        unpack8(pre.a, o); unpack8(pre.b, w);
#pragma unroll
        for (int j = 0; j < 8; ++j) { o[j] += v0[j]; w[j] += v1[j]; }
        const u32x4 po = pack8(o), pw = pack8(w);
        *(u32x4*)(XB + off) = po; *(u32x4*)(XB + off + 128) = pw;
        unpack8(po, o); unpack8(pw, w);
#pragma unroll
        for (int j = 0; j < 8; ++j) ss += o[j] * o[j] + w[j] * w[j];
        return ss;
    }
    __device__ __forceinline__ void put_ssq(const GUnit& u, int r, int slot, float s) const { ssq[(size_t)(u.pm * 256 + r) * 16 + u.pn * 4 + slot] = s; }
};
struct EpiSwiGLU {
    const float* ssq; const int* rowtok; bf16_t* HID; int ldh;
    static constexpr bool CARRY = false; static constexpr bool HAS_SSQ = false, HAS_SCALE = true; typedef NoPre Pre;
    __device__ __forceinline__ float row_scale(const GUnit& u, int r) const { const int row = u.pm * 256 + r; return rowtok ? ((const float*)rowtok)[row] : row_rstd16(ssq, row); }
    __device__ __forceinline__ Pre load(const GUnit&, int, int) const { return Pre{}; }
    __device__ __forceinline__ float apply(const GUnit& u, int r, int c, const float (&v0)[8], const float (&v1)[8], float rstd, const Pre&) const {
        const int row = u.pm * 256 + r; float o[8];
#pragma unroll
        for (int j = 0; j < 8; ++j) { const float g = v0[j] * rstd, up = v1[j] * rstd; o[j] = g * sigmoidf_(g) * up; }
        const int col = u.pn * 128 + c;
        store8(HID + ((size_t)(u.pm * (ldh >> 6) + (col >> 6)) * 256 + r) * 64 + (col & 63), o); return 0.f;
    }
};
struct EpiSlab {
    float* SL;
    static constexpr bool CARRY = false; static constexpr bool HAS_SSQ = false, HAS_SCALE = false; typedef NoPre Pre;
    __device__ __forceinline__ float row_scale(const GUnit&, int) const { return 0.f; }
    __device__ __forceinline__ Pre load(const GUnit&, int, int) const { return Pre{}; }
    __device__ __forceinline__ float apply(const GUnit& u, int r, int c, const float (&v0)[8], const float (&v1)[8], float, const Pre&) const {
        float* q = SL + (size_t)u.aux * 65536 + r * 256 + c;
        *(f32x4*)q = (f32x4){v0[0], v0[1], v0[2], v0[3]}; *(f32x4*)(q + 4) = (f32x4){v0[4], v0[5], v0[6], v0[7]};
        *(f32x4*)(q + 128) = (f32x4){v1[0], v1[1], v1[2], v1[3]}; *(f32x4*)(q + 132) = (f32x4){v1[4], v1[5], v1[6], v1[7]}; return 0.f;
    }
};
struct EpiMoeDown {
    const float* roww; bf16_t* OUTS;
    static constexpr bool CARRY = false; static constexpr bool HAS_SSQ = false, HAS_SCALE = true; typedef NoPre Pre;
    __device__ __forceinline__ float row_scale(const GUnit& u, int r) const { return roww[u.pm * 256 + r]; }
    __device__ __forceinline__ Pre load(const GUnit&, int, int) const { return Pre{}; }
    __device__ __forceinline__ float apply(const GUnit& u, int r, int c, const float (&v0)[8], const float (&v1)[8], float w, const Pre&) const {
        const int row = u.pm * 256 + r; float o0[8], o1[8];
#pragma unroll
        for (int j = 0; j < 8; ++j) { o0[j] = v0[j] * w; o1[j] = v1[j] * w; }
        bf16_t* q = OUTS + (size_t)row * 1024 + u.pn * 256 + c; store8(q, o0); store8(q + 128, o1); return 0.f;
    }
};

template <class Sched, class Epi>
__device__ __forceinline__ void gemm_naive(const Sched& S, const Epi& E, int K, int lda) {
    const int tid = threadIdx.x, r = tid & 255, s = __builtin_amdgcn_readfirstlane(tid >> 8);
    GUnit u;
    for (int i = 0; S.next(i, u); ++i) {
        const bf16_t* arow = u.rows ? u.A + (size_t)u.rows[r] * lda : u.A + (size_t)r * lda;
        float ss = 0.f;
        for (int g = 0; g < 8; ++g) {
            const int c = s * 64 + g * 8;
            float a0[8], a1[8];
#pragma unroll
            for (int j = 0; j < 8; ++j) { a0[j] = 0.f; a1[j] = 0.f; }
#pragma unroll 1
            for (int k = 0; k < K; k += 8) {
                float af[8]; load8(arow + k, af);
#pragma unroll
                for (int j = 0; j < 8; ++j) {
                    float b0[8], b1[8]; load8(u.B + (size_t)(c + j) * K + k, b0); load8(u.B + (size_t)(128 + c + j) * K + k, b1);
#pragma unroll
                    for (int e = 0; e < 8; ++e) { a0[j] = fmaf(af[e], b0[e], a0[j]); a1[j] = fmaf(af[e], b1[e], a1[j]); }
                }
            }
            ss += E.apply(u, r, c, a0, a1, E.row_scale(u, r), E.load(u, r, c));
        }
        if constexpr (Epi::HAS_SSQ) { E.put_ssq(u, r, s, ss); E.put_ssq(u, r, 2 + s, 0.f); }
    }
}

__device__ __forceinline__ int launder_v(int x) { asm volatile("" : "+v"(x)); return x; }
template <class Tp> __device__ __forceinline__ Tp* launder_s(Tp* p) { GAS Tp* g = (GAS Tp*)p; asm volatile("" : "+s"(g)); return (Tp*)g; }
__device__ __forceinline__ int launder_i(int x) { asm volatile("" : "+s"(x)); return x; }
__device__ __forceinline__ bool in_phase(int lo, int hi, int k) { asm volatile("" : "+s"(lo), "+s"(hi)); return lo <= k && k < hi; }
namespace pg8 {
constexpr int BK = 64, HALF = 128, HTB = HALF * BK * 2, STAGE_BYTES = 8 * HTB;
__device__ __forceinline__ int lds_byte(int r, int c) { const int st = (r >> 4) * 2 + (c >> 5), rr = r & 15, cc = c & 31, ob = rr * 64 + cc * 2; return st * 1024 + (ob ^ (((ob >> 9) & 1) << 5)); }
__device__ __forceinline__ void stage_rc(int b, int& R, int& C) { const int st = b / 1024, sb = b % 1024, swz = sb ^ (((sb >> 9) & 1) << 5); R = (st >> 1) * 16 + swz / 64; C = (st & 1) * 32 + (swz % 64) / 2; }
__device__ __forceinline__ int perm32(int rho) { const int n = rho >> 4, i = rho & 15; return 8 * (i >> 2) + 4 * n + (i & 3); }

template <bool GATHER, bool HALFN = false, class Sched, class Epi>
__device__ __forceinline__ void gemm_phase(LAS unsigned char* lds, const Sched& S, const Epi& E, const int K, const int lda, const int tid_, const int ldb_ = 0, const bool tiled = false) {
    const int ldb = ldb_ ? ldb_ : K;
    const int tid = launder_v(tid_), wid = __builtin_amdgcn_readfirstlane(tid >> 6), lane = tid & 63, wr = wid >> 2, wc = wid & 3, fr = lane & 15, fq = lane >> 4;
    const int nt = K / BK;
    int RA[2], CA[2]; unsigned voffB[2];
#pragma unroll
    for (int i = 0; i < 2; ++i) { int R, C; stage_rc(tid * 16 + i * 8192, R, C); RA[i] = R; CA[i] = C; const int Rb = (R & ~31) + perm32(R & 31); voffB[i] = (unsigned)(Rb * ldb + C) * 2u; }
    const size_t kstep = tiled ? (size_t)(256 * BK * 2) : (size_t)(BK * 2);
    const size_t hstepB = (size_t)HALF * ldb * 2;
    const unsigned ldsw = (unsigned)wid * 1024u;
    const int aoff = lds_byte(wr * 64 + fr, fq * 8), boff = lds_byte(wc * 32 + fr, fq * 8);
#define PG8_SA(b, h) (((b) * 2 + (h)) * HTB)
#define PG8_SB(b, h) ((4 + (b) * 2 + (h)) * HTB)
#define PG8_STAGE2(bufoff, gbase, v0_, v1_) do { \
        __builtin_amdgcn_global_load_lds((const unsigned*)((const char*)(gbase) + (v0_)), (LAS unsigned*)(lds + (bufoff) + ldsw), 16, 0, 0); \
        __builtin_amdgcn_global_load_lds((const unsigned*)((const char*)(gbase) + (v1_)), (LAS unsigned*)(lds + (bufoff) + ldsw + 8192), 16, 0, 0); } while (0)
#define PG8_STAGEB(bufoff, gbase) PG8_STAGE2(bufoff, gbase, voffB[0], voffB[1])
#define PG8_LDA(dst, b, h) do { _Pragma("unroll") for (int m = 0; m < 4; ++m) _Pragma("unroll") for (int k = 0; k < 2; ++k) dst[m][k] = *(const LAS bf16x8*)(lds + PG8_SA(b, h) + aoff + m * 2048 + k * 1024); } while (0)
#define PG8_LDB(dst, b, h) do { _Pragma("unroll") for (int n = 0; n < 2; ++n) _Pragma("unroll") for (int k = 0; k < 2; ++k) dst[n][k] = *(const LAS bf16x8*)(lds + PG8_SB(b, h) + boff + n * 2048 + k * 1024); } while (0)
#define PG8_MMA(ai, bj, At, Bt) do { __builtin_amdgcn_s_setprio(1); _Pragma("unroll") for (int m = 0; m < 4; ++m) _Pragma("unroll") for (int n = 0; n < 2; ++n) _Pragma("unroll") for (int k = 0; k < 2; ++k) \
        acc[ai][bj][m][n] = __builtin_amdgcn_mfma_f32_16x16x32_bf16(Bt[n][k], At[m][k], acc[ai][bj][m][n], 0, 0, 0); __builtin_amdgcn_s_setprio(0); } while (0)
#define PG8_WAIT_V(n) asm volatile("s_waitcnt vmcnt(" #n ")" ::: "memory")
#define PG8_WAIT_L(n) asm volatile("s_waitcnt lgkmcnt(" #n ")" ::: "memory")
#define PG8_BAR __builtin_amdgcn_s_barrier()
#define PG8_SCHED __builtin_amdgcn_sched_barrier(0)
#define PG8_VOFFA(dst, u_) do { _Pragma("unroll") for (int h_ = 0; h_ < 2; ++h_) _Pragma("unroll") for (int i_ = 0; i_ < 2; ++i_) { \
        const unsigned row_ = GATHER ? (unsigned)(u_).rows[h_ * HALF + RA[i_]] : (unsigned)RA[i_]; dst[h_][i_] = (row_ * (unsigned)lda + (unsigned)CA[i_]) * 2u; } } while (0)
    GUnit cur, nxt; int ui = 0;
    if (!S.next(0, cur)) return;
    f32x4 acc[2][2][4][2];
#pragma unroll
    for (int a = 0; a < 2; ++a)
#pragma unroll
        for (int b = 0; b < 2; ++b)
#pragma unroll
            for (int m = 0; m < 4; ++m)
#pragma unroll
                for (int n = 0; n < 2; ++n) acc[a][b][m][n] = (f32x4){0.f, 0.f, 0.f, 0.f};
    bf16x8 At[4][2], B0[2][2], B1[2][2];
    f32x4 car[2][4][2];
    unsigned vc[2][2], vn[2][2];
    const size_t hstepA = GATHER ? (size_t)0 : (size_t)HALF * lda * 2;
    PG8_VOFFA(vc, cur);
    const char* cA = (const char*)cur.A; const char* cB = (const char*)cur.B;
    if constexpr (Epi::HAS_SCALE) { if (tid < 256) ((LAS float*)(lds + LDS_RING))[tid] = E.row_scale(cur, tid); }
    if constexpr (HALFN) {
        PG8_STAGEB(PG8_SB(0, 0), cB); PG8_STAGE2(PG8_SA(0, 0), cA, vc[0][0], vc[0][1]); PG8_STAGE2(PG8_SA(0, 1), cA + hstepA, vc[1][0], vc[1][1]);
        if (wr == 1) PG8_BAR;
        PG8_WAIT_V(2); PG8_BAR;
        PG8_STAGEB(PG8_SB(1, 0), cB + kstep); PG8_STAGE2(PG8_SA(1, 0), cA + kstep, vc[0][0], vc[0][1]);
        PG8_WAIT_V(4); PG8_BAR;
    } else {
    PG8_STAGEB(PG8_SB(0, 0), cB); PG8_STAGEB(PG8_SB(0, 1), cB + hstepB); PG8_STAGE2(PG8_SA(0, 0), cA, vc[0][0], vc[0][1]); PG8_STAGE2(PG8_SA(0, 1), cA + hstepA, vc[1][0], vc[1][1]);
    if (wr == 1) PG8_BAR;
    PG8_WAIT_V(2); PG8_BAR;
    PG8_STAGEB(PG8_SB(1, 0), cB + kstep); PG8_STAGE2(PG8_SA(1, 0), cA + kstep, vc[0][0], vc[0][1]); PG8_STAGEB(PG8_SB(1, 1), cB + hstepB + kstep);
    PG8_WAIT_V(6); PG8_BAR;
    }
    for (;;) {
        const bool has_next = S.next(ui + 1, nxt);
        const char* nA = has_next ? (const char*)nxt.A : cA; const char* nB = has_next ? (const char*)nxt.B : cB;
        if constexpr (Epi::HAS_SCALE) { if (has_next && tid < 256) ((LAS float*)(lds + LDS_RING))[((ui + 1) % 3) * 256 + tid] = E.row_scale(nxt, tid); }
        if (has_next) { PG8_VOFFA(vn, nxt); } else {
#pragma unroll
            for (int h_ = 0; h_ < 2; ++h_)
#pragma unroll
                for (int i_ = 0; i_ < 2; ++i_) vn[h_][i_] = vc[h_][i_]; }
        for (int t = 0; t < nt; t += 2) {
            const bool last = (t == nt - 2);
            const char* a1 = cA + (size_t)(t + 1) * kstep;
            const char* a2 = last ? nA : cA + (size_t)(t + 2) * kstep; const char* b2 = last ? nB : cB + (size_t)(t + 2) * kstep;
            const char* a3 = a2 + kstep; const char* b3 = b2 + kstep;
            const unsigned w00 = last ? vn[0][0] : vc[0][0], w01 = last ? vn[0][1] : vc[0][1], w10 = last ? vn[1][0] : vc[1][0], w11 = last ? vn[1][1] : vc[1][1];
            if constexpr (HALFN) {
            PG8_LDB(B0, 0, 0); PG8_SCHED; PG8_LDA(At, 0, 0); PG8_STAGE2(PG8_SA(1, 1), a1 + hstepA, vc[1][0], vc[1][1]);
            PG8_WAIT_V(6); PG8_WAIT_L(0); PG8_BAR; PG8_MMA(0, 0, At, B0); PG8_BAR; PG8_SCHED;
            PG8_LDA(At, 0, 1); PG8_STAGEB(PG8_SB(0, 0), b2); PG8_STAGE2(PG8_SA(0, 0), a2, w00, w01);
            PG8_WAIT_V(6); PG8_WAIT_L(0); PG8_BAR; PG8_MMA(1, 0, At, B0); PG8_BAR; PG8_SCHED;
            PG8_LDB(B0, 1, 0); PG8_SCHED; PG8_LDA(At, 1, 0); PG8_STAGE2(PG8_SA(0, 1), a2 + hstepA, w10, w11);
            PG8_WAIT_V(6); PG8_WAIT_L(0); PG8_BAR; PG8_MMA(0, 0, At, B0); PG8_BAR; PG8_SCHED;
            PG8_LDA(At, 1, 1); PG8_STAGEB(PG8_SB(1, 0), b3); PG8_STAGE2(PG8_SA(1, 0), a3, w00, w01);
            PG8_WAIT_V(6); PG8_WAIT_L(0); PG8_BAR; PG8_MMA(1, 0, At, B0); PG8_BAR; PG8_SCHED;
            } else {
            PG8_LDB(B0, 0, 0); PG8_LDB(B1, 0, 1); PG8_SCHED; PG8_LDA(At, 0, 0); PG8_STAGE2(PG8_SA(1, 1), a1 + hstepA, vc[1][0], vc[1][1]);
            PG8_WAIT_V(8); PG8_WAIT_L(0); PG8_BAR; PG8_MMA(0, 0, At, B0); PG8_MMA(0, 1, At, B1); PG8_BAR; PG8_SCHED;
            PG8_LDA(At, 0, 1); PG8_STAGEB(PG8_SB(0, 0), b2); PG8_STAGEB(PG8_SB(0, 1), b2 + hstepB); PG8_STAGE2(PG8_SA(0, 0), a2, w00, w01);
            PG8_WAIT_V(8); PG8_WAIT_L(0); PG8_BAR; PG8_MMA(1, 0, At, B0); PG8_MMA(1, 1, At, B1); PG8_BAR; PG8_SCHED;
            PG8_LDB(B0, 1, 0); PG8_LDB(B1, 1, 1); PG8_SCHED; PG8_LDA(At, 1, 0); PG8_STAGE2(PG8_SA(0, 1), a2 + hstepA, w10, w11);
            PG8_WAIT_V(8); PG8_WAIT_L(0); PG8_BAR; PG8_MMA(0, 0, At, B0); PG8_MMA(0, 1, At, B1); PG8_BAR; PG8_SCHED;
            PG8_LDA(At, 1, 1); PG8_STAGEB(PG8_SB(1, 0), b3); PG8_STAGEB(PG8_SB(1, 1), b3 + hstepB); PG8_STAGE2(PG8_SA(1, 0), a3, w00, w01);
            PG8_WAIT_V(8); PG8_WAIT_L(0); PG8_BAR; PG8_MMA(1, 0, At, B0); PG8_MMA(1, 1, At, B1); PG8_BAR; PG8_SCHED;
            }
        }
        if (wr == 0) PG8_BAR;
        {
            const int fr2 = launder_v(fr), fq2 = launder_v(fq);
            const int c = wc * 32 + fq2 * 8, rb = wr * 64 + fr2;
            const LAS float* sct = (const LAS float*)(lds + LDS_RING) + (ui % 3) * 256;
            float sc[8];
            if constexpr (Epi::HAS_SCALE) {
#pragma unroll
                for (int i = 0; i < 8; ++i) sc[i] = sct[(i >> 2) * HALF + (i & 3) * 16 + rb];
            }
            typename Epi::Pre pre = E.load(cur, rb, c);
#pragma unroll
            for (int i = 0; i < 8; ++i) {
                const int ai = i >> 2, m = i & 3, r = ai * HALF + m * 16 + rb;
                typename Epi::Pre nx = pre;
                if (i < 7) nx = E.load(cur, ((i + 1) >> 2) * HALF + ((i + 1) & 3) * 16 + rb, c);
                asm volatile("" ::: "memory");
                const f32x4 p0 = acc[ai][0][m][0], p1 = acc[ai][0][m][1], q0 = acc[ai][1][m][0], q1 = acc[ai][1][m][1];
                const float v0[8] = {p0[0], p0[1], p0[2], p0[3], p1[0], p1[1], p1[2], p1[3]}, v1[8] = {q0[0], q0[1], q0[2], q0[3], q1[0], q1[1], q1[2], q1[3]};
                float ss;
                if constexpr (Epi::CARRY) ss = E.apply_carry(cur, r, c, v0, car[ai][m][0], car[ai][m][1], pre);
                else if constexpr (epi_is_ratio<Epi>::value) {
                    if (cur.aux < 2) { E.scale(cur, r, c, acc[ai][0][m][0], acc[ai][0][m][1], acc[ai][1][m][0], acc[ai][1][m][1], pre); ss = 0.f; }
                    else ss = E.apply(cur, r, c, v0, v1, 0.f, pre);
                }
                else ss = E.apply(cur, r, c, v0, v1, Epi::HAS_SCALE ? sc[i] : 0.f, pre);
                if constexpr (Epi::HAS_SSQ) { ss += shx<16>(ss); ss = sum_halves(ss); if (fq2 == 0) E.put_ssq(cur, r, wc, ss); }
                asm volatile("" ::: "memory");
                pre = nx;
            }
        }
        if (!has_next) break;
        if (!epi_is_ratio<Epi>::value || cur.aux >= 2) {
#pragma unroll
        for (int a = 0; a < 2; ++a)
#pragma unroll
            for (int b = 0; b < 2; ++b)
#pragma unroll
                for (int m = 0; m < 4; ++m)
#pragma unroll
                    for (int n = 0; n < 2; ++n) acc[a][b][m][n] = (f32x4){0.f, 0.f, 0.f, 0.f};
        }
        cur = nxt; cA = nA; cB = nB; ++ui;
#pragma unroll
        for (int h_ = 0; h_ < 2; ++h_)
#pragma unroll
            for (int i_ = 0; i_ < 2; ++i_) vc[h_][i_] = vn[h_][i_];
        if (wr == 1) PG8_BAR;
    }
    PG8_WAIT_V(0);
    PG8_BAR;
#undef PG8_SA
#undef PG8_SB
#undef PG8_STAGE2
#undef PG8_STAGEB
#undef PG8_LDA
#undef PG8_LDB
#undef PG8_MMA
#undef PG8_WAIT_V
#undef PG8_WAIT_L
#undef PG8_BAR
#undef PG8_SCHED
#undef PG8_VOFFA
}
}

__device__ __forceinline__ int inproj_perm(int m) { if (m >= INPROJ_PERM_TILES * 256) return m; const int t = m & 255; return (m & ~255) + ((t >> 5) & 1) * 128 + (t >> 6) * 32 + (t & 31); }
__device__ __forceinline__ int rowmap(int code, int n) {
    switch (code) {
        case 1: { const int m = n < 640 ? n : (n < 768 ? n + 5760 : (n < 1280 ? n : (n < 1312 ? n - 640 : (n < 3360 ? n - 32 : (n < 3392 ? n - 2688 : n - 64)))));
            return inproj_perm(m); }
        case 2: { const int h = n >> 7, j = n & 127; return j < 64 ? h * 64 + j : 512 + h * 64 + (j - 64); }
        case 3: return (n >> 7) * 256 + (n & 127);
        case 4: return (n >> 7) * 256 + 128 + (n & 127);
        default: return n;
    }
}
struct TJob { const float* W; bf16_t* WT; const float* g; int K, N, code; bool tiled; };
__device__ __forceinline__ void transpose_item(const TJob& jb, LAS float* scr, int item, int lane) {
    const int K = jb.K, N = jb.N, nblk = N / 64, kb = item / nblk, nb = item % nblk, k0 = 64 * kb, n0 = 64 * nb;
    const float* src = jb.W + (size_t)k0 * N + n0 + lane;
    float v[64];
#pragma unroll
    for (int i = 0; i < 64; ++i) v[i] = __builtin_nontemporal_load(src + (size_t)i * N);
    if (jb.g) {
#pragma unroll
        for (int i = 0; i < 64; ++i) v[i] *= jb.g[k0 + i];
    }
    LAS unsigned char* sb = (LAS unsigned char*)scr;
#pragma unroll
    for (int c = 0; c < 8; ++c) { u32x4 o; o.x = pk2(v[8 * c], v[8 * c + 1]); o.y = pk2(v[8 * c + 2], v[8 * c + 3]); o.z = pk2(v[8 * c + 4], v[8 * c + 5]); o.w = pk2(v[8 * c + 6], v[8 * c + 7]);
        *(LAS u32x4*)(sb + lane * 144 + c * 16) = o; }
    asm volatile("s_waitcnt lgkmcnt(0)" ::: "memory");
#pragma unroll
    for (int j = 0; j < 8; ++j) { const int n = (lane >> 3) + 8 * j, c = lane & 7; const u32x4 o = *(const LAS u32x4*)(sb + n * 144 + c * 16);
        const int rr = rowmap(jb.code, n0 + n);
        bf16_t* d = jb.tiled ? jb.WT + ((size_t)((rr >> 8) * (K >> 6) + kb) * 256 + (rr & 255)) * 64 + 8 * c : jb.WT + (size_t)rr * K + k0 + 8 * c;
        *(u32x4*)d = o; }
    asm volatile("s_waitcnt lgkmcnt(0)" ::: "memory");
}
__device__ __forceinline__ bool common_job(const Ctx& a, int j, TJob& jb) {
    unsigned char* ws = a.ws;
    if (j < 14) { const int l = j / 7, k = j % 7;
        switch (k) {
            case 0: jb = TJob{a.in[I_WIN] + (size_t)l * 1024 * 6464, (bf16_t*)(ws + O_WIN + l * SZ_WIN1), a.in[I_GMIX] + l * 1024, 1024, 6464, 1, false}; break;
            case 1: jb = TJob{a.in[I_WBQUP] + (size_t)l * 256 * 768, (bf16_t*)(ws + O_WQUP + l * SZ_WQUP1), a.in[I_GBQ] + l * 256, 256, 768, 0, false}; break;
            case 2: jb = TJob{a.in[I_WBKVUP] + (size_t)l * 256 * 1024, (bf16_t*)(ws + O_WKVUP + l * SZ_WKVUP1), a.in[I_GBKV] + l * 256, 256, 1024, 2, false}; break;
            case 3: jb = TJob{a.in[I_WPA] + (size_t)l * 512 * 1024, (bf16_t*)(ws + O_WP + (l * 3 + 0) * SZ_WP1), nullptr, 512, 1024, 0, false}; break;
            case 4: jb = TJob{a.in[I_WPB] + (size_t)l * 512 * 1024, (bf16_t*)(ws + O_WP + (l * 3 + 1) * SZ_WP1), nullptr, 512, 1024, 0, false}; break;
            case 5: jb = TJob{a.in[I_WPC] + (size_t)l * 512 * 1024, (bf16_t*)(ws + O_WP + (l * 3 + 2) * SZ_WP1), nullptr, 512, 1024, 0, false}; break;
            default: jb = TJob{a.in[I_WOUT] + (size_t)l * 1024 * 1024, (bf16_t*)(ws + O_WOUT + l * SZ_WOUT1), nullptr, 1024, 1024, 0, false}; break;
        }
        return true; }
    if (j == 14) { jb = TJob{a.in[I_WFFG], (bf16_t*)(ws + O_WFFGU), a.in[I_GFFN], 1024, DFF, 3, false}; return true; }
    if (j == 15) { jb = TJob{a.in[I_WFFU], (bf16_t*)(ws + O_WFFGU), a.in[I_GFFN], 1024, DFF, 4, false}; return true; }
    if (j == 16) { jb = TJob{a.in[I_WFFD], (bf16_t*)(ws + O_WFFD), nullptr, DFF, 1024, 0, true}; return true; }
    return false;
}
__device__ __forceinline__ bool expert_job(const Ctx& a, int j, TJob& jb) {
    if (j >= 24) return false;
    unsigned char* ws = a.ws; const int e = j / 3, k = j % 3;
    if (k == 0) jb = TJob{a.in[I_WEG] + (size_t)e * 1024 * DFE, (bf16_t*)(ws + O_WEGU) + (size_t)e * 2 * DFE * 1024, a.in[I_GFFN] + 1024, 1024, DFE, 3, false};
    else if (k == 1) jb = TJob{a.in[I_WEU] + (size_t)e * 1024 * DFE, (bf16_t*)(ws + O_WEGU) + (size_t)e * 2 * DFE * 1024, a.in[I_GFFN] + 1024, 1024, DFE, 4, false};
    else jb = TJob{a.in[I_WED] + (size_t)e * DFE * 1024, (bf16_t*)(ws + O_WED) + (size_t)e * 1024 * DFE, nullptr, DFE, 1024, 0, true};
    return true;
}
__device__ __forceinline__ void common_find(int set, int it, int& j, int& r) {
    if (set == 0) { if (it < 1616) { j = 0; r = it; } else if (it < 1664) { j = 1; r = it - 1616; } else { j = 2; r = it - 1664; } return; }
    if (it < 640) { if (it < 384) { j = 3 + (it >> 7); r = it & 127; } else { j = 6; r = it - 384; } }
    else if (it < 3008) { r = it - 640;
        if (r < 1616) j = 7; else if ((r -= 1616) < 48) j = 8; else if ((r -= 48) < 64) j = 9; else if ((r -= 64) < 384) { j = 10 + (r >> 7); r &= 127; } else { r -= 384; j = 13; } }
    else { r = it - 3008; j = 14 + r / 704; r = r % 704; }
}
constexpr int CONV0_ITEMS = 5120, CONV_PER_UNIT = 32;
constexpr int NEXP_EARLY = 5;
constexpr int CONV1_ITEMS = NEXP_EARLY * 2 * 896;
static_assert((size_t)NEXP_EARLY * 2 * DFE * 1024 * 2 <= (size_t)M * PW * 2, "early expert copies must stay inside P");
template <bool EXPERTS>
__device__ __forceinline__ void run_transposes(const Ctx& a, LAS unsigned char* lds, int gw, int NGW, int wave, int lane) {
    LAS float* scr = (LAS float*)(lds + wave * 16384);
    TJob jb;
    if (EXPERTS) {
        constexpr int PER = (1024 / 64) * (DFE / 64), NGU = (NEXP - NEXP_EARLY) * 2 * PER;
        for (int it = gw; it < NGU + NEXP * PER; it += NGW) {
            const int j = it < NGU ? NEXP_EARLY * 3 + (it / (2 * PER)) * 3 + (it / PER) % 2 : ((it - NGU) / PER) * 3 + 2;
            expert_job(a, j, jb); transpose_item(jb, scr, it % PER, lane); }
    } else {
        for (int it = gw; it < 1728; it += NGW) { int j, r; common_find(0, it, j, r); common_job(a, j, jb); transpose_item(jb, scr, r, lane); }
    }
}
__device__ __forceinline__ void conv_unit0(const Ctx& a, LAS unsigned char* lds, int layer, int cu, int wave, int lane) {
    LAS float* scr = (LAS float*)(lds + wave * 16384);
    TJob jb;
    for (int i = 0; i < CONV_PER_UNIT / NWAVES; ++i) { const int it = cu * CONV_PER_UNIT + i * NWAVES + wave;
        if (layer == 0) { if (it < CONV0_ITEMS) { int j, r; common_find(1, it, j, r); common_job(a, j, jb); transpose_item(jb, scr, r, lane); } }
        else if (it < CONV1_ITEMS) { expert_job(a, (it / 1792) * 3 + (it / 896) % 2, jb); transpose_item(jb, scr, it % 896, lane); } }
}
__device__ __forceinline__ void phase_prologue(const Ctx& a, LAS unsigned char* lds, int vcu, int G, int tid) {
    const int wave = __builtin_amdgcn_readfirstlane(tid >> 6), lane = tid & 63, gw = vcu * NWAVES + wave, NGW = G * NWAVES;
    unsigned char* ws = a.ws;
    run_transposes<false>(a, lds, gw, NGW, wave, lane);
    for (int l = 0; l < 2; ++l) { u32x4* p = (u32x4*)(ws + O_WIN + l * SZ_WIN1 + (size_t)6528 * 1024 * 2); const int n16 = 128 * 1024 * 2 / 16;
        for (int i = gw * 64 + lane; i < n16; i += NGW * 64) p[i] = (u32x4){0u, 0u, 0u, 0u};
        const int m16 = 64 * 1024 * 2 / 16;
        for (int i = gw * 64 + lane; i < m16; i += NGW * 64) { const int rrow = inproj_perm(704 + (i >> 7)); ((u32x4*)(ws + O_WIN + l * SZ_WIN1 + (size_t)rrow * 1024 * 2))[i & 127] = (u32x4){0u, 0u, 0u, 0u}; } }
    float* ta = (float*)(ws + O_TABA); float* tb = (float*)(ws + O_TABB);
    for (int i = gw * 64 + lane; i < T * 32; i += NGW * 64) { const int t = i >> 5, k = i & 31, blk = k >> 4, fi = k & 15;
        const float inv = exp2f(-(float)fi * (13.287712379549449f / 16.0f)); const float pos = (float)(blk ? (t & 63) : (t >> 6)); const float ang = pos * inv;
        ta[t * 64 + k] = cosf(ang); ta[t * 64 + 32 + k] = sinf(ang); }
    for (int i = gw * 64 + lane; i < T * 16; i += NGW * 64) { const int t = i >> 4, k = i & 15, blk = k >> 3, fi = k & 7;
        const float inv = exp2f(-(float)fi * (13.287712379549449f / 8.0f)); const float pos = (float)(blk ? (t & 63) : (t >> 6)); const float ang = pos * inv;
        tb[t * 32 + k] = cosf(ang); tb[t * 32 + 16 + k] = sinf(ang); }
    const float* x = a.in[I_X]; bf16_t* XB = (bf16_t*)(ws + O_XB); float* ssq = (float*)(ws + O_SSQ);
    for (int m0 = gw; m0 < M; m0 += 4 * NGW) {
        f32x4 v[4][4];
#pragma unroll
        for (int q = 0; q < 4; ++q) { const int m = m0 + q * NGW; const f32x4* xr = (const f32x4*)(x + (size_t)(m < M ? m : gw) * D) + lane;
#pragma unroll
            for (int j = 0; j < 4; ++j) v[q][j] = __builtin_nontemporal_load(xr + 64 * j); }
#pragma unroll
        for (int q = 0; q < 4; ++q) { const int m = m0 + q * NGW; float s = 0.f;
#pragma unroll
            for (int j = 0; j < 4; ++j) s += (v[q][j].x * v[q][j].x + v[q][j].y * v[q][j].y) + (v[q][j].z * v[q][j].z + v[q][j].w * v[q][j].w);
            s = wave_sum(s);
            if (m < M) {
#pragma unroll
                for (int j = 0; j < 4; ++j) *(u32x2*)(XB + (size_t)m * D + (lane + 64 * j) * 4) = (u32x2){pk2(v[q][j].x, v[q][j].y), pk2(v[q][j].z, v[q][j].w)};
                if (lane < 16) ssq[(size_t)m * 16 + lane] = lane == 0 ? s : 0.f; } }
    }
}

template <bool WRITE_LA>
__device__ __forceinline__ void post_item(const Ctx& a, int layer, int it, LAS unsigned char* lds, int tid) {
    unsigned char* ws = a.ws; const int wave = __builtin_amdgcn_readfirstlane(tid >> 6), lane = tid & 63;
    const bf16_t* P = (const bf16_t*)(ws + O_P); const float* ta = (const float*)(ws + O_TABA); const float* tb = (const float*)(ws + O_TABB);
    bf16_t* QA = (bf16_t*)(ws + O_QA); bf16_t* KA = (bf16_t*)(ws + O_KA); bf16_t* KR = (bf16_t*)(ws + O_KROPE);
    const int r0 = it * 64;
    LAS float* caf = (LAS float*)lds;
    LAS bf16_t* qk = (LAS bf16_t*)(lds + 8192);
    __syncthreads();
    for (int i = tid; i < 64 * 32; i += NTHR) { const int r = i >> 5, j = i & 31; caf[i] = bf2f(P[(size_t)(r0 + r) * PW + PC_SMALL + 32 + j]); }
#pragma unroll
    for (int i = 0; i < 16; ++i) { const int idx = wave * 16 + i, r = idx >> 1, hf = idx & 1;
        __builtin_amdgcn_global_load_lds((const unsigned*)(P + (size_t)(r0 + r) * PW + PC_CQ + hf * 512 + lane * 8), (LAS unsigned*)(lds + 8192 + r * 2048 + hf * 1024), 16, 0, 0); }
    {
        const int seg = lane & 7; float gq[8], gk[8]; ld8f(a.in[I_GAQ] + layer * 64 + seg * 8, gq); ld8f(a.in[I_GAK] + layer * 64 + seg * 8, gk);
#pragma unroll
        for (int jb = 0; jb < 8; jb += 4) {
            u32x4 rq[4]; float cs[4][8], sn[4][8];
#pragma unroll
            for (int q = 0; q < 4; ++q) { const int row = r0 + wave * 8 + jb + q, t = row & (T - 1); const int tb_ = t * 64 + (seg >> 2) * 16 + (seg & 1) * 8;
                rq[q] = *(const u32x4*)(P + (size_t)row * PW + PC_AQ + lane * 8); ld8f(ta + tb_, cs[q]); ld8f(ta + tb_ + 32, sn[q]); }
#pragma unroll
            for (int q = 0; q < 4; ++q) { const int row = r0 + wave * 8 + jb + q; float x[8], o[8]; unpack8(rq[q], x);
                float ss = 0.f;
#pragma unroll
                for (int e = 0; e < 8; ++e) ss += x[e] * x[e];
                ss += shx<1>(ss); ss += shx<2>(ss); ss += shx<4>(ss);
                const float rstd = rsqrtf(ss * (1.0f / 64.0f) + EPS);
#pragma unroll
                for (int e = 0; e < 8; ++e) { const float xn = x[e] * rstd * gq[e]; const float pr = shx<2>(xn);
                    o[e] = ((seg & 2) ? xn * cs[q][e] + pr * sn[q][e] : xn * cs[q][e] - pr * sn[q][e]) * C2A; }
                store8(QA + (size_t)row * 512 + lane * 8, o); }
        }
        {
            u32x4 rk[2]; float cs[2][8], sn[2][8]; const int l2 = lane & 15;
#pragma unroll
            for (int q = 0; q < 2; ++q) { const int row = r0 + wave * 8 + q * 4 + (lane >> 4), t = row & (T - 1); const int tb_ = t * 64 + (seg >> 2) * 16 + (seg & 1) * 8;
                rk[q] = *(const u32x4*)(P + (size_t)row * PW + PC_AK + l2 * 8); ld8f(ta + tb_, cs[q]); ld8f(ta + tb_ + 32, sn[q]); }
#pragma unroll
            for (int q = 0; q < 2; ++q) { const int row = r0 + wave * 8 + q * 4 + (lane >> 4); float x[8], o[8]; unpack8(rk[q], x);
                float ss = 0.f;
#pragma unroll
                for (int e = 0; e < 8; ++e) ss += x[e] * x[e];
                ss += shx<1>(ss); ss += shx<2>(ss); ss += shx<4>(ss);
                const float rstd = rsqrtf(ss * (1.0f / 64.0f) + EPS);
#pragma unroll
                for (int e = 0; e < 8; ++e) { const float xn = x[e] * rstd * gk[e]; const float pr = shx<2>(xn);
                    o[e] = (seg & 2) ? xn * cs[q][e] + pr * sn[q][e] : xn * cs[q][e] - pr * sn[q][e]; }
                store8(KA + (size_t)row * 128 + l2 * 8, o); }
        }
        {
            const int sg = lane & 3, row = r0 + wave * 8 + ((lane >> 2) & 7), t = row & (T - 1); float x[8], o[8], cs[8], sn[8];
            load8(P + (size_t)row * PW + PC_SMALL + sg * 8, x); const int tb_ = t * 32 + (sg >> 1) * 8; ld8f(tb + tb_, cs); ld8f(tb + tb_ + 16, sn);
#pragma unroll
            for (int e = 0; e < 8; ++e) { const float pr = shx<1>(x[e]); o[e] = (sg & 1) ? x[e] * cs[e] + pr * sn[e] : x[e] * cs[e] - pr * sn[e]; }
            if (lane < 32) store8(KR + (size_t)row * 32 + sg * 8, o);
        }
    }
    __syncthreads();
    const int col = tid;
    for (int dir = 0; dir < 2; ++dir) {
        const float* Wup = a.in[dir ? I_WCAB : I_WCAF] + (size_t)layer * 16 * 512; const float bias = a.in[dir ? I_BCAB : I_BCAF][layer * 512 + col];
        float w[16];
#pragma unroll
        for (int j = 0; j < 16; ++j) w[j] = Wup[j * 512 + col];
        bf16_t* QT = (bf16_t*)(ws + O_QT) + (size_t)(dir * 2) * M * 512; bf16_t* KT = QT + (size_t)M * 512;
        float* LA = (float*)(ws + O_QT) + (size_t)dir * M * 512;
        float b = 0.f;
        for (int s0 = 0; s0 < 64; s0 += 8) {
            float z[8], la[8];
#pragma unroll
            for (int u = 0; u < 8; ++u) { const int r = dir ? 63 - (s0 + u) : s0 + u; const LAS float* cr = caf + r * 32 + dir * 16; f32x2_t zz = {bias, 0.f};
#pragma unroll
                for (int j = 0; j < 16; j += 2) zz = __builtin_elementwise_fma((f32x2_t){cr[j], cr[j + 1]}, (f32x2_t){w[j], w[j + 1]}, zz);
                z[u] = zz.x + zz.y; }
#pragma unroll
            for (int u = 0; u < 8; ++u) la[u] = (fminf(z[u], 0.f) - 0.6931471805599453f * __builtin_amdgcn_logf(1.0f + __builtin_amdgcn_exp2f(-LOG2E * fabsf(z[u])))) * (1.0f / 16.0f);
#pragma unroll
            for (int u = 0; u < 8; ++u) { b += la[u]; z[u] = b; }
#pragma unroll
            for (int u = 0; u < 8; ++u) { const int r = dir ? 63 - (s0 + u) : s0 + u; const size_t row = (size_t)(r0 + r);
                if (WRITE_LA) LA[row * 512 + col] = la[u];
                else { const float e = __builtin_amdgcn_exp2f(LOG2E * z[u]), ei = __builtin_amdgcn_exp2f(-LOG2E * z[u]); const float q = bf2f(qk[r * 1024 + col]), k = bf2f(qk[r * 1024 + 512 + col]);
                    QT[row * 512 + col] = (bf16_t)f2bf(q * e * GLA_QSCALE); KT[row * 512 + col] = (bf16_t)f2bf(k * ei); } }
        }
        if (!WRITE_LA) ((float*)(ws + O_DEC))[(size_t)dir * 256 * 512 + (size_t)it * 512 + col] = __expf(b);
    }
}

template <int BR>
__device__ __forceinline__ void attn_naive_unit(const Ctx& a, int b, int h, int qb, LAS unsigned char* lds, int tid) {
    unsigned char* ws = a.ws; constexpr int DQ = BR ? 96 : 64;
    const bf16_t* P = (const bf16_t*)(ws + O_P);
    LAS float* Ks = (LAS float*)lds;
    LAS float* Vs = Ks + 64 * 96;
    LAS float* Qs = Vs + 64 * 64;
    const int r = tid >> 1, half = tid & 1; const size_t row0 = (size_t)b * T + qb * 256; const size_t row = row0 + r;
    __syncthreads();
    for (int i = tid; i < 256 * (DQ / 8); i += NTHR) { const int rr = i / (DQ / 8), ch = i % (DQ / 8); float f[8];
        if (BR == 0) load8((const bf16_t*)(ws + O_QA) + (row0 + rr) * 512 + h * 64 + ch * 8, f); else load8((const bf16_t*)(ws + O_QB) + (row0 + rr) * 768 + h * 96 + ch * 8, f);
#pragma unroll
        for (int e = 0; e < 8; ++e) Qs[rr * 97 + ch * 8 + e] = f[e]; }
    __syncthreads();
    if (BR == 1 && tid < 256) {
        const int t = (int)((row0 + tid) & (T - 1)); const float* tb = (const float*)(ws + O_TABB) + t * 32; LAS float* q = Qs + tid * 97 + 64;
        for (int blk = 0; blk < 2; ++blk)
            for (int e = 0; e < 8; ++e) { const float cs = tb[blk * 8 + e], sn = tb[16 + blk * 8 + e]; const float x1 = q[blk * 16 + e], x2 = q[blk * 16 + 8 + e];
                q[blk * 16 + e] = x1 * cs - x2 * sn; q[blk * 16 + 8 + e] = x2 * cs + x1 * sn; } }
    float m = -1e30f, l = 0.f, o[32];
#pragma unroll
    for (int j = 0; j < 32; ++j) o[j] = 0.f;
    for (int kt = 0; kt < T / 64; ++kt) {
        __syncthreads();
        for (int i = tid; i < 64 * (DQ / 8); i += NTHR) { const int kr = i / (DQ / 8), ch = i % (DQ / 8); const size_t krow = (size_t)b * T + kt * 64 + kr; float f[8];
            if (BR == 0) load8((const bf16_t*)(ws + O_KA) + krow * 128 + (h >> 2) * 64 + ch * 8, f);
            else if (ch < 8) load8((const bf16_t*)(ws + O_KNOPE) + krow * 512 + h * 64 + ch * 8, f);
            else load8((const bf16_t*)(ws + O_KROPE) + krow * 32 + (ch - 8) * 8, f);
#pragma unroll
            for (int e = 0; e < 8; ++e) Ks[kr * 96 + ch * 8 + e] = f[e]; }
        for (int i = tid; i < 64 * 8; i += NTHR) { const int kr = i >> 3, ch = i & 7; const size_t krow = (size_t)b * T + kt * 64 + kr; float f[8];
            if (BR == 0) load8((const bf16_t*)(ws + O_VA) + krow * 128 + (h >> 2) * 64 + ch * 8, f); else load8((const bf16_t*)(ws + O_VB) + krow * 512 + h * 64 + ch * 8, f);
#pragma unroll
            for (int e = 0; e < 8; ++e) Vs[kr * 64 + ch * 8 + e] = f[e]; }
        __syncthreads();
#pragma unroll 1
        for (int kr = 0; kr < 64; ++kr) { float s = 0.f;
#pragma unroll 8
            for (int d = 0; d < DQ; ++d) s = fmaf(Qs[r * 97 + d], Ks[kr * 96 + d], s);
            if (s > m) { const float al = exp2f(m - s); l *= al;
#pragma unroll
                for (int j = 0; j < 32; ++j) o[j] *= al;
                m = s; }
            const float p = exp2f(s - m); l += p;
#pragma unroll
            for (int j = 0; j < 32; ++j) o[j] = fmaf(p, Vs[kr * 64 + half * 32 + j], o[j]); }
    }
    const float inv = 1.0f / l; bf16_t* Y = (bf16_t*)(ws + (BR ? O_YB : O_YA)) + row * 512 + h * 64 + half * 32;
#pragma unroll
    for (int j = 0; j < 32; j += 8) { float f[8];
#pragma unroll
        for (int e = 0; e < 8; ++e) f[e] = o[j + e] * inv;
        store8(Y + j, f); }
}

namespace att {
typedef short s16x4 __attribute__((ext_vector_type(4)));
typedef float f32x16 __attribute__((ext_vector_type(16)));
constexpr int SHM_V = 64 * 64 * 2, SHM_K = 64 * 256, OFF_K = 2 * SHM_V, OFF_WS = OFF_K + 2 * SHM_K, OFF_OST = OFF_WS + NWAVES * 64 * 4, ATT_LDS = OFF_OST + NWAVES * 4096;
constexpr float THRL = 8.0f;
#define KSWZ(row, colB) ((row) * 256 + ((colB) ^ (((row) & 7) << 4)))
#define SBAR() __builtin_amdgcn_sched_barrier(0)
__device__ __forceinline__ int crow(int r, int hi) { return (r & 3) + 8 * (r >> 2) + 4 * hi; }
__device__ __forceinline__ unsigned cvtpk(float lo, float hi) { unsigned r; asm volatile("v_cvt_pk_bf16_f32 %0, %1, %2" : "=v"(r) : "v"(lo), "v"(hi)); return r; }
__device__ __forceinline__ void partialSM(f32x16& p0, f32x16& p1, float& m_reg, float& mn, float& alpha) {
    float pmax = p0[0];
#pragma unroll
    for (int r = 1; r < 16; ++r) pmax = fmaxf(pmax, p0[r]);
#pragma unroll
    for (int r = 0; r < 16; ++r) pmax = fmaxf(pmax, p1[r]);
    { auto rr = __builtin_amdgcn_permlane32_swap(__float_as_uint(pmax), __float_as_uint(pmax), false, false); pmax = fmaxf(__uint_as_float(rr[0]), __uint_as_float(rr[1])); }
    if (__builtin_expect(__all(pmax - m_reg <= THRL), 1)) { mn = m_reg; alpha = 1.f; }
    else { mn = fmaxf(m_reg, pmax); alpha = __builtin_amdgcn_exp2f(m_reg - mn); m_reg = mn; }
#pragma unroll
    for (int r = 0; r < 16; ++r) { p0[r] -= mn; p1[r] -= mn; }
#pragma unroll
    for (int r = 0; r < 16; ++r) p0[r] = __builtin_amdgcn_exp2f(p0[r]);
}
__device__ __forceinline__ void finishSM(f32x16& p0, f32x16& p1, float alpha, float& l_reg, bf16x8& pa0, bf16x8& pa1, bf16x8& pa2, bf16x8& pa3) {
#pragma unroll
    for (int r = 0; r < 16; ++r) p1[r] = __builtin_amdgcn_exp2f(p1[r]);
    float ps = 0;
#pragma unroll
    for (int r = 0; r < 16; ++r) ps += p0[r];
#pragma unroll
    for (int r = 0; r < 16; ++r) ps += p1[r];
    { auto rr = __builtin_amdgcn_permlane32_swap(__float_as_uint(ps), __float_as_uint(ps), false, false); ps = __uint_as_float(rr[0]) + __uint_as_float(rr[1]); }
    l_reg = l_reg * alpha + ps;
#define PK4(P, BASE, OUT) do { unsigned a0 = cvtpk(P[BASE + 0], P[BASE + 1]), a1 = cvtpk(P[BASE + 2], P[BASE + 3]);   \
    unsigned b0 = cvtpk(P[BASE + 4], P[BASE + 5]), b1 = cvtpk(P[BASE + 6], P[BASE + 7]);                              \
    auto r0 = __builtin_amdgcn_permlane32_swap(a0, b0, false, false); auto r1 = __builtin_amdgcn_permlane32_swap(a1, b1, false, false); \
    u32x4 w = {r0[0], r1[0], r0[1], r1[1]}; OUT = __builtin_bit_cast(bf16x8, w); } while (0)
    PK4(p0, 0, pa0); PK4(p0, 8, pa1); PK4(p1, 0, pa2); PK4(p1, 8, pa3);
#undef PK4
}
template <int ND0>
__device__ __forceinline__ void qkt(f32x16& p0, f32x16& p1, const LAS unsigned char* Ks, const bf16x8* qr, int r32, int hi) {
    p0 = f32x16{}; p1 = f32x16{};
#pragma unroll
    for (int d0 = 0; d0 < ND0; ++d0) { const int cb = (d0 * 16 + hi * 8) * 2;
        const bf16x8 b0 = *(const LAS bf16x8*)(Ks + KSWZ(r32, cb)); const bf16x8 b1 = *(const LAS bf16x8*)(Ks + KSWZ(32 + r32, cb));
        p0 = __builtin_amdgcn_mfma_f32_32x32x16_bf16(b0, qr[d0], p0, 0, 0, 0); p1 = __builtin_amdgcn_mfma_f32_32x32x16_bf16(b1, qr[d0], p1, 0, 0, 0); }
}
__device__ __forceinline__ int v_st(int k, int c) { const int kk = (k & ~0xC) | ((k & 4) << 1) | ((k & 8) >> 1); return ((kk >> 3) * 2 + (c >> 5)) * 512 + ((kk & 7) * 32 + (c & 31)) * 2; }
__device__ __forceinline__ int v_rd_base(int lane) { return ((lane & 3) << 3) | (((lane >> 2) & 3) << 6) | (((lane >> 4) & 1) << 5) | (((lane >> 5) & 1) << 8); }
constexpr int v_rd_off(int d0, int ks, int half) { return d0 * 512 + ks * 2048 + half * 1024; }
template <int OFF> __device__ __forceinline__ s16x4 tr_read(int vb) { s16x4 r; asm volatile("ds_read_b64_tr_b16 %0, %1 offset:%2" : "=&v"(r) : "v"(vb), "i"(OFF) : "memory"); return r; }
template <int D0> __device__ __forceinline__ void pv_one(f32x16& od, int vb, bf16x8 pa0, bf16x8 pa1, bf16x8 pa2, bf16x8 pa3) {
    const s16x4 l0 = tr_read<v_rd_off(D0, 0, 0)>(vb), h0 = tr_read<v_rd_off(D0, 0, 1)>(vb), l1 = tr_read<v_rd_off(D0, 1, 0)>(vb), h1 = tr_read<v_rd_off(D0, 1, 1)>(vb);
    const s16x4 l2 = tr_read<v_rd_off(D0, 2, 0)>(vb), h2 = tr_read<v_rd_off(D0, 2, 1)>(vb), l3 = tr_read<v_rd_off(D0, 3, 0)>(vb), h3 = tr_read<v_rd_off(D0, 3, 1)>(vb);
    asm volatile("s_waitcnt lgkmcnt(0)" ::: "memory"); SBAR();
#define PK(L, H) (bf16x8){L[0], L[1], L[2], L[3], H[0], H[1], H[2], H[3]}
    od = __builtin_amdgcn_mfma_f32_32x32x16_bf16(pa0, PK(l0, h0), od, 0, 0, 0);
    od = __builtin_amdgcn_mfma_f32_32x32x16_bf16(pa1, PK(l1, h1), od, 0, 0, 0);
    od = __builtin_amdgcn_mfma_f32_32x32x16_bf16(pa2, PK(l2, h2), od, 0, 0, 0);
    od = __builtin_amdgcn_mfma_f32_32x32x16_bf16(pa3, PK(l3, h3), od, 0, 0, 0);
#undef PK
}
__device__ __forceinline__ void pv2(f32x16* o, int vb, bf16x8 pa0, bf16x8 pa1, bf16x8 pa2, bf16x8 pa3) { pv_one<0>(o[0], vb, pa0, pa1, pa2, pa3); pv_one<1>(o[1], vb, pa0, pa1, pa2, pa3); }

template <int BR>
__device__ __forceinline__ void unit(const Ctx& a, int b, int h, int qb, LAS unsigned char* lds, int tid_) {
    const int tid = launder_v(tid_);
    unsigned char* ws = a.ws; constexpr int DQ = BR ? 96 : 64, ND0 = DQ / 16, NKL = BR ? 2 : 1;
    const int wid = __builtin_amdgcn_readfirstlane(tid >> 6), lane = tid & 63, r32 = lane & 31, hi = lane >> 5;
    LAS unsigned char* V_lds = lds; LAS unsigned char* K_lds = lds + OFF_K;
    LAS float* wsf = (LAS float*)(lds + OFF_WS) + wid * 64; LAS float* li_l = wsf; LAS float* al_l = wsf + 32;
    const size_t row0 = (size_t)b * T + qb * 256, krow0 = (size_t)b * T;
    float m_reg = -1e30f, l_reg = 0; f32x16 o[2]; o[0] = f32x16{}; o[1] = f32x16{}; bf16x8 qr[ND0];
    {
        const size_t qrow = row0 + wid * 32 + r32;
        const bf16_t* Qw = BR ? (const bf16_t*)(ws + O_QB) + qrow * 768 + h * 96 + hi * 8 : (const bf16_t*)(ws + O_QA) + qrow * 512 + h * 64 + hi * 8;
#pragma unroll
        for (int d0 = 0; d0 < ND0; ++d0) qr[d0] = *(const bf16x8*)(Qw + d0 * 16);
        if (BR) {
            const float* tb = (const float*)(ws + O_TABB) + (int)(qrow & (T - 1)) * 32;
#pragma unroll
            for (int blk = 0; blk < 2; ++blk) { float x[8]; unpack8(__builtin_bit_cast(u32x4, qr[4 + blk]), x); float o8[8];
#pragma unroll
                for (int e = 0; e < 8; ++e) { const float pr = other_half(x[e], hi); const float cs = tb[blk * 8 + e], sn = tb[16 + blk * 8 + e]; o8[e] = hi ? x[e] * cs + pr * sn : x[e] * cs - pr * sn; }
                qr[4 + blk] = __builtin_bit_cast(bf16x8, pack8(o8)); } }
    }
    const int vr = tid >> 3, vc = (tid & 7) * 8, vst = v_st(vr, vc);
    int kr_[NKL], kc_[NKL];
#pragma unroll
    for (int i = 0; i < NKL; ++i) { int c = tid + i * 512; if (BR) { if (c >= 768) c -= 512; kr_[i] = c / 12; kc_[i] = c % 12; } else { kr_[i] = c >> 3; kc_[i] = c & 7; } }
    const bf16_t* Vsrc = BR ? (const bf16_t*)(ws + O_VB) + (krow0 + vr) * 512 + h * 64 + vc : (const bf16_t*)(ws + O_VA) + (krow0 + vr) * 128 + (h >> 2) * 64 + vc;
    const size_t vstep = (size_t)64 * (BR ? 512 : 128);
    const bf16_t* Ksrc[NKL]; size_t kstep_[NKL];
#pragma unroll
    for (int i = 0; i < NKL; ++i) {
        if (!BR) { Ksrc[i] = (const bf16_t*)(ws + O_KA) + (krow0 + kr_[i]) * 128 + (h >> 2) * 64 + kc_[i] * 8; kstep_[i] = (size_t)64 * 128; }
        else if (kc_[i] < 8) { Ksrc[i] = (const bf16_t*)(ws + O_KNOPE) + (krow0 + kr_[i]) * 512 + h * 64 + kc_[i] * 8; kstep_[i] = (size_t)64 * 512; }
        else { Ksrc[i] = (const bf16_t*)(ws + O_KROPE) + (krow0 + kr_[i]) * 32 + (kc_[i] - 8) * 8; kstep_[i] = (size_t)64 * 32; } }
    const bool k1_valid = !BR || tid < 256;
    const int vb0 = (int)(uintptr_t)V_lds + v_rd_base(lane);
    struct { bf16x8 v, k[NKL]; } sr_[2];
#define SLOAD(i, t) do { sr_[i].v = *(const bf16x8*)(Vsrc + (size_t)(t) * vstep); _Pragma("unroll") for (int q_ = 0; q_ < NKL; ++q_) sr_[i].k[q_] = *(const bf16x8*)(Ksrc[q_] + (size_t)(t) * kstep_[q_]); } while (0)
#define SWRITE(bb, i) do { *(LAS bf16x8*)(V_lds + (bb) * SHM_V + vst) = sr_[i].v; *(LAS bf16x8*)(K_lds + (bb) * SHM_K + KSWZ(kr_[0], kc_[0] * 16)) = sr_[i].k[0]; \
        if (NKL > 1) { if (k1_valid) *(LAS bf16x8*)(K_lds + (bb) * SHM_K + KSWZ(kr_[NKL - 1], kc_[NKL - 1] * 16)) = sr_[i].k[NKL - 1]; } } while (0)
#define RESC(al) do { if (__any((al) < 1.f)) { if (hi == 0) al_l[r32] = (al); asm volatile("s_waitcnt lgkmcnt(0)" ::: "memory"); \
        _Pragma("unroll") for (int d = 0; d < 2; ++d) _Pragma("unroll") for (int r = 0; r < 16; ++r) o[d][r] *= al_l[crow(r, hi)]; } } while (0)
    f32x16 pA0, pA1, pB0, pB1; float mnA, mnB, alA, alB; bf16x8 pa0, pa1, pa2, pa3; constexpr int NT = T / 64;
    __syncthreads();
    SLOAD(0, 0); SWRITE(0, 0); __syncthreads();
    qkt<ND0>(pA0, pA1, K_lds, qr, r32, hi); partialSM(pA0, pA1, m_reg, mnA, alA);
    SLOAD(1, 1); SLOAD(0, 2);
    SWRITE(1, 1); __syncthreads();
    for (int j = 1; j + 1 < NT; j += 2) {
        SBAR(); qkt<ND0>(pB0, pB1, K_lds + SHM_K, qr, r32, hi);
        finishSM(pA0, pA1, alA, l_reg, pa0, pa1, pa2, pa3); SBAR();
        SLOAD(1, j + 2); SBAR();
        pv2(o, vb0, pa0, pa1, pa2, pa3); partialSM(pB0, pB1, m_reg, mnB, alB);
        __syncthreads(); SWRITE(0, 0);
        RESC(alB); __syncthreads();
        SBAR(); qkt<ND0>(pA0, pA1, K_lds, qr, r32, hi);
        finishSM(pB0, pB1, alB, l_reg, pa0, pa1, pa2, pa3); SBAR();
        if (j + 3 < NT) SLOAD(0, j + 3); SBAR();
        pv2(o, vb0 + SHM_V, pa0, pa1, pa2, pa3); partialSM(pA0, pA1, m_reg, mnA, alA);
        __syncthreads(); SWRITE(1, 1);
        RESC(alA); __syncthreads();
    }
    SBAR(); qkt<ND0>(pB0, pB1, K_lds + SHM_K, qr, r32, hi);
    finishSM(pA0, pA1, alA, l_reg, pa0, pa1, pa2, pa3); SBAR();
    pv2(o, vb0, pa0, pa1, pa2, pa3); partialSM(pB0, pB1, m_reg, mnB, alB);
    __syncthreads(); RESC(alB);
    finishSM(pB0, pB1, alB, l_reg, pa0, pa1, pa2, pa3); SBAR();
    pv2(o, vb0 + SHM_V, pa0, pa1, pa2, pa3);
    if (hi == 0) li_l[r32] = l_reg; asm volatile("s_waitcnt lgkmcnt(0)" ::: "memory");
    float rli[16];
#pragma unroll
    for (int r = 0; r < 16; ++r) rli[r] = __builtin_amdgcn_rcpf(li_l[crow(r, hi)]);
    LAS bf16_t* stg = (LAS bf16_t*)(lds + OFF_OST) + wid * 2048;
#pragma unroll
    for (int r = 0; r < 16; ++r) { const int orow = crow(r, hi);
#pragma unroll
        for (int d0 = 0; d0 < 2; ++d0) stg[orow * 64 + d0 * 32 + r32] = (bf16_t)f2bf(o[d0][r] * rli[r]); }
    asm volatile("s_waitcnt lgkmcnt(0)" ::: "memory");
    bf16_t* Y = (bf16_t*)(ws + (BR ? O_YB : O_YA)) + (row0 + wid * 32) * 512 + h * 64;
#pragma unroll
    for (int i = 0; i < 4; ++i) { const int row = i * 8 + (lane >> 3), ch = lane & 7; const u32x4 v = *(const LAS u32x4*)(stg + row * 64 + ch * 8); *(u32x4*)(Y + (size_t)row * 512 + ch * 8) = v; }
#undef SLOAD
#undef SWRITE
#undef RESC
}
#undef KSWZ
#undef SBAR
}

namespace att64 {
typedef unsigned short bf16;
using s16x4=__attribute__((ext_vector_type(4)))short;
using f32x16=__attribute__((ext_vector_type(16)))float;
constexpr int SEQ=2048,D=64,QP=512,KP=128,VP=128,OP=512;
constexpr int NW=8,QBLK=32,QB=QBLK*NW,KVBLK=64,NQB=SEQ/QB;
__device__ __forceinline__ int crow(int r,int hi){return (r&3)+8*(r>>2)+4*hi;}
#define SBAR() __builtin_amdgcn_sched_barrier(0)
constexpr int NSLOT=3, SLOTB=8192;
constexpr int LDS_K=0, LDS_V=NSLOT*SLOTB, LDS_WS=2*NSLOT*SLOTB, LDS_OST=LDS_WS+NW*64*4, LDS_BYTES=LDS_OST+NW*4096;
constexpr float C2=0.125f*1.4426950408889634f;
__device__ __forceinline__ void glds16(const void*gsrc,unsigned lds_dst){unsigned keep;
  asm volatile("s_mov_b32 %0, m0\n\ts_mov_b32 m0, %2\n\ts_nop 0\n\tglobal_load_lds_dwordx4 %1, off\n\ts_mov_b32 m0, %0":"=&s"(keep):"v"(gsrc),"s"(lds_dst):"memory");}
__device__ __forceinline__ float max3f(float a,float b,float c){float r;asm("v_max3_f32 %0, %1, %2, %3":"=v"(r):"v"(a),"v"(b),"v"(c));return r;}
__device__ __forceinline__ float max2f(float a,float b){float r;asm("v_max_f32_e32 %0, %1, %2":"=v"(r):"v"(a),"v"(b));return r;}
__device__ __forceinline__ float fadd_s(float a,float b){float r;asm("v_add_f32_e32 %0, %1, %2":"=v"(r):"v"(a),"v"(b));return r;}
__device__ __forceinline__ float fsub_s(float a,float b){float r;asm("v_sub_f32_e32 %0, %1, %2":"=v"(r):"v"(a),"v"(b));return r;}
typedef float f32x2_t __attribute__((ext_vector_type(2))); typedef __bf16 bf16x2_t __attribute__((ext_vector_type(2)));
__device__ __forceinline__ unsigned cvtpk_s(float lo,float hi){f32x2_t v={lo,hi};bf16x2_t b=__builtin_convertvector(v,bf16x2_t);return __builtin_bit_cast(unsigned,b);}
#define WAIT_BAR(N) asm volatile("s_waitcnt vmcnt(" #N ") lgkmcnt(0)\n\ts_barrier":::"memory")

__device__ __forceinline__ void qkt(f32x16&p0,f32x16&p1,const char*Kslot,const bf16x8*qr,const f32x16&negm,int r32,int hi){
  const char*kb=Kslot+hi*1024+r32*16;
  #pragma unroll
  for(int d0=0;d0<4;++d0){
    const bf16x8 b0=*reinterpret_cast<const bf16x8*>(kb+d0*2048);
    const bf16x8 b1=*reinterpret_cast<const bf16x8*>(kb+d0*2048+512);
    if(d0==0){p0=__builtin_amdgcn_mfma_f32_32x32x16_bf16(b0,qr[0],negm,0,0,0);p1=__builtin_amdgcn_mfma_f32_32x32x16_bf16(b1,qr[0],negm,0,0,0);}
    else{p0=__builtin_amdgcn_mfma_f32_32x32x16_bf16(b0,qr[d0],p0,0,0,0);p1=__builtin_amdgcn_mfma_f32_32x32x16_bf16(b1,qr[d0],p1,0,0,0);}}
}
typedef __attribute__((address_space(3))) const char* lds_cptr;
typedef short v4i16_t __attribute__((ext_vector_type(4)));
__device__ __forceinline__ void kload8(bf16x8*kf,lds_cptr kp){
  kf[0]=*(const __attribute__((address_space(3))) bf16x8*)(kp);      kf[1]=*(const __attribute__((address_space(3))) bf16x8*)(kp+512);
  kf[2]=*(const __attribute__((address_space(3))) bf16x8*)(kp+2048); kf[3]=*(const __attribute__((address_space(3))) bf16x8*)(kp+2560);
  kf[4]=*(const __attribute__((address_space(3))) bf16x8*)(kp+4096); kf[5]=*(const __attribute__((address_space(3))) bf16x8*)(kp+4608);
  kf[6]=*(const __attribute__((address_space(3))) bf16x8*)(kp+6144); kf[7]=*(const __attribute__((address_space(3))) bf16x8*)(kp+6656);
}
__device__ __forceinline__ void kload2(bf16x8*kf,lds_cptr kp,int j){ kf[2*j]=*(const __attribute__((address_space(3))) bf16x8*)(kp+j*2048); kf[2*j+1]=*(const __attribute__((address_space(3))) bf16x8*)(kp+j*2048+512); }
__device__ __forceinline__ s16x4 vtr(lds_cptr p){ return __builtin_bit_cast(s16x4,__builtin_amdgcn_ds_read_tr16_b64_v4i16((__attribute__((address_space(3))) v4i16_t*)p)); }
__device__ __forceinline__ float rowmax(const f32x16&p0,const f32x16&p1){
  float a=max3f(p0[0],p0[1],p1[0]),b=max3f(p0[2],p0[3],p1[1]);a=max3f(a,p1[2],p1[3]);
  #pragma unroll
  for(int r=4;r<16;r+=4){a=max3f(a,p0[r],p0[r+1]);b=max3f(b,p0[r+2],p0[r+3]);a=max3f(a,p1[r],p1[r+1]);b=max3f(b,p1[r+2],p1[r+3]);}
  const float m=max2f(a,b);
  auto rr=__builtin_amdgcn_permlane32_swap(__float_as_uint(m),__float_as_uint(m),false,false);
  return max2f(__uint_as_float(rr[0]),__uint_as_float(rr[1]));
}
__device__ __forceinline__ void pv(f32x16*o,int vb,bf16x8 pa0,bf16x8 pa1,bf16x8 pa2,bf16x8 pa3){
  #pragma unroll
  for(int d0=0;d0<2;++d0){s16x4 lo[4],hi[4];
    #pragma unroll
    for(int ks=0;ks<4;++ks){
      asm volatile("ds_read_b64_tr_b16 %0,%1 offset:%c2":"=&v"(lo[ks]):"v"(vb),"i"(d0*4096+ks*1024):"memory");
      asm volatile("ds_read_b64_tr_b16 %0,%1 offset:%c2":"=&v"(hi[ks]):"v"(vb),"i"(d0*4096+ks*1024+512):"memory");}
    asm volatile("s_waitcnt lgkmcnt(0)":::"memory");SBAR();
    #define PK(k) (bf16x8){lo[k][0],lo[k][1],lo[k][2],lo[k][3],hi[k][0],hi[k][1],hi[k][2],hi[k][3]}
    o[d0]=__builtin_amdgcn_mfma_f32_32x32x16_bf16(pa0,PK(0),o[d0],0,0,0);
    o[d0]=__builtin_amdgcn_mfma_f32_32x32x16_bf16(pa1,PK(1),o[d0],0,0,0);
    o[d0]=__builtin_amdgcn_mfma_f32_32x32x16_bf16(pa2,PK(2),o[d0],0,0,0);
    o[d0]=__builtin_amdgcn_mfma_f32_32x32x16_bf16(pa3,PK(3),o[d0],0,0,0);
    #undef PK
  }
}

#ifndef ATTN_STORE16
#define ATTN_STORE16(p,v) (*(u32x4*)(p)=(v))
#endif
template<int THRL> __device__ __forceinline__ void attn_unit(int b,int h,int qb,const bf16*Q,const bf16*__restrict__ K,const bf16*__restrict__ V,bf16*O,char*shm,int tid_){
  const int tid=launder_v(tid_),lane=tid&63,r32=lane&31,hi=lane>>5; const int wid=__builtin_amdgcn_readfirstlane(tid>>6);
  const long rowbase=(long)b*SEQ; const int q0=qb*QB;
  const bf16*Qw=Q+(rowbase+q0+wid*QBLK)*QP+h*D;
  const bf16*Kh=K+rowbase*KP,*Vh=V+rowbase*VP;
  const unsigned lds0=(unsigned)(uintptr_t)shm;
  float*wsf=(float*)(shm+LDS_WS)+wid*64;
  const bf16*ksrc=Kh+(long)lane*KP+wid*8;
  const bf16*vsrc=Vh+(long)(16*(wid&3)+(lane>>2))*VP+(wid>>2)*32+(lane&3)*8;
  const unsigned kdst=lds0+LDS_K+wid*1024, vdst=lds0+LDS_V+wid*1024;
  #define DMA_K(t,slot) glds16(ksrc+(long)(t)*KVBLK*KP,(unsigned)__builtin_amdgcn_readfirstlane(kdst+(slot)))
  #define DMA_V(t,slot) glds16(vsrc+(long)(t)*KVBLK*VP,(unsigned)__builtin_amdgcn_readfirstlane(vdst+(slot)))
  const int vb0=(int)(lds0+LDS_V)+((lane>>4)&1)*32+(lane&3)*8+(4*hi+((lane&15)>>2))*64;
  const char*Kbase=shm+LDS_K; bf16x8 kf[8];
  const lds_cptr shm3=(lds_cptr)shm; const lds_cptr kp0=shm3+LDS_K+hi*1024+r32*16; const lds_cptr vp0=shm3+LDS_V+((lane>>4)&1)*32+(lane&3)*8+(4*hi+((lane&15)>>2))*64;
  constexpr int NT=SEQ/KVBLK;
  DMA_K(0,0);DMA_V(0,0);DMA_K(1,SLOTB);
  bf16x8 qr[4];
  #pragma unroll
  for(int d0=0;d0<4;++d0)qr[d0]=*reinterpret_cast<const bf16x8*>(&Qw[(long)r32*QP+d0*16+hi*8]);
  float mhat=0.f,l_reg=0.f;f32x16 o[2];o[0]=f32x16{};o[1]=f32x16{};f32x16 negm=f32x16{};asm volatile("":"+v"(negm));
  #define CMASK(P0,P1,t) do{}while(0)
  bool resc=false;
  #define START(P0,P1) do{ const float rm=rowmax(P0,P1); resc=false; \
    { const float dl=rm; mhat=fadd_s(mhat,dl); \
      _Pragma("unroll") for(int r=0;r<16;++r){P0[r]=fsub_s(P0[r],dl);P1[r]=fsub_s(P1[r],dl);} \
      _Pragma("unroll") for(int r=0;r<16;++r)negm[r]=-mhat; asm volatile("":"+v"(negm)); } \
    _Pragma("unroll") for(int r=0;r<16;++r)P0[r]=__builtin_amdgcn_exp2f(P0[r]); }while(0)
  #define RESC() do{ if(resc){ asm volatile("s_waitcnt lgkmcnt(0)":::"memory"); \
      _Pragma("unroll") for(int d_=0;d_<2;++d_) _Pragma("unroll") for(int r=0;r<16;++r)o[d_][r]*=wsf[crow(r,hi)]; } }while(0)
  f32x16 pA0,pA1,pB0,pB1;
  int sl_prev=0,sl_cur=0,sl_next=SLOTB;
  #define ROT() do{sl_prev=sl_cur;sl_cur=sl_next;sl_next=(sl_next==(NSLOT-1)*SLOTB)?0:sl_next+SLOTB;}while(0)
  DMA_K(2,2*SLOTB);
  WAIT_BAR(3);
  qkt(pA0,pA1,Kbase,qr,negm,r32,hi);asm volatile("s_nop 15\n\ts_nop 7":"+v"(pA0),"+v"(pA1));CMASK(pA0,pA1,0);
  START(pA0,pA1);
  _Pragma("unroll") for(int r=0;r<16;++r)pA1[r]=__builtin_amdgcn_exp2f(pA1[r]);
  WAIT_BAR(0);
  DMA_K(3,0);DMA_V(1,SLOTB);
  ROT();
  kload8(kf,kp0+sl_cur);
  WAIT_BAR(2);
  s16x4 vlo[8],vhi[8]; u32x4 pw0,pw1,pw2,pw3;
  #define PKW(P,B) cvtpk_s(P[B],P[B+1])
  #define PAF(k) __builtin_bit_cast(bf16x8,pw##k)
  #define VFR(i) (bf16x8){vlo[i][0],vlo[i][1],vlo[i][2],vlo[i][3],vhi[i][0],vhi[i][1],vhi[i][2],vhi[i][3]}
  #define PIN(x) asm volatile("":"+v"(x))
  #define MX3(a,b,c) __builtin_fmaxf(__builtin_fmaxf((a),(b)),(c))
  #define GAPA(MF,A0,A1,A2,A3,W0,W1,PW) do{ MF; sacc+=A0; sacc+=A1; sacc+=A2; sacc+=A3; PIN(sacc); W0; W1; PIN(PW); SBAR(); }while(0)
  #define EX(v) __builtin_amdgcn_exp2f(v)
  #define GAPB(MF,X,B) do{ MF; X[B]=EX(X[B]); X[B+1]=EX(X[B+1]); X[B+2]=EX(X[B+2]); X[B+3]=EX(X[B+3]); PIN(X); SBAR(); }while(0)
  #define VRD(i) do{ vlo[i]=vtr(vp_+(((i)>>2)*4096+((i)&3)*1024)); vhi[i]=vtr(vp_+(((i)>>2)*4096+((i)&3)*1024+512)); }while(0)
  #define KRD(G,j) do{ if(G){ kload2(kf,kp0+sl_next,j); SBAR(); } }while(0)
  #define STEP(C0,C1,P0,P1,t,GK,GV,GL) do{ SBAR(); \
    const lds_cptr vp_=vp0+sl_prev; \
    VRD(0); SBAR(); float sacc=(P0[0]+P0[1]); \
    GAPA(C0=__builtin_amdgcn_mfma_f32_32x32x16_bf16(kf[0],qr[0],negm,0,0,0), P0[2],P0[3],P0[4],P0[5],     pw0[0]=PKW(P0,0), pw0[1]=PKW(P0,2), pw0); \
    VRD(4); SBAR(); GAPA(C1=__builtin_amdgcn_mfma_f32_32x32x16_bf16(kf[1],qr[0],negm,0,0,0), P0[6],P0[7],P0[8],P0[9],     pw0[2]=PKW(P0,4), pw0[3]=PKW(P0,6), pw0); \
    VRD(1); SBAR(); GAPA(C0=__builtin_amdgcn_mfma_f32_32x32x16_bf16(kf[2],qr[1],C0,0,0,0),   P0[10],P0[11],P0[12],P0[13], pw1[0]=PKW(P0,8), pw1[1]=PKW(P0,10), pw1); \
    VRD(5); SBAR(); GAPA(C1=__builtin_amdgcn_mfma_f32_32x32x16_bf16(kf[3],qr[1],C1,0,0,0),   P0[14],P0[15],P1[0],P1[1],   pw1[2]=PKW(P0,12),pw1[3]=PKW(P0,14), pw1); \
    VRD(2); SBAR(); GAPA(C0=__builtin_amdgcn_mfma_f32_32x32x16_bf16(kf[4],qr[2],C0,0,0,0),   P1[2],P1[3],P1[4],P1[5],     pw2[0]=PKW(P1,0), pw2[1]=PKW(P1,2), pw2); \
    VRD(6); SBAR(); GAPA(C1=__builtin_amdgcn_mfma_f32_32x32x16_bf16(kf[5],qr[2],C1,0,0,0),   P1[6],P1[7],P1[8],P1[9],     pw2[2]=PKW(P1,4), pw2[3]=PKW(P1,6), pw2); \
    VRD(3); SBAR(); GAPA(C0=__builtin_amdgcn_mfma_f32_32x32x16_bf16(kf[6],qr[3],C0,0,0,0),   P1[10],P1[11],P1[12],P1[13], pw3[0]=PKW(P1,8), pw3[1]=PKW(P1,10), pw3); \
    VRD(7); SBAR(); GAPA(C1=__builtin_amdgcn_mfma_f32_32x32x16_bf16(kf[7],qr[3],C1,0,0,0),   P1[14],P1[15],0.f,0.f,       pw3[2]=PKW(P1,12),pw3[3]=PKW(P1,14), pw3); \
    l_reg+=sacc; \
    if(GK){DMA_K((t)+3,sl_cur);} if(GV){DMA_V((t)+1,sl_next);} \
    CMASK(C0,C1,t); \
    { float a=MX3(C0[0],C0[1],C1[0]),b=MX3(C0[2],C0[3],C1[1]); a=MX3(a,C1[2],C1[3]); \
      _Pragma("unroll") for(int r=4;r<16;r+=4){a=MX3(a,C0[r],C0[r+1]);b=MX3(b,C0[r+2],C0[r+3]);a=MX3(a,C1[r],C1[r+1]);b=MX3(b,C1[r+2],C1[r+3]);} \
      float rm=__builtin_fmaxf(a,b); { auto rr=__builtin_amdgcn_permlane32_swap(__float_as_uint(rm),__float_as_uint(rm),false,false); rm=__builtin_fmaxf(__uint_as_float(rr[0]),__uint_as_float(rr[1])); } \
      resc=false; \
      if(__builtin_expect(__any(rm>(float)THRL),0)){ const float dl=__builtin_fmaxf(rm,0.f); mhat+=dl; \
        _Pragma("unroll") for(int r=0;r<16;++r){C0[r]-=dl;C1[r]-=dl;} \
        _Pragma("unroll") for(int r=0;r<16;++r)negm[r]=-mhat; asm volatile("":"+v"(negm)); \
        const float f=__builtin_amdgcn_exp2f(-dl); l_reg*=f; if(hi==0)wsf[r32]=f; resc=true; } } \
    SBAR(); \
    GAPB(o[0]=__builtin_amdgcn_mfma_f32_32x32x16_bf16(PAF(0),VFR(0),o[0],0,0,0), C0,0); \
    GAPB(o[1]=__builtin_amdgcn_mfma_f32_32x32x16_bf16(PAF(0),VFR(4),o[1],0,0,0), C0,4); \
    KRD(GL,0); GAPB(o[0]=__builtin_amdgcn_mfma_f32_32x32x16_bf16(PAF(1),VFR(1),o[0],0,0,0), C0,8); \
    KRD(GL,1); GAPB(o[1]=__builtin_amdgcn_mfma_f32_32x32x16_bf16(PAF(1),VFR(5),o[1],0,0,0), C0,12); \
    KRD(GL,2); GAPB(o[0]=__builtin_amdgcn_mfma_f32_32x32x16_bf16(PAF(2),VFR(2),o[0],0,0,0), C1,0); \
    KRD(GL,3); GAPB(o[1]=__builtin_amdgcn_mfma_f32_32x32x16_bf16(PAF(2),VFR(6),o[1],0,0,0), C1,4); \
    GAPB(o[0]=__builtin_amdgcn_mfma_f32_32x32x16_bf16(PAF(3),VFR(3),o[0],0,0,0), C1,8); \
    GAPB(o[1]=__builtin_amdgcn_mfma_f32_32x32x16_bf16(PAF(3),VFR(7),o[1],0,0,0), C1,12); \
    }while(0)
  int t=1;
  for(;t+5<NT;t+=2){
    STEP(pB0,pB1,pA0,pA1,t,true,true,true);     WAIT_BAR(2); RESC(); ROT();
    STEP(pA0,pA1,pB0,pB1,t+1,true,true,true);   WAIT_BAR(2); RESC(); ROT();
  }
  #define ENDW(tt) do{ if((tt)+3<NT){WAIT_BAR(2);} else if((tt)+2<NT){WAIT_BAR(1);} else {WAIT_BAR(0);} }while(0)
  for(;t+1<NT;t+=2){
    STEP(pB0,pB1,pA0,pA1,t,(t+3<NT),(t+1<NT),(t+1<NT));       ENDW(t);   RESC(); ROT();
    STEP(pA0,pA1,pB0,pB1,t+1,(t+4<NT),(t+2<NT),(t+2<NT));     ENDW(t+1); RESC(); ROT();
  }
  STEP(pB0,pB1,pA0,pA1,NT-1,false,false,false); RESC();
  { float sacc=pB0[0]+pB0[1]; _Pragma("unroll") for(int r=2;r<16;++r)sacc+=pB0[r]; _Pragma("unroll") for(int r=0;r<16;++r)sacc+=pB1[r]; l_reg+=sacc;
    pw0=(u32x4){PKW(pB0,0),PKW(pB0,2),PKW(pB0,4),PKW(pB0,6)};pw1=(u32x4){PKW(pB0,8),PKW(pB0,10),PKW(pB0,12),PKW(pB0,14)};pw2=(u32x4){PKW(pB1,0),PKW(pB1,2),PKW(pB1,4),PKW(pB1,6)};pw3=(u32x4){PKW(pB1,8),PKW(pB1,10),PKW(pB1,12),PKW(pB1,14)};
    SBAR(); pv(o,vb0+sl_cur,PAF(0),PAF(1),PAF(2),PAF(3)); }
  #undef PKW
  #undef PAF
  #undef VFR
  #undef PIN
  #undef MX3
  #undef GAPA
  #undef GAPB
  #undef EX
  #undef VRD
  #undef KRD
  #undef STEP
  #undef ENDW
  {auto rr=__builtin_amdgcn_permlane32_swap(__float_as_uint(l_reg),__float_as_uint(l_reg),false,false);l_reg=__uint_as_float(rr[0])+__uint_as_float(rr[1]);}
  if(hi==0)wsf[32+r32]=l_reg;asm volatile("s_waitcnt lgkmcnt(0)":::"memory");
  float rli[16];
  #pragma unroll
  for(int r=0;r<16;++r)rli[r]=__builtin_amdgcn_rcpf(wsf[32+crow(r,hi)]);
  bf16*Ow=O+(rowbase+q0+wid*QBLK)*OP+h*D;
  { bf16*stg=(bf16*)(shm+LDS_OST)+wid*2048;
    #pragma unroll
    for(int r=0;r<16;++r){const int orow=crow(r,hi);
      #pragma unroll
      for(int d0=0;d0<2;++d0)stg[orow*64+d0*32+r32]=(bf16)f2bf(o[d0][r]*rli[r]);}
    asm volatile("s_waitcnt lgkmcnt(0)":::"memory");
    #pragma unroll
    for(int i=0;i<4;++i){const int row=i*8+(lane>>3),ch=lane&7; const u32x4 v=*(const u32x4*)(stg+row*64+ch*8); ATTN_STORE16(Ow+(long)row*OP+ch*8,v);} }
  asm volatile("s_waitcnt lgkmcnt(0)\n\ts_barrier":::"memory");
  #undef DMA_K
  #undef DMA_V
  #undef CMASK
  #undef START
  #undef RESC
  #undef ROT
}
constexpr int ATTN_LDS_BYTES=LDS_BYTES;
#undef SBAR
#undef WAIT_BAR
}

namespace att96 {
typedef unsigned short bf16;
using s16x4=__attribute__((ext_vector_type(4)))short;
using f32x16=__attribute__((ext_vector_type(16)))float;
constexpr int SEQ=2048,D=64,DQ=96,QP=768,KP=512,RP=32,VP=512,OP=512;
constexpr int NW=8,QBLK=32,QB=QBLK*NW,KVBLK=64,NQB=SEQ/QB;
__device__ __forceinline__ int crow(int r,int hi){return (r&3)+8*(r>>2)+4*hi;}
#define SBAR() __builtin_amdgcn_sched_barrier(0)
constexpr int NSLOT=3, SLOTB=8192;
constexpr int LDS_K=0, LDS_V=NSLOT*2*SLOTB, LDS_WS=LDS_V+NSLOT*SLOTB, LDS_OST=LDS_WS+NW*64*4, LDS_BYTES=LDS_OST+NW*4096;
constexpr float C2=0.125f*1.4426950408889634f;
__device__ __forceinline__ void glds16(const void*gsrc,unsigned lds_dst){unsigned keep;
  asm volatile("s_mov_b32 %0, m0\n\ts_mov_b32 m0, %2\n\ts_nop 0\n\tglobal_load_lds_dwordx4 %1, off\n\ts_mov_b32 m0, %0":"=&s"(keep):"v"(gsrc),"s"(lds_dst):"memory");}
__device__ __forceinline__ float max3f(float a,float b,float c){float r;asm("v_max3_f32 %0, %1, %2, %3":"=v"(r):"v"(a),"v"(b),"v"(c));return r;}
__device__ __forceinline__ float max2f(float a,float b){float r;asm("v_max_f32_e32 %0, %1, %2":"=v"(r):"v"(a),"v"(b));return r;}
__device__ __forceinline__ float fadd_s(float a,float b){float r;asm("v_add_f32_e32 %0, %1, %2":"=v"(r):"v"(a),"v"(b));return r;}
__device__ __forceinline__ float fsub_s(float a,float b){float r;asm("v_sub_f32_e32 %0, %1, %2":"=v"(r):"v"(a),"v"(b));return r;}
typedef float f32x2_t __attribute__((ext_vector_type(2))); typedef __bf16 bf16x2_t __attribute__((ext_vector_type(2)));
__device__ __forceinline__ unsigned cvtpk_s(float lo,float hi){f32x2_t v={lo,hi};bf16x2_t b=__builtin_convertvector(v,bf16x2_t);return __builtin_bit_cast(unsigned,b);}
#define WAIT_BAR(N) asm volatile("s_waitcnt vmcnt(" #N ") lgkmcnt(0)\n\ts_barrier":::"memory")

__device__ __forceinline__ void qkt(f32x16&p0,f32x16&p1,const char*Kslot,const bf16x8*qr,int r32,int hi){
  const char*kb=Kslot+hi*1024+r32*16;
  #pragma unroll
  for(int d0=0;d0<6;++d0){
    const bf16x8 b0=*reinterpret_cast<const bf16x8*>(kb+d0*2048);
    const bf16x8 b1=*reinterpret_cast<const bf16x8*>(kb+d0*2048+512);
    if(d0==0){p0=__builtin_amdgcn_mfma_f32_32x32x16_bf16(b0,qr[0],f32x16{},0,0,0);p1=__builtin_amdgcn_mfma_f32_32x32x16_bf16(b1,qr[0],f32x16{},0,0,0);}
    else{p0=__builtin_amdgcn_mfma_f32_32x32x16_bf16(b0,qr[d0],p0,0,0,0);p1=__builtin_amdgcn_mfma_f32_32x32x16_bf16(b1,qr[d0],p1,0,0,0);}}
}
typedef __attribute__((address_space(3))) const char* lds_cptr;
typedef short v4i16_t __attribute__((ext_vector_type(4)));
__device__ __forceinline__ void kload8(bf16x8*kf,lds_cptr kp){
  kf[0]=*(const __attribute__((address_space(3))) bf16x8*)(kp);      kf[1]=*(const __attribute__((address_space(3))) bf16x8*)(kp+512);
  kf[2]=*(const __attribute__((address_space(3))) bf16x8*)(kp+2048); kf[3]=*(const __attribute__((address_space(3))) bf16x8*)(kp+2560);
  kf[4]=*(const __attribute__((address_space(3))) bf16x8*)(kp+4096); kf[5]=*(const __attribute__((address_space(3))) bf16x8*)(kp+4608);
  kf[6]=*(const __attribute__((address_space(3))) bf16x8*)(kp+6144); kf[7]=*(const __attribute__((address_space(3))) bf16x8*)(kp+6656);
  kf[8]=*(const __attribute__((address_space(3))) bf16x8*)(kp+8192); kf[9]=*(const __attribute__((address_space(3))) bf16x8*)(kp+8704);
  kf[10]=*(const __attribute__((address_space(3))) bf16x8*)(kp+10240); kf[11]=*(const __attribute__((address_space(3))) bf16x8*)(kp+10752);
}
__device__ __forceinline__ void kload2(bf16x8*kf,lds_cptr kp,int j){ kf[2*j]=*(const __attribute__((address_space(3))) bf16x8*)(kp+j*2048); kf[2*j+1]=*(const __attribute__((address_space(3))) bf16x8*)(kp+j*2048+512); }
__device__ __forceinline__ s16x4 vtr(lds_cptr p){ return __builtin_bit_cast(s16x4,__builtin_amdgcn_ds_read_tr16_b64_v4i16((__attribute__((address_space(3))) v4i16_t*)p)); }
__device__ __forceinline__ float rowmax(const f32x16&p0,const f32x16&p1){
  float a=max3f(p0[0],p0[1],p1[0]),b=max3f(p0[2],p0[3],p1[1]);a=max3f(a,p1[2],p1[3]);
  #pragma unroll
  for(int r=4;r<16;r+=4){a=max3f(a,p0[r],p0[r+1]);b=max3f(b,p0[r+2],p0[r+3]);a=max3f(a,p1[r],p1[r+1]);b=max3f(b,p1[r+2],p1[r+3]);}
  const float m=max2f(a,b);
  auto rr=__builtin_amdgcn_permlane32_swap(__float_as_uint(m),__float_as_uint(m),false,false);
  return max2f(__uint_as_float(rr[0]),__uint_as_float(rr[1]));
}
__device__ __forceinline__ void pv(f32x16*o,int vb,bf16x8 pa0,bf16x8 pa1,bf16x8 pa2,bf16x8 pa3){
  #pragma unroll
  for(int d0=0;d0<2;++d0){s16x4 lo[4],hi[4];
    #pragma unroll
    for(int ks=0;ks<4;++ks){
      asm volatile("ds_read_b64_tr_b16 %0,%1 offset:%c2":"=&v"(lo[ks]):"v"(vb),"i"(d0*4096+ks*1024):"memory");
      asm volatile("ds_read_b64_tr_b16 %0,%1 offset:%c2":"=&v"(hi[ks]):"v"(vb),"i"(d0*4096+ks*1024+512):"memory");}
    asm volatile("s_waitcnt lgkmcnt(0)":::"memory");SBAR();
    #define PK(k) (bf16x8){lo[k][0],lo[k][1],lo[k][2],lo[k][3],hi[k][0],hi[k][1],hi[k][2],hi[k][3]}
    o[d0]=__builtin_amdgcn_mfma_f32_32x32x16_bf16(pa0,PK(0),o[d0],0,0,0);
    o[d0]=__builtin_amdgcn_mfma_f32_32x32x16_bf16(pa1,PK(1),o[d0],0,0,0);
    o[d0]=__builtin_amdgcn_mfma_f32_32x32x16_bf16(pa2,PK(2),o[d0],0,0,0);
    o[d0]=__builtin_amdgcn_mfma_f32_32x32x16_bf16(pa3,PK(3),o[d0],0,0,0);
    #undef PK
  }
}

#ifndef ATTN_STORE16
#define ATTN_STORE16(p,v) (*(u32x4*)(p)=(v))
#endif
template<int THRL> __device__ __forceinline__ void attn_unit(int b,int h,int qb,const bf16*Q,const bf16*__restrict__ K,const bf16*__restrict__ KR,const bf16*__restrict__ V,bf16*O,const float*tabb,char*shm,int tid_){
  const int tid=launder_v(tid_),lane=tid&63,r32=lane&31,hi=lane>>5; const int wid=__builtin_amdgcn_readfirstlane(tid>>6);
  const long rowbase=(long)b*SEQ; const int q0=qb*QB;
  const bf16*Qw=Q+(rowbase+q0+wid*QBLK)*QP+h*DQ;
  const bf16*Kh=K+rowbase*KP,*KRh=KR+rowbase*RP,*Vh=V+rowbase*VP;
  const unsigned lds0=(unsigned)(uintptr_t)shm;
  float*wsf=(float*)(shm+LDS_WS)+wid*64;
  const bf16*ksrc=Kh+(long)lane*KP+wid*8;
  const bf16*ksrc2=KRh+(long)lane*RP+(wid&3)*8;
  const bf16*vsrc=Vh+(long)(16*(wid&3)+(lane>>2))*VP+(wid>>2)*32+(lane&3)*8;
  const unsigned kdst=lds0+LDS_K+wid*1024, vdst=lds0+LDS_V+wid*1024;
  #define DMA_K(t,slot) do{ glds16(ksrc+(long)(t)*KVBLK*KP,(unsigned)__builtin_amdgcn_readfirstlane(kdst+2*(slot))); glds16(ksrc2+(long)(t)*KVBLK*RP,(unsigned)__builtin_amdgcn_readfirstlane(kdst+8192+2*(slot))); }while(0)
  #define DMA_V(t,slot) glds16(vsrc+(long)(t)*KVBLK*VP,(unsigned)__builtin_amdgcn_readfirstlane(vdst+(slot)))
  const int vb0=(int)(lds0+LDS_V)+((lane>>4)&1)*32+(lane&3)*8+(4*hi+((lane&15)>>2))*64;
  const char*Kbase=shm+LDS_K; bf16x8 kf[12];
  const lds_cptr shm3=(lds_cptr)shm; const lds_cptr kp0=shm3+LDS_K+hi*1024+r32*16; const lds_cptr vp0=shm3+LDS_V+((lane>>4)&1)*32+(lane&3)*8+(4*hi+((lane&15)>>2))*64;
  constexpr int NT=SEQ/KVBLK;
  DMA_K(0,0);DMA_V(0,0);DMA_K(1,SLOTB);
  bf16x8 qr[6];
  #pragma unroll
  for(int d0=0;d0<6;++d0)qr[d0]=*reinterpret_cast<const bf16x8*>(&Qw[(long)r32*QP+d0*16+hi*8]);
  { const float*tb=tabb+(int)((rowbase+q0+wid*QBLK+r32)&(SEQ-1))*32;
    #pragma unroll
    for(int blk=0;blk<2;++blk){ float x[8],o8[8]; unpack8(__builtin_bit_cast(u32x4,qr[4+blk]),x);
      #pragma unroll
      for(int e=0;e<8;++e){ const float pr=other_half(x[e],hi); const float cs=tb[blk*8+e],sn=tb[16+blk*8+e]; o8[e]=hi?x[e]*cs+pr*sn:x[e]*cs-pr*sn; }
      qr[4+blk]=__builtin_bit_cast(bf16x8,pack8(o8)); } }
  __attribute__((address_space(3))) bf16x8* const qpark=(__attribute__((address_space(3))) bf16x8*)((lds_cptr)shm+LDS_OST+wid*4096)+lane*2;
  qpark[0]=qr[4]; qpark[1]=qr[5];
  float mhat=0.f,l_reg=0.f;f32x16 o[2];o[0]=f32x16{};o[1]=f32x16{};
  #define CMASK(P0,P1,t) do{}while(0)
  bool resc=false;
  #define START(P0,P1) do{ const float rm=rowmax(P0,P1); resc=false; \
    { const float dl=rm; mhat=fadd_s(mhat,dl); \
      _Pragma("unroll") for(int r=0;r<16;++r){P0[r]=fsub_s(P0[r],dl);P1[r]=fsub_s(P1[r],dl);} } \
    _Pragma("unroll") for(int r=0;r<16;++r)P0[r]=__builtin_amdgcn_exp2f(P0[r]); }while(0)
  #define RESC() do{ if(resc){ asm volatile("s_waitcnt lgkmcnt(0)":::"memory"); \
      _Pragma("unroll") for(int d_=0;d_<2;++d_) _Pragma("unroll") for(int r=0;r<16;++r)o[d_][r]*=wsf[crow(r,hi)]; } }while(0)
  f32x16 pA0,pA1,pB0,pB1;
  int sl_prev=0,sl_cur=0,sl_next=SLOTB;
  #define ROT() do{sl_prev=sl_cur;sl_cur=sl_next;sl_next=(sl_next==(NSLOT-1)*SLOTB)?0:sl_next+SLOTB;}while(0)
  DMA_K(2,2*SLOTB);
  WAIT_BAR(5);
  qkt(pA0,pA1,Kbase,qr,r32,hi);asm volatile("s_nop 15\n\ts_nop 7":"+v"(pA0),"+v"(pA1));CMASK(pA0,pA1,0);
  START(pA0,pA1);
  _Pragma("unroll") for(int r=0;r<16;++r)pA1[r]=__builtin_amdgcn_exp2f(pA1[r]);
  WAIT_BAR(0);
  DMA_K(3,0);DMA_V(1,SLOTB);
  ROT();
  kload8(kf,kp0+2*sl_cur);
  WAIT_BAR(3);
  s16x4 vlo[8],vhi[8]; u32x4 pw0,pw1,pw2,pw3;
  #define PKW(P,B) cvtpk_s(P[B],P[B+1])
  #define PAF(k) __builtin_bit_cast(bf16x8,pw##k)
  #define VFR(i) (bf16x8){vlo[i][0],vlo[i][1],vlo[i][2],vlo[i][3],vhi[i][0],vhi[i][1],vhi[i][2],vhi[i][3]}
  #define PIN(x) asm volatile("":"+v"(x))
  #define MX3(a,b,c) __builtin_fmaxf(__builtin_fmaxf((a),(b)),(c))
  #define GAPA(MF,A0,A1,A2,A3,W0,W1,PW) do{ MF; sacc+=A0; sacc+=A1; sacc+=A2; sacc+=A3; PIN(sacc); W0; W1; PIN(PW); SBAR(); }while(0)
  #define EX(v) __builtin_amdgcn_exp2f(v)
  #define GAPB(MF,X,B) do{ MF; X[B]=EX(X[B]); X[B+1]=EX(X[B+1]); X[B+2]=EX(X[B+2]); X[B+3]=EX(X[B+3]); PIN(X); SBAR(); }while(0)
  #define VRD(i) do{ vlo[i]=vtr(vp_+(((i)>>2)*4096+((i)&3)*1024)); vhi[i]=vtr(vp_+(((i)>>2)*4096+((i)&3)*1024+512)); }while(0)
  #define KRD(G,j) do{ if(G){ kload2(kf,kp0+2*sl_next,j); SBAR(); } }while(0)
  #define STEP(C0,C1,P0,P1,t,GK,GV,GL) do{ SBAR(); \
    const lds_cptr vp_=vp0+sl_prev; \
    VRD(0); SBAR(); float sacc=(P0[0]+P0[1]); \
    GAPA(C0=__builtin_amdgcn_mfma_f32_32x32x16_bf16(kf[0],qr[0],f32x16{},0,0,0), P0[2],P0[3],P0[4],P0[5],     pw0[0]=PKW(P0,0), pw0[1]=PKW(P0,2), pw0); \
    VRD(4); SBAR(); GAPA(C1=__builtin_amdgcn_mfma_f32_32x32x16_bf16(kf[1],qr[0],f32x16{},0,0,0), P0[6],P0[7],P0[8],P0[9],     pw0[2]=PKW(P0,4), pw0[3]=PKW(P0,6), pw0); \
    VRD(1); SBAR(); GAPA(C0=__builtin_amdgcn_mfma_f32_32x32x16_bf16(kf[2],qr[1],C0,0,0,0),   P0[10],P0[11],P0[12],P0[13], pw1[0]=PKW(P0,8), pw1[1]=PKW(P0,10), pw1); \
    VRD(5); SBAR(); GAPA(C1=__builtin_amdgcn_mfma_f32_32x32x16_bf16(kf[3],qr[1],C1,0,0,0),   P0[14],P0[15],P1[0],P1[1],   pw1[2]=PKW(P0,12),pw1[3]=PKW(P0,14), pw1); \
    VRD(2); SBAR(); GAPA(C0=__builtin_amdgcn_mfma_f32_32x32x16_bf16(kf[4],qr[2],C0,0,0,0),   P1[2],P1[3],P1[4],P1[5],     pw2[0]=PKW(P1,0), pw2[1]=PKW(P1,2), pw2); \
    VRD(6); SBAR(); GAPA(C1=__builtin_amdgcn_mfma_f32_32x32x16_bf16(kf[5],qr[2],C1,0,0,0),   P1[6],P1[7],P1[8],P1[9],     pw2[2]=PKW(P1,4), pw2[3]=PKW(P1,6), pw2); \
    VRD(3); SBAR(); GAPA(C0=__builtin_amdgcn_mfma_f32_32x32x16_bf16(kf[6],qr[3],C0,0,0,0),   P1[10],P1[11],P1[12],P1[13], pw3[0]=PKW(P1,8), pw3[1]=PKW(P1,10), pw3); \
    VRD(7); SBAR(); GAPA(C1=__builtin_amdgcn_mfma_f32_32x32x16_bf16(kf[7],qr[3],C1,0,0,0),   P1[14],P1[15],0.f,0.f,       pw3[2]=PKW(P1,12),pw3[3]=PKW(P1,14), pw3); \
    l_reg+=sacc; \
    { const bf16x8 q4_=qpark[0], q5_=qpark[1]; SBAR(); \
      C0=__builtin_amdgcn_mfma_f32_32x32x16_bf16(kf[8],q4_,C0,0,0,0); C1=__builtin_amdgcn_mfma_f32_32x32x16_bf16(kf[9],q4_,C1,0,0,0); \
      C0=__builtin_amdgcn_mfma_f32_32x32x16_bf16(kf[10],q5_,C0,0,0,0); C1=__builtin_amdgcn_mfma_f32_32x32x16_bf16(kf[11],q5_,C1,0,0,0); SBAR(); } \
    if(GK){DMA_K((t)+3,sl_cur);} if(GV){DMA_V((t)+1,sl_next);} \
    { const float nm_=-mhat; _Pragma("unroll") for(int r=0;r<16;++r){C0[r]+=nm_;C1[r]+=nm_;} } \
    CMASK(C0,C1,t); \
    { float a=MX3(C0[0],C0[1],C1[0]),b=MX3(C0[2],C0[3],C1[1]); a=MX3(a,C1[2],C1[3]); \
      _Pragma("unroll") for(int r=4;r<16;r+=4){a=MX3(a,C0[r],C0[r+1]);b=MX3(b,C0[r+2],C0[r+3]);a=MX3(a,C1[r],C1[r+1]);b=MX3(b,C1[r+2],C1[r+3]);} \
      float rm=__builtin_fmaxf(a,b); { auto rr=__builtin_amdgcn_permlane32_swap(__float_as_uint(rm),__float_as_uint(rm),false,false); rm=__builtin_fmaxf(__uint_as_float(rr[0]),__uint_as_float(rr[1])); } \
      resc=false; \
      if(__builtin_expect(__any(rm>(float)THRL),0)){ const float dl=__builtin_fmaxf(rm,0.f); mhat+=dl; \
        _Pragma("unroll") for(int r=0;r<16;++r){C0[r]-=dl;C1[r]-=dl;} \
        const float f=__builtin_amdgcn_exp2f(-dl); l_reg*=f; if(hi==0)wsf[r32]=f; resc=true; } } \
    SBAR(); \
    GAPB(o[0]=__builtin_amdgcn_mfma_f32_32x32x16_bf16(PAF(0),VFR(0),o[0],0,0,0), C0,0); \
    GAPB(o[1]=__builtin_amdgcn_mfma_f32_32x32x16_bf16(PAF(0),VFR(4),o[1],0,0,0), C0,4); \
    KRD(GL,0); GAPB(o[0]=__builtin_amdgcn_mfma_f32_32x32x16_bf16(PAF(1),VFR(1),o[0],0,0,0), C0,8); \
    KRD(GL,1); GAPB(o[1]=__builtin_amdgcn_mfma_f32_32x32x16_bf16(PAF(1),VFR(5),o[1],0,0,0), C0,12); \
    KRD(GL,2); GAPB(o[0]=__builtin_amdgcn_mfma_f32_32x32x16_bf16(PAF(2),VFR(2),o[0],0,0,0), C1,0); \
    KRD(GL,3); GAPB(o[1]=__builtin_amdgcn_mfma_f32_32x32x16_bf16(PAF(2),VFR(6),o[1],0,0,0), C1,4); \
    KRD(GL,4); GAPB(o[0]=__builtin_amdgcn_mfma_f32_32x32x16_bf16(PAF(3),VFR(3),o[0],0,0,0), C1,8); \
    KRD(GL,5); GAPB(o[1]=__builtin_amdgcn_mfma_f32_32x32x16_bf16(PAF(3),VFR(7),o[1],0,0,0), C1,12); \
    }while(0)
  int t=1;
  for(;t+5<NT;t+=2){
    STEP(pB0,pB1,pA0,pA1,t,true,true,true);     WAIT_BAR(3); RESC(); ROT();
    STEP(pA0,pA1,pB0,pB1,t+1,true,true,true);   WAIT_BAR(3); RESC(); ROT();
  }
  #define ENDW(tt) do{ if((tt)+3<NT){WAIT_BAR(3);} else if((tt)+2<NT){WAIT_BAR(1);} else {WAIT_BAR(0);} }while(0)
  for(;t+1<NT;t+=2){
    STEP(pB0,pB1,pA0,pA1,t,(t+3<NT),(t+1<NT),(t+1<NT));       ENDW(t);   RESC(); ROT();
    STEP(pA0,pA1,pB0,pB1,t+1,(t+4<NT),(t+2<NT),(t+2<NT));     ENDW(t+1); RESC(); ROT();
  }
  STEP(pB0,pB1,pA0,pA1,NT-1,false,false,false); RESC();
  { float sacc=pB0[0]+pB0[1]; _Pragma("unroll") for(int r=2;r<16;++r)sacc+=pB0[r]; _Pragma("unroll") for(int r=0;r<16;++r)sacc+=pB1[r]; l_reg+=sacc;
    pw0=(u32x4){PKW(pB0,0),PKW(pB0,2),PKW(pB0,4),PKW(pB0,6)};pw1=(u32x4){PKW(pB0,8),PKW(pB0,10),PKW(pB0,12),PKW(pB0,14)};pw2=(u32x4){PKW(pB1,0),PKW(pB1,2),PKW(pB1,4),PKW(pB1,6)};pw3=(u32x4){PKW(pB1,8),PKW(pB1,10),PKW(pB1,12),PKW(pB1,14)};
    SBAR(); pv(o,vb0+sl_cur,PAF(0),PAF(1),PAF(2),PAF(3)); }
  #undef PKW
  #undef PAF
  #undef VFR
  #undef PIN
  #undef MX3
  #undef GAPA
  #undef GAPB
  #undef EX
  #undef VRD
  #undef KRD
  #undef STEP
  #undef ENDW
  {auto rr=__builtin_amdgcn_permlane32_swap(__float_as_uint(l_reg),__float_as_uint(l_reg),false,false);l_reg=__uint_as_float(rr[0])+__uint_as_float(rr[1]);}
  if(hi==0)wsf[32+r32]=l_reg;asm volatile("s_waitcnt lgkmcnt(0)":::"memory");
  float rli[16];
  #pragma unroll
  for(int r=0;r<16;++r)rli[r]=__builtin_amdgcn_rcpf(wsf[32+crow(r,hi)]);
  bf16*Ow=O+(rowbase+q0+wid*QBLK)*OP+h*D;
  { bf16*stg=(bf16*)(shm+LDS_OST)+wid*2048;
    #pragma unroll
    for(int r=0;r<16;++r){const int orow=crow(r,hi);
      #pragma unroll
      for(int d0=0;d0<2;++d0)stg[orow*64+d0*32+r32]=(bf16)f2bf(o[d0][r]*rli[r]);}
    asm volatile("s_waitcnt lgkmcnt(0)":::"memory");
    #pragma unroll
    for(int i=0;i<4;++i){const int row=i*8+(lane>>3),ch=lane&7; const u32x4 v=*(const u32x4*)(stg+row*64+ch*8); ATTN_STORE16(Ow+(long)row*OP+ch*8,v);} }
  asm volatile("s_waitcnt lgkmcnt(0)\n\ts_barrier":::"memory");
  #undef DMA_K
  #undef DMA_V
  #undef CMASK
  #undef START
  #undef RESC
  #undef ROT
}
constexpr int ATTN_LDS_BYTES=LDS_BYTES;
#undef SBAR
#undef WAIT_BAR
}

namespace gla {
constexpr int LQ = 136, LT = 72;
constexpr int O_QS = 0, O_KS = O_QS + 64 * LQ * 2, O_KST = O_KS + 64 * LQ * 2, O_VST = O_KST + 128 * LT * 2, O_PS = O_VST + 128 * LT * 2, O_SST = O_PS + 64 * LT * 2, O_DECS = O_SST + 128 * LQ * 2, GLA_LDS = O_DECS + 32 * 128 * 4;
static_assert(GLA_LDS <= LDS_CTL, "GLA LDS");
__device__ __forceinline__ bf16x8 frag(const LAS bf16_t* base, int ld, int row0, int k0, int lane) { return *(const LAS bf16x8*)(base + (row0 + (lane & 15)) * ld + k0 + 8 * (lane >> 4)); }
__device__ __forceinline__ void unit(const Ctx& a, int b, int h, int dir, LAS unsigned char* lds, int tid_) {
    const int tid = launder_v(tid_);
    unsigned char* ws = a.ws; const int wid = __builtin_amdgcn_readfirstlane(tid >> 6), lane = tid & 63, l15 = lane & 15, q4 = (lane >> 4) * 4;
    LAS bf16_t* Qs = (LAS bf16_t*)(lds + O_QS); LAS bf16_t* Ks = (LAS bf16_t*)(lds + O_KS); LAS bf16_t* KsT = (LAS bf16_t*)(lds + O_KST);
    LAS bf16_t* VsT = (LAS bf16_t*)(lds + O_VST); LAS bf16_t* Ps = (LAS bf16_t*)(lds + O_PS); LAS bf16_t* SsT = (LAS bf16_t*)(lds + O_SST);
    const bf16_t* QT = (const bf16_t*)(ws + O_QT) + (size_t)(dir * 2) * M * 512; const bf16_t* KT = QT + (size_t)M * 512;
    const bf16_t* Pm = (const bf16_t*)(ws + O_VG); const float* DEC = (const float*)(ws + O_DEC) + (size_t)dir * 256 * 512;
    bf16_t* OC = (bf16_t*)(ws + (dir ? O_OCB : O_YC));
    const int srow = tid >> 3, scg = tid & 7;
    const int spc = (((srow >> 3) ^ scg) << 3) + (srow & 7);
    int aoff[4];
#pragma unroll
    for (int c = 0; c < 4; ++c) aoff[c] = l15 * LT + ((((lane >> 4) ^ (l15 >> 3)) ^ (2 * c)) << 3);
    const int voff0 = (wid * 16 + l15) * LT + ((((lane >> 4) ^ (l15 >> 3)) ^ ((2 * wid) & 7)) << 3), voff1 = (wid * 16 + l15) * LT + ((((lane >> 4) ^ (l15 >> 3)) ^ (4 ^ ((2 * wid) & 7))) << 3);
#define LDS_BAR() asm volatile("s_waitcnt lgkmcnt(0)\n\ts_barrier" ::: "memory")
#define SCHED_FENCE() __builtin_amdgcn_sched_barrier(0)
    f32x4 S[8];
#pragma unroll
    for (int i = 0; i < 8; ++i) S[i] = (f32x4){0.f, 0.f, 0.f, 0.f};
    __syncthreads();
    { const unsigned z = (unsigned)launder_v(0);
      for (int i = tid; i < 128 * LQ / 8; i += NTHR) ((LAS u32x4*)SsT)[i] = (u32x4){z, z, z, z}; }
    { LAS float* decs = (LAS float*)(lds + O_DECS);
#pragma unroll
      for (int i = 0; i < 2; ++i) { const int e4 = (tid + i * NTHR) * 4, c = e4 >> 7, k = e4 & 127; *(LAS f32x4*)(decs + e4) = *(const f32x4*)(DEC + (size_t)(b * 32 + c) * 512 + h * 128 + k); } }
    bf16x8 gq[2][2], gk[2][2], gv[2][2];
#define GLD(dst_, ptr_) asm volatile("global_load_dwordx4 %0, %1, off" : "=&v"(dst_) : "v"(ptr_) : "memory")
#define GLOAD(n_, s_) do { const int ci_ = dir ? 31 - (n_) : (n_); const size_t r_ = (size_t)b * T + ci_ * 64 + srow; _Pragma("unroll") for (int j_ = 0; j_ < 2; ++j_) { const int c8_ = (scg + 8 * j_) * 8; \
        GLD(gq[s_][j_], QT + r_ * 512 + h * 128 + c8_); GLD(gk[s_][j_], KT + r_ * 512 + h * 128 + c8_); GLD(gv[s_][j_], Pm + r_ * 1024 + h * 128 + c8_); } } while (0)
    GLOAD(0, 0); GLOAD(1, 1);
    for (int n2 = 0; n2 < 32; n2 += 2) {
#pragma unroll
      for (int hs = 0; hs < 2; ++hs) {
        const int n = n2 + hs;
        const int ci = dir ? 31 - n : n;
        LDS_BAR();
        f32x4 dec[8];
        u32x4 ost[2];
        if (n > 0) {
#pragma unroll
            for (int j = 0; j < 2; ++j) ost[j] = *(const LAS u32x4*)(Qs + srow * LQ + (scg + 8 * j) * 8); }
        if (n2 == 0) asm volatile("s_waitcnt vmcnt(6)" ::: "memory"); else if (n == 31) asm volatile("s_waitcnt vmcnt(2)" ::: "memory"); else asm volatile("s_waitcnt vmcnt(8)" ::: "memory");
        asm volatile("" : "+v"(gq[hs][0]), "+v"(gq[hs][1]), "+v"(gk[hs][0]), "+v"(gk[hs][1]), "+v"(gv[hs][0]), "+v"(gv[hs][1]));
#pragma unroll
        for (int j = 0; j < 2; ++j) { const int c8 = (scg + 8 * j) * 8;
            *(LAS bf16x8*)(Qs + srow * LQ + c8) = gq[hs][j]; *(LAS bf16x8*)(Ks + srow * LQ + c8) = gk[hs][j];
#pragma unroll
            for (int e = 0; e < 8; ++e) { KsT[(c8 + e) * LT + spc] = (bf16_t)gk[hs][j][e]; VsT[(c8 + e) * LT + spc] = (bf16_t)gv[hs][j][e]; } }
        LDS_BAR();
        if (n > 0) { const size_t rowprev = (size_t)b * T + (dir ? ci + 1 : ci - 1) * 64;
#pragma unroll
            for (int j = 0; j < 2; ++j) *(u32x4*)(OC + (rowprev + srow) * 512 + h * 128 + (scg + 8 * j) * 8) = ost[j]; }
        if (n + 2 < 32) GLOAD(n + 2, hs);
        SCHED_FENCE();
        const int it = wid >> 1, st0 = (wid & 1) * 2;
        bf16x8 qf[4], kf[2][4], sf[4], kt[8][2], q2[4][4];
#pragma unroll
        for (int kk = 0; kk < 4; ++kk) qf[kk] = frag(Qs, LQ, it * 16, kk * 32, lane);
#pragma unroll
        for (int ss = 0; ss < 2; ++ss) {
#pragma unroll
            for (int kk = 0; kk < 4; ++kk) kf[ss][kk] = frag(Ks, LQ, (st0 + ss) * 16, kk * 32, lane); }
#pragma unroll
        for (int kk = 0; kk < 4; ++kk) sf[kk] = frag(SsT, LQ, wid * 16, kk * 32, lane);
        const bf16x8 v0 = *(const LAS bf16x8*)(VsT + voff0), v1 = *(const LAS bf16x8*)(VsT + voff1);
#pragma unroll
        for (int t = 0; t < 4; ++t) { kt[t][0] = *(const LAS bf16x8*)(KsT + t * 16 * LT + aoff[((2 * t) & 7) >> 1]); kt[t][1] = *(const LAS bf16x8*)(KsT + t * 16 * LT + aoff[(4 ^ ((2 * t) & 7)) >> 1]); dec[t] = *(const LAS f32x4*)((LAS float*)(lds + O_DECS) + ci * 128 + t * 16 + q4); }
        SCHED_FENCE();
        {
#pragma unroll
            for (int ss = 0; ss < 2; ++ss) { const int st = st0 + ss; f32x4 acc = (f32x4){0.f, 0.f, 0.f, 0.f};
                const bool dead = dir ? (st < it) : (st > it);
                if (!dead) {
#pragma unroll
                    for (int kk = 0; kk < 4; ++kk) acc = __builtin_amdgcn_mfma_f32_16x16x32_bf16(kf[ss][kk], qf[kk], acc, 0, 0, 0);
                    if (st == it) {
#pragma unroll
                        for (int r = 0; r < 4; ++r) { const bool keep = dir ? (q4 + r >= l15) : (q4 + r <= l15); if (!keep) acc[r] = 0.f; } }
                }
                *(LAS u32x2*)(Ps + (it * 16 + l15) * LT + st * 16 + q4) = (u32x2){pk2(acc[0], acc[1]), pk2(acc[2], acc[3])}; }
        }
        SCHED_FENCE();
#pragma unroll
        for (int t = 4; t < 8; ++t) { kt[t][0] = *(const LAS bf16x8*)(KsT + t * 16 * LT + aoff[((2 * t) & 7) >> 1]); kt[t][1] = *(const LAS bf16x8*)(KsT + t * 16 * LT + aoff[(4 ^ ((2 * t) & 7)) >> 1]); dec[t] = *(const LAS f32x4*)((LAS float*)(lds + O_DECS) + ci * 128 + t * 16 + q4); }
        SCHED_FENCE();
#pragma unroll
        for (int t = 0; t < 4; ++t) { S[t] = __builtin_amdgcn_mfma_f32_16x16x32_bf16(kt[t][0], v0, S[t], 0, 0, 0); S[t] = __builtin_amdgcn_mfma_f32_16x16x32_bf16(kt[t][1], v1, S[t], 0, 0, 0);
            S[t] = S[t] * dec[t];
            *(LAS u32x2*)(SsT + (wid * 16 + l15) * LQ + t * 16 + q4) = (u32x2){pk2(S[t][0], S[t][1]), pk2(S[t][2], S[t][3])}; }
        SCHED_FENCE();
#pragma unroll
        for (int i2 = 0; i2 < 2; ++i2) {
#pragma unroll
            for (int kk = 0; kk < 4; ++kk) q2[i2][kk] = frag(Qs, LQ, i2 * 16, kk * 32, lane); }
        SCHED_FENCE();
#pragma unroll
        for (int t = 4; t < 8; ++t) { S[t] = __builtin_amdgcn_mfma_f32_16x16x32_bf16(kt[t][0], v0, S[t], 0, 0, 0); S[t] = __builtin_amdgcn_mfma_f32_16x16x32_bf16(kt[t][1], v1, S[t], 0, 0, 0);
            S[t] = S[t] * dec[t];
            *(LAS u32x2*)(SsT + (wid * 16 + l15) * LQ + t * 16 + q4) = (u32x2){pk2(S[t][0], S[t][1]), pk2(S[t][2], S[t][3])}; }
        SCHED_FENCE();
#pragma unroll
        for (int i2 = 2; i2 < 4; ++i2) {
#pragma unroll
            for (int kk = 0; kk < 4; ++kk) q2[i2][kk] = frag(Qs, LQ, i2 * 16, kk * 32, lane); }
        SCHED_FENCE();
        f32x4 ao[4];
#pragma unroll
        for (int i2 = 0; i2 < 4; ++i2) { ao[i2] = (f32x4){0.f, 0.f, 0.f, 0.f};
#pragma unroll
            for (int kk = 0; kk < 4; ++kk) ao[i2] = __builtin_amdgcn_mfma_f32_16x16x32_bf16(sf[kk], q2[i2][kk], ao[i2], 0, 0, 0);
            if (i2 == 1) SCHED_FENCE(); }
        LDS_BAR();
        { bf16x8 pf[4][2];
#pragma unroll
          for (int i2 = 0; i2 < 4; ++i2) { pf[i2][0] = frag(Ps, LT, i2 * 16, 0, lane); pf[i2][1] = frag(Ps, LT, i2 * 16, 32, lane); }
          SCHED_FENCE();
#pragma unroll
          for (int i2 = 0; i2 < 4; ++i2) { ao[i2] = __builtin_amdgcn_mfma_f32_16x16x32_bf16(v0, pf[i2][0], ao[i2], 0, 0, 0); ao[i2] = __builtin_amdgcn_mfma_f32_16x16x32_bf16(v1, pf[i2][1], ao[i2], 0, 0, 0); } }
#pragma unroll
        for (int i2 = 0; i2 < 4; ++i2) *(LAS u32x2*)(Qs + (i2 * 16 + l15) * LQ + wid * 16 + q4) = (u32x2){pk2(ao[i2][0], ao[i2][1]), pk2(ao[i2][2], ao[i2][3])};
      }
    }
    LDS_BAR();
    { const int ci = dir ? 0 : 31; const size_t rowbase = (size_t)b * T + ci * 64;
#pragma unroll
      for (int j = 0; j < 2; ++j) *(u32x4*)(OC + (rowbase + srow) * 512 + h * 128 + (scg + 8 * j) * 8) = *(const LAS u32x4*)(Qs + srow * LQ + (scg + 8 * j) * 8); }
#undef GLOAD
#undef GLD
#undef LDS_BAR
#undef SCHED_FENCE
}
__device__ __forceinline__ void combine_phase(const Ctx& a, int layer, int gw, int NGW, int lane) {
    unsigned char* ws = a.ws; bf16_t* YC = (bf16_t*)(ws + O_YC); const bf16_t* OCB = (const bf16_t*)(ws + O_OCB); const bf16_t* Pm = (const bf16_t*)(ws + O_VG);
    float g[8]; { const float* gp = a.in[I_GCOUT] + layer * 128 + (lane & 15) * 8; const f32x4 g0 = *(const f32x4*)gp, g1 = *(const f32x4*)(gp + 4); g[0] = g0.x; g[1] = g0.y; g[2] = g0.z; g[3] = g0.w; g[4] = g1.x; g[5] = g1.y; g[6] = g1.z; g[7] = g1.w; }
    for (int m0 = gw; m0 < M; m0 += 4 * NGW) {
        u32x4 rf[4], rb[4], rc[4];
#pragma unroll
        for (int q = 0; q < 4; ++q) { const int m_ = m0 + q * NGW, m = m_ < M ? m_ : gw;
            rf[q] = *(const u32x4*)(YC + (size_t)m * 512 + lane * 8); rb[q] = *(const u32x4*)(OCB + (size_t)m * 512 + lane * 8); rc[q] = *(const u32x4*)(Pm + (size_t)m * 1024 + 512 + lane * 8); }
#pragma unroll
        for (int q = 0; q < 4; ++q) { const int m = m0 + q * NGW;
            float f[8], bb[8], cg[8]; unpack8(rf[q], f); unpack8(rb[q], bb); unpack8(rc[q], cg);
            float ss = 0.f;
#pragma unroll
            for (int e = 0; e < 8; ++e) { f[e] += bb[e]; ss += f[e] * f[e]; }
            ss += shx<1>(ss); ss += shx<2>(ss); ss += shx<4>(ss); ss += shx<8>(ss);
            const float rstd = rsqrtf(ss * (1.0f / 128.0f) + EPS);
#pragma unroll
            for (int e = 0; e < 8; ++e) f[e] = f[e] * rstd * g[e] * (cg[e] * sigmoidf_(cg[e]));
            if (m < M) store8(YC + (size_t)m * 512 + lane * 8, f); }
    }
}
}

__device__ __forceinline__ void gla_naive_unit(const Ctx& a, int layer, int b, int h, LAS unsigned char* lds, int tid) {
    unsigned char* ws = a.ws; const bf16_t* P = (const bf16_t*)(ws + O_P); bf16_t* YC = (bf16_t*)(ws + O_YC);
    LAS float* qs = (LAS float*)lds; LAS float* ks = qs + 128; LAS float* as = ks + 128; LAS float* part = as + 128; LAS float* red = part + 512;
    const int j = tid & 127, qd = tid >> 7; const float gco = a.in[I_GCOUT][layer * 128 + j];
    for (int dir = 0; dir < 2; ++dir) {
        const float* LA = (const float*)(ws + O_QT) + (size_t)dir * M * 512;
        float S[32];
#pragma unroll
        for (int i = 0; i < 32; ++i) S[i] = 0.f;
        for (int step = 0; step < T; ++step) {
            const int tok = dir ? T - 1 - step : step; const size_t row = (size_t)b * T + tok;
            __syncthreads();
            if (tid < 128) { qs[tid] = bf2f(P[row * PW + PC_CQ + h * 128 + tid]) * GLA_QSCALE; ks[tid] = bf2f(P[row * PW + PC_CK + h * 128 + tid]); as[tid] = __expf(LA[row * 512 + h * 128 + tid]); }
            const float v = bf2f(((const bf16_t*)(ws + O_VG))[row * 1024 + h * 128 + j]);
            __syncthreads();
            float o = 0.f;
#pragma unroll
            for (int i = 0; i < 32; ++i) { const int dk = qd * 32 + i; S[i] = as[dk] * S[i] + ks[dk] * v; o = fmaf(qs[dk], S[i], o); }
            part[qd * 128 + j] = o;
            __syncthreads();
            float v2 = 0.f;
            if (tid < 128) {
                const float tot = (part[tid] + part[128 + tid]) + (part[256 + tid] + part[384 + tid]);
                if (dir == 0) YC[row * 512 + h * 128 + tid] = (bf16_t)f2bf(tot);
                else { v2 = tot + bf2f(YC[row * 512 + h * 128 + tid]); const float ss = wave_sum(v2 * v2); if ((tid & 63) == 0) red[tid >> 6] = ss; }
            }
            if (dir == 1) {
                __syncthreads();
                if (tid < 128) {
                    const float rstd = rsqrtf((red[0] + red[1]) * (1.0f / 128.0f) + EPS);
                    const float g = bf2f(((const bf16_t*)(ws + O_VG))[row * 1024 + 512 + h * 128 + tid]);
                    YC[row * 512 + h * 128 + tid] = (bf16_t)f2bf(v2 * rstd * gco * (g * sigmoidf_(g)));
                }
            }
        }
    }
}

__device__ __forceinline__ void router_item(const Ctx& a, int blk, LAS unsigned char* lds, int tid) {
    unsigned char* ws = a.ws; int* mi = (int*)(ws + O_MOEI); float* mf = (float*)(ws + O_MOEI);
    const int wave = __builtin_amdgcn_readfirstlane(tid >> 6), lane = tid & 63;
    LAS float* lg = (LAS float*)lds;
    const bf16_t* x1 = (const bf16_t*)(ws + O_XB); const float* g = a.in[I_GFFN] + 1024; const float* wr = a.in[I_WROUTER];
    __syncthreads();
    {
        u32x2 rx[8][4]; f32x4 gg[4];
#pragma unroll
        for (int jj = 0; jj < 4; ++jj) gg[jj] = *(const f32x4*)(g + (lane + 64 * jj) * 4);
#pragma unroll
        for (int j = 0; j < 8; ++j)
#pragma unroll
            for (int jj = 0; jj < 4; ++jj) rx[j][jj] = *(const u32x2*)(x1 + (size_t)(blk * 64 + wave * 8 + j) * D + (lane + 64 * jj) * 4);
#pragma unroll
        for (int j = 0; j < 8; ++j) {
            float acc[8], ss = 0.f;
#pragma unroll
            for (int e = 0; e < 8; ++e) acc[e] = 0.f;
#pragma unroll
            for (int jj = 0; jj < 4; ++jj) { const int idx = (lane + 64 * jj) * 4; const u32x2 xr = rx[j][jj];
                const f32x4 v = (f32x4){bf2f(xr.x & 0xffffu), bf2f(xr.x >> 16), bf2f(xr.y & 0xffffu), bf2f(xr.y >> 16)};
                ss += (v.x * v.x + v.y * v.y) + (v.z * v.z + v.w * v.w);
                const float hv[4] = {v.x * gg[jj].x, v.y * gg[jj].y, v.z * gg[jj].z, v.w * gg[jj].w};
#pragma unroll
                for (int c = 0; c < 4; ++c) { const f32x4 w0 = *(const f32x4*)(wr + (size_t)(idx + c) * 8), w1 = *(const f32x4*)(wr + (size_t)(idx + c) * 8 + 4);
                    acc[0] = fmaf(hv[c], w0.x, acc[0]); acc[1] = fmaf(hv[c], w0.y, acc[1]); acc[2] = fmaf(hv[c], w0.z, acc[2]); acc[3] = fmaf(hv[c], w0.w, acc[3]);
                    acc[4] = fmaf(hv[c], w1.x, acc[4]); acc[5] = fmaf(hv[c], w1.y, acc[5]); acc[6] = fmaf(hv[c], w1.z, acc[6]); acc[7] = fmaf(hv[c], w1.w, acc[7]); } }
            ss = wave_sum(ss); const float rstd = rsqrtf(ss * (1.0f / 1024.0f) + EPS);
#pragma unroll
            for (int e = 0; e < 8; ++e) { const float s = wave_sum(acc[e]); if (lane == 0) lg[(wave * 8 + j) * 8 + e] = s * rstd; }
        }
    }
    __syncthreads();
    if (wave == 0) {
        const int tok = blk * 64 + lane; float v[8];
#pragma unroll
        for (int e = 0; e < 8; ++e) v[e] = lg[lane * 8 + e];
        int e1 = 0; float v1 = v[0];
#pragma unroll
        for (int e = 1; e < 8; ++e) if (v[e] > v1) { v1 = v[e]; e1 = e; }
        int e2 = -1; float v2 = -3.0e38f;
#pragma unroll
        for (int e = 0; e < 8; ++e) if (e != e1 && v[e] > v2) { v2 = v[e]; e2 = e; }
        const float w1 = 1.0f / (1.0f + __expf(v2 - v1)), w2 = 1.0f - w1;
        const unsigned long long lt = (1ull << lane) - 1ull; int ra = 0, rb = 0, mycnt = 0;
#pragma unroll
        for (int e = 0; e < 8; ++e) { const unsigned long long m0 = __ballot(e1 == e), m1 = __ballot(e2 == e); const int c0 = __popcll(m0);
            if (e1 == e) ra = __popcll(m0 & lt); if (e2 == e) rb = c0 + __popcll(m1 & lt); if (lane == e) mycnt = c0 + __popcll(m1); }
        mi[MI_TOKE + tok] = e1 | (e2 << 8); mi[MI_TOKR + tok] = ra | (rb << 16); mf[MI_TOKW + tok * 2] = w1; mf[MI_TOKW + tok * 2 + 1] = w2;
        if (lane < 8) mi[MI_CNT + blk * 8 + lane] = mycnt;
    }
}
__device__ __forceinline__ void positions_phase(const Ctx& a, LAS unsigned char* lds, int G, int bid, int tid) {
    unsigned char* ws = a.ws; int* mi = (int*)(ws + O_MOEI); float* mf = (float*)(ws + O_MOEI);
    LAS int* cnt = (LAS int*)lds; LAS int* base = cnt + 2048;
    __syncthreads();
    for (int i = tid; i < 2048; i += NTHR) cnt[i] = mi[MI_CNT + i];
    __syncthreads();
    {
        LAS int* segs = base + 32; const int e = tid & 7, seg = tid >> 3; int c4[4], loc = 0;
#pragma unroll
        for (int k = 0; k < 4; ++k) { c4[k] = cnt[(seg * 4 + k) * 8 + e]; loc += c4[k]; }
        segs[seg * 8 + e] = loc;
        __syncthreads();
        int run = 0; for (int s = 0; s < seg; ++s) run += segs[s * 8 + e];
        if (seg == 63) base[8 + e] = run + loc;
#pragma unroll
        for (int k = 0; k < 4; ++k) { cnt[(seg * 4 + k) * 8 + e] = run; run += c4[k]; }
    }
    __syncthreads();
    if (tid == 0) { int off = 0; for (int e = 0; e < 8; ++e) { base[e] = off; off += (base[8 + e] + 255) & ~255; } base[16] = off >> 8; }
    __syncthreads();
    if (bid == 0) {
        const int nt = base[16];
        for (int t = tid; t < nt; t += NTHR) { int e = 0;
#pragma unroll
            for (int k = 1; k < 8; ++k) if (t * 256 >= base[k]) e = k;
            mi[MI_TILEE + t] = e; }
        if (tid == 0) mi[MI_TILEE + MAXTILES] = nt;
        {
            const int nunits = nt * 4, rem = nunits % G; const bool split = rem > 0 && rem <= MAXSPLIT; const int nmain = split ? nunits - rem : nunits, nsplit = split ? rem : 0;
            for (int i = tid; i < MAXTILES * 4; i += NTHR) mi[MI_SPLIT + i] = -1;
            __syncthreads();
            for (int i = tid; i < nsplit; i += NTHR) { int pm, pn; tile_order(nmain + i, nt, 4, pm, pn); mi[MI_SPLIT + pm * 4 + pn] = i; }
            if (tid == 0) { mi[MI_SPLIT + MAXTILES * 4] = nmain; mi[MI_SPLIT + MAXTILES * 4 + 1] = nsplit; }
        }
        for (int e = 0; e < 8; ++e) { const int lo = base[e] + base[8 + e], hi = base[e] + ((base[8 + e] + 255) & ~255);
            for (int r = lo + tid; r < hi; r += NTHR) { mi[MI_ROWTOK + r] = 0; mf[MI_ROWW + r] = 0.f; mf[MI_ROWSC + r] = 0.f; } }
    }
    for (int blk = bid; blk < 256; blk += G) if (tid < 64) {
        const int tok = blk * 64 + tid; const int ee = mi[MI_TOKE + tok], rr = mi[MI_TOKR + tok]; const int e1 = ee & 255, e2 = ee >> 8;
        const int pa = base[e1] + cnt[blk * 8 + e1] + (rr & 0xffff), pb = base[e2] + cnt[blk * 8 + e2] + (rr >> 16);
        mi[MI_ROWTOK + pa] = tok; mf[MI_ROWW + pa] = mf[MI_TOKW + tok * 2]; mi[MI_ROWTOK + pb] = tok; mf[MI_ROWW + pb] = mf[MI_TOKW + tok * 2 + 1];
        mi[MI_TOKPOS + tok * 2] = pa; mi[MI_TOKPOS + tok * 2 + 1] = pb;
        const float rs = row_rstd16((const float*)(ws + O_SSQ), tok); mf[MI_ROWSC + pa] = rs; mf[MI_ROWSC + pb] = rs;
    }
}
__device__ __forceinline__ void final_phase(const Ctx& a, int gw, int NGW, int lane) {
    unsigned char* ws = a.ws; const int* mi = (const int*)(ws + O_MOEI); const float* mf = (const float*)(ws + O_MOEI); const bf16_t* OUTS = (const bf16_t*)(ws + O_OUTS); const float* gf = a.in[I_GFINAL];
    const bf16_t* XBf = (const bf16_t*)(ws + O_XB); const float* SL = (const float*)(ws + O_SLAB);
    f32x4 g[4];
#pragma unroll
    for (int j = 0; j < 4; ++j) g[j] = *(const f32x4*)(gf + (lane + 64 * j) * 4);
    for (int m0 = gw; m0 < M; m0 += 2 * NGW) {
        int pos[2][2];
#pragma unroll
        for (int q = 0; q < 2; ++q) { const int m_ = m0 + q * NGW, m = m_ < M ? m_ : gw; pos[q][0] = mi[MI_TOKPOS + m * 2]; pos[q][1] = mi[MI_TOKPOS + m * 2 + 1]; }
        u32x2 rx[2][4], ro[2][2][4];
#pragma unroll
        for (int q = 0; q < 2; ++q) { const int m_ = m0 + q * NGW, m = m_ < M ? m_ : gw;
#pragma unroll
            for (int j = 0; j < 4; ++j) { const int idx = (lane + 64 * j) * 4; rx[q][j] = *(const u32x2*)(XBf + (size_t)m * D + idx);
                ro[q][0][j] = *(const u32x2*)(OUTS + (size_t)pos[q][0] * 1024 + idx); ro[q][1][j] = *(const u32x2*)(OUTS + (size_t)pos[q][1] * 1024 + idx); } }
#pragma unroll
        for (int q = 0; q < 2; ++q) { const int m = m0 + q * NGW; f32x4 v[4]; float s = 0.f;
#pragma unroll
            for (int j = 0; j < 4; ++j) {
                v[j] = (f32x4){bf2f(rx[q][j].x & 0xffffu), bf2f(rx[q][j].x >> 16), bf2f(rx[q][j].y & 0xffffu), bf2f(rx[q][j].y >> 16)};
#pragma unroll
                for (int e = 0; e < 2; ++e) { const int ps = pos[q][e]; const int sp = mi[MI_SPLIT + (ps >> 8) * 4 + j];
                    if (sp < 0) { const u32x2 ua = ro[q][e][j]; v[j].x += bf2f(ua.x & 0xffffu); v[j].y += bf2f(ua.x >> 16); v[j].z += bf2f(ua.y & 0xffffu); v[j].w += bf2f(ua.y >> 16); }
                    else { const float w = mf[MI_ROWW + ps]; f32x4 acc = (f32x4){0.f, 0.f, 0.f, 0.f};
#pragma unroll
                        for (int k = 0; k < KSPLIT; ++k) acc += *(const f32x4*)(SL + (size_t)(sp * KSPLIT + k) * 65536 + (ps & 255) * 256 + lane * 4);
                        v[j] += acc * w; } }
                s += (v[j].x * v[j].x + v[j].y * v[j].y) + (v[j].z * v[j].z + v[j].w * v[j].w); }
            s = wave_sum(s); const float rstd = rsqrtf(s * (1.0f / 1024.0f) + EPS);
            if (m < M) {
#pragma unroll
                for (int j = 0; j < 4; ++j) *(f32x4*)(a.out + (size_t)m * D + (lane + 64 * j) * 4) = (f32x4){v[j].x * rstd * g[j].x, v[j].y * rstd * g[j].y, v[j].z * rstd * g[j].z, v[j].w * rstd * g[j].w}; } }
    }
}

#ifndef FAST_MASK
#define FAST_MASK 0xfff
#endif
template <int SITE, bool GATHER = false, bool HALFN = false, class Sched, class Epi>
__device__ __forceinline__ void gemm_run(LAS unsigned char* lds, const Sched& S, const Epi& E, int K, int lda, int tid, int ldb = 0, bool tiled = false) {
    if constexpr ((NAIVE_GEMM || !((FAST_MASK >> SITE) & 1)) && !HALFN) gemm_naive(S, E, K, lda);
    else pg8::gemm_phase<GATHER, HALFN>(lds, S, E, K, lda, tid, ldb, tiled);
}

constexpr int NPHASE = 20;
__global__ void __launch_bounds__(NTHR, 2) mega_fwd(Args args) {
    extern __shared__ __attribute__((aligned(16))) unsigned char lds_raw[];
    LAS unsigned char* lds = (LAS unsigned char*)lds_raw;
    const int wave_s = __builtin_amdgcn_readfirstlane((int)threadIdx.x >> 6);
    { const int tid0 = threadIdx.x; for (int u = tid0; u < (LDS_BYTES - LDS_CTL) / 4; u += NTHR) ((LAS unsigned*)(lds + LDS_CTL))[u] = 0u; }
    __syncthreads();
    XcdBarrier bar; bar.bar = (unsigned*)args.ws + CW_BAR; bar.x = 0; bar.st = nullptr; bar.wave = wave_s;
#if N_LAUNCH_MODE == 1
    bar = xcd_barrier_post((unsigned*)args.ws + CW_BAR, (volatile LAS unsigned*)(lds + LDS_MISC) + 8, wave_s);
#endif
    const int lo = args.ph_lo, hi = args.ph_hi;
#define IN(k) in_phase(lo, hi, (k))
#define PROBE_SPIN(k) do { if ((PROBE_MASK >> (k)) & 1) { const unsigned long long t1_ = __builtin_amdgcn_s_memrealtime(), dt_ = t1_ - ph_t0; \
        while (__builtin_amdgcn_s_memrealtime() - t1_ < dt_) __builtin_amdgcn_s_sleep(8); } } while (0)
#if N_LAUNCH_MODE == 1
#define SEAM(k) do { PROBE_SPIN(k); if (IN(k) && IN((k) + 1)) { xcd_barrier(bar); if ((PROBE_MASK >> 20) & 1) xcd_barrier(bar); } } while (0)
#else
#define SEAM(k) do { } while (0)
#endif
#define PH_BEGIN unsigned char* ws = launder_s(args.ws); const Ctx A{InTab{(const float* const*)(ws + O_PTAB)}, (float*)(GAS float*)args.out, ws}; const int tid = (launder_i(wave_s) << 6) | (int)__builtin_amdgcn_mbcnt_hi(~0u, __builtin_amdgcn_mbcnt_lo(~0u, (unsigned)launder_v(0))); \
    const int G = launder_i((int)gridDim.x), bid = launder_i((int)blockIdx.x); \
    const int lane = tid & 63, wave = __builtin_amdgcn_readfirstlane(tid >> 6); const int vcu = (G % 8 == 0) ? (bid % 8) * (G / 8) + bid / 8 : bid; \
    const int gw = vcu * NWAVES + wave, NGW = G * NWAVES; (void)lane; (void)gw; (void)NGW; (void)ws; \
    const unsigned long long ph_t0 = PROBE_MASK ? __builtin_amdgcn_s_memrealtime() : 0ull; (void)ph_t0;

    if (IN(0)) {
        if (xb_thread0(wave_s)) { const float** tab = (const float**)(args.ws + O_PTAB);
#pragma unroll
            for (int i = 0; i < 28; ++i) tab[i] = args.in[i]; }
        asm volatile("s_waitcnt vmcnt(0)" ::: "memory"); __syncthreads();
        PH_BEGIN; phase_prologue(A, lds, vcu, G, tid); SEAM(0); }

    for (int l = 0; l < 2; ++l) {
        const int pb = l ? 9 : 1;
        if (IN(pb)) {
            PH_BEGIN;
            const bool tail = (G == 256), tail_first = tail && bid < 192 && ((bid >> 3) & 1) == 0;
            SchedDense S{(const bf16_t*)(ws + O_XB), (const bf16_t*)(ws + O_WIN + l * SZ_WIN1), 1024, 1024, 64, NIN / 256, G, bid, tail ? 6 * 256 : 0};
            EpiInProj E{(bf16_t*)(ws + O_P), (bf16_t*)(ws + O_GATES), (const float*)(ws + O_SSQ), A.in[I_BGATE] + l * 3072, (float*)(ws + O_RSP)};
            SchedInTail S2{(const bf16_t*)(ws + O_XB), (const bf16_t*)(ws + O_WIN + l * SZ_WIN1), G, bid}; EpiInProjH E2{E};
            if (tail_first) gemm_run<9, false, true>(lds, S2, E2, 1024, 1024, tid);
            gemm_run<0>(lds, S, E, 1024, 1024, tid);
            if (tail && !tail_first) gemm_run<10, false, true>(lds, S2, E2, 1024, 1024, tid);
            SEAM(pb);
        }
        if (IN(pb + 1)) {
            PH_BEGIN;
            for (int it = bid; it < 256; it += G) post_item<(NAIVE_GLA != 0)>(A, l, it, lds, tid);
            __syncthreads();
            SchedUp S{(const bf16_t*)(ws + O_P), (const bf16_t*)(ws + O_WQUP + l * SZ_WQUP1), (const bf16_t*)(ws + O_WKVUP + l * SZ_WKVUP1), G, bid};
            EpiUpProj E{(const float*)(ws + O_RSP), (bf16_t*)(ws + O_QB), (bf16_t*)(ws + O_KNOPE), (bf16_t*)(ws + O_VB)};
            gemm_run<1>(lds, S, E, 256, PW, tid);
            SEAM(pb + 1);
        }
        if (IN(pb + 2)) {
            PH_BEGIN;
            unsigned* qh = (unsigned*)ws + CW_Q + 64 * l; LAS unsigned* slot = (LAS unsigned*)(lds + LDS_CTL + 64);
            constexpr int NGLA = NAIVE_GLA ? 32 : 64;
            for (;;) {
                __syncthreads();
                if (tid == 0) *slot = __hip_atomic_fetch_add(qh, 1u, __ATOMIC_RELAXED, __HIP_MEMORY_SCOPE_AGENT);
                __syncthreads();
                const int u = (int)*slot;
                const int NCI = l == 0 ? 80 : 140, NCT = l == 0 ? 80 : 140;
                if (u >= NGLA + 1024 + NCI + NCT) break;
                int v = u - NGLA, ci = -1;
                if (v >= 1024 + NCI) ci = v - 1024;
                else if (v >= 0 && NCI > 0) { const int c0 = (v * NCI) / (1024 + NCI), c1 = ((v + 1) * NCI) / (1024 + NCI); if (c1 > c0) ci = c0; else v -= c0; }
                if (ci >= 0) { conv_unit0(A, lds, l, ci, wave, lane); continue; }
#if NAIVE_GLA
                if (u < NGLA) gla_naive_unit(A, l, u >> 2, u & 3, lds, tid);
#else
                if (u < NGLA) gla::unit(A, u >> 3, (u >> 1) & 3, u & 1, lds, tid);
#endif
#if NAIVE_ATTN
                else if (v < 512) { attn_naive_unit<1>(A, v >> 6, (v >> 3) & 7, v & 7, lds, tid); }
                else { v -= 512; attn_naive_unit<0>(A, v >> 6, (v >> 3) & 7, v & 7, lds, tid); }
#else
                else if (v < 512) { const int b_ = v >> 6, h_ = (v >> 3) & 7, qb_ = v & 7;
                    att96::attn_unit<8>(b_, h_, qb_, (const att96::bf16*)(ws + O_QB), (const att96::bf16*)(ws + O_KNOPE) + h_ * 64, (const att96::bf16*)(ws + O_KROPE), (const att96::bf16*)(ws + O_VB) + h_ * 64,
                                        (att96::bf16*)(ws + O_YB), (const float*)(ws + O_TABB), (char*)lds, tid); }
                else { v -= 512; const int b_ = v >> 6, h_ = (v >> 3) & 7, qb_ = v & 7;
                    att64::attn_unit<8>(b_, h_, qb_, (const att64::bf16*)(ws + O_QA), (const att64::bf16*)(ws + O_KA) + (h_ >> 2) * 64, (const att64::bf16*)(ws + O_VA) + (h_ >> 2) * 64,
                                        (att64::bf16*)(ws + O_YA), (char*)lds, tid); }
#endif
            }
            SEAM(pb + 2);
        }
        if (IN(pb + 3)) {
            PH_BEGIN;
#if !NAIVE_GLA
            gla::combine_phase(A, l, gw, NGW, lane);
#endif
            SEAM(pb + 3);
        }
        if (IN(pb + 4)) {
            PH_BEGIN;
            SchedMerge S{(const bf16_t*)(ws + O_YA), (const bf16_t*)(ws + O_WP + l * 3 * SZ_WP1), G, bid};
            EpiMergeR E{(const bf16_t*)(ws + O_GATES), (bf16_t*)(ws + O_MB)};
            gemm_run<2>(lds, S, E, 512, 512, tid);
            SEAM(pb + 4);
        }
        if (IN(pb + 5)) {
            PH_BEGIN;
            SchedDense S{(const bf16_t*)(ws + O_MB), (const bf16_t*)(ws + O_WOUT + l * SZ_WOUT1), 1024, 1024, 64, 4, G, bid};
            EpiResid E{(bf16_t*)(ws + O_XB), (float*)(ws + O_SSQ)};
            gemm_run<3>(lds, S, E, 1024, 1024, tid);
            SEAM(pb + 5);
        }
        if (l == 0) {
            if (IN(7)) {
                PH_BEGIN;
                SchedDense S{(const bf16_t*)(ws + O_XB), (const bf16_t*)(ws + O_WFFGU), 1024, 1024, 64, 2 * DFF / 256, G, bid};
                EpiSwiGLU E{(const float*)(ws + O_SSQ), nullptr, (bf16_t*)(ws + O_HID), DFF};
                gemm_run<4>(lds, S, E, 1024, 1024, tid);
                SEAM(7);
            }
            if (IN(8)) {
                PH_BEGIN;
                SchedDense S{(const bf16_t*)(ws + O_HID), (const bf16_t*)(ws + O_WFFD), DFF, DFF, 64, 4, G, bid};
                EpiResid E{(bf16_t*)(ws + O_XB), (float*)(ws + O_SSQ)};
                gemm_run<5>(lds, S, E, DFF, 64, tid, 64, true);
                SEAM(8);
            }
        }
    }
    if (IN(15)) {
        PH_BEGIN;
        for (int blk = bid; blk < 256; blk += G) router_item(A, blk, lds, tid);
        __syncthreads();
        run_transposes<true>(A, lds, gw, NGW, wave, lane);
        SEAM(15);
    }
    if (IN(16)) { PH_BEGIN; positions_phase(A, lds, G, bid, tid); SEAM(16); }
    if (IN(17)) {
        PH_BEGIN; int* mi = (int*)(ws + O_MOEI);
        LAS int* te = (LAS int*)(lds + LDS_RING + 4096);
        __syncthreads(); if (tid < MAXTILES + 8) te[tid] = mi[MI_TILEE + tid]; __syncthreads();
        SchedMoe S{(const bf16_t*)(ws + O_XB), (const bf16_t*)(ws + O_WEGU), te, mi + MI_ROWTOK, 1024, 1024, 2 * DFE / 256, G, bid, (size_t)2 * DFE * 1024, true, te[MAXTILES], 0};
        EpiSwiGLU E{(const float*)(ws + O_SSQ), mi + MI_ROWSC, (bf16_t*)(ws + O_HIDS), DFE};
        gemm_run<6, true>(lds, S, E, 1024, 1024, tid);
        SEAM(17);
    }
    if (IN(18)) {
        PH_BEGIN; int* mi = (int*)(ws + O_MOEI);
        LAS int* te = (LAS int*)(lds + LDS_RING + 4096);
        __syncthreads(); if (tid < MAXTILES + 8) te[tid] = mi[MI_TILEE + tid]; if (tid >= 256 && tid < 258) te[MAXTILES + 8 + (tid - 256)] = mi[MI_SPLIT + MAXTILES * 4 + (tid - 256)]; __syncthreads();
        const int nmain_ = te[MAXTILES + 8], nsplit_ = te[MAXTILES + 9];
        SchedMoe S{(const bf16_t*)(ws + O_HIDS), (const bf16_t*)(ws + O_WED), te, mi + MI_ROWTOK, DFE, DFE, 4, G, bid, (size_t)1024 * DFE, false, te[MAXTILES], nmain_};
        EpiMoeDown E{(const float*)(ws + O_MOEI) + MI_ROWW, (bf16_t*)(ws + O_OUTS)};
        gemm_run<7>(lds, S, E, DFE, 64, tid, 64, true);
        {
            SchedMoeSlice S2{(const bf16_t*)(ws + O_HIDS), (const bf16_t*)(ws + O_WED), te, te[MAXTILES], nmain_, nsplit_, G, bid};
            EpiSlab E2{(float*)(ws + O_SLAB)};
            gemm_run<8>(lds, S2, E2, DFE / KSPLIT, 64, tid, 64, true);
        }
        SEAM(18);
    }
    if (IN(19)) { PH_BEGIN; final_phase(A, gw, NGW, lane); PROBE_SPIN(19); }
#undef IN
#undef SEAM
#undef PH_BEGIN
}

extern "C" void kernel_launch(void* const* d_in, const int* in_sizes, int n_in, void* d_out, int out_size, void* d_ws, size_t ws_size, hipStream_t stream) {
    static int grid = 0;
    if (grid == 0) {
        if (n_in != 28 || out_size != M * D || ws_size < WS_NEED) { fprintf(stderr, "kernel_launch: unexpected shapes (n_in %d out %d ws %zu need %zu)\n", n_in, out_size, ws_size, (size_t)WS_NEED); grid = -1; return; }
        int dev = 0, cus = 0;
        if (hipGetDevice(&dev) != hipSuccess || hipDeviceGetAttribute(&cus, hipDeviceAttributeMultiprocessorCount, dev) != hipSuccess) { grid = -1; return; }
        if (hipFuncSetAttribute((const void*)mega_fwd, hipFuncAttributeMaxDynamicSharedMemorySize, LDS_BYTES) != hipSuccess) { grid = -1; return; }
        int per_cu = 0;
        if (hipOccupancyMaxActiveBlocksPerMultiprocessor(&per_cu, (const void*)mega_fwd, NTHR, LDS_BYTES) != hipSuccess || per_cu < 1) { fprintf(stderr, "kernel_launch: occupancy query says %d\n", per_cu); }
        (void)hipGetLastError();
        grid = cus;
    }
    if (grid < 0) return;
    (void)hipMemsetAsync(d_ws, 0, CTL_BYTES, stream);
    Args a{};
    for (int i = 0; i < 28; ++i) a.in[i] = (const float*)d_in[i];
    a.out = (float*)d_out; a.ws = (unsigned char*)d_ws; a.li = 0; a.pad = 0;
#if N_LAUNCH_MODE == 1
    a.ph_lo = 0; a.ph_hi = NPHASE;
    hipLaunchKernelGGL(mega_fwd, dim3(grid), dim3(NTHR), LDS_BYTES, stream, a);
#else
    for (int p = 0; p < NPHASE; ++p) { a.ph_lo = p; a.ph_hi = p + 1; hipLaunchKernelGGL(mega_fwd, dim3(grid), dim3(NTHR), LDS_BYTES, stream, a); }
#endif
}
```

```cpp
#include <hip/hip_runtime.h>
#include <cstdio>
#include <cstdint>

#ifndef N_LAUNCH_MODE
#define N_LAUNCH_MODE 1
#endif
#ifndef PROBE_MASK
#define PROBE_MASK 0
#endif
#ifndef NAIVE_GEMM
#define NAIVE_GEMM 0
#endif
#ifndef NAIVE_ATTN
#define NAIVE_ATTN 0
#endif
#ifndef NAIVE_GLA
#define NAIVE_GLA 0
#endif

#define LAS __attribute__((address_space(3)))
#define GAS __attribute__((address_space(1)))
typedef unsigned short bf16_t;
typedef short bf16x8 __attribute__((ext_vector_type(8)));
typedef float f32x4 __attribute__((ext_vector_type(4)));
typedef unsigned u32x4 __attribute__((ext_vector_type(4)));
typedef unsigned u32x2 __attribute__((ext_vector_type(2)));

constexpr int M = 16384, D = 1024, T = 2048, NBATCH = 8, NWAVES = 8, NTHR = 512;
constexpr float EPS = 1e-6f;
constexpr int PW = 2304;
constexpr int PC_AQ = 0, PC_AK = 512, PC_SMALL = 640, PC_BCQ = 768, PC_BCKV = 1024, PC_CQ = 1280, PC_CK = 1792;
constexpr int NIN = 6656;
constexpr int DFF = 2816, DFE = 3584, NEXP = 8;
constexpr int MAXTILES = 136, MAXROWS = MAXTILES * 256;
constexpr float LOG2E = 1.4426950408889634f;
constexpr float C2A = 0.125f * LOG2E;
constexpr float C2B = 0.10206207261596575f * LOG2E;
constexpr float GLA_QSCALE = 0.08838834764831845f;

constexpr size_t CTL_BYTES = 1u << 20;
constexpr size_t SZ_WIN1 = (size_t)NIN * 1024 * 2, SZ_WQUP1 = 768 * 256 * 2, SZ_WKVUP1 = 1024 * 256 * 2, SZ_WP1 = 1024 * 512 * 2, SZ_WOUT1 = 1024 * 1024 * 2;
constexpr size_t O_WIN = CTL_BYTES;
constexpr size_t O_WQUP = O_WIN + 2 * SZ_WIN1;
constexpr size_t O_WKVUP = O_WQUP + 2 * SZ_WQUP1;
constexpr size_t O_WP = O_WKVUP + 2 * SZ_WKVUP1;
constexpr size_t O_WOUT = O_WP + 6 * SZ_WP1;
constexpr size_t O_WFFGU = O_WOUT + 2 * SZ_WOUT1;
constexpr size_t O_WFFD = O_WFFGU + (size_t)2 * DFF * 1024 * 2;
constexpr size_t O_TABA = O_WFFD + (size_t)1024 * DFF * 2;
constexpr size_t O_TABB = O_TABA + (size_t)T * 64 * 4;
constexpr size_t O_XB = O_TABB + (size_t)T * 32 * 4;
constexpr size_t O_SSQ = O_XB + (size_t)M * 1024 * 2;
constexpr size_t O_RSP = O_SSQ + (size_t)M * 16 * 4;
constexpr size_t O_PTAB = O_RSP + (size_t)M * 32 * 4;
constexpr size_t O_MOEI = O_PTAB + 256;
constexpr size_t SZ_MOEI = 2u << 20;
constexpr size_t O_R = O_MOEI + SZ_MOEI;
constexpr size_t O_P = O_R;
constexpr size_t O_VA = O_P + (size_t)M * PW * 2;
constexpr size_t O_VG = O_VA + (size_t)M * 128 * 2;
constexpr size_t O_GATES = O_VG + (size_t)M * 1024 * 2;
constexpr size_t O_QA = O_GATES + (size_t)M * 3072 * 2;
constexpr size_t O_KA = O_QA + (size_t)M * 512 * 2;
constexpr size_t O_KROPE = O_KA + (size_t)M * 128 * 2;
constexpr size_t O_QB = O_KROPE + (size_t)M * 32 * 2;
constexpr size_t O_KNOPE = O_QB + (size_t)M * 768 * 2;
constexpr size_t O_VB = O_KNOPE + (size_t)M * 512 * 2;
constexpr size_t O_QT = O_VB + (size_t)M * 512 * 2;
constexpr size_t O_DEC = O_QT + (size_t)4 * M * 512 * 2;
constexpr size_t O_YA = O_DEC + (size_t)2 * 256 * 512 * 4;
constexpr size_t O_YB = O_YA + (size_t)M * 512 * 2;
constexpr size_t O_YC = O_YB + (size_t)M * 512 * 2;
constexpr size_t O_OCB = O_YC + (size_t)M * 512 * 2;
constexpr size_t O_MIX_END = O_OCB + (size_t)M * 512 * 2;
constexpr size_t O_PART = O_QT;
constexpr size_t O_MB = O_QT;
constexpr size_t O_HID = O_P;
constexpr size_t O_WEGU = O_R;
constexpr size_t O_WED = O_WEGU + (size_t)NEXP * 2 * DFE * 1024 * 2;
constexpr size_t O_HIDS = O_WED + (size_t)NEXP * 1024 * DFE * 2;
constexpr size_t O_MOE_END = O_HIDS + (size_t)MAXROWS * DFE * 2;
constexpr size_t O_OUTS = O_WEGU;
constexpr int KSPLIT = 4, MAXSPLIT = 32;
constexpr size_t O_SLAB = O_OUTS + (size_t)MAXROWS * 1024 * 2;
static_assert(O_SLAB + (size_t)MAXSPLIT * KSPLIT * 65536 * 4 <= O_WED, "slabs overlay");
constexpr size_t WS_NEED = O_MIX_END > O_MOE_END ? O_MIX_END : O_MOE_END;
static_assert(WS_NEED <= 531851264ull, "workspace map exceeds the guaranteed ws_size");
static_assert((size_t)M * 1024 * 4 <= (size_t)4 * M * 512 * 2, "PART overlay");
static_assert((size_t)MAXROWS * 1024 * 2 <= (size_t)NEXP * 2 * DFE * 1024 * 2, "OUTS overlay");
constexpr int MI_CNT = 0;
constexpr int MI_TOKE = 4096;
constexpr int MI_TOKR = MI_TOKE + M;
constexpr int MI_TOKW = MI_TOKR + M;
constexpr int MI_TOKPOS = MI_TOKW + 2 * M;
constexpr int MI_ROWTOK = MI_TOKPOS + 2 * M;
constexpr int MI_ROWW = MI_ROWTOK + MAXROWS;
constexpr int MI_TILEE = MI_ROWW + MAXROWS;
constexpr int MI_ROWSC = MI_TILEE + MAXTILES + 8;
constexpr int MI_SPLIT = MI_ROWSC + MAXROWS;
constexpr int MI_END = MI_SPLIT + MAXTILES * 4 + 8;
static_assert((size_t)MI_END * 4 <= SZ_MOEI, "moe lists");

constexpr int CW_TMO = 0;
constexpr int CW_Q = 1024;
constexpr int CW_BAR = 4096;

constexpr int LDS_RING = 131072, LDS_CTL = 145408, LDS_MISC = LDS_CTL + 320, LDS_BYTES = 147456;

__device__ __forceinline__ float bf2f(unsigned v) { return __uint_as_float(v << 16); }
__device__ __forceinline__ unsigned f2bf(float f) { typedef float f2_ __attribute__((ext_vector_type(2))); typedef __bf16 b2_ __attribute__((ext_vector_type(2))); f2_ v = {f, 0.f}; b2_ b = __builtin_convertvector(v, b2_); return __builtin_bit_cast(unsigned, b) & 0xffffu; }
typedef float f32x2_t __attribute__((ext_vector_type(2))); typedef __bf16 bf16x2_t __attribute__((ext_vector_type(2)));
__device__ __forceinline__ unsigned pk2(float lo, float hi) { f32x2_t v = {lo, hi}; bf16x2_t b = __builtin_convertvector(v, bf16x2_t); return __builtin_bit_cast(unsigned, b); }
__device__ __forceinline__ void unpack8(const u32x4 w, float (&f)[8]) {
    f[0] = __uint_as_float(w.x << 16); f[1] = __uint_as_float(w.x & 0xffff0000u); f[2] = __uint_as_float(w.y << 16); f[3] = __uint_as_float(w.y & 0xffff0000u);
    f[4] = __uint_as_float(w.z << 16); f[5] = __uint_as_float(w.z & 0xffff0000u); f[6] = __uint_as_float(w.w << 16); f[7] = __uint_as_float(w.w & 0xffff0000u);
}
__device__ __forceinline__ u32x4 pack8(const float (&f)[8]) { u32x4 w; w.x = pk2(f[0], f[1]); w.y = pk2(f[2], f[3]); w.z = pk2(f[4], f[5]); w.w = pk2(f[6], f[7]); return w; }
__device__ __forceinline__ void load8(const bf16_t* p, float (&f)[8]) { unpack8(*(const u32x4*)p, f); }
__device__ __forceinline__ void store8(bf16_t* p, const float (&f)[8]) { *(u32x4*)p = pack8(f); }
__device__ __forceinline__ void ld8f(const float* p, float (&f)[8]) { const f32x4 a = *(const f32x4*)p, b = *(const f32x4*)(p + 4); f[0] = a.x; f[1] = a.y; f[2] = a.z; f[3] = a.w; f[4] = b.x; f[5] = b.y; f[6] = b.z; f[7] = b.w; }
template <int CTRL> __device__ __forceinline__ float dppf(float v) { return __int_as_float(__builtin_amdgcn_update_dpp(0, __float_as_int(v), CTRL, 0xF, 0xF, true)); }
template <int MASK> __device__ __forceinline__ float shx(float v) { static_assert(MASK > 0 && MASK < 32, "shx: 1..31");
    if constexpr (MASK == 1) return dppf<0xB1>(v);
    else if constexpr (MASK == 2) return dppf<0x4E>(v);
    else return __int_as_float(__builtin_amdgcn_ds_swizzle(__float_as_int(v), 0x1f | (MASK << 10))); }
__device__ __forceinline__ float sum8(float v) { v += dppf<0xB1>(v); v += dppf<0x4E>(v); v += dppf<0x141>(v); return v; }
__device__ __forceinline__ float sum16(float v) { v = sum8(v); v += dppf<0x140>(v); return v; }
__device__ __forceinline__ float add_row_pair(float v) { auto r = __builtin_amdgcn_permlane16_swap(__float_as_uint(v), __float_as_uint(v), false, false); return __uint_as_float(r[0]) + __uint_as_float(r[1]); }
__device__ __forceinline__ float sum_halves(float v) { auto r = __builtin_amdgcn_permlane32_swap(__float_as_uint(v), __float_as_uint(v), false, false); return __uint_as_float(r[0]) + __uint_as_float(r[1]); }
__device__ __forceinline__ float other_half(float v, int hi) { auto r = __builtin_amdgcn_permlane32_swap(__float_as_uint(v), __float_as_uint(v), false, false); return __uint_as_float(hi ? r[0] : r[1]); }
__device__ __forceinline__ float wave_sum(float v) { return sum_halves(add_row_pair(sum16(v))); }
__device__ __forceinline__ float row_rstd16(const float* ssq, int row) {
    const f32x4* p = (const f32x4*)(ssq + (size_t)row * 16);
    const f32x4 a = p[0], b = p[1], c = p[2], d = p[3];
    const float s = ((a.x + a.y) + (a.z + a.w)) + ((b.x + b.y) + (b.z + b.w)) + ((c.x + c.y) + (c.z + c.w)) + ((d.x + d.y) + (d.z + d.w));
    return rsqrtf(s * (1.0f / 1024.0f) + EPS);
}
__device__ __forceinline__ float sigmoidf_(float x) { return __builtin_amdgcn_rcpf(1.0f + __builtin_amdgcn_exp2f(x * -LOG2E)); }

#define XB_TMO      128
#define XB_XCNT(j)  (256  + 64 * (j))
#define XB_XSUB(j)  (1280 + 64 * (j))
#define XB_XGEN(j)  (2304 + 64 * (j))
#define XB_TOP      3328
#define XB_TOPGEN   3392
#define XCD_BAR_WORDS 3456
#define XB_SPIN_CAP (1u << 18)
__device__ __forceinline__ unsigned xb_ld(unsigned* p)              { return __hip_atomic_load(p, __ATOMIC_RELAXED, __HIP_MEMORY_SCOPE_AGENT); }
__device__ __forceinline__ unsigned xb_add(unsigned* p, unsigned v) { return __hip_atomic_fetch_add(p, v, __ATOMIC_RELAXED, __HIP_MEMORY_SCOPE_AGENT); }
__device__ __forceinline__ unsigned xb_xcc_id() { return (unsigned)__builtin_amdgcn_s_getreg((3 << 11) | 20) & 0xFu; }
#define XB_SPIN(cond, bar) do { unsigned _sp = 0; while (cond) { __builtin_amdgcn_s_sleep(1); \
    if ((++_sp & 255u) == 0u) { if (xb_ld(&(bar)[XB_TMO])) break; if (_sp > XB_SPIN_CAP) { atomicAdd(&(bar)[XB_TMO], 1u); break; } } } } while (0)
struct XcdBarrier { unsigned* bar; unsigned x; volatile LAS unsigned* st; int wave; };
__device__ __forceinline__ bool xb_thread0(int wave) { unsigned z = 0u; asm volatile("" : "+v"(z)); return wave == 0 && __builtin_amdgcn_mbcnt_hi(~0u, __builtin_amdgcn_mbcnt_lo(~0u, z)) == 0u; }
__device__ __forceinline__ XcdBarrier xcd_barrier_post(unsigned* bar, volatile LAS unsigned* st, int wave) {
    XcdBarrier b; b.bar = bar; b.x = xb_xcc_id(); b.st = st; b.wave = wave;
    if (xb_thread0(wave)) (void)xb_add(&bar[XB_XCNT(b.x)], 1u);
    return b;
}
__device__ __forceinline__ void xcd_barrier_complete(unsigned* bar, unsigned x, unsigned& nloc, unsigned& nx) {
    const unsigned G = gridDim.x * gridDim.y * gridDim.z;
    unsigned sum, cnt, mine, sp = 0u;
    for (;;) {
        sum = 0u; cnt = 0u; mine = 0u;
#pragma unroll
        for (unsigned j = 0; j < 16; ++j) { const unsigned c = xb_ld(&bar[XB_XCNT(j)]); sum += c; cnt += (c > 0u) ? 1u : 0u; mine = (j == x) ? c : mine; }
        if (sum == G) break;
        __builtin_amdgcn_s_sleep(1);
        if ((++sp & 255u) == 0u) { if (xb_ld(&bar[XB_TMO])) break; if (sp > XB_SPIN_CAP) { atomicAdd(&bar[XB_TMO], 1u); break; } }
    }
    nloc = mine > 0u ? mine : 1u; nx = cnt > 0u ? cnt : 1u;
}
__device__ __forceinline__ void xcd_barrier(const XcdBarrier& b) {
    asm volatile("s_waitcnt vmcnt(0)" ::: "memory");
    __syncthreads();
    if (xb_thread0(b.wave)) {
        unsigned* bar = b.bar;
        __builtin_amdgcn_s_waitcnt(0);
        unsigned nloc = b.st[0], nx = b.st[1];
        if (nloc == 0u) { xcd_barrier_complete(bar, b.x, nloc, nx); b.st[0] = nloc; b.st[1] = nx; }
        const unsigned old = xb_add(&bar[XB_XSUB(b.x)], 1u);
        const unsigned gen = old / nloc;
        if (old + 1u == (gen + 1u) * nloc) {
            __builtin_amdgcn_fence(__ATOMIC_RELEASE, "agent");
            asm volatile("s_waitcnt vmcnt(0)" ::: "memory");
            const unsigned og = xb_add(&bar[XB_TOP], 1u);
            const unsigned tg = og / nx;
            if (og + 1u == (tg + 1u) * nx) xb_add(&bar[XB_TOPGEN], 1u);
            else XB_SPIN(xb_ld(&bar[XB_TOPGEN]) == tg, bar);
            __builtin_amdgcn_fence(__ATOMIC_ACQUIRE, "agent");
            xb_add(&bar[XB_XGEN(b.x)], 1u);
            asm volatile("s_waitcnt vmcnt(0)" ::: "memory");
        } else {
            XB_SPIN(xb_ld(&bar[XB_XGEN(b.x)]) == gen, bar);
            __builtin_amdgcn_fence(__ATOMIC_ACQUIRE, "agent");
            asm volatile("s_waitcnt vmcnt(0)" ::: "memory");
        }
    }
    __syncthreads();
}

struct Args { const float* in[28]; float* out; unsigned char* ws; int ph_lo, ph_hi, li, pad; };
struct InTab { const float* const* t; __device__ __forceinline__ const float* operator[](int i) const { return (const float*)(const GAS float*)(uintptr_t)(((const GAS unsigned long long*)t)[i]); } };
struct Ctx { InTab in; float* out; unsigned char* ws; };
enum { I_X = 0, I_WIN, I_BGATE, I_GMIX, I_GAQ, I_GAK, I_GBQ, I_WBQUP, I_GBKV, I_WBKVUP, I_WCAF, I_BCAF, I_WCAB, I_BCAB, I_GCOUT, I_WPA, I_WPB, I_WPC, I_WOUT, I_GFFN,
       I_WFFG, I_WFFU, I_WFFD, I_WROUTER, I_WEG, I_WEU, I_WED, I_GFINAL };

struct GUnit { const bf16_t* A; const bf16_t* B; const int* rows; int pm, pn, aux; };
__device__ __forceinline__ void tile_order(int L, int nM, int nN, int& pm, int& pn) {
    const int nwg = nM * nN; int wgid = L;
    { const int q = nwg / 8, r = nwg % 8, xcd = wgid % 8, off = wgid / 8; wgid = (xcd < r ? xcd * (q + 1) : r * (q + 1) + (xcd - r) * q) + off; }
    const int nig = 8 * nN, gid = wgid / nig, fm = gid * 8, gsz = (nM - fm) < 8 ? (nM - fm) : 8;
    pm = fm + ((wgid % nig) % gsz); pn = (wgid % nig) / gsz;
}
struct SchedDense {
    const bf16_t* A; const bf16_t* B; int lda, K, nM, nN, G, c; int lim = 0;
    __device__ __forceinline__ bool next(int i, GUnit& u) const {
        const long L = (long)i * G + c; if (L >= (long)nM * nN || (lim && L >= lim)) return false;
        tile_order((int)L, nM, nN, u.pm, u.pn);
        u.A = A + (size_t)u.pm * 256 * lda; u.B = B + (size_t)u.pn * 256 * K; u.rows = nullptr; u.aux = 0; return true;
    }
};
struct SchedInTail {
    const bf16_t* A; const bf16_t* B; int G, c;
    __device__ __forceinline__ bool next(int i, GUnit& u) const {
        const int s = i * G + c; if (s >= 192) return false;
        u.pm = s & 63; u.pn = 48 + (s >> 6); u.aux = 0; u.A = A + (size_t)u.pm * 256 * 1024; u.B = B + (size_t)u.pn * 128 * 1024; u.rows = nullptr; return true;
    }
};
struct SchedUp {
    const bf16_t* P; const bf16_t* Wq; const bf16_t* Wkv; int G, c;
    __device__ __forceinline__ bool next(int i, GUnit& u) const {
        const int L = i * G + c; if (L >= 448) return false;
        if (L < 192) { tile_order(L, 64, 3, u.pm, u.pn); u.aux = 0; u.A = P + (size_t)u.pm * 256 * PW + PC_BCQ; u.B = Wq + (size_t)u.pn * 256 * 256; }
        else { tile_order(L - 192, 64, 4, u.pm, u.pn); u.aux = 1; u.A = P + (size_t)u.pm * 256 * PW + PC_BCKV; u.B = Wkv + (size_t)u.pn * 256 * 256; }
        u.rows = nullptr; return true;
    }
};
struct SchedMerge {
    const bf16_t* Y0; const bf16_t* W; int G, c;
    __device__ __forceinline__ bool next(int i, GUnit& u) const {
        const int tile = (i / 3) * G + c, br = i % 3; if (tile >= 256) return false;
        tile_order(tile, 64, 4, u.pm, u.pn); u.aux = br;
        u.A = Y0 + (size_t)br * M * 512 + (size_t)u.pm * 256 * 512; u.B = W + (size_t)br * 1024 * 512 + (size_t)u.pn * 256 * 512; u.rows = nullptr; return true;
    }
};
struct SchedMergeH {
    const bf16_t* Y0; const bf16_t* W; int G, c;
    __device__ __forceinline__ bool next(int i, GUnit& u) const {
        const int tile = (i / 3) * G + c, br = i % 3; if (tile >= 512) return false;
        tile_order(tile, 64, 8, u.pm, u.pn); u.aux = br;
        u.A = Y0 + (size_t)br * M * 512 + (size_t)u.pm * 256 * 512; u.B = W + (size_t)br * 1024 * 512 + (size_t)u.pn * 128 * 512; u.rows = nullptr; return true;
    }
};
struct SchedMoeSlice {
    const bf16_t* A; const bf16_t* B; const LAS int* tile_e; int nM, nmain, nsplit; int G, c;
    __device__ __forceinline__ bool next(int i, GUnit& u) const {
        const int s = i * G + c; if (s >= nsplit * KSPLIT) return false;
        tile_order(nmain + s / KSPLIT, nM, 4, u.pm, u.pn); const int e = tile_e[u.pm], j = s % KSPLIT; u.aux = s;
        const size_t koff = (size_t)j * (DFE / KSPLIT / 64) * 256 * 64;
        u.A = A + (size_t)u.pm * 256 * DFE + koff; u.B = B + (size_t)e * 1024 * DFE + (size_t)u.pn * 256 * DFE + koff; u.rows = nullptr; return true;
    }
};
struct SchedMoe {
    const bf16_t* A; const bf16_t* B; const LAS int* tile_e; const int* rowtok; int lda, K, nN, G, c; size_t bstride; bool gather; int nM, lim;
    __device__ __forceinline__ bool next(int i, GUnit& u) const {
        const long L = (long)i * G + c; if (L >= (long)nM * nN || (lim && L >= lim)) return false;
        tile_order((int)L, nM, nN, u.pm, u.pn); const int e = tile_e[u.pm]; u.aux = e;
        u.B = B + (size_t)e * bstride + (size_t)u.pn * 256 * K;
        if (gather) { u.A = A; u.rows = rowtok + u.pm * 256; } else { u.A = A + (size_t)u.pm * 256 * lda; u.rows = nullptr; }
        return true;
    }
};

struct NoPre {};
constexpr int INPROJ_PERM_TILES = 24;
struct EpiInProj {
    bf16_t* P; bf16_t* GATES; const float* ssq; const float* bgate; float* rsp;
    static constexpr bool CARRY = false; static constexpr bool HAS_SSQ = false, HAS_SCALE = true; typedef NoPre Pre;
    __device__ __forceinline__ float row_scale(const GUnit& u, int r) const { return row_rstd16(ssq, u.pm * 256 + r); }
    __device__ __forceinline__ Pre load(const GUnit&, int, int) const { return Pre{}; }
    __device__ __forceinline__ void half(int H, int row, int c, const float (&v)[8], float rstd) const {
        float o[8];
        if (H >= 26 && H < 50) {
            const int gc = (H - 26) * 128 + c; const f32x4 b0 = *(const f32x4*)(bgate + gc), b1 = *(const f32x4*)(bgate + gc + 4);
            o[0] = sigmoidf_(v[0] * rstd + b0.x); o[1] = sigmoidf_(v[1] * rstd + b0.y); o[2] = sigmoidf_(v[2] * rstd + b0.z); o[3] = sigmoidf_(v[3] * rstd + b0.w);
            o[4] = sigmoidf_(v[4] * rstd + b1.x); o[5] = sigmoidf_(v[5] * rstd + b1.y); o[6] = sigmoidf_(v[6] * rstd + b1.z); o[7] = sigmoidf_(v[7] * rstd + b1.w);
            store8(GATES + (size_t)row * 3072 + gc, o);
        } else if (H < 51) {
#pragma unroll
            for (int j = 0; j < 8; ++j) o[j] = v[j] * rstd;
            const bool inP = H < 18, inG = H < 26;
            bf16_t* base = inP ? P + H * 128 : (inG ? (bf16_t*)((unsigned char*)P + (O_VG - O_P)) + (H - 18) * 128 : (bf16_t*)((unsigned char*)P + (O_VA - O_P)));
            const int pitch = inP ? PW : (inG ? 1024 : 128);
            store8(base + (size_t)row * pitch + c, o);
        }
    }
    __device__ __forceinline__ u32x4 val(int H, int c, const float (&v)[8], float rstd) const {
        float o[8];
        if (H >= 26) {
            const int gc = (H - 26) * 128 + c; const f32x4 b0 = *(const f32x4*)(bgate + gc), b1 = *(const f32x4*)(bgate + gc + 4);
            o[0] = sigmoidf_(v[0] * rstd + b0.x); o[1] = sigmoidf_(v[1] * rstd + b0.y); o[2] = sigmoidf_(v[2] * rstd + b0.z); o[3] = sigmoidf_(v[3] * rstd + b0.w);
            o[4] = sigmoidf_(v[4] * rstd + b1.x); o[5] = sigmoidf_(v[5] * rstd + b1.y); o[6] = sigmoidf_(v[6] * rstd + b1.z); o[7] = sigmoidf_(v[7] * rstd + b1.w);
        } else {
#pragma unroll
            for (int j = 0; j < 8; ++j) o[j] = v[j] * rstd;
        }
        return pack8(o);
    }
    __device__ __forceinline__ float apply(const GUnit& u, int r, int c, const float (&v0)[8], const float (&v1)[8], float rstd, const Pre&) const {
        const int row = u.pm * 256 + r;
        if (u.pn < INPROJ_PERM_TILES) {
            const int wc = c >> 5, ch = (wc & 1) * 64 + (c & 31), H = u.pn * 2 + (wc >> 1);
            const u32x4 pk0 = val(H, ch, v0, rstd), pk1 = val(H, ch + 32, v1, rstd);
            const bool odd = (r & 1) != 0;
            const u32x4 snd = odd ? pk0 : pk1; u32x4 rcv;
            rcv.x = (unsigned)__builtin_amdgcn_mov_dpp((int)snd.x, 0xB1, 0xF, 0xF, true); rcv.y = (unsigned)__builtin_amdgcn_mov_dpp((int)snd.y, 0xB1, 0xF, 0xF, true);
            rcv.z = (unsigned)__builtin_amdgcn_mov_dpp((int)snd.z, 0xB1, 0xF, 0xF, true); rcv.w = (unsigned)__builtin_amdgcn_mov_dpp((int)snd.w, 0xB1, 0xF, 0xF, true);
            const u32x4 da = odd ? rcv : pk0, db = odd ? pk1 : rcv;
            const int col = ch + (odd ? 32 : 0);
            bf16_t* d; int pitch;
            if (H >= 26) { d = GATES + (H - 26) * 128 + col; pitch = 3072; }
            else { const bool inP = H < 18; d = (inP ? P + H * 128 : (bf16_t*)((unsigned char*)P + (O_VG - O_P)) + (H - 18) * 128) + col; pitch = inP ? PW : 1024; }
            *(u32x4*)(d + (size_t)(row & ~1) * pitch) = da; *(u32x4*)(d + (size_t)(row | 1) * pitch) = db;
        } else { half(u.pn * 2, row, c, v0, rstd); half(u.pn * 2 + 1, row, c, v1, rstd); }
        if (u.pn == 3 || u.pn == 4) { float s = 0.f;
#pragma unroll
            for (int j = 0; j < 8; ++j) s += (v0[j] * v0[j] + v1[j] * v1[j]);
            rsp[(size_t)row * 32 + (u.pn - 3) * 16 + (c >> 3)] = s * rstd * rstd; }
        return 0.f;
    }
};
struct EpiInProjH {
    EpiInProj e;
    static constexpr bool CARRY = false, HAS_SSQ = false, HAS_SCALE = true; typedef NoPre Pre;
    __device__ __forceinline__ float row_scale(const GUnit& u, int r) const { return e.row_scale(u, r); }
    __device__ __forceinline__ Pre load(const GUnit&, int, int) const { return Pre{}; }
    __device__ __forceinline__ float apply(const GUnit& u, int r, int c, const float (&v0)[8], const float (&)[8], float rstd, const Pre&) const { e.half(u.pn, u.pm * 256 + r, c, v0, rstd); return 0.f; }
};
struct EpiUpProj {
    const float* rsp; bf16_t* QB; bf16_t* KNOPE; bf16_t* VB;
    static constexpr bool CARRY = false; static constexpr bool HAS_SSQ = false, HAS_SCALE = true; typedef NoPre Pre;
    __device__ __forceinline__ float row_scale(const GUnit& u, int r) const {
        const f32x4* p = (const f32x4*)(rsp + (size_t)(u.pm * 256 + r) * 32 + u.aux * 16); float s = 0.f;
#pragma unroll
        for (int j = 0; j < 4; ++j) { const f32x4 a = p[j]; s += (a.x + a.y) + (a.z + a.w); }
        const float rstd = rsqrtf(s * (1.0f / 256.0f) + EPS); return u.aux == 0 ? rstd * C2B : rstd;
    }
    __device__ __forceinline__ Pre load(const GUnit&, int, int) const { return Pre{}; }
    __device__ __forceinline__ float apply(const GUnit& u, int r, int c, const float (&v0)[8], const float (&v1)[8], float rstd, const Pre&) const {
        const int row = u.pm * 256 + r; float o0[8], o1[8];
#pragma unroll
        for (int j = 0; j < 8; ++j) { o0[j] = v0[j] * rstd; o1[j] = v1[j] * rstd; }
        bf16_t* q = (u.aux == 0 ? QB + (size_t)row * 768 + u.pn * 256 : (u.pn < 2 ? KNOPE + (size_t)row * 512 + u.pn * 256 : VB + (size_t)row * 512 + (u.pn - 2) * 256)) + c;
        store8(q, o0); store8(q + 128, o1);
        return 0.f;
    }
};
struct EpiMerge {
    const bf16_t* GATES; bf16_t* PART; bf16_t* MB;
    static constexpr bool CARRY = false; static constexpr bool HAS_SSQ = false, HAS_SCALE = false;
    struct Pre { u32x4 g0, g1, p0, p1; };
    __device__ __forceinline__ float row_scale(const GUnit&, int) const { return 0.f; }
    __device__ __forceinline__ Pre load(const GUnit& u, int r, int c) const {
        const int row = u.pm * 256 + r, col = u.pn * 256 + c; Pre p;
        const bf16_t* g = GATES + (size_t)row * 3072 + u.aux * 1024 + col; p.g0 = *(const u32x4*)g; p.g1 = *(const u32x4*)(g + 128);
        if (u.aux > 0) { const bf16_t* pp = PART + (size_t)row * 1024 + col; p.p0 = *(const u32x4*)pp; p.p1 = *(const u32x4*)(pp + 128); } else { p.p0 = (u32x4){0u, 0u, 0u, 0u}; p.p1 = p.p0; }
        return p;
    }
    __device__ __forceinline__ float apply(const GUnit& u, int r, int c, const float (&v0)[8], const float (&v1)[8], float, const Pre& pre) const {
        const int row = u.pm * 256 + r, col = u.pn * 256 + c, br = u.aux;
        float g[8], p[8], o[8];
        unpack8(pre.g0, g); unpack8(pre.p0, p);
#pragma unroll
        for (int j = 0; j < 8; ++j) o[j] = g[j] * v0[j] + p[j];
        store8((br < 2 ? PART : MB) + (size_t)row * 1024 + col, o);
        unpack8(pre.g1, g); unpack8(pre.p1, p);
#pragma unroll
        for (int j = 0; j < 8; ++j) o[j] = g[j] * v1[j] + p[j];
        store8((br < 2 ? PART : MB) + (size_t)row * 1024 + col + 128, o);
        return 0.f;
    }
};
struct EpiMergeH {
    const bf16_t* GATES; bf16_t* MB;
    static constexpr bool CARRY = true, HAS_SSQ = false, HAS_SCALE = false;
    struct Pre { u32x4 g; };
    __device__ __forceinline__ float row_scale(const GUnit&, int) const { return 0.f; }
    __device__ __forceinline__ Pre load(const GUnit& u, int r, int c) const { Pre p; p.g = *(const u32x4*)(GATES + (size_t)(u.pm * 256 + r) * 3072 + u.aux * 1024 + u.pn * 128 + c); return p; }
    __device__ __forceinline__ float apply_carry(const GUnit& u, int r, int c, const float (&v0)[8], f32x4& c0, f32x4& c1, const Pre& pre) const {
        float g[8]; unpack8(pre.g, g);
        const f32x4 t0 = (f32x4){g[0] * v0[0], g[1] * v0[1], g[2] * v0[2], g[3] * v0[3]}, t1 = (f32x4){g[4] * v0[4], g[5] * v0[5], g[6] * v0[6], g[7] * v0[7]};
        if (u.aux == 0) { c0 = t0; c1 = t1; }
        else { c0 += t0; c1 += t1; }
        if (u.aux == 2) { const float o[8] = {c0[0], c0[1], c0[2], c0[3], c1[0], c1[1], c1[2], c1[3]}; store8(MB + (size_t)(u.pm * 256 + r) * 1024 + u.pn * 128 + c, o); }
        return 0.f;
    }
    __device__ __forceinline__ float apply(const GUnit&, int, int, const float (&)[8], const float (&)[8], float, const Pre&) const { return 0.f; }
};
struct EpiMergeR {
    const bf16_t* GATES; bf16_t* MB;
    static constexpr bool CARRY = false, HAS_SSQ = false, HAS_SCALE = false, RATIO = true;
    struct Pre { u32x4 a0, a1, b0, b1; };
    __device__ __forceinline__ float row_scale(const GUnit&, int) const { return 0.f; }
    __device__ __forceinline__ Pre load(const GUnit& u, int r, int c) const {
        const bf16_t* g = GATES + (size_t)(u.pm * 256 + r) * 3072 + u.aux * 1024 + u.pn * 256 + c; Pre p;
        p.a0 = *(const u32x4*)g; p.a1 = *(const u32x4*)(g + 128);
        if (u.aux < 2) { p.b0 = *(const u32x4*)(g + 1024); p.b1 = *(const u32x4*)(g + 1024 + 128); } else { p.b0 = p.a0; p.b1 = p.a1; }
        return p;
    }
    __device__ __forceinline__ void scale(const GUnit&, int, int, f32x4& p0, f32x4& p1, f32x4& q0, f32x4& q1, const Pre& pre) const {
        float a[8], b[8], t[8];
        unpack8(pre.a0, a); unpack8(pre.b0, b);
#pragma unroll
        for (int j = 0; j < 8; ++j) t[j] = fmaxf(a[j], 1e-30f) * __builtin_amdgcn_rcpf(fmaxf(b[j], 1e-30f));
        p0 = (f32x4){p0[0] * t[0], p0[1] * t[1], p0[2] * t[2], p0[3] * t[3]}; p1 = (f32x4){p1[0] * t[4], p1[1] * t[5], p1[2] * t[6], p1[3] * t[7]};
        unpack8(pre.a1, a); unpack8(pre.b1, b);
#pragma unroll
        for (int j = 0; j < 8; ++j) t[j] = fmaxf(a[j], 1e-30f) * __builtin_amdgcn_rcpf(fmaxf(b[j], 1e-30f));
        q0 = (f32x4){q0[0] * t[0], q0[1] * t[1], q0[2] * t[2], q0[3] * t[3]}; q1 = (f32x4){q1[0] * t[4], q1[1] * t[5], q1[2] * t[6], q1[3] * t[7]};
    }
    __device__ __forceinline__ float apply(const GUnit& u, int r, int c, const float (&v0)[8], const float (&v1)[8], float, const Pre& pre) const {
        bf16_t* d = MB + (size_t)(u.pm * 256 + r) * 1024 + u.pn * 256 + c; float g[8], o[8];
        unpack8(pre.a0, g);
#pragma unroll
        for (int j = 0; j < 8; ++j) o[j] = fmaxf(g[j], 1e-30f) * v0[j];
        store8(d, o);
        unpack8(pre.a1, g);
#pragma unroll
        for (int j = 0; j < 8; ++j) o[j] = fmaxf(g[j], 1e-30f) * v1[j];
        store8(d + 128, o);
        return 0.f;
    }
};
template <class T, class = void> struct epi_is_ratio { static constexpr bool value = false; };
template <class T> struct epi_is_ratio<T, decltype((void)T::RATIO)> { static constexpr bool value = T::RATIO; };
struct EpiResid {
    bf16_t* XB; float* ssq;
    static constexpr bool CARRY = false; static constexpr bool HAS_SSQ = true, HAS_SCALE = false;
    struct Pre { u32x4 a, b; };
    __device__ __forceinline__ float row_scale(const GUnit&, int) const { return 0.f; }
    __device__ __forceinline__ Pre load(const GUnit& u, int r, int c) const {
        const size_t off = (size_t)(u.pm * 256 + r) * 1024 + u.pn * 256 + c; Pre p; p.a = *(const u32x4*)(XB + off); p.b = *(const u32x4*)(XB + off + 128); return p;
    }
    __device__ __forceinline__ float apply(const GUnit& u, int r, int c, const float (&v0)[8], const float (&v1)[8], float, const Pre& pre) const {
        const size_t off = (size_t)(u.pm * 256 + r) * 1024 + u.pn * 256 + c; float ss = 0.f, o[8], w[8];
        unpack8(pre.a, o); unpack8(pre.b, w);
#pragma unroll
        for (int j = 0; j < 8; ++j) { o[j] += v0[j]; w[j] += v1[j]; }
        const u32x4 po = pack8(o), pw = pack8(w);
        *(u32x4*)(XB + off) = po; *(u32x4*)(XB + off + 128) = pw;
        unpack8(po, o); unpack8(pw, w);
#pragma unroll
        for (int j = 0; j < 8; ++j) ss += o[j] * o[j] + w[j] * w[j];
        return ss;
    }
    __device__ __forceinline__ void put_ssq(const GUnit& u, int r, int slot, float s) const { ssq[(size_t)(u.pm * 256 + r) * 16 + u.pn * 4 + slot] = s; }
};
struct EpiSwiGLU {
    const float* ssq; const int* rowtok; bf16_t* HID; int ldh;
    static constexpr bool CARRY = false; static constexpr bool HAS_SSQ = false, HAS_SCALE = true; typedef NoPre Pre;
    __device__ __forceinline__ float row_scale(const GUnit& u, int r) const { const int row = u.pm * 256 + r; return rowtok ? ((const float*)rowtok)[row] : row_rstd16(ssq, row); }
    __device__ __forceinline__ Pre load(const GUnit&, int, int) const { return Pre{}; }
    __device__ __forceinline__ float apply(const GUnit& u, int r, int c, const float (&v0)[8], const float (&v1)[8], float rstd, const Pre&) const {
        const int row = u.pm * 256 + r; float o[8];
#pragma unroll
        for (int j = 0; j < 8; ++j) { const float g = v0[j] * rstd, up = v1[j] * rstd; o[j] = g * sigmoidf_(g) * up; }
        const int col = u.pn * 128 + c;
        store8(HID + ((size_t)(u.pm * (ldh >> 6) + (col >> 6)) * 256 + r) * 64 + (col & 63), o); return 0.f;
    }
};
struct EpiSlab {
    float* SL;
    static constexpr bool CARRY = false; static constexpr bool HAS_SSQ = false, HAS_SCALE = false; typedef NoPre Pre;
    __device__ __forceinline__ float row_scale(const GUnit&, int) const { return 0.f; }
    __device__ __forceinline__ Pre load(const GUnit&, int, int) const { return Pre{}; }
    __device__ __forceinline__ float apply(const GUnit& u, int r, int c, const float (&v0)[8], const float (&v1)[8], float, const Pre&) const {
        float* q = SL + (size_t)u.aux * 65536 + r * 256 + c;
        *(f32x4*)q = (f32x4){v0[0], v0[1], v0[2], v0[3]}; *(f32x4*)(q + 4) = (f32x4){v0[4], v0[5], v0[6], v0[7]};
        *(f32x4*)(q + 128) = (f32x4){v1[0], v1[1], v1[2], v1[3]}; *(f32x4*)(q + 132) = (f32x4){v1[4], v1[5], v1[6], v1[7]}; return 0.f;
    }
};
struct EpiMoeDown {
    const float* roww; bf16_t* OUTS;
    static constexpr bool CARRY = false; static constexpr bool HAS_SSQ = false, HAS_SCALE = true; typedef NoPre Pre;
    __device__ __forceinline__ float row_scale(const GUnit& u, int r) const { return roww[u.pm * 256 + r]; }
    __device__ __forceinline__ Pre load(const GUnit&, int, int) const { return Pre{}; }
    __device__ __forceinline__ float apply(const GUnit& u, int r, int c, const float (&v0)[8], const float (&v1)[8], float w, const Pre&) const {
        const int row = u.pm * 256 + r; float o0[8], o1[8];
#pragma unroll
        for (int j = 0; j < 8; ++j) { o0[j] = v0[j] * w; o1[j] = v1[j] * w; }
        bf16_t* q = OUTS + (size_t)row * 1024 + u.pn * 256 + c; store8(q, o0); store8(q + 128, o1); return 0.f;
    }
};

template <class Sched, class Epi>
__device__ __forceinline__ void gemm_naive(const Sched& S, const Epi& E, int K, int lda) {
    const int tid = threadIdx.x, r = tid & 255, s = __builtin_amdgcn_readfirstlane(tid >> 8);
    GUnit u;
    for (int i = 0; S.next(i, u); ++i) {
        const bf16_t* arow = u.rows ? u.A + (size_t)u.rows[r] * lda : u.A + (size_t)r * lda;
        float ss = 0.f;
        for (int g = 0; g < 8; ++g) {
            const int c = s * 64 + g * 8;
            float a0[8], a1[8];
#pragma unroll
            for (int j = 0; j < 8; ++j) { a0[j] = 0.f; a1[j] = 0.f; }
#pragma unroll 1
            for (int k = 0; k < K; k += 8) {
                float af[8]; load8(arow + k, af);
#pragma unroll
                for (int j = 0; j < 8; ++j) {
                    float b0[8], b1[8]; load8(u.B + (size_t)(c + j) * K + k, b0); load8(u.B + (size_t)(128 + c + j) * K + k, b1);
#pragma unroll
                    for (int e = 0; e < 8; ++e) { a0[j] = fmaf(af[e], b0[e], a0[j]); a1[j] = fmaf(af[e], b1[e], a1[j]); }
                }
            }
            ss += E.apply(u, r, c, a0, a1, E.row_scale(u, r), E.load(u, r, c));
        }
        if constexpr (Epi::HAS_SSQ) { E.put_ssq(u, r, s, ss); E.put_ssq(u, r, 2 + s, 0.f); }
    }
}

__device__ __forceinline__ int launder_v(int x) { asm volatile("" : "+v"(x)); return x; }
template <class Tp> __device__ __forceinline__ Tp* launder_s(Tp* p) { GAS Tp* g = (GAS Tp*)p; asm volatile("" : "+s"(g)); return (Tp*)g; }
__device__ __forceinline__ int launder_i(int x) { asm volatile("" : "+s"(x)); return x; }
__device__ __forceinline__ bool in_phase(int lo, int hi, int k) { asm volatile("" : "+s"(lo), "+s"(hi)); return lo <= k && k < hi; }
namespace pg8 {
constexpr int BK = 64, HALF = 128, HTB = HALF * BK * 2, STAGE_BYTES = 8 * HTB;
__device__ __forceinline__ int lds_byte(int r, int c) { const int st = (r >> 4) * 2 + (c >> 5), rr = r & 15, cc = c & 31, ob = rr * 64 + cc * 2; return st * 1024 + (ob ^ (((ob >> 9) & 1) << 5)); }
__device__ __forceinline__ void stage_rc(int b, int& R, int& C) { const int st = b / 1024, sb = b % 1024, swz = sb ^ (((sb >> 9) & 1) << 5); R = (st >> 1) * 16 + swz / 64; C = (st & 1) * 32 + (swz % 64) / 2; }
__device__ __forceinline__ int perm32(int rho) { const int n = rho >> 4, i = rho & 15; return 8 * (i >> 2) + 4 * n + (i & 3); }

template <bool GATHER, bool HALFN = false, class Sched, class Epi>
__device__ __forceinline__ void gemm_phase(LAS unsigned char* lds, const Sched& S, const Epi& E, const int K, const int lda, const int tid_, const int ldb_ = 0, const bool tiled = false, const bool tiledB_only = false) {
    const int ldb = ldb_ ? ldb_ : K;
    const int tid = launder_v(tid_), wid = __builtin_amdgcn_readfirstlane(tid >> 6), lane = tid & 63, wr = wid >> 2, wc = wid & 3, fr = lane & 15, fq = lane >> 4;
    const int nt = K / BK;
    int RA[2], CA[2]; unsigned voffB[2];
#pragma unroll
    for (int i = 0; i < 2; ++i) { int R, C; stage_rc(tid * 16 + i * 8192, R, C); RA[i] = R; CA[i] = C; const int Rb = (R & ~31) + perm32(R & 31); voffB[i] = (unsigned)(Rb * ldb + C) * 2u; }
    const size_t kstepB = tiled ? (size_t)(256 * BK * 2) : (size_t)(BK * 2);
    const size_t kstep = (tiled && !tiledB_only) ? (size_t)(256 * BK * 2) : (size_t)(BK * 2);
    const size_t hstepB = (size_t)HALF * ldb * 2;
    const unsigned ldsw = (unsigned)wid * 1024u;
    const int aoff = lds_byte(wr * 64 + fr, fq * 8), boff = lds_byte(wc * 32 + fr, fq * 8);
#define PG8_SA(b, h) (((b) * 2 + (h)) * HTB)
#define PG8_SB(b, h) ((4 + (b) * 2 + (h)) * HTB)
#define PG8_STAGE2(bufoff, gbase, v0_, v1_) do { \
        __builtin_amdgcn_global_load_lds((const unsigned*)((const char*)(gbase) + (v0_)), (LAS unsigned*)(lds + (bufoff) + ldsw), 16, 0, 0); \
        __builtin_amdgcn_global_load_lds((const unsigned*)((const char*)(gbase) + (v1_)), (LAS unsigned*)(lds + (bufoff) + ldsw + 8192), 16, 0, 0); } while (0)
#define PG8_STAGEB(bufoff, gbase) PG8_STAGE2(bufoff, gbase, voffB[0], voffB[1])
#define PG8_LDA(dst, b, h) do { _Pragma("unroll") for (int m = 0; m < 4; ++m) _Pragma("unroll") for (int k = 0; k < 2; ++k) dst[m][k] = *(const LAS bf16x8*)(lds + PG8_SA(b, h) + aoff + m * 2048 + k * 1024); } while (0)
#define PG8_LDB(dst, b, h) do { _Pragma("unroll") for (int n = 0; n < 2; ++n) _Pragma("unroll") for (int k = 0; k < 2; ++k) dst[n][k] = *(const LAS bf16x8*)(lds + PG8_SB(b, h) + boff + n * 2048 + k * 1024); } while (0)
#define PG8_MMA(ai, bj, At, Bt) do { __builtin_amdgcn_s_setprio(1); _Pragma("unroll") for (int m = 0; m < 4; ++m) _Pragma("unroll") for (int n = 0; n < 2; ++n) _Pragma("unroll") for (int k = 0; k < 2; ++k) \
        acc[ai][bj][m][n] = __builtin_amdgcn_mfma_f32_16x16x32_bf16(Bt[n][k], At[m][k], acc[ai][bj][m][n], 0, 0, 0); __builtin_amdgcn_s_setprio(0); } while (0)
#define PG8_WAIT_V(n) asm volatile("s_waitcnt vmcnt(" #n ")" ::: "memory")
#define PG8_WAIT_L(n) asm volatile("s_waitcnt lgkmcnt(" #n ")" ::: "memory")
#define PG8_BAR __builtin_amdgcn_s_barrier()
#define PG8_SCHED __builtin_amdgcn_sched_barrier(0)
#define PG8_VOFFA(dst, u_) do { _Pragma("unroll") for (int h_ = 0; h_ < 2; ++h_) _Pragma("unroll") for (int i_ = 0; i_ < 2; ++i_) { \
        const unsigned row_ = GATHER ? (unsigned)(u_).rows[h_ * HALF + RA[i_]] : (unsigned)RA[i_]; dst[h_][i_] = (row_ * (unsigned)lda + (unsigned)CA[i_]) * 2u; } } while (0)
    GUnit cur, nxt; int ui = 0;
    if (!S.next(0, cur)) return;
    f32x4 acc[2][2][4][2];
#pragma unroll
    for (int a = 0; a < 2; ++a)
#pragma unroll
        for (int b = 0; b < 2; ++b)
#pragma unroll
            for (int m = 0; m < 4; ++m)
#pragma unroll
                for (int n = 0; n < 2; ++n) acc[a][b][m][n] = (f32x4){0.f, 0.f, 0.f, 0.f};
    bf16x8 At[4][2], B0[2][2], B1[2][2];
    f32x4 car[2][4][2];
    unsigned vc[2][2], vn[2][2];
    const size_t hstepA = GATHER ? (size_t)0 : (size_t)HALF * lda * 2;
    PG8_VOFFA(vc, cur);
    const char* cA = (const char*)cur.A; const char* cB = (const char*)cur.B;
    if constexpr (Epi::HAS_SCALE) { if (tid < 256) ((LAS float*)(lds + LDS_RING))[tid] = E.row_scale(cur, tid); }
    if constexpr (HALFN) {
        PG8_STAGEB(PG8_SB(0, 0), cB); PG8_STAGE2(PG8_SA(0, 0), cA, vc[0][0], vc[0][1]); PG8_STAGE2(PG8_SA(0, 1), cA + hstepA, vc[1][0], vc[1][1]);
        if (wr == 1) PG8_BAR;
        PG8_WAIT_V(2); PG8_BAR;
        PG8_STAGEB(PG8_SB(1, 0), cB + kstepB); PG8_STAGE2(PG8_SA(1, 0), cA + kstep, vc[0][0], vc[0][1]);
        PG8_WAIT_V(4); PG8_BAR;
    } else {
    PG8_STAGEB(PG8_SB(0, 0), cB); PG8_STAGEB(PG8_SB(0, 1), cB + hstepB); PG8_STAGE2(PG8_SA(0, 0), cA, vc[0][0], vc[0][1]); PG8_STAGE2(PG8_SA(0, 1), cA + hstepA, vc[1][0], vc[1][1]);
    if (wr == 1) PG8_BAR;
    PG8_WAIT_V(2); PG8_BAR;
    PG8_STAGEB(PG8_SB(1, 0), cB + kstepB); PG8_STAGE2(PG8_SA(1, 0), cA + kstep, vc[0][0], vc[0][1]); PG8_STAGEB(PG8_SB(1, 1), cB + hstepB + kstepB);
    PG8_WAIT_V(6); PG8_BAR;
    }
    for (;;) {
        const bool has_next = S.next(ui + 1, nxt);
        const char* nA = has_next ? (const char*)nxt.A : cA; const char* nB = has_next ? (const char*)nxt.B : cB;
        if constexpr (Epi::HAS_SCALE) { if (has_next && tid < 256) ((LAS float*)(lds + LDS_RING))[((ui + 1) % 3) * 256 + tid] = E.row_scale(nxt, tid); }
        if (has_next) { PG8_VOFFA(vn, nxt); } else {
#pragma unroll
            for (int h_ = 0; h_ < 2; ++h_)
#pragma unroll
                for (int i_ = 0; i_ < 2; ++i_) vn[h_][i_] = vc[h_][i_]; }
        for (int t = 0; t < nt; t += 2) {
            const bool last = (t == nt - 2);
            const char* a1 = cA + (size_t)(t + 1) * kstep;
            const char* a2 = last ? nA : cA + (size_t)(t + 2) * kstep; const char* b2 = last ? nB : cB + (size_t)(t + 2) * kstepB;
            const char* a3 = a2 + kstep; const char* b3 = b2 + kstepB;
            const unsigned w00 = last ? vn[0][0] : vc[0][0], w01 = last ? vn[0][1] : vc[0][1], w10 = last ? vn[1][0] : vc[1][0], w11 = last ? vn[1][1] : vc[1][1];
            if constexpr (HALFN) {
            PG8_LDB(B0, 0, 0); PG8_SCHED; PG8_LDA(At, 0, 0); PG8_STAGE2(PG8_SA(1, 1), a1 + hstepA, vc[1][0], vc[1][1]);
            PG8_WAIT_V(6); PG8_WAIT_L(0); PG8_BAR; PG8_MMA(0, 0, At, B0); PG8_BAR; PG8_SCHED;
            PG8_LDA(At, 0, 1); PG8_STAGEB(PG8_SB(0, 0), b2); PG8_STAGE2(PG8_SA(0, 0), a2, w00, w01);
            PG8_WAIT_V(6); PG8_WAIT_L(0); PG8_BAR; PG8_MMA(1, 0, At, B0); PG8_BAR; PG8_SCHED;
            PG8_LDB(B0, 1, 0); PG8_SCHED; PG8_LDA(At, 1, 0); PG8_STAGE2(PG8_SA(0, 1), a2 + hstepA, w10, w11);
            PG8_WAIT_V(6); PG8_WAIT_L(0); PG8_BAR; PG8_MMA(0, 0, At, B0); PG8_BAR; PG8_SCHED;
            PG8_LDA(At, 1, 1); PG8_STAGEB(PG8_SB(1, 0), b3); PG8_STAGE2(PG8_SA(1, 0), a3, w00, w01);
            PG8_WAIT_V(6); PG8_WAIT_L(0); PG8_BAR; PG8_MMA(1, 0, At, B0); PG8_BAR; PG8_SCHED;
            } else {
            PG8_LDB(B0, 0, 0); PG8_LDB(B1, 0, 1); PG8_SCHED; PG8_LDA(At, 0, 0); PG8_STAGE2(PG8_SA(1, 1), a1 + hstepA, vc[1][0], vc[1][1]);
            PG8_WAIT_V(8); PG8_WAIT_L(0); PG8_BAR; PG8_MMA(0, 0, At, B0); PG8_MMA(0, 1, At, B1); PG8_BAR; PG8_SCHED;
            PG8_LDA(At, 0, 1); PG8_STAGEB(PG8_SB(0, 0), b2); PG8_STAGEB(PG8_SB(0, 1), b2 + hstepB); PG8_STAGE2(PG8_SA(0, 0), a2, w00, w01);
            PG8_WAIT_V(8); PG8_WAIT_L(0); PG8_BAR; PG8_MMA(1, 0, At, B0); PG8_MMA(1, 1, At, B1); PG8_BAR; PG8_SCHED;
            PG8_LDB(B0, 1, 0); PG8_LDB(B1, 1, 1); PG8_SCHED; PG8_LDA(At, 1, 0); PG8_STAGE2(PG8_SA(0, 1), a2 + hstepA, w10, w11);
            PG8_WAIT_V(8); PG8_WAIT_L(0); PG8_BAR; PG8_MMA(0, 0, At, B0); PG8_MMA(0, 1, At, B1); PG8_BAR; PG8_SCHED;
            PG8_LDA(At, 1, 1); PG8_STAGEB(PG8_SB(1, 0), b3); PG8_STAGEB(PG8_SB(1, 1), b3 + hstepB); PG8_STAGE2(PG8_SA(1, 0), a3, w00, w01);
            PG8_WAIT_V(8); PG8_WAIT_L(0); PG8_BAR; PG8_MMA(1, 0, At, B0); PG8_MMA(1, 1, At, B1); PG8_BAR; PG8_SCHED;
            }
        }
        if (wr == 0) PG8_BAR;
        {
            const int fr2 = launder_v(fr), fq2 = launder_v(fq);
            const int c = wc * 32 + fq2 * 8, rb = wr * 64 + fr2;
            const LAS float* sct = (const LAS float*)(lds + LDS_RING) + (ui % 3) * 256;
            float sc[8];
            if constexpr (Epi::HAS_SCALE) {
#pragma unroll
                for (int i = 0; i < 8; ++i) sc[i] = sct[(i >> 2) * HALF + (i & 3) * 16 + rb];
            }
            typename Epi::Pre pre = E.load(cur, rb, c);
#pragma unroll
            for (int i = 0; i < 8; ++i) {
                const int ai = i >> 2, m = i & 3, r = ai * HALF + m * 16 + rb;
                typename Epi::Pre nx = pre;
                if (i < 7) nx = E.load(cur, ((i + 1) >> 2) * HALF + ((i + 1) & 3) * 16 + rb, c);
                asm volatile("" ::: "memory");
                const f32x4 p0 = acc[ai][0][m][0], p1 = acc[ai][0][m][1], q0 = acc[ai][1][m][0], q1 = acc[ai][1][m][1];
                const float v0[8] = {p0[0], p0[1], p0[2], p0[3], p1[0], p1[1], p1[2], p1[3]}, v1[8] = {q0[0], q0[1], q0[2], q0[3], q1[0], q1[1], q1[2], q1[3]};
                float ss;
                if constexpr (Epi::CARRY) ss = E.apply_carry(cur, r, c, v0, car[ai][m][0], car[ai][m][1], pre);
                else if constexpr (epi_is_ratio<Epi>::value) {
                    if (cur.aux < 2) { E.scale(cur, r, c, acc[ai][0][m][0], acc[ai][0][m][1], acc[ai][1][m][0], acc[ai][1][m][1], pre); ss = 0.f; }
                    else ss = E.apply(cur, r, c, v0, v1, 0.f, pre);
                }
                else ss = E.apply(cur, r, c, v0, v1, Epi::HAS_SCALE ? sc[i] : 0.f, pre);
                if constexpr (Epi::HAS_SSQ) { ss = sum_halves(add_row_pair(ss)); if (fq2 == 0) E.put_ssq(cur, r, wc, ss); }
                asm volatile("" ::: "memory");
                pre = nx;
            }
        }
        if (!has_next) break;
        if (!epi_is_ratio<Epi>::value || cur.aux >= 2) {
#pragma unroll
        for (int a = 0; a < 2; ++a)
#pragma unroll
            for (int b = 0; b < 2; ++b)
#pragma unroll
                for (int m = 0; m < 4; ++m)
#pragma unroll
                    for (int n = 0; n < 2; ++n) acc[a][b][m][n] = (f32x4){0.f, 0.f, 0.f, 0.f};
        }
        cur = nxt; cA = nA; cB = nB; ++ui;
#pragma unroll
        for (int h_ = 0; h_ < 2; ++h_)
#pragma unroll
            for (int i_ = 0; i_ < 2; ++i_) vc[h_][i_] = vn[h_][i_];
        if (wr == 1) PG8_BAR;
    }
    PG8_WAIT_V(0);
    PG8_BAR;
#undef PG8_SA
#undef PG8_SB
#undef PG8_STAGE2
#undef PG8_STAGEB
#undef PG8_LDA
#undef PG8_LDB
#undef PG8_MMA
#undef PG8_WAIT_V
#undef PG8_WAIT_L
#undef PG8_BAR
#undef PG8_SCHED
#undef PG8_VOFFA
}
}

__device__ __forceinline__ int inproj_perm(int m) { if (m >= INPROJ_PERM_TILES * 256) return m; const int t = m & 255; return (m & ~255) + ((t >> 5) & 1) * 128 + (t >> 6) * 32 + (t & 31); }
__device__ __forceinline__ int rowmap(int code, int n) {
    switch (code) {
        case 1: { const int m = n < 640 ? n : (n < 768 ? n + 5760 : (n < 1280 ? n : (n < 1312 ? n - 640 : (n < 3360 ? n - 32 : (n < 3392 ? n - 2688 : n - 64)))));
            return inproj_perm(m); }
        case 2: { const int h = n >> 7, j = n & 127; return j < 64 ? h * 64 + j : 512 + h * 64 + (j - 64); }
        case 3: return (n >> 7) * 256 + (n & 127);
        case 4: return (n >> 7) * 256 + 128 + (n & 127);
        default: return n;
    }
}
struct TJob { const float* W; bf16_t* WT; const float* g; int K, N, code; bool tiled; };
__device__ __forceinline__ void transpose_item(const TJob& jb, LAS float* scr, int item, int lane) {
    const int K = jb.K, N = jb.N, nblk = N / 64, kb = item / nblk, nb = item % nblk, k0 = 64 * kb, n0 = 64 * nb;
    const float* src = jb.W + (size_t)k0 * N + n0 + lane;
    float v[64];
#pragma unroll
    for (int i = 0; i < 64; ++i) v[i] = __builtin_nontemporal_load(src + (size_t)i * N);
    if (jb.g) {
#pragma unroll
        for (int i = 0; i < 64; ++i) v[i] *= jb.g[k0 + i];
    }
    LAS unsigned char* sb = (LAS unsigned char*)scr;
#pragma unroll
    for (int c = 0; c < 8; ++c) { u32x4 o; o.x = pk2(v[8 * c], v[8 * c + 1]); o.y = pk2(v[8 * c + 2], v[8 * c + 3]); o.z = pk2(v[8 * c + 4], v[8 * c + 5]); o.w = pk2(v[8 * c + 6], v[8 * c + 7]);
        *(LAS u32x4*)(sb + lane * 144 + c * 16) = o; }
    asm volatile("s_waitcnt lgkmcnt(0)" ::: "memory");
#pragma unroll
    for (int j = 0; j < 8; ++j) { const int n = (lane >> 3) + 8 * j, c = lane & 7; const u32x4 o = *(const LAS u32x4*)(sb + n * 144 + c * 16);
        const int rr = rowmap(jb.code, n0 + n);
        bf16_t* d = jb.tiled ? jb.WT + ((size_t)((rr >> 8) * (K >> 6) + kb) * 256 + (rr & 255)) * 64 + 8 * c : jb.WT + (size_t)rr * K + k0 + 8 * c;
        *(u32x4*)d = o; }
    asm volatile("s_waitcnt lgkmcnt(0)" ::: "memory");
}
__device__ __forceinline__ bool common_job(const Ctx& a, int j, TJob& jb) {
    unsigned char* ws = a.ws;
    if (j < 14) { const int l = j / 7, k = j % 7;
        switch (k) {
            case 0: jb = TJob{a.in[I_WIN] + (size_t)l * 1024 * 6464, (bf16_t*)(ws + O_WIN + l * SZ_WIN1), a.in[I_GMIX] + l * 1024, 1024, 6464, 1, false}; break;
            case 1: jb = TJob{a.in[I_WBQUP] + (size_t)l * 256 * 768, (bf16_t*)(ws + O_WQUP + l * SZ_WQUP1), a.in[I_GBQ] + l * 256, 256, 768, 0, false}; break;
            case 2: jb = TJob{a.in[I_WBKVUP] + (size_t)l * 256 * 1024, (bf16_t*)(ws + O_WKVUP + l * SZ_WKVUP1), a.in[I_GBKV] + l * 256, 256, 1024, 2, false}; break;
            case 3: jb = TJob{a.in[I_WPA] + (size_t)l * 512 * 1024, (bf16_t*)(ws + O_WP + (l * 3 + 0) * SZ_WP1), nullptr, 512, 1024, 0, false}; break;
            case 4: jb = TJob{a.in[I_WPB] + (size_t)l * 512 * 1024, (bf16_t*)(ws + O_WP + (l * 3 + 1) * SZ_WP1), nullptr, 512, 1024, 0, false}; break;
            case 5: jb = TJob{a.in[I_WPC] + (size_t)l * 512 * 1024, (bf16_t*)(ws + O_WP + (l * 3 + 2) * SZ_WP1), nullptr, 512, 1024, 0, false}; break;
            default: jb = TJob{a.in[I_WOUT] + (size_t)l * 1024 * 1024, (bf16_t*)(ws + O_WOUT + l * SZ_WOUT1), nullptr, 1024, 1024, 0, false}; break;
        }
        return true; }
    if (j == 14) { jb = TJob{a.in[I_WFFG], (bf16_t*)(ws + O_WFFGU), a.in[I_GFFN], 1024, DFF, 3, false}; return true; }
    if (j == 15) { jb = TJob{a.in[I_WFFU], (bf16_t*)(ws + O_WFFGU), a.in[I_GFFN], 1024, DFF, 4, false}; return true; }
    if (j == 16) { jb = TJob{a.in[I_WFFD], (bf16_t*)(ws + O_WFFD), nullptr, DFF, 1024, 0, true}; return true; }
    return false;
}
__device__ __forceinline__ bool expert_job(const Ctx& a, int j, TJob& jb) {
    if (j >= 24) return false;
    unsigned char* ws = a.ws; const int e = j / 3, k = j % 3;
    if (k == 0) jb = TJob{a.in[I_WEG] + (size_t)e * 1024 * DFE, (bf16_t*)(ws + O_WEGU) + (size_t)e * 2 * DFE * 1024, a.in[I_GFFN] + 1024, 1024, DFE, 3, true};
    else if (k == 1) jb = TJob{a.in[I_WEU] + (size_t)e * 1024 * DFE, (bf16_t*)(ws + O_WEGU) + (size_t)e * 2 * DFE * 1024, a.in[I_GFFN] + 1024, 1024, DFE, 4, true};
    else jb = TJob{a.in[I_WED] + (size_t)e * DFE * 1024, (bf16_t*)(ws + O_WED) + (size_t)e * 1024 * DFE, nullptr, DFE, 1024, 0, true};
    return true;
}
__device__ __forceinline__ void common_find(int set, int it, int& j, int& r) {
    if (set == 0) { if (it < 1616) { j = 0; r = it; } else if (it < 1664) { j = 1; r = it - 1616; } else { j = 2; r = it - 1664; } return; }
    if (set == 2) { r = it;
        if (r < 1616) j = 7; else if ((r -= 1616) < 48) j = 8; else if ((r -= 48) < 64) j = 9; else if ((r -= 64) < 384) { j = 10 + (r >> 7); r &= 127; } else { r -= 384; j = 13; }
        return; }
    if (it < 640) { if (it < 384) { j = 3 + (it >> 7); r = it & 127; } else { j = 6; r = it - 384; } }
    else { r = it - 640; j = 14 + r / 704; r = r % 704; }
}
constexpr int CONV0_ITEMS = 2752, CONV2_ITEMS = 2368, CONV_PER_UNIT = 32;
constexpr int NEXP_EARLY = 5;
constexpr int CONV1_ITEMS = NEXP_EARLY * 2 * 896;
static_assert((size_t)NEXP_EARLY * 2 * DFE * 1024 * 2 <= (size_t)M * PW * 2, "early expert copies must stay inside P");
template <bool EXPERTS>
__device__ __forceinline__ void run_transposes(const Ctx& a, LAS unsigned char* lds, int gw, int NGW, int wave, int lane) {
    LAS float* scr = (LAS float*)(lds + wave * 16384);
    TJob jb;
    if (EXPERTS) {
        constexpr int PER = (1024 / 64) * (DFE / 64), NGU = (NEXP - NEXP_EARLY) * 2 * PER;
        for (int it = gw; it < NGU; it += NGW) {
            const int j = NEXP_EARLY * 3 + (it / (2 * PER)) * 3 + (it / PER) % 2;
            expert_job(a, j, jb); transpose_item(jb, scr, it % PER, lane); }
    } else {
        for (int it = gw; it < 1728; it += NGW) { int j, r; common_find(0, it, j, r); common_job(a, j, jb); transpose_item(jb, scr, r, lane); }
    }
}
__device__ __forceinline__ void conv_unit0(const Ctx& a, LAS unsigned char* lds, int layer, int cu, int wave, int lane) {
    LAS float* scr = (LAS float*)(lds + wave * 16384);
    TJob jb;
    for (int i = 0; i < CONV_PER_UNIT / NWAVES; ++i) { const int it = cu * CONV_PER_UNIT + i * NWAVES + wave;
        if (layer == 0) { if (it < CONV0_ITEMS) { int j, r; common_find(1, it, j, r); common_job(a, j, jb); transpose_item(jb, scr, r, lane); } }
        else if (it < CONV1_ITEMS) { expert_job(a, (it / 1792) * 3 + (it / 896) % 2, jb); transpose_item(jb, scr, it % 896, lane); } }
}
__device__ __forceinline__ void phase_prologue(const Ctx& a, LAS unsigned char* lds, int vcu, int G, int tid) {
    const int wave = __builtin_amdgcn_readfirstlane(tid >> 6), lane = tid & 63, gw = vcu * NWAVES + wave, NGW = G * NWAVES;
    unsigned char* ws = a.ws;
    run_transposes<false>(a, lds, gw, NGW, wave, lane);
    for (int l = 0; l < 2; ++l) { u32x4* p = (u32x4*)(ws + O_WIN + l * SZ_WIN1 + (size_t)6528 * 1024 * 2); const int n16 = 128 * 1024 * 2 / 16;
        for (int i = gw * 64 + lane; i < n16; i += NGW * 64) p[i] = (u32x4){0u, 0u, 0u, 0u};
        const int m16 = 64 * 1024 * 2 / 16;
        for (int i = gw * 64 + lane; i < m16; i += NGW * 64) { const int rrow = inproj_perm(704 + (i >> 7)); ((u32x4*)(ws + O_WIN + l * SZ_WIN1 + (size_t)rrow * 1024 * 2))[i & 127] = (u32x4){0u, 0u, 0u, 0u}; } }
    float* ta = (float*)(ws + O_TABA); float* tb = (float*)(ws + O_TABB);
    for (int i = gw * 64 + lane; i < T * 32; i += NGW * 64) { const int t = i >> 5, k = i & 31, blk = k >> 4, fi = k & 15;
        const float inv = exp2f(-(float)fi * (13.287712379549449f / 16.0f)); const float pos = (float)(blk ? (t & 63) : (t >> 6)); const float ang = pos * inv;
        ta[t * 64 + k] = cosf(ang); ta[t * 64 + 32 + k] = sinf(ang); }
    for (int i = gw * 64 + lane; i < T * 16; i += NGW * 64) { const int t = i >> 4, k = i & 15, blk = k >> 3, fi = k & 7;
        const float inv = exp2f(-(float)fi * (13.287712379549449f / 8.0f)); const float pos = (float)(blk ? (t & 63) : (t >> 6)); const float ang = pos * inv;
        tb[t * 32 + k] = cosf(ang); tb[t * 32 + 16 + k] = sinf(ang); }
    const float* x = a.in[I_X]; bf16_t* XB = (bf16_t*)(ws + O_XB); float* ssq = (float*)(ws + O_SSQ);
    for (int m0 = gw; m0 < M; m0 += 4 * NGW) {
        f32x4 v[4][4];
#pragma unroll
        for (int q = 0; q < 4; ++q) { const int m = m0 + q * NGW; const f32x4* xr = (const f32x4*)(x + (size_t)(m < M ? m : gw) * D) + lane;
#pragma unroll
            for (int j = 0; j < 4; ++j) v[q][j] = __builtin_nontemporal_load(xr + 64 * j); }
#pragma unroll
        for (int q = 0; q < 4; ++q) { const int m = m0 + q * NGW; float s = 0.f;
#pragma unroll
            for (int j = 0; j < 4; ++j) s += (v[q][j].x * v[q][j].x + v[q][j].y * v[q][j].y) + (v[q][j].z * v[q][j].z + v[q][j].w * v[q][j].w);
            s = wave_sum(s);
            if (m < M) {
#pragma unroll
                for (int j = 0; j < 4; ++j) *(u32x2*)(XB + (size_t)m * D + (lane + 64 * j) * 4) = (u32x2){pk2(v[q][j].x, v[q][j].y), pk2(v[q][j].z, v[q][j].w)};
                if (lane < 16) ssq[(size_t)m * 16 + lane] = lane == 0 ? s : 0.f; } }
    }
}

template <bool WRITE_LA>
__device__ __forceinline__ void post_item(const Ctx& a, int layer, int it, LAS unsigned char* lds, int tid) {
    unsigned char* ws = a.ws; const int wave = __builtin_amdgcn_readfirstlane(tid >> 6), lane = tid & 63;
    const bf16_t* P = (const bf16_t*)(ws + O_P); const float* ta = (const float*)(ws + O_TABA); const float* tb = (const float*)(ws + O_TABB);
    bf16_t* QA = (bf16_t*)(ws + O_QA); bf16_t* KA = (bf16_t*)(ws + O_KA); bf16_t* KR = (bf16_t*)(ws + O_KROPE);
    const int r0 = it * 64;
    LAS float* caf = (LAS float*)lds;
    LAS bf16_t* qk = (LAS bf16_t*)(lds + 8192);
    __syncthreads();
    for (int i = tid; i < 64 * 32; i += NTHR) { const int r = i >> 5, j = i & 31; caf[i] = bf2f(P[(size_t)(r0 + r) * PW + PC_SMALL + 32 + j]); }
#pragma unroll
    for (int i = 0; i < 16; ++i) { const int idx = wave * 16 + i, r = idx >> 1, hf = idx & 1;
        __builtin_amdgcn_global_load_lds((const unsigned*)(P + (size_t)(r0 + r) * PW + PC_CQ + hf * 512 + lane * 8), (LAS unsigned*)(lds + 8192 + r * 2048 + hf * 1024), 16, 0, 0); }
    {
        const int seg = lane & 7; float gq[8], gk[8]; ld8f(a.in[I_GAQ] + layer * 64 + seg * 8, gq); ld8f(a.in[I_GAK] + layer * 64 + seg * 8, gk);
#pragma unroll
        for (int jb = 0; jb < 8; jb += 4) {
            u32x4 rq[4]; float cs[4][8], sn[4][8];
#pragma unroll
            for (int q = 0; q < 4; ++q) { const int row = r0 + wave * 8 + jb + q, t = row & (T - 1); const int tb_ = t * 64 + (seg >> 2) * 16 + (seg & 1) * 8;
                rq[q] = *(const u32x4*)(P + (size_t)row * PW + PC_AQ + lane * 8); ld8f(ta + tb_, cs[q]); ld8f(ta + tb_ + 32, sn[q]); }
#pragma unroll
            for (int q = 0; q < 4; ++q) { const int row = r0 + wave * 8 + jb + q; float x[8], o[8]; unpack8(rq[q], x);
                float ss = 0.f;
#pragma unroll
                for (int e = 0; e < 8; ++e) ss += x[e] * x[e];
                ss = sum8(ss);
                const float rstd = rsqrtf(ss * (1.0f / 64.0f) + EPS);
#pragma unroll
                for (int e = 0; e < 8; ++e) { const float xn = x[e] * rstd * gq[e]; const float pr = shx<2>(xn);
                    o[e] = ((seg & 2) ? xn * cs[q][e] + pr * sn[q][e] : xn * cs[q][e] - pr * sn[q][e]) * C2A; }
                store8(QA + (size_t)row * 512 + lane * 8, o); }
        }
        {
            u32x4 rk[2]; float cs[2][8], sn[2][8]; const int l2 = lane & 15;
#pragma unroll
            for (int q = 0; q < 2; ++q) { const int row = r0 + wave * 8 + q * 4 + (lane >> 4), t = row & (T - 1); const int tb_ = t * 64 + (seg >> 2) * 16 + (seg & 1) * 8;
                rk[q] = *(const u32x4*)(P + (size_t)row * PW + PC_AK + l2 * 8); ld8f(ta + tb_, cs[q]); ld8f(ta + tb_ + 32, sn[q]); }
#pragma unroll
            for (int q = 0; q < 2; ++q) { const int row = r0 + wave * 8 + q * 4 + (lane >> 4); float x[8], o[8]; unpack8(rk[q], x);
                float ss = 0.f;
#pragma unroll
                for (int e = 0; e < 8; ++e) ss += x[e] * x[e];
                ss = sum8(ss);
                const float rstd = rsqrtf(ss * (1.0f / 64.0f) + EPS);
#pragma unroll
                for (int e = 0; e < 8; ++e) { const float xn = x[e] * rstd * gk[e]; const float pr = shx<2>(xn);
                    o[e] = (seg & 2) ? xn * cs[q][e] + pr * sn[q][e] : xn * cs[q][e] - pr * sn[q][e]; }
                store8(KA + (size_t)row * 128 + l2 * 8, o); }
        }
        {
            const int sg = lane & 3, row = r0 + wave * 8 + ((lane >> 2) & 7), t = row & (T - 1); float x[8], o[8], cs[8], sn[8];
            load8(P + (size_t)row * PW + PC_SMALL + sg * 8, x); const int tb_ = t * 32 + (sg >> 1) * 8; ld8f(tb + tb_, cs); ld8f(tb + tb_ + 16, sn);
#pragma unroll
            for (int e = 0; e < 8; ++e) { const float pr = shx<1>(x[e]); o[e] = (sg & 1) ? x[e] * cs[e] + pr * sn[e] : x[e] * cs[e] - pr * sn[e]; }
            if (lane < 32) store8(KR + (size_t)row * 32 + sg * 8, o);
        }
    }
    __syncthreads();
    const int col = tid;
    for (int dir = 0; dir < 2; ++dir) {
        const float* Wup = a.in[dir ? I_WCAB : I_WCAF] + (size_t)layer * 16 * 512; const float bias = a.in[dir ? I_BCAB : I_BCAF][layer * 512 + col];
        float w[16];
#pragma unroll
        for (int j = 0; j < 16; ++j) w[j] = Wup[j * 512 + col];
        bf16_t* QT = (bf16_t*)(ws + O_QT) + (size_t)(dir * 2) * M * 512; bf16_t* KT = QT + (size_t)M * 512;
        float* LA = (float*)(ws + O_QT) + (size_t)dir * M * 512;
        float b = 0.f;
        for (int s0 = 0; s0 < 64; s0 += 8) {
            float z[8], la[8];
#pragma unroll
            for (int u = 0; u < 8; ++u) { const int r = dir ? 63 - (s0 + u) : s0 + u; const LAS float* cr = caf + r * 32 + dir * 16; f32x2_t zz = {bias, 0.f};
#pragma unroll
                for (int j = 0; j < 16; j += 2) zz = __builtin_elementwise_fma((f32x2_t){cr[j], cr[j + 1]}, (f32x2_t){w[j], w[j + 1]}, zz);
                z[u] = zz.x + zz.y; }
#pragma unroll
            for (int u = 0; u < 8; ++u) la[u] = (fminf(z[u], 0.f) - 0.6931471805599453f * __builtin_amdgcn_logf(1.0f + __builtin_amdgcn_exp2f(-LOG2E * fabsf(z[u])))) * (1.0f / 16.0f);
#pragma unroll
            for (int u = 0; u < 8; ++u) { b += la[u]; z[u] = b; }
#pragma unroll
            for (int u = 0; u < 8; ++u) { const int r = dir ? 63 - (s0 + u) : s0 + u; const size_t row = (size_t)(r0 + r);
                if (WRITE_LA) LA[row * 512 + col] = la[u];
                else { const float e = __builtin_amdgcn_exp2f(LOG2E * z[u]), ei = __builtin_amdgcn_exp2f(-LOG2E * z[u]); const float q = bf2f(qk[r * 1024 + col]), k = bf2f(qk[r * 1024 + 512 + col]);
                    QT[row * 512 + col] = (bf16_t)f2bf(q * e * GLA_QSCALE); KT[row * 512 + col] = (bf16_t)f2bf(k * ei); } }
        }
        if (!WRITE_LA) ((float*)(ws + O_DEC))[(size_t)dir * 256 * 512 + (size_t)it * 512 + col] = __expf(b);
    }
}

template <int BR>
__device__ __forceinline__ void attn_naive_unit(const Ctx& a, int b, int h, int qb, LAS unsigned char* lds, int tid) {
    unsigned char* ws = a.ws; constexpr int DQ = BR ? 96 : 64;
    const bf16_t* P = (const bf16_t*)(ws + O_P);
    LAS float* Ks = (LAS float*)lds;
    LAS float* Vs = Ks + 64 * 96;
    LAS float* Qs = Vs + 64 * 64;
    const int r = tid >> 1, half = tid & 1; const size_t row0 = (size_t)b * T + qb * 256; const size_t row = row0 + r;
    __syncthreads();
    for (int i = tid; i < 256 * (DQ / 8); i += NTHR) { const int rr = i / (DQ / 8), ch = i % (DQ / 8); float f[8];
        if (BR == 0) load8((const bf16_t*)(ws + O_QA) + (row0 + rr) * 512 + h * 64 + ch * 8, f); else load8((const bf16_t*)(ws + O_QB) + (row0 + rr) * 768 + h * 96 + ch * 8, f);
#pragma unroll
        for (int e = 0; e < 8; ++e) Qs[rr * 97 + ch * 8 + e] = f[e]; }
    __syncthreads();
    if (BR == 1 && tid < 256) {
        const int t = (int)((row0 + tid) & (T - 1)); const float* tb = (const float*)(ws + O_TABB) + t * 32; LAS float* q = Qs + tid * 97 + 64;
        for (int blk = 0; blk < 2; ++blk)
            for (int e = 0; e < 8; ++e) { const float cs = tb[blk * 8 + e], sn = tb[16 + blk * 8 + e]; const float x1 = q[blk * 16 + e], x2 = q[blk * 16 + 8 + e];
                q[blk * 16 + e] = x1 * cs - x2 * sn; q[blk * 16 + 8 + e] = x2 * cs + x1 * sn; } }
    float m = -1e30f, l = 0.f, o[32];
#pragma unroll
    for (int j = 0; j < 32; ++j) o[j] = 0.f;
    for (int kt = 0; kt < T / 64; ++kt) {
        __syncthreads();
        for (int i = tid; i < 64 * (DQ / 8); i += NTHR) { const int kr = i / (DQ / 8), ch = i % (DQ / 8); const size_t krow = (size_t)b * T + kt * 64 + kr; float f[8];
            if (BR == 0) load8((const bf16_t*)(ws + O_KA) + krow * 128 + (h >> 2) * 64 + ch * 8, f);
            else if (ch < 8) load8((const bf16_t*)(ws + O_KNOPE) + krow * 512 + h * 64 + ch * 8, f);
            else load8((const bf16_t*)(ws + O_KROPE) + krow * 32 + (ch - 8) * 8, f);
#pragma unroll
            for (int e = 0; e < 8; ++e) Ks[kr * 96 + ch * 8 + e] = f[e]; }
        for (int i = tid; i < 64 * 8; i += NTHR) { const int kr = i >> 3, ch = i & 7; const size_t krow = (size_t)b * T + kt * 64 + kr; float f[8];
            if (BR == 0) load8((const bf16_t*)(ws + O_VA) + krow * 128 + (h >> 2) * 64 + ch * 8, f); else load8((const bf16_t*)(ws + O_VB) + krow * 512 + h * 64 + ch * 8, f);
#pragma unroll
            for (int e = 0; e < 8; ++e) Vs[kr * 64 + ch * 8 + e] = f[e]; }
        __syncthreads();
#pragma unroll 1
        for (int kr = 0; kr < 64; ++kr) { float s = 0.f;
#pragma unroll 8
            for (int d = 0; d < DQ; ++d) s = fmaf(Qs[r * 97 + d], Ks[kr * 96 + d], s);
            if (s > m) { const float al = exp2f(m - s); l *= al;
#pragma unroll
                for (int j = 0; j < 32; ++j) o[j] *= al;
                m = s; }
            const float p = exp2f(s - m); l += p;
#pragma unroll
            for (int j = 0; j < 32; ++j) o[j] = fmaf(p, Vs[kr * 64 + half * 32 + j], o[j]); }
    }
    const float inv = 1.0f / l; bf16_t* Y = (bf16_t*)(ws + (BR ? O_YB : O_YA)) + row * 512 + h * 64 + half * 32;
#pragma unroll
    for (int j = 0; j < 32; j += 8) { float f[8];
#pragma unroll
        for (int e = 0; e < 8; ++e) f[e] = o[j + e] * inv;
        store8(Y + j, f); }
}

namespace att {
typedef short s16x4 __attribute__((ext_vector_type(4)));
typedef float f32x16 __attribute__((ext_vector_type(16)));
constexpr int SHM_V = 64 * 64 * 2, SHM_K = 64 * 256, OFF_K = 2 * SHM_V, OFF_WS = OFF_K + 2 * SHM_K, OFF_OST = OFF_WS + NWAVES * 64 * 4, ATT_LDS = OFF_OST + NWAVES * 4096;
constexpr float THRL = 8.0f;
#define KSWZ(row, colB) ((row) * 256 + ((colB) ^ (((row) & 7) << 4)))
#define SBAR() __builtin_amdgcn_sched_barrier(0)
__device__ __forceinline__ int crow(int r, int hi) { return (r & 3) + 8 * (r >> 2) + 4 * hi; }
__device__ __forceinline__ unsigned cvtpk(float lo, float hi) { unsigned r; asm volatile("v_cvt_pk_bf16_f32 %0, %1, %2" : "=v"(r) : "v"(lo), "v"(hi)); return r; }
__device__ __forceinline__ void partialSM(f32x16& p0, f32x16& p1, float& m_reg, float& mn, float& alpha) {
    float pmax = p0[0];
#pragma unroll
    for (int r = 1; r < 16; ++r) pmax = fmaxf(pmax, p0[r]);
#pragma unroll
    for (int r = 0; r < 16; ++r) pmax = fmaxf(pmax, p1[r]);
    { auto rr = __builtin_amdgcn_permlane32_swap(__float_as_uint(pmax), __float_as_uint(pmax), false, false); pmax = fmaxf(__uint_as_float(rr[0]), __uint_as_float(rr[1])); }
    if (__builtin_expect(__all(pmax - m_reg <= THRL), 1)) { mn = m_reg; alpha = 1.f; }
    else { mn = fmaxf(m_reg, pmax); alpha = __builtin_amdgcn_exp2f(m_reg - mn); m_reg = mn; }
#pragma unroll
    for (int r = 0; r < 16; ++r) { p0[r] -= mn; p1[r] -= mn; }
#pragma unroll
    for (int r = 0; r < 16; ++r) p0[r] = __builtin_amdgcn_exp2f(p0[r]);
}
__device__ __forceinline__ void finishSM(f32x16& p0, f32x16& p1, float alpha, float& l_reg, bf16x8& pa0, bf16x8& pa1, bf16x8& pa2, bf16x8& pa3) {
#pragma unroll
    for (int r = 0; r < 16; ++r) p1[r] = __builtin_amdgcn_exp2f(p1[r]);
    float ps = 0;
#pragma unroll
    for (int r = 0; r < 16; ++r) ps += p0[r];
#pragma unroll
    for (int r = 0; r < 16; ++r) ps += p1[r];
    { auto rr = __builtin_amdgcn_permlane32_swap(__float_as_uint(ps), __float_as_uint(ps), false, false); ps = __uint_as_float(rr[0]) + __uint_as_float(rr[1]); }
    l_reg = l_reg * alpha + ps;
#define PK4(P, BASE, OUT) do { unsigned a0 = cvtpk(P[BASE + 0], P[BASE + 1]), a1 = cvtpk(P[BASE + 2], P[BASE + 3]);   \
    unsigned b0 = cvtpk(P[BASE + 4], P[BASE + 5]), b1 = cvtpk(P[BASE + 6], P[BASE + 7]);                              \
    auto r0 = __builtin_amdgcn_permlane32_swap(a0, b0, false, false); auto r1 = __builtin_amdgcn_permlane32_swap(a1, b1, false, false); \
    u32x4 w = {r0[0], r1[0], r0[1], r1[1]}; OUT = __builtin_bit_cast(bf16x8, w); } while (0)
    PK4(p0, 0, pa0); PK4(p0, 8, pa1); PK4(p1, 0, pa2); PK4(p1, 8, pa3);
#undef PK4
}
template <int ND0>
__device__ __forceinline__ void qkt(f32x16& p0, f32x16& p1, const LAS unsigned char* Ks, const bf16x8* qr, int r32, int hi) {
    p0 = f32x16{}; p1 = f32x16{};
#pragma unroll
    for (int d0 = 0; d0 < ND0; ++d0) { const int cb = (d0 * 16 + hi * 8) * 2;
        const bf16x8 b0 = *(const LAS bf16x8*)(Ks + KSWZ(r32, cb)); const bf16x8 b1 = *(const LAS bf16x8*)(Ks + KSWZ(32 + r32, cb));
        p0 = __builtin_amdgcn_mfma_f32_32x32x16_bf16(b0, qr[d0], p0, 0, 0, 0); p1 = __builtin_amdgcn_mfma_f32_32x32x16_bf16(b1, qr[d0], p1, 0, 0, 0); }
}
__device__ __forceinline__ int v_st(int k, int c) { const int kk = (k & ~0xC) | ((k & 4) << 1) | ((k & 8) >> 1); return ((kk >> 3) * 2 + (c >> 5)) * 512 + ((kk & 7) * 32 + (c & 31)) * 2; }
__device__ __forceinline__ int v_rd_base(int lane) { return ((lane & 3) << 3) | (((lane >> 2) & 3) << 6) | (((lane >> 4) & 1) << 5) | (((lane >> 5) & 1) << 8); }
constexpr int v_rd_off(int d0, int ks, int half) { return d0 * 512 + ks * 2048 + half * 1024; }
template <int OFF> __device__ __forceinline__ s16x4 tr_read(int vb) { s16x4 r; asm volatile("ds_read_b64_tr_b16 %0, %1 offset:%2" : "=&v"(r) : "v"(vb), "i"(OFF) : "memory"); return r; }
template <int D0> __device__ __forceinline__ void pv_one(f32x16& od, int vb, bf16x8 pa0, bf16x8 pa1, bf16x8 pa2, bf16x8 pa3) {
    const s16x4 l0 = tr_read<v_rd_off(D0, 0, 0)>(vb), h0 = tr_read<v_rd_off(D0, 0, 1)>(vb), l1 = tr_read<v_rd_off(D0, 1, 0)>(vb), h1 = tr_read<v_rd_off(D0, 1, 1)>(vb);
    const s16x4 l2 = tr_read<v_rd_off(D0, 2, 0)>(vb), h2 = tr_read<v_rd_off(D0, 2, 1)>(vb), l3 = tr_read<v_rd_off(D0, 3, 0)>(vb), h3 = tr_read<v_rd_off(D0, 3, 1)>(vb);
    asm volatile("s_waitcnt lgkmcnt(0)" ::: "memory"); SBAR();
#define PK(L, H) (bf16x8){L[0], L[1], L[2], L[3], H[0], H[1], H[2], H[3]}
    od = __builtin_amdgcn_mfma_f32_32x32x16_bf16(pa0, PK(l0, h0), od, 0, 0, 0);
    od = __builtin_amdgcn_mfma_f32_32x32x16_bf16(pa1, PK(l1, h1), od, 0, 0, 0);
    od = __builtin_amdgcn_mfma_f32_32x32x16_bf16(pa2, PK(l2, h2), od, 0, 0, 0);
    od = __builtin_amdgcn_mfma_f32_32x32x16_bf16(pa3, PK(l3, h3), od, 0, 0, 0);
#undef PK
}
__device__ __forceinline__ void pv2(f32x16* o, int vb, bf16x8 pa0, bf16x8 pa1, bf16x8 pa2, bf16x8 pa3) { pv_one<0>(o[0], vb, pa0, pa1, pa2, pa3); pv_one<1>(o[1], vb, pa0, pa1, pa2, pa3); }

template <int BR>
__device__ __forceinline__ void unit(const Ctx& a, int b, int h, int qb, LAS unsigned char* lds, int tid_) {
    const int tid = launder_v(tid_);
    unsigned char* ws = a.ws; constexpr int DQ = BR ? 96 : 64, ND0 = DQ / 16, NKL = BR ? 2 : 1;
    const int wid = __builtin_amdgcn_readfirstlane(tid >> 6), lane = tid & 63, r32 = lane & 31, hi = lane >> 5;
    LAS unsigned char* V_lds = lds; LAS unsigned char* K_lds = lds + OFF_K;
    LAS float* wsf = (LAS float*)(lds + OFF_WS) + wid * 64; LAS float* li_l = wsf; LAS float* al_l = wsf + 32;
    const size_t row0 = (size_t)b * T + qb * 256, krow0 = (size_t)b * T;
    float m_reg = -1e30f, l_reg = 0; f32x16 o[2]; o[0] = f32x16{}; o[1] = f32x16{}; bf16x8 qr[ND0];
    {
        const size_t qrow = row0 + wid * 32 + r32;
        const bf16_t* Qw = BR ? (const bf16_t*)(ws + O_QB) + qrow * 768 + h * 96 + hi * 8 : (const bf16_t*)(ws + O_QA) + qrow * 512 + h * 64 + hi * 8;
#pragma unroll
        for (int d0 = 0; d0 < ND0; ++d0) qr[d0] = *(const bf16x8*)(Qw + d0 * 16);
        if (BR) {
            const float* tb = (const float*)(ws + O_TABB) + (int)(qrow & (T - 1)) * 32;
#pragma unroll
            for (int blk = 0; blk < 2; ++blk) { float x[8]; unpack8(__builtin_bit_cast(u32x4, qr[4 + blk]), x); float o8[8];
#pragma unroll
                for (int e = 0; e < 8; ++e) { const float pr = other_half(x[e], hi); const float cs = tb[blk * 8 + e], sn = tb[16 + blk * 8 + e]; o8[e] = hi ? x[e] * cs + pr * sn : x[e] * cs - pr * sn; }
                qr[4 + blk] = __builtin_bit_cast(bf16x8, pack8(o8)); } }
    }
    const int vr = tid >> 3, vc = (tid & 7) * 8, vst = v_st(vr, vc);
    int kr_[NKL], kc_[NKL];
#pragma unroll
    for (int i = 0; i < NKL; ++i) { int c = tid + i * 512; if (BR) { if (c >= 768) c -= 512; kr_[i] = c / 12; kc_[i] = c % 12; } else { kr_[i] = c >> 3; kc_[i] = c & 7; } }
    const bf16_t* Vsrc = BR ? (const bf16_t*)(ws + O_VB) + (krow0 + vr) * 512 + h * 64 + vc : (const bf16_t*)(ws + O_VA) + (krow0 + vr) * 128 + (h >> 2) * 64 + vc;
    const size_t vstep = (size_t)64 * (BR ? 512 : 128);
    const bf16_t* Ksrc[NKL]; size_t kstep_[NKL];
#pragma unroll
    for (int i = 0; i < NKL; ++i) {
        if (!BR) { Ksrc[i] = (const bf16_t*)(ws + O_KA) + (krow0 + kr_[i]) * 128 + (h >> 2) * 64 + kc_[i] * 8; kstep_[i] = (size_t)64 * 128; }
        else if (kc_[i] < 8) { Ksrc[i] = (const bf16_t*)(ws + O_KNOPE) + (krow0 + kr_[i]) * 512 + h * 64 + kc_[i] * 8; kstep_[i] = (size_t)64 * 512; }
        else { Ksrc[i] = (const bf16_t*)(ws + O_KROPE) + (krow0 + kr_[i]) * 32 + (kc_[i] - 8) * 8; kstep_[i] = (size_t)64 * 32; } }
    const bool k1_valid = !BR || tid < 256;
    const int vb0 = (int)(uintptr_t)V_lds + v_rd_base(lane);
    struct { bf16x8 v, k[NKL]; } sr_[2];
#define SLOAD(i, t) do { sr_[i].v = *(const bf16x8*)(Vsrc + (size_t)(t) * vstep); _Pragma("unroll") for (int q_ = 0; q_ < NKL; ++q_) sr_[i].k[q_] = *(const bf16x8*)(Ksrc[q_] + (size_t)(t) * kstep_[q_]); } while (0)
#define SWRITE(bb, i) do { *(LAS bf16x8*)(V_lds + (bb) * SHM_V + vst) = sr_[i].v; *(LAS bf16x8*)(K_lds + (bb) * SHM_K + KSWZ(kr_[0], kc_[0] * 16)) = sr_[i].k[0]; \
        if (NKL > 1) { if (k1_valid) *(LAS bf16x8*)(K_lds + (bb) * SHM_K + KSWZ(kr_[NKL - 1], kc_[NKL - 1] * 16)) = sr_[i].k[NKL - 1]; } } while (0)
#define RESC(al) do { if (__any((al) < 1.f)) { if (hi == 0) al_l[r32] = (al); asm volatile("s_waitcnt lgkmcnt(0)" ::: "memory"); \
        _Pragma("unroll") for (int d = 0; d < 2; ++d) _Pragma("unroll") for (int r = 0; r < 16; ++r) o[d][r] *= al_l[crow(r, hi)]; } } while (0)
    f32x16 pA0, pA1, pB0, pB1; float mnA, mnB, alA, alB; bf16x8 pa0, pa1, pa2, pa3; constexpr int NT = T / 64;
    __syncthreads();
    SLOAD(0, 0); SWRITE(0, 0); __syncthreads();
    qkt<ND0>(pA0, pA1, K_lds, qr, r32, hi); partialSM(pA0, pA1, m_reg, mnA, alA);
    SLOAD(1, 1); SLOAD(0, 2);
    SWRITE(1, 1); __syncthreads();
    for (int j = 1; j + 1 < NT; j += 2) {
        SBAR(); qkt<ND0>(pB0, pB1, K_lds + SHM_K, qr, r32, hi);
        finishSM(pA0, pA1, alA, l_reg, pa0, pa1, pa2, pa3); SBAR();
        SLOAD(1, j + 2); SBAR();
        pv2(o, vb0, pa0, pa1, pa2, pa3); partialSM(pB0, pB1, m_reg, mnB, alB);
        __syncthreads(); SWRITE(0, 0);
        RESC(alB); __syncthreads();
        SBAR(); qkt<ND0>(pA0, pA1, K_lds, qr, r32, hi);
        finishSM(pB0, pB1, alB, l_reg, pa0, pa1, pa2, pa3); SBAR();
        if (j + 3 < NT) SLOAD(0, j + 3); SBAR();
        pv2(o, vb0 + SHM_V, pa0, pa1, pa2, pa3); partialSM(pA0, pA1, m_reg, mnA, alA);
        __syncthreads(); SWRITE(1, 1);
        RESC(alA); __syncthreads();
    }
    SBAR(); qkt<ND0>(pB0, pB1, K_lds + SHM_K, qr, r32, hi);
    finishSM(pA0, pA1, alA, l_reg, pa0, pa1, pa2, pa3); SBAR();
    pv2(o, vb0, pa0, pa1, pa2, pa3); partialSM(pB0, pB1, m_reg, mnB, alB);
    __syncthreads(); RESC(alB);
    finishSM(pB0, pB1, alB, l_reg, pa0, pa1, pa2, pa3); SBAR();
    pv2(o, vb0 + SHM_V, pa0, pa1, pa2, pa3);
    if (hi == 0) li_l[r32] = l_reg; asm volatile("s_waitcnt lgkmcnt(0)" ::: "memory");
    float rli[16];
#pragma unroll
    for (int r = 0; r < 16; ++r) rli[r] = __builtin_amdgcn_rcpf(li_l[crow(r, hi)]);
    LAS bf16_t* stg = (LAS bf16_t*)(lds + OFF_OST) + wid * 2048;
#pragma unroll
    for (int r = 0; r < 16; ++r) { const int orow = crow(r, hi);
#pragma unroll
        for (int d0 = 0; d0 < 2; ++d0) stg[orow * 64 + d0 * 32 + r32] = (bf16_t)f2bf(o[d0][r] * rli[r]); }
    asm volatile("s_waitcnt lgkmcnt(0)" ::: "memory");
    bf16_t* Y = (bf16_t*)(ws + (BR ? O_YB : O_YA)) + (row0 + wid * 32) * 512 + h * 64;
#pragma unroll
    for (int i = 0; i < 4; ++i) { const int row = i * 8 + (lane >> 3), ch = lane & 7; const u32x4 v = *(const LAS u32x4*)(stg + row * 64 + ch * 8); *(u32x4*)(Y + (size_t)row * 512 + ch * 8) = v; }
#undef SLOAD
#undef SWRITE
#undef RESC
}
#undef KSWZ
#undef SBAR
}

namespace att64 {
typedef unsigned short bf16;
using s16x4=__attribute__((ext_vector_type(4)))short;
using f32x16=__attribute__((ext_vector_type(16)))float;
constexpr int SEQ=2048,D=64,QP=512,KP=128,VP=128,OP=512;
constexpr int NW=8,QBLK=32,QB=QBLK*NW,KVBLK=64,NQB=SEQ/QB;
__device__ __forceinline__ int crow(int r,int hi){return (r&3)+8*(r>>2)+4*hi;}
#define SBAR() __builtin_amdgcn_sched_barrier(0)
constexpr int NSLOT=3, SLOTB=8192;
constexpr int LDS_K=0, LDS_V=NSLOT*SLOTB, LDS_WS=2*NSLOT*SLOTB, LDS_OST=LDS_WS+NW*64*4, LDS_BYTES=LDS_OST+NW*4096;
constexpr float C2=0.125f*1.4426950408889634f;
__device__ __forceinline__ void glds16(const void*gsrc,unsigned lds_dst){unsigned keep;
  asm volatile("s_mov_b32 %0, m0\n\ts_mov_b32 m0, %2\n\ts_nop 0\n\tglobal_load_lds_dwordx4 %1, off\n\ts_mov_b32 m0, %0":"=&s"(keep):"v"(gsrc),"s"(lds_dst):"memory");}
__device__ __forceinline__ float max3f(float a,float b,float c){float r;asm("v_max3_f32 %0, %1, %2, %3":"=v"(r):"v"(a),"v"(b),"v"(c));return r;}
__device__ __forceinline__ float max2f(float a,float b){float r;asm("v_max_f32_e32 %0, %1, %2":"=v"(r):"v"(a),"v"(b));return r;}
__device__ __forceinline__ float fadd_s(float a,float b){float r;asm("v_add_f32_e32 %0, %1, %2":"=v"(r):"v"(a),"v"(b));return r;}
__device__ __forceinline__ float fsub_s(float a,float b){float r;asm("v_sub_f32_e32 %0, %1, %2":"=v"(r):"v"(a),"v"(b));return r;}
typedef float f32x2_t __attribute__((ext_vector_type(2))); typedef __bf16 bf16x2_t __attribute__((ext_vector_type(2)));
__device__ __forceinline__ unsigned cvtpk_s(float lo,float hi){f32x2_t v={lo,hi};bf16x2_t b=__builtin_convertvector(v,bf16x2_t);return __builtin_bit_cast(unsigned,b);}
#define WAIT_BAR(N) asm volatile("s_waitcnt vmcnt(" #N ") lgkmcnt(0)\n\ts_barrier":::"memory")

__device__ __forceinline__ void qkt(f32x16&p0,f32x16&p1,const char*Kslot,const bf16x8*qr,const f32x16&negm,int r32,int hi){
  const char*kb=Kslot+hi*1024+r32*16;
  #pragma unroll
  for(int d0=0;d0<4;++d0){
    const bf16x8 b0=*reinterpret_cast<const bf16x8*>(kb+d0*2048);
    const bf16x8 b1=*reinterpret_cast<const bf16x8*>(kb+d0*2048+512);
    if(d0==0){p0=__builtin_amdgcn_mfma_f32_32x32x16_bf16(b0,qr[0],negm,0,0,0);p1=__builtin_amdgcn_mfma_f32_32x32x16_bf16(b1,qr[0],negm,0,0,0);}
    else{p0=__builtin_amdgcn_mfma_f32_32x32x16_bf16(b0,qr[d0],p0,0,0,0);p1=__builtin_amdgcn_mfma_f32_32x32x16_bf16(b1,qr[d0],p1,0,0,0);}}
}
typedef __attribute__((address_space(3))) const char* lds_cptr;
typedef short v4i16_t __attribute__((ext_vector_type(4)));
__device__ __forceinline__ void kload8(bf16x8*kf,lds_cptr kp){
  kf[0]=*(const __attribute__((address_space(3))) bf16x8*)(kp);      kf[1]=*(const __attribute__((address_space(3))) bf16x8*)(kp+512);
  kf[2]=*(const __attribute__((address_space(3))) bf16x8*)(kp+2048); kf[3]=*(const __attribute__((address_space(3))) bf16x8*)(kp+2560);
  kf[4]=*(const __attribute__((address_space(3))) bf16x8*)(kp+4096); kf[5]=*(const __attribute__((address_space(3))) bf16x8*)(kp+4608);
  kf[6]=*(const __attribute__((address_space(3))) bf16x8*)(kp+6144); kf[7]=*(const __attribute__((address_space(3))) bf16x8*)(kp+6656);
}
__device__ __forceinline__ void kload2(bf16x8*kf,lds_cptr kp,int j){ kf[2*j]=*(const __attribute__((address_space(3))) bf16x8*)(kp+j*2048); kf[2*j+1]=*(const __attribute__((address_space(3))) bf16x8*)(kp+j*2048+512); }
__device__ __forceinline__ s16x4 vtr(lds_cptr p){ return __builtin_bit_cast(s16x4,__builtin_amdgcn_ds_read_tr16_b64_v4i16((__attribute__((address_space(3))) v4i16_t*)p)); }
__device__ __forceinline__ float rowmax(const f32x16&p0,const f32x16&p1){
  float a=max3f(p0[0],p0[1],p1[0]),b=max3f(p0[2],p0[3],p1[1]);a=max3f(a,p1[2],p1[3]);
  #pragma unroll
  for(int r=4;r<16;r+=4){a=max3f(a,p0[r],p0[r+1]);b=max3f(b,p0[r+2],p0[r+3]);a=max3f(a,p1[r],p1[r+1]);b=max3f(b,p1[r+2],p1[r+3]);}
  const float m=max2f(a,b);
  auto rr=__builtin_amdgcn_permlane32_swap(__float_as_uint(m),__float_as_uint(m),false,false);
  return max2f(__uint_as_float(rr[0]),__uint_as_float(rr[1]));
}
__device__ __forceinline__ void pv(f32x16*o,int vb,bf16x8 pa0,bf16x8 pa1,bf16x8 pa2,bf16x8 pa3){
  #pragma unroll
  for(int d0=0;d0<2;++d0){s16x4 lo[4],hi[4];
    #pragma unroll
    for(int ks=0;ks<4;++ks){
      asm volatile("ds_read_b64_tr_b16 %0,%1 offset:%c2":"=&v"(lo[ks]):"v"(vb),"i"(d0*4096+ks*1024):"memory");
      asm volatile("ds_read_b64_tr_b16 %0,%1 offset:%c2":"=&v"(hi[ks]):"v"(vb),"i"(d0*4096+ks*1024+512):"memory");}
    asm volatile("s_waitcnt lgkmcnt(0)":::"memory");SBAR();
    #define PK(k) (bf16x8){lo[k][0],lo[k][1],lo[k][2],lo[k][3],hi[k][0],hi[k][1],hi[k][2],hi[k][3]}
    o[d0]=__builtin_amdgcn_mfma_f32_32x32x16_bf16(pa0,PK(0),o[d0],0,0,0);
    o[d0]=__builtin_amdgcn_mfma_f32_32x32x16_bf16(pa1,PK(1),o[d0],0,0,0);
    o[d0]=__builtin_amdgcn_mfma_f32_32x32x16_bf16(pa2,PK(2),o[d0],0,0,0);
    o[d0]=__builtin_amdgcn_mfma_f32_32x32x16_bf16(pa3,PK(3),o[d0],0,0,0);
    #undef PK
  }
}

#ifndef ATTN_STORE16
#define ATTN_STORE16(p,v) (*(u32x4*)(p)=(v))
#endif
template<int THRL> __device__ __forceinline__ void attn_unit(int b,int h,int qb,const bf16*Q,const bf16*__restrict__ K,const bf16*__restrict__ V,bf16*O,char*shm,int tid_){
  const int tid=launder_v(tid_),lane=tid&63,r32=lane&31,hi=lane>>5; const int wid=__builtin_amdgcn_readfirstlane(tid>>6);
  const long rowbase=(long)b*SEQ; const int q0=qb*QB;
  const bf16*Qw=Q+(rowbase+q0+wid*QBLK)*QP+h*D;
  const bf16*Kh=K+rowbase*KP,*Vh=V+rowbase*VP;
  const unsigned lds0=(unsigned)(uintptr_t)shm;
  float*wsf=(float*)(shm+LDS_WS)+wid*64;
  const bf16*ksrc=Kh+(long)lane*KP+wid*8;
  const bf16*vsrc=Vh+(long)(16*(wid&3)+(lane>>2))*VP+(wid>>2)*32+(lane&3)*8;
  const unsigned kdst=lds0+LDS_K+wid*1024, vdst=lds0+LDS_V+wid*1024;
  #define DMA_K(t,slot) glds16(ksrc+(long)(t)*KVBLK*KP,(unsigned)__builtin_amdgcn_readfirstlane(kdst+(slot)))
  #define DMA_V(t,slot) glds16(vsrc+(long)(t)*KVBLK*VP,(unsigned)__builtin_amdgcn_readfirstlane(vdst+(slot)))
  const int vb0=(int)(lds0+LDS_V)+((lane>>4)&1)*32+(lane&3)*8+(4*hi+((lane&15)>>2))*64;
  const char*Kbase=shm+LDS_K; bf16x8 kf[8];
  const lds_cptr shm3=(lds_cptr)shm; const lds_cptr kp0=shm3+LDS_K+hi*1024+r32*16; const lds_cptr vp0=shm3+LDS_V+((lane>>4)&1)*32+(lane&3)*8+(4*hi+((lane&15)>>2))*64;
  constexpr int NT=SEQ/KVBLK;
  DMA_K(0,0);DMA_V(0,0);DMA_K(1,SLOTB);
  bf16x8 qr[4];
  #pragma unroll
  for(int d0=0;d0<4;++d0)qr[d0]=*reinterpret_cast<const bf16x8*>(&Qw[(long)r32*QP+d0*16+hi*8]);
  float mhat=0.f,l_reg=0.f;f32x16 o[2];o[0]=f32x16{};o[1]=f32x16{};f32x16 negm=f32x16{};asm volatile("":"+v"(negm));
  #define CMASK(P0,P1,t) do{}while(0)
  bool resc=false;
  #define START(P0,P1) do{ const float rm=rowmax(P0,P1); resc=false; \
    { const float dl=rm; mhat=fadd_s(mhat,dl); \
      _Pragma("unroll") for(int r=0;r<16;++r){P0[r]=fsub_s(P0[r],dl);P1[r]=fsub_s(P1[r],dl);} \
      _Pragma("unroll") for(int r=0;r<16;++r)negm[r]=-mhat; asm volatile("":"+v"(negm)); } \
    _Pragma("unroll") for(int r=0;r<16;++r)P0[r]=__builtin_amdgcn_exp2f(P0[r]); }while(0)
  #define RESC() do{ if(resc){ asm volatile("s_waitcnt lgkmcnt(0)":::"memory"); \
      _Pragma("unroll") for(int d_=0;d_<2;++d_) _Pragma("unroll") for(int r=0;r<16;++r)o[d_][r]*=wsf[crow(r,hi)]; } }while(0)
  f32x16 pA0,pA1,pB0,pB1;
  int sl_prev=0,sl_cur=0,sl_next=SLOTB;
  #define ROT() do{sl_prev=sl_cur;sl_cur=sl_next;sl_next=(sl_next==(NSLOT-1)*SLOTB)?0:sl_next+SLOTB;}while(0)
  DMA_K(2,2*SLOTB);
  WAIT_BAR(3);
  qkt(pA0,pA1,Kbase,qr,negm,r32,hi);asm volatile("s_nop 15\n\ts_nop 7":"+v"(pA0),"+v"(pA1));CMASK(pA0,pA1,0);
  START(pA0,pA1);
  _Pragma("unroll") for(int r=0;r<16;++r)pA1[r]=__builtin_amdgcn_exp2f(pA1[r]);
  WAIT_BAR(0);
  DMA_K(3,0);DMA_V(1,SLOTB);
  ROT();
  kload8(kf,kp0+sl_cur);
  WAIT_BAR(2);
  s16x4 vlo[8],vhi[8]; u32x4 pw0,pw1,pw2,pw3;
  #define PKW(P,B) cvtpk_s(P[B],P[B+1])
  #define PAF(k) __builtin_bit_cast(bf16x8,pw##k)
  #define VFR(i) (bf16x8){vlo[i][0],vlo[i][1],vlo[i][2],vlo[i][3],vhi[i][0],vhi[i][1],vhi[i][2],vhi[i][3]}
  #define PIN(x) asm volatile("":"+v"(x))
  #define MX3(a,b,c) __builtin_fmaxf(__builtin_fmaxf((a),(b)),(c))
  #define GAPA(MF,A0,A1,A2,A3,W0,W1,PW) do{ MF; sacc+=A0; sacc+=A1; sacc+=A2; sacc+=A3; PIN(sacc); W0; W1; PIN(PW); SBAR(); }while(0)
  #define EX(v) __builtin_amdgcn_exp2f(v)
  #define GAPB(MF,X,B) do{ MF; X[B]=EX(X[B]); X[B+1]=EX(X[B+1]); X[B+2]=EX(X[B+2]); X[B+3]=EX(X[B+3]); PIN(X); SBAR(); }while(0)
  #define VRD(i) do{ vlo[i]=vtr(vp_+(((i)>>2)*4096+((i)&3)*1024)); vhi[i]=vtr(vp_+(((i)>>2)*4096+((i)&3)*1024+512)); }while(0)
  #define KRD(G,j) do{ if(G){ kload2(kf,kp0+sl_next,j); SBAR(); } }while(0)
  #define STEP(C0,C1,P0,P1,t,GK,GV,GL) do{ SBAR(); \
    const lds_cptr vp_=vp0+sl_prev; \
    VRD(0); SBAR(); float sacc=(P0[0]+P0[1]); \
    GAPA(C0=__builtin_amdgcn_mfma_f32_32x32x16_bf16(kf[0],qr[0],negm,0,0,0), P0[2],P0[3],P0[4],P0[5],     pw0[0]=PKW(P0,0), pw0[1]=PKW(P0,2), pw0); \
    VRD(4); SBAR(); GAPA(C1=__builtin_amdgcn_mfma_f32_32x32x16_bf16(kf[1],qr[0],negm,0,0,0), P0[6],P0[7],P0[8],P0[9],     pw0[2]=PKW(P0,4), pw0[3]=PKW(P0,6), pw0); \
    VRD(1); SBAR(); GAPA(C0=__builtin_amdgcn_mfma_f32_32x32x16_bf16(kf[2],qr[1],C0,0,0,0),   P0[10],P0[11],P0[12],P0[13], pw1[0]=PKW(P0,8), pw1[1]=PKW(P0,10), pw1); \
    VRD(5); SBAR(); GAPA(C1=__builtin_amdgcn_mfma_f32_32x32x16_bf16(kf[3],qr[1],C1,0,0,0),   P0[14],P0[15],P1[0],P1[1],   pw1[2]=PKW(P0,12),pw1[3]=PKW(P0,14), pw1); \
    VRD(2); SBAR(); GAPA(C0=__builtin_amdgcn_mfma_f32_32x32x16_bf16(kf[4],qr[2],C0,0,0,0),   P1[2],P1[3],P1[4],P1[5],     pw2[0]=PKW(P1,0), pw2[1]=PKW(P1,2), pw2); \
    VRD(6); SBAR(); GAPA(C1=__builtin_amdgcn_mfma_f32_32x32x16_bf16(kf[5],qr[2],C1,0,0,0),   P1[6],P1[7],P1[8],P1[9],     pw2[2]=PKW(P1,4), pw2[3]=PKW(P1,6), pw2); \
    VRD(3); SBAR(); GAPA(C0=__builtin_amdgcn_mfma_f32_32x32x16_bf16(kf[6],qr[3],C0,0,0,0),   P1[10],P1[11],P1[12],P1[13], pw3[0]=PKW(P1,8), pw3[1]=PKW(P1,10), pw3); \
    VRD(7); SBAR(); GAPA(C1=__builtin_amdgcn_mfma_f32_32x32x16_bf16(kf[7],qr[3],C1,0,0,0),   P1[14],P1[15],0.f,0.f,       pw3[2]=PKW(P1,12),pw3[3]=PKW(P1,14), pw3); \
    l_reg+=sacc; \
    if(GK){DMA_K((t)+3,sl_cur);} if(GV){DMA_V((t)+1,sl_next);} \
    CMASK(C0,C1,t); \
    { float a=MX3(C0[0],C0[1],C1[0]),b=MX3(C0[2],C0[3],C1[1]); a=MX3(a,C1[2],C1[3]); \
      _Pragma("unroll") for(int r=4;r<16;r+=4){a=MX3(a,C0[r],C0[r+1]);b=MX3(b,C0[r+2],C0[r+3]);a=MX3(a,C1[r],C1[r+1]);b=MX3(b,C1[r+2],C1[r+3]);} \
      float rm=__builtin_fmaxf(a,b); { auto rr=__builtin_amdgcn_permlane32_swap(__float_as_uint(rm),__float_as_uint(rm),false,false); rm=__builtin_fmaxf(__uint_as_float(rr[0]),__uint_as_float(rr[1])); } \
      resc=false; \
      if(__builtin_expect(__any(rm>(float)THRL),0)){ const float dl=__builtin_fmaxf(rm,0.f); mhat+=dl; \
        _Pragma("unroll") for(int r=0;r<16;++r){C0[r]-=dl;C1[r]-=dl;} \
        _Pragma("unroll") for(int r=0;r<16;++r)negm[r]=-mhat; asm volatile("":"+v"(negm)); \
        const float f=__builtin_amdgcn_exp2f(-dl); l_reg*=f; if(hi==0)wsf[r32]=f; resc=true; } } \
    SBAR(); \
    GAPB(o[0]=__builtin_amdgcn_mfma_f32_32x32x16_bf16(PAF(0),VFR(0),o[0],0,0,0), C0,0); \
    GAPB(o[1]=__builtin_amdgcn_mfma_f32_32x32x16_bf16(PAF(0),VFR(4),o[1],0,0,0), C0,4); \
    KRD(GL,0); GAPB(o[0]=__builtin_amdgcn_mfma_f32_32x32x16_bf16(PAF(1),VFR(1),o[0],0,0,0), C0,8); \
    KRD(GL,1); GAPB(o[1]=__builtin_amdgcn_mfma_f32_32x32x16_bf16(PAF(1),VFR(5),o[1],0,0,0), C0,12); \
    KRD(GL,2); GAPB(o[0]=__builtin_amdgcn_mfma_f32_32x32x16_bf16(PAF(2),VFR(2),o[0],0,0,0), C1,0); \
    KRD(GL,3); GAPB(o[1]=__builtin_amdgcn_mfma_f32_32x32x16_bf16(PAF(2),VFR(6),o[1],0,0,0), C1,4); \
    GAPB(o[0]=__builtin_amdgcn_mfma_f32_32x32x16_bf16(PAF(3),VFR(3),o[0],0,0,0), C1,8); \
    GAPB(o[1]=__builtin_amdgcn_mfma_f32_32x32x16_bf16(PAF(3),VFR(7),o[1],0,0,0), C1,12); \
    }while(0)
  int t=1;
  for(;t+5<NT;t+=2){
    STEP(pB0,pB1,pA0,pA1,t,true,true,true);     WAIT_BAR(2); RESC(); ROT();
    STEP(pA0,pA1,pB0,pB1,t+1,true,true,true);   WAIT_BAR(2); RESC(); ROT();
  }
  #define ENDW(tt) do{ if((tt)+3<NT){WAIT_BAR(2);} else if((tt)+2<NT){WAIT_BAR(1);} else {WAIT_BAR(0);} }while(0)
  for(;t+1<NT;t+=2){
    STEP(pB0,pB1,pA0,pA1,t,(t+3<NT),(t+1<NT),(t+1<NT));       ENDW(t);   RESC(); ROT();
    STEP(pA0,pA1,pB0,pB1,t+1,(t+4<NT),(t+2<NT),(t+2<NT));     ENDW(t+1); RESC(); ROT();
  }
  STEP(pB0,pB1,pA0,pA1,NT-1,false,false,false); RESC();
  { float sacc=pB0[0]+pB0[1]; _Pragma("unroll") for(int r=2;r<16;++r)sacc+=pB0[r]; _Pragma("unroll") for(int r=0;r<16;++r)sacc+=pB1[r]; l_reg+=sacc;
    pw0=(u32x4){PKW(pB0,0),PKW(pB0,2),PKW(pB0,4),PKW(pB0,6)};pw1=(u32x4){PKW(pB0,8),PKW(pB0,10),PKW(pB0,12),PKW(pB0,14)};pw2=(u32x4){PKW(pB1,0),PKW(pB1,2),PKW(pB1,4),PKW(pB1,6)};pw3=(u32x4){PKW(pB1,8),PKW(pB1,10),PKW(pB1,12),PKW(pB1,14)};
    SBAR(); pv(o,vb0+sl_cur,PAF(0),PAF(1),PAF(2),PAF(3)); }
  #undef PKW
  #undef PAF
  #undef VFR
  #undef PIN
  #undef MX3
  #undef GAPA
  #undef GAPB
  #undef EX
  #undef VRD
  #undef KRD
  #undef STEP
  #undef ENDW
  {auto rr=__builtin_amdgcn_permlane32_swap(__float_as_uint(l_reg),__float_as_uint(l_reg),false,false);l_reg=__uint_as_float(rr[0])+__uint_as_float(rr[1]);}
  if(hi==0)wsf[32+r32]=l_reg;asm volatile("s_waitcnt lgkmcnt(0)":::"memory");
  float rli[16];
  #pragma unroll
  for(int r=0;r<16;++r)rli[r]=__builtin_amdgcn_rcpf(wsf[32+crow(r,hi)]);
  bf16*Ow=O+(rowbase+q0+wid*QBLK)*OP+h*D;
  { bf16*stg=(bf16*)(shm+LDS_OST)+wid*2048;
    #pragma unroll
    for(int r=0;r<16;++r){const int orow=crow(r,hi);
      #pragma unroll
      for(int d0=0;d0<2;++d0)stg[orow*64+d0*32+r32]=(bf16)f2bf(o[d0][r]*rli[r]);}
    asm volatile("s_waitcnt lgkmcnt(0)":::"memory");
    #pragma unroll
    for(int i=0;i<4;++i){const int row=i*8+(lane>>3),ch=lane&7; const u32x4 v=*(const u32x4*)(stg+row*64+ch*8); ATTN_STORE16(Ow+(long)row*OP+ch*8,v);} }
  asm volatile("s_waitcnt lgkmcnt(0)\n\ts_barrier":::"memory");
  #undef DMA_K
  #undef DMA_V
  #undef CMASK
  #undef START
  #undef RESC
  #undef ROT
}
constexpr int ATTN_LDS_BYTES=LDS_BYTES;
#undef SBAR
#undef WAIT_BAR
}

namespace att96 {
typedef unsigned short bf16;
using s16x4=__attribute__((ext_vector_type(4)))short;
using f32x16=__attribute__((ext_vector_type(16)))float;
constexpr int SEQ=2048,D=64,DQ=96,QP=768,KP=512,RP=32,VP=512,OP=512;
constexpr int NW=8,QBLK=32,QB=QBLK*NW,KVBLK=64,NQB=SEQ/QB;
__device__ __forceinline__ int crow(int r,int hi){return (r&3)+8*(r>>2)+4*hi;}
#define SBAR() __builtin_amdgcn_sched_barrier(0)
constexpr int NSLOT=3, SLOTB=8192;
constexpr int LDS_K=0, LDS_V=NSLOT*2*SLOTB, LDS_WS=LDS_V+NSLOT*SLOTB, LDS_OST=LDS_WS+NW*64*4, LDS_BYTES=LDS_OST+NW*4096;
constexpr float C2=0.125f*1.4426950408889634f;
__device__ __forceinline__ void glds16(const void*gsrc,unsigned lds_dst){unsigned keep;
  asm volatile("s_mov_b32 %0, m0\n\ts_mov_b32 m0, %2\n\ts_nop 0\n\tglobal_load_lds_dwordx4 %1, off\n\ts_mov_b32 m0, %0":"=&s"(keep):"v"(gsrc),"s"(lds_dst):"memory");}
__device__ __forceinline__ float max3f(float a,float b,float c){float r;asm("v_max3_f32 %0, %1, %2, %3":"=v"(r):"v"(a),"v"(b),"v"(c));return r;}
__device__ __forceinline__ float max2f(float a,float b){float r;asm("v_max_f32_e32 %0, %1, %2":"=v"(r):"v"(a),"v"(b));return r;}
__device__ __forceinline__ float fadd_s(float a,float b){float r;asm("v_add_f32_e32 %0, %1, %2":"=v"(r):"v"(a),"v"(b));return r;}
__device__ __forceinline__ float fsub_s(float a,float b){float r;asm("v_sub_f32_e32 %0, %1, %2":"=v"(r):"v"(a),"v"(b));return r;}
typedef float f32x2_t __attribute__((ext_vector_type(2))); typedef __bf16 bf16x2_t __attribute__((ext_vector_type(2)));
__device__ __forceinline__ unsigned cvtpk_s(float lo,float hi){f32x2_t v={lo,hi};bf16x2_t b=__builtin_convertvector(v,bf16x2_t);return __builtin_bit_cast(unsigned,b);}
#define WAIT_BAR(N) asm volatile("s_waitcnt vmcnt(" #N ") lgkmcnt(0)\n\ts_barrier":::"memory")

__device__ __forceinline__ void qkt(f32x16&p0,f32x16&p1,const char*Kslot,const bf16x8*qr,int r32,int hi){
  const char*kb=Kslot+hi*1024+r32*16;
  #pragma unroll
  for(int d0=0;d0<6;++d0){
    const bf16x8 b0=*reinterpret_cast<const bf16x8*>(kb+d0*2048);
    const bf16x8 b1=*reinterpret_cast<const bf16x8*>(kb+d0*2048+512);
    if(d0==0){p0=__builtin_amdgcn_mfma_f32_32x32x16_bf16(b0,qr[0],f32x16{},0,0,0);p1=__builtin_amdgcn_mfma_f32_32x32x16_bf16(b1,qr[0],f32x16{},0,0,0);}
    else{p0=__builtin_amdgcn_mfma_f32_32x32x16_bf16(b0,qr[d0],p0,0,0,0);p1=__builtin_amdgcn_mfma_f32_32x32x16_bf16(b1,qr[d0],p1,0,0,0);}}
}
typedef __attribute__((address_space(3))) const char* lds_cptr;
typedef short v4i16_t __attribute__((ext_vector_type(4)));
__device__ __forceinline__ void kload8(bf16x8*kf,lds_cptr kp){
  kf[0]=*(const __attribute__((address_space(3))) bf16x8*)(kp);      kf[1]=*(const __attribute__((address_space(3))) bf16x8*)(kp+512);
  kf[2]=*(const __attribute__((address_space(3))) bf16x8*)(kp+2048); kf[3]=*(const __attribute__((address_space(3))) bf16x8*)(kp+2560);
  kf[4]=*(const __attribute__((address_space(3))) bf16x8*)(kp+4096); kf[5]=*(const __attribute__((address_space(3))) bf16x8*)(kp+4608);
  kf[6]=*(const __attribute__((address_space(3))) bf16x8*)(kp+6144); kf[7]=*(const __attribute__((address_space(3))) bf16x8*)(kp+6656);
  kf[8]=*(const __attribute__((address_space(3))) bf16x8*)(kp+8192); kf[9]=*(const __attribute__((address_space(3))) bf16x8*)(kp+8704);
  kf[10]=*(const __attribute__((address_space(3))) bf16x8*)(kp+10240); kf[11]=*(const __attribute__((address_space(3))) bf16x8*)(kp+10752);
}
__device__ __forceinline__ void kload2(bf16x8*kf,lds_cptr kp,int j){ kf[2*j]=*(const __attribute__((address_space(3))) bf16x8*)(kp+j*2048); kf[2*j+1]=*(const __attribute__((address_space(3))) bf16x8*)(kp+j*2048+512); }
__device__ __forceinline__ s16x4 vtr(lds_cptr p){ return __builtin_bit_cast(s16x4,__builtin_amdgcn_ds_read_tr16_b64_v4i16((__attribute__((address_space(3))) v4i16_t*)p)); }
__device__ __forceinline__ float rowmax(const f32x16&p0,const f32x16&p1){
  float a=max3f(p0[0],p0[1],p1[0]),b=max3f(p0[2],p0[3],p1[1]);a=max3f(a,p1[2],p1[3]);
  #pragma unroll
  for(int r=4;r<16;r+=4){a=max3f(a,p0[r],p0[r+1]);b=max3f(b,p0[r+2],p0[r+3]);a=max3f(a,p1[r],p1[r+1]);b=max3f(b,p1[r+2],p1[r+3]);}
  const float m=max2f(a,b);
  auto rr=__builtin_amdgcn_permlane32_swap(__float_as_uint(m),__float_as_uint(m),false,false);
  return max2f(__uint_as_float(rr[0]),__uint_as_float(rr[1]));
}
__device__ __forceinline__ void pv(f32x16*o,int vb,bf16x8 pa0,bf16x8 pa1,bf16x8 pa2,bf16x8 pa3){
  #pragma unroll
  for(int d0=0;d0<2;++d0){s16x4 lo[4],hi[4];
    #pragma unroll
    for(int ks=0;ks<4;++ks){
      asm volatile("ds_read_b64_tr_b16 %0,%1 offset:%c2":"=&v"(lo[ks]):"v"(vb),"i"(d0*4096+ks*1024):"memory");
      asm volatile("ds_read_b64_tr_b16 %0,%1 offset:%c2":"=&v"(hi[ks]):"v"(vb),"i"(d0*4096+ks*1024+512):"memory");}
    asm volatile("s_waitcnt lgkmcnt(0)":::"memory");SBAR();
    #define PK(k) (bf16x8){lo[k][0],lo[k][1],lo[k][2],lo[k][3],hi[k][0],hi[k][1],hi[k][2],hi[k][3]}
    o[d0]=__builtin_amdgcn_mfma_f32_32x32x16_bf16(pa0,PK(0),o[d0],0,0,0);
    o[d0]=__builtin_amdgcn_mfma_f32_32x32x16_bf16(pa1,PK(1),o[d0],0,0,0);
    o[d0]=__builtin_amdgcn_mfma_f32_32x32x16_bf16(pa2,PK(2),o[d0],0,0,0);
    o[d0]=__builtin_amdgcn_mfma_f32_32x32x16_bf16(pa3,PK(3),o[d0],0,0,0);
    #undef PK
  }
}

#ifndef ATTN_STORE16
#define ATTN_STORE16(p,v) (*(u32x4*)(p)=(v))
#endif
template<int THRL> __device__ __forceinline__ void attn_unit(int b,int h,int qb,const bf16*Q,const bf16*__restrict__ K,const bf16*__restrict__ KR,const bf16*__restrict__ V,bf16*O,const float*tabb,char*shm,int tid_){
  const int tid=launder_v(tid_),lane=tid&63,r32=lane&31,hi=lane>>5; const int wid=__builtin_amdgcn_readfirstlane(tid>>6);
  const long rowbase=(long)b*SEQ; const int q0=qb*QB;
  const bf16*Qw=Q+(rowbase+q0+wid*QBLK)*QP+h*DQ;
  const bf16*Kh=K+rowbase*KP,*KRh=KR+rowbase*RP,*Vh=V+rowbase*VP;
  const unsigned lds0=(unsigned)(uintptr_t)shm;
  float*wsf=(float*)(shm+LDS_WS)+wid*64;
  const bf16*ksrc=Kh+(long)lane*KP+wid*8;
  const bf16*ksrc2=KRh+(long)lane*RP+(wid&3)*8;
  const bf16*vsrc=Vh+(long)(16*(wid&3)+(lane>>2))*VP+(wid>>2)*32+(lane&3)*8;
  const unsigned kdst=lds0+LDS_K+wid*1024, vdst=lds0+LDS_V+wid*1024;
  #define DMA_K(t,slot) do{ glds16(ksrc+(long)(t)*KVBLK*KP,(unsigned)__builtin_amdgcn_readfirstlane(kdst+2*(slot))); glds16(ksrc2+(long)(t)*KVBLK*RP,(unsigned)__builtin_amdgcn_readfirstlane(kdst+8192+2*(slot))); }while(0)
  #define DMA_V(t,slot) glds16(vsrc+(long)(t)*KVBLK*VP,(unsigned)__builtin_amdgcn_readfirstlane(vdst+(slot)))
  const int vb0=(int)(lds0+LDS_V)+((lane>>4)&1)*32+(lane&3)*8+(4*hi+((lane&15)>>2))*64;
  const char*Kbase=shm+LDS_K; bf16x8 kf[12];
  const lds_cptr shm3=(lds_cptr)shm; const lds_cptr kp0=shm3+LDS_K+hi*1024+r32*16; const lds_cptr vp0=shm3+LDS_V+((lane>>4)&1)*32+(lane&3)*8+(4*hi+((lane&15)>>2))*64;
  constexpr int NT=SEQ/KVBLK;
  DMA_K(0,0);DMA_V(0,0);DMA_K(1,SLOTB);
  bf16x8 qr[6];
  #pragma unroll
  for(int d0=0;d0<6;++d0)qr[d0]=*reinterpret_cast<const bf16x8*>(&Qw[(long)r32*QP+d0*16+hi*8]);
  { const float*tb=tabb+(int)((rowbase+q0+wid*QBLK+r32)&(SEQ-1))*32;
    #pragma unroll
    for(int blk=0;blk<2;++blk){ float x[8],o8[8]; unpack8(__builtin_bit_cast(u32x4,qr[4+blk]),x);
      #pragma unroll
      for(int e=0;e<8;++e){ const float pr=other_half(x[e],hi); const float cs=tb[blk*8+e],sn=tb[16+blk*8+e]; o8[e]=hi?x[e]*cs+pr*sn:x[e]*cs-pr*sn; }
      qr[4+blk]=__builtin_bit_cast(bf16x8,pack8(o8)); } }
  __attribute__((address_space(3))) bf16x8* const qpark=(__attribute__((address_space(3))) bf16x8*)((lds_cptr)shm+LDS_OST+wid*4096)+lane*2;
  qpark[0]=qr[4]; qpark[1]=qr[5];
  float mhat=0.f,l_reg=0.f;f32x16 o[2];o[0]=f32x16{};o[1]=f32x16{};
  #define CMASK(P0,P1,t) do{}while(0)
  bool resc=false;
  #define START(P0,P1) do{ const float rm=rowmax(P0,P1); resc=false; \
    { const float dl=rm; mhat=fadd_s(mhat,dl); \
      _Pragma("unroll") for(int r=0;r<16;++r){P0[r]=fsub_s(P0[r],dl);P1[r]=fsub_s(P1[r],dl);} } \
    _Pragma("unroll") for(int r=0;r<16;++r)P0[r]=__builtin_amdgcn_exp2f(P0[r]); }while(0)
  #define RESC() do{ if(resc){ asm volatile("s_waitcnt lgkmcnt(0)":::"memory"); \
      _Pragma("unroll") for(int d_=0;d_<2;++d_) _Pragma("unroll") for(int r=0;r<16;++r)o[d_][r]*=wsf[crow(r,hi)]; } }while(0)
  f32x16 pA0,pA1,pB0,pB1;
  int sl_prev=0,sl_cur=0,sl_next=SLOTB;
  #define ROT() do{sl_prev=sl_cur;sl_cur=sl_next;sl_next=(sl_next==(NSLOT-1)*SLOTB)?0:sl_next+SLOTB;}while(0)
  DMA_K(2,2*SLOTB);
  WAIT_BAR(5);
  qkt(pA0,pA1,Kbase,qr,r32,hi);asm volatile("s_nop 15\n\ts_nop 7":"+v"(pA0),"+v"(pA1));CMASK(pA0,pA1,0);
  START(pA0,pA1);
  _Pragma("unroll") for(int r=0;r<16;++r)pA1[r]=__builtin_amdgcn_exp2f(pA1[r]);
  WAIT_BAR(0);
  DMA_K(3,0);DMA_V(1,SLOTB);
  ROT();
  kload8(kf,kp0+2*sl_cur);
  WAIT_BAR(3);
  s16x4 vlo[8],vhi[8]; u32x4 pw0,pw1,pw2,pw3;
  #define PKW(P,B) cvtpk_s(P[B],P[B+1])
  #define PAF(k) __builtin_bit_cast(bf16x8,pw##k)
  #define VFR(i) (bf16x8){vlo[i][0],vlo[i][1],vlo[i][2],vlo[i][3],vhi[i][0],vhi[i][1],vhi[i][2],vhi[i][3]}
  #define PIN(x) asm volatile("":"+v"(x))
  #define MX3(a,b,c) __builtin_fmaxf(__builtin_fmaxf((a),(b)),(c))
  #define GAPA(MF,A0,A1,A2,A3,W0,W1,PW) do{ MF; sacc+=A0; sacc+=A1; sacc+=A2; sacc+=A3; PIN(sacc); W0; W1; PIN(PW); SBAR(); }while(0)
  #define EX(v) __builtin_amdgcn_exp2f(v)
  #define GAPB(MF,X,B) do{ MF; X[B]=EX(X[B]); X[B+1]=EX(X[B+1]); X[B+2]=EX(X[B+2]); X[B+3]=EX(X[B+3]); PIN(X); SBAR(); }while(0)
  #define VRD(i) do{ vlo[i]=vtr(vp_+(((i)>>2)*4096+((i)&3)*1024)); vhi[i]=vtr(vp_+(((i)>>2)*4096+((i)&3)*1024+512)); }while(0)
  #define KRD(G,j) do{ if(G){ kload2(kf,kp0+2*sl_next,j); SBAR(); } }while(0)
  #define STEP(C0,C1,P0,P1,t,GK,GV,GL) do{ SBAR(); \
    const lds_cptr vp_=vp0+sl_prev; \
    VRD(0); SBAR(); float sacc=(P0[0]+P0[1]); \
    GAPA(C0=__builtin_amdgcn_mfma_f32_32x32x16_bf16(kf[0],qr[0],f32x16{},0,0,0), P0[2],P0[3],P0[4],P0[5],     pw0[0]=PKW(P0,0), pw0[1]=PKW(P0,2), pw0); \
    VRD(4); SBAR(); GAPA(C1=__builtin_amdgcn_mfma_f32_32x32x16_bf16(kf[1],qr[0],f32x16{},0,0,0), P0[6],P0[7],P0[8],P0[9],     pw0[2]=PKW(P0,4), pw0[3]=PKW(P0,6), pw0); \
    VRD(1); SBAR(); GAPA(C0=__builtin_amdgcn_mfma_f32_32x32x16_bf16(kf[2],qr[1],C0,0,0,0),   P0[10],P0[11],P0[12],P0[13], pw1[0]=PKW(P0,8), pw1[1]=PKW(P0,10), pw1); \
    VRD(5); SBAR(); GAPA(C1=__builtin_amdgcn_mfma_f32_32x32x16_bf16(kf[3],qr[1],C1,0,0,0),   P0[14],P0[15],P1[0],P1[1],   pw1[2]=PKW(P0,12),pw1[3]=PKW(P0,14), pw1); \
    VRD(2); SBAR(); GAPA(C0=__builtin_amdgcn_mfma_f32_32x32x16_bf16(kf[4],qr[2],C0,0,0,0),   P1[2],P1[3],P1[4],P1[5],     pw2[0]=PKW(P1,0), pw2[1]=PKW(P1,2), pw2); \
    VRD(6); SBAR(); GAPA(C1=__builtin_amdgcn_mfma_f32_32x32x16_bf16(kf[5],qr[2],C1,0,0,0),   P1[6],P1[7],P1[8],P1[9],     pw2[2]=PKW(P1,4), pw2[3]=PKW(P1,6), pw2); \
    VRD(3); SBAR(); GAPA(C0=__builtin_amdgcn_mfma_f32_32x32x16_bf16(kf[6],qr[3],C0,0,0,0),   P1[10],P1[11],P1[12],P1[13], pw3[0]=PKW(P1,8), pw3[1]=PKW(P1,10), pw3); \
    VRD(7); SBAR(); GAPA(C1=__builtin_amdgcn_mfma_f32_32x32x16_bf16(kf[7],qr[3],C1,0,0,0),   P1[14],P1[15],0.f,0.f,       pw3[2]=PKW(P1,12),pw3[3]=PKW(P1,14), pw3); \
    l_reg+=sacc; \
    { const bf16x8 q4_=qpark[0], q5_=qpark[1]; SBAR(); \
      C0=__builtin_amdgcn_mfma_f32_32x32x16_bf16(kf[8],q4_,C0,0,0,0); C1=__builtin_amdgcn_mfma_f32_32x32x16_bf16(kf[9],q4_,C1,0,0,0); \
      C0=__builtin_amdgcn_mfma_f32_32x32x16_bf16(kf[10],q5_,C0,0,0,0); C1=__builtin_amdgcn_mfma_f32_32x32x16_bf16(kf[11],q5_,C1,0,0,0); SBAR(); } \
    if(GK){DMA_K((t)+3,sl_cur);} if(GV){DMA_V((t)+1,sl_next);} \
    { const float nm_=-mhat; _Pragma("unroll") for(int r=0;r<16;++r){C0[r]+=nm_;C1[r]+=nm_;} } \
    CMASK(C0,C1,t); \
    { float a=MX3(C0[0],C0[1],C1[0]),b=MX3(C0[2],C0[3],C1[1]); a=MX3(a,C1[2],C1[3]); \
      _Pragma("unroll") for(int r=4;r<16;r+=4){a=MX3(a,C0[r],C0[r+1]);b=MX3(b,C0[r+2],C0[r+3]);a=MX3(a,C1[r],C1[r+1]);b=MX3(b,C1[r+2],C1[r+3]);} \
      float rm=__builtin_fmaxf(a,b); { auto rr=__builtin_amdgcn_permlane32_swap(__float_as_uint(rm),__float_as_uint(rm),false,false); rm=__builtin_fmaxf(__uint_as_float(rr[0]),__uint_as_float(rr[1])); } \
      resc=false; \
      if(__builtin_expect(__any(rm>(float)THRL),0)){ const float dl=__builtin_fmaxf(rm,0.f); mhat+=dl; \
        _Pragma("unroll") for(int r=0;r<16;++r){C0[r]-=dl;C1[r]-=dl;} \
        const float f=__builtin_amdgcn_exp2f(-dl); l_reg*=f; if(hi==0)wsf[r32]=f; resc=true; } } \
    SBAR(); \
    GAPB(o[0]=__builtin_amdgcn_mfma_f32_32x32x16_bf16(PAF(0),VFR(0),o[0],0,0,0), C0,0); \
    GAPB(o[1]=__builtin_amdgcn_mfma_f32_32x32x16_bf16(PAF(0),VFR(4),o[1],0,0,0), C0,4); \
    KRD(GL,0); GAPB(o[0]=__builtin_amdgcn_mfma_f32_32x32x16_bf16(PAF(1),VFR(1),o[0],0,0,0), C0,8); \
    KRD(GL,1); GAPB(o[1]=__builtin_amdgcn_mfma_f32_32x32x16_bf16(PAF(1),VFR(5),o[1],0,0,0), C0,12); \
    KRD(GL,2); GAPB(o[0]=__builtin_amdgcn_mfma_f32_32x32x16_bf16(PAF(2),VFR(2),o[0],0,0,0), C1,0); \
    KRD(GL,3); GAPB(o[1]=__builtin_amdgcn_mfma_f32_32x32x16_bf16(PAF(2),VFR(6),o[1],0,0,0), C1,4); \
    KRD(GL,4); GAPB(o[0]=__builtin_amdgcn_mfma_f32_32x32x16_bf16(PAF(3),VFR(3),o[0],0,0,0), C1,8); \
    KRD(GL,5); GAPB(o[1]=__builtin_amdgcn_mfma_f32_32x32x16_bf16(PAF(3),VFR(7),o[1],0,0,0), C1,12); \
    }while(0)
  int t=1;
  for(;t+5<NT;t+=2){
    STEP(pB0,pB1,pA0,pA1,t,true,true,true);     WAIT_BAR(3); RESC(); ROT();
    STEP(pA0,pA1,pB0,pB1,t+1,true,true,true);   WAIT_BAR(3); RESC(); ROT();
  }
  #define ENDW(tt) do{ if((tt)+3<NT){WAIT_BAR(3);} else if((tt)+2<NT){WAIT_BAR(1);} else {WAIT_BAR(0);} }while(0)
  for(;t+1<NT;t+=2){
    STEP(pB0,pB1,pA0,pA1,t,(t+3<NT),(t+1<NT),(t+1<NT));       ENDW(t);   RESC(); ROT();
    STEP(pA0,pA1,pB0,pB1,t+1,(t+4<NT),(t+2<NT),(t+2<NT));     ENDW(t+1); RESC(); ROT();
  }
  STEP(pB0,pB1,pA0,pA1,NT-1,false,false,false); RESC();
  { float sacc=pB0[0]+pB0[1]; _Pragma("unroll") for(int r=2;r<16;++r)sacc+=pB0[r]; _Pragma("unroll") for(int r=0;r<16;++r)sacc+=pB1[r]; l_reg+=sacc;
    pw0=(u32x4){PKW(pB0,0),PKW(pB0,2),PKW(pB0,4),PKW(pB0,6)};pw1=(u32x4){PKW(pB0,8),PKW(pB0,10),PKW(pB0,12),PKW(pB0,14)};pw2=(u32x4){PKW(pB1,0),PKW(pB1,2),PKW(pB1,4),PKW(pB1,6)};pw3=(u32x4){PKW(pB1,8),PKW(pB1,10),PKW(pB1,12),PKW(pB1,14)};
    SBAR(); pv(o,vb0+sl_cur,PAF(0),PAF(1),PAF(2),PAF(3)); }
  #undef PKW
  #undef PAF
  #undef VFR
  #undef PIN
  #undef MX3
  #undef GAPA
  #undef GAPB
  #undef EX
  #undef VRD
  #undef KRD
  #undef STEP
  #undef ENDW
  {auto rr=__builtin_amdgcn_permlane32_swap(__float_as_uint(l_reg),__float_as_uint(l_reg),false,false);l_reg=__uint_as_float(rr[0])+__uint_as_float(rr[1]);}
  if(hi==0)wsf[32+r32]=l_reg;asm volatile("s_waitcnt lgkmcnt(0)":::"memory");
  float rli[16];
  #pragma unroll
  for(int r=0;r<16;++r)rli[r]=__builtin_amdgcn_rcpf(wsf[32+crow(r,hi)]);
  bf16*Ow=O+(rowbase+q0+wid*QBLK)*OP+h*D;
  { bf16*stg=(bf16*)(shm+LDS_OST)+wid*2048;
    #pragma unroll
    for(int r=0;r<16;++r){const int orow=crow(r,hi);
      #pragma unroll
      for(int d0=0;d0<2;++d0)stg[orow*64+d0*32+r32]=(bf16)f2bf(o[d0][r]*rli[r]);}
    asm volatile("s_waitcnt lgkmcnt(0)":::"memory");
    #pragma unroll
    for(int i=0;i<4;++i){const int row=i*8+(lane>>3),ch=lane&7; const u32x4 v=*(const u32x4*)(stg+row*64+ch*8); ATTN_STORE16(Ow+(long)row*OP+ch*8,v);} }
  asm volatile("s_waitcnt lgkmcnt(0)\n\ts_barrier":::"memory");
  #undef DMA_K
  #undef DMA_V
  #undef CMASK
  #undef START
  #undef RESC
  #undef ROT
}
constexpr int ATTN_LDS_BYTES=LDS_BYTES;
#undef SBAR
#undef WAIT_BAR
}

namespace gla {
constexpr int LQ = 136, LT = 72;
constexpr int O_QS = 0, O_KS = O_QS + 64 * LQ * 2, O_KST = O_KS + 64 * LQ * 2, O_VST = O_KST + 128 * LT * 2, O_PS = O_VST + 128 * LT * 2, O_SST = O_PS + 64 * LT * 2, O_DECS = O_SST + 128 * LQ * 2, GLA_LDS = O_DECS + 32 * 128 * 4;
static_assert(GLA_LDS <= LDS_CTL, "GLA LDS");
__device__ __forceinline__ bf16x8 frag(const LAS bf16_t* base, int ld, int row0, int k0, int lane) { return *(const LAS bf16x8*)(base + (row0 + (lane & 15)) * ld + k0 + 8 * (lane >> 4)); }
__device__ __forceinline__ void unit(const Ctx& a, int b, int h, int dir, LAS unsigned char* lds, int tid_) {
    const int tid = launder_v(tid_);
    unsigned char* ws = a.ws; const int wid = __builtin_amdgcn_readfirstlane(tid >> 6), lane = tid & 63, l15 = lane & 15, q4 = (lane >> 4) * 4;
    LAS bf16_t* Qs = (LAS bf16_t*)(lds + O_QS); LAS bf16_t* Ks = (LAS bf16_t*)(lds + O_KS); LAS bf16_t* KsT = (LAS bf16_t*)(lds + O_KST);
    LAS bf16_t* VsT = (LAS bf16_t*)(lds + O_VST); LAS bf16_t* Ps = (LAS bf16_t*)(lds + O_PS); LAS bf16_t* SsT = (LAS bf16_t*)(lds + O_SST);
    const bf16_t* QT = (const bf16_t*)(ws + O_QT) + (size_t)(dir * 2) * M * 512; const bf16_t* KT = QT + (size_t)M * 512;
    const bf16_t* Pm = (const bf16_t*)(ws + O_VG); const float* DEC = (const float*)(ws + O_DEC) + (size_t)dir * 256 * 512;
    bf16_t* OC = (bf16_t*)(ws + (dir ? O_OCB : O_YC));
    const int srow = tid >> 3, scg = tid & 7;
    const int spc = (((srow >> 3) ^ scg) << 3) + (srow & 7);
    int aoff[4];
#pragma unroll
    for (int c = 0; c < 4; ++c) aoff[c] = l15 * LT + ((((lane >> 4) ^ (l15 >> 3)) ^ (2 * c)) << 3);
    const int voff0 = (wid * 16 + l15) * LT + ((((lane >> 4) ^ (l15 >> 3)) ^ ((2 * wid) & 7)) << 3), voff1 = (wid * 16 + l15) * LT + ((((lane >> 4) ^ (l15 >> 3)) ^ (4 ^ ((2 * wid) & 7))) << 3);
#define LDS_BAR() asm volatile("s_waitcnt lgkmcnt(0)\n\ts_barrier" ::: "memory")
#define SCHED_FENCE() __builtin_amdgcn_sched_barrier(0)
    f32x4 S[8];
#pragma unroll
    for (int i = 0; i < 8; ++i) S[i] = (f32x4){0.f, 0.f, 0.f, 0.f};
    __syncthreads();
    { const unsigned z = (unsigned)launder_v(0);
      for (int i = tid; i < 128 * LQ / 8; i += NTHR) ((LAS u32x4*)SsT)[i] = (u32x4){z, z, z, z}; }
    { LAS float* decs = (LAS float*)(lds + O_DECS);
#pragma unroll
      for (int i = 0; i < 2; ++i) { const int e4 = (tid + i * NTHR) * 4, c = e4 >> 7, k = e4 & 127; *(LAS f32x4*)(decs + e4) = *(const f32x4*)(DEC + (size_t)(b * 32 + c) * 512 + h * 128 + k); } }
    bf16x8 gq[2][2], gk[2][2], gv[2][2];
#define GLD(dst_, ptr_) asm volatile("global_load_dwordx4 %0, %1, off" : "=&v"(dst_) : "v"(ptr_) : "memory")
#define GLOAD(n_, s_) do { const int ci_ = dir ? 31 - (n_) : (n_); const size_t r_ = (size_t)b * T + ci_ * 64 + srow; _Pragma("unroll") for (int j_ = 0; j_ < 2; ++j_) { const int c8_ = (scg + 8 * j_) * 8; \
        GLD(gq[s_][j_], QT + r_ * 512 + h * 128 + c8_); GLD(gk[s_][j_], KT + r_ * 512 + h * 128 + c8_); GLD(gv[s_][j_], Pm + r_ * 1024 + h * 128 + c8_); } } while (0)
    GLOAD(0, 0); GLOAD(1, 1);
    for (int n2 = 0; n2 < 32; n2 += 2) {
#pragma unroll
      for (int hs = 0; hs < 2; ++hs) {
        const int n = n2 + hs;
        const int ci = dir ? 31 - n : n;
        LDS_BAR();
        f32x4 dec[8];
        u32x4 ost[2];
        if (n > 0) {
#pragma unroll
            for (int j = 0; j < 2; ++j) ost[j] = *(const LAS u32x4*)(Qs + srow * LQ + (scg + 8 * j) * 8); }
        if (n2 == 0) asm volatile("s_waitcnt vmcnt(6)" ::: "memory"); else if (n == 31) asm volatile("s_waitcnt vmcnt(1)" ::: "memory"); else asm volatile("s_waitcnt vmcnt(7)" ::: "memory");
        asm volatile("" : "+v"(gq[hs][0]), "+v"(gq[hs][1]), "+v"(gk[hs][0]), "+v"(gk[hs][1]), "+v"(gv[hs][0]), "+v"(gv[hs][1]));
#pragma unroll
        for (int j = 0; j < 2; ++j) { const int c8 = (scg + 8 * j) * 8;
            *(LAS bf16x8*)(Qs + srow * LQ + c8) = gq[hs][j]; *(LAS bf16x8*)(Ks + srow * LQ + c8) = gk[hs][j];
#pragma unroll
            for (int e = 0; e < 8; ++e) { KsT[(c8 + e) * LT + spc] = (bf16_t)gk[hs][j][e]; VsT[(c8 + e) * LT + spc] = (bf16_t)gv[hs][j][e]; } }
        LDS_BAR();
        if (n > 0) { const size_t rowprev = (size_t)b * T + (dir ? ci + 1 : ci - 1) * 64;
#pragma unroll
            for (int j = 0; j < 2; ++j) *(u32x4*)(OC + (rowprev + srow) * 512 + h * 128 + (scg + 8 * j) * 8) = ost[j]; }
        if (n + 2 < 32) GLOAD(n + 2, hs);
        SCHED_FENCE();
        const int it = wid >> 1, st0 = (wid & 1) * 2;
        bf16x8 qf[4], kf[2][4], sf[4], kt[8][2], q2[4][4];
#pragma unroll
        for (int kk = 0; kk < 4; ++kk) qf[kk] = frag(Qs, LQ, it * 16, kk * 32, lane);
#pragma unroll
        for (int ss = 0; ss < 2; ++ss) {
#pragma unroll
            for (int kk = 0; kk < 4; ++kk) kf[ss][kk] = frag(Ks, LQ, (st0 + ss) * 16, kk * 32, lane); }
#pragma unroll
        for (int kk = 0; kk < 4; ++kk) sf[kk] = frag(SsT, LQ, wid * 16, kk * 32, lane);
        const bf16x8 v0 = *(const LAS bf16x8*)(VsT + voff0), v1 = *(const LAS bf16x8*)(VsT + voff1);
#pragma unroll
        for (int t = 0; t < 4; ++t) { kt[t][0] = *(const LAS bf16x8*)(KsT + t * 16 * LT + aoff[((2 * t) & 7) >> 1]); kt[t][1] = *(const LAS bf16x8*)(KsT + t * 16 * LT + aoff[(4 ^ ((2 * t) & 7)) >> 1]); dec[t] = *(const LAS f32x4*)((LAS float*)(lds + O_DECS) + ci * 128 + t * 16 + q4); }
        SCHED_FENCE();
        {
#pragma unroll
            for (int ss = 0; ss < 2; ++ss) { const int st = st0 + ss; f32x4 acc = (f32x4){0.f, 0.f, 0.f, 0.f};
                const bool dead = dir ? (st < it) : (st > it);
                if (!dead) {
#pragma unroll
                    for (int kk = 0; kk < 4; ++kk) acc = __builtin_amdgcn_mfma_f32_16x16x32_bf16(kf[ss][kk], qf[kk], acc, 0, 0, 0);
                    if (st == it) {
#pragma unroll
                        for (int r = 0; r < 4; ++r) { const bool keep = dir ? (q4 + r >= l15) : (q4 + r <= l15); if (!keep) acc[r] = 0.f; } }
                }
                *(LAS u32x2*)(Ps + (it * 16 + l15) * LT + st * 16 + q4) = (u32x2){pk2(acc[0], acc[1]), pk2(acc[2], acc[3])}; }
        }
        SCHED_FENCE();
#pragma unroll
        for (int t = 4; t < 8; ++t) { kt[t][0] = *(const LAS bf16x8*)(KsT + t * 16 * LT + aoff[((2 * t) & 7) >> 1]); kt[t][1] = *(const LAS bf16x8*)(KsT + t * 16 * LT + aoff[(4 ^ ((2 * t) & 7)) >> 1]); dec[t] = *(const LAS f32x4*)((LAS float*)(lds + O_DECS) + ci * 128 + t * 16 + q4); }
        SCHED_FENCE();
#pragma unroll
        for (int t = 0; t < 4; ++t) { S[t] = __builtin_amdgcn_mfma_f32_16x16x32_bf16(kt[t][0], v0, S[t], 0, 0, 0); S[t] = __builtin_amdgcn_mfma_f32_16x16x32_bf16(kt[t][1], v1, S[t], 0, 0, 0);
            S[t] = S[t] * dec[t];
            *(LAS u32x2*)(SsT + (wid * 16 + l15) * LQ + t * 16 + q4) = (u32x2){pk2(S[t][0], S[t][1]), pk2(S[t][2], S[t][3])}; }
        SCHED_FENCE();
#pragma unroll
        for (int i2 = 0; i2 < 2; ++i2) {
#pragma unroll
            for (int kk = 0; kk < 4; ++kk) q2[i2][kk] = frag(Qs, LQ, i2 * 16, kk * 32, lane); }
        SCHED_FENCE();
#pragma unroll
        for (int t = 4; t < 8; ++t) { S[t] = __builtin_amdgcn_mfma_f32_16x16x32_bf16(kt[t][0], v0, S[t], 0, 0, 0); S[t] = __builtin_amdgcn_mfma_f32_16x16x32_bf16(kt[t][1], v1, S[t], 0, 0, 0);
            S[t] = S[t] * dec[t];
            *(LAS u32x2*)(SsT + (wid * 16 + l15) * LQ + t * 16 + q4) = (u32x2){pk2(S[t][0], S[t][1]), pk2(S[t][2], S[t][3])}; }
        SCHED_FENCE();
#pragma unroll
        for (int i2 = 2; i2 < 4; ++i2) {
#pragma unroll
            for (int kk = 0; kk < 4; ++kk) q2[i2][kk] = frag(Qs, LQ, i2 * 16, kk * 32, lane); }
        SCHED_FENCE();
        f32x4 ao[4];
#pragma unroll
        for (int i2 = 0; i2 < 4; ++i2) { ao[i2] = (f32x4){0.f, 0.f, 0.f, 0.f};
#pragma unroll
            for (int kk = 0; kk < 4; ++kk) ao[i2] = __builtin_amdgcn_mfma_f32_16x16x32_bf16(sf[kk], q2[i2][kk], ao[i2], 0, 0, 0);
            if (i2 == 1) SCHED_FENCE(); }
        LDS_BAR();
        { bf16x8 pf[4][2];
#pragma unroll
          for (int i2 = 0; i2 < 4; ++i2) { pf[i2][0] = frag(Ps, LT, i2 * 16, 0, lane); pf[i2][1] = frag(Ps, LT, i2 * 16, 32, lane); }
          SCHED_FENCE();
#pragma unroll
          for (int i2 = 0; i2 < 4; ++i2) { ao[i2] = __builtin_amdgcn_mfma_f32_16x16x32_bf16(v0, pf[i2][0], ao[i2], 0, 0, 0); ao[i2] = __builtin_amdgcn_mfma_f32_16x16x32_bf16(v1, pf[i2][1], ao[i2], 0, 0, 0); } }
#pragma unroll
        for (int i2 = 0; i2 < 4; ++i2) *(LAS u32x2*)(Qs + (i2 * 16 + l15) * LQ + wid * 16 + q4) = (u32x2){pk2(ao[i2][0], ao[i2][1]), pk2(ao[i2][2], ao[i2][3])};
      }
    }
    LDS_BAR();
    { const int ci = dir ? 0 : 31; const size_t rowbase = (size_t)b * T + ci * 64;
#pragma unroll
      for (int j = 0; j < 2; ++j) *(u32x4*)(OC + (rowbase + srow) * 512 + h * 128 + (scg + 8 * j) * 8) = *(const LAS u32x4*)(Qs + srow * LQ + (scg + 8 * j) * 8); }
#undef GLOAD
#undef GLD
#undef LDS_BAR
#undef SCHED_FENCE
}
__device__ __forceinline__ void combine_phase(const Ctx& a, int layer, int gw, int NGW, int lane) {
    unsigned char* ws = a.ws; bf16_t* YC = (bf16_t*)(ws + O_YC); const bf16_t* OCB = (const bf16_t*)(ws + O_OCB); const bf16_t* Pm = (const bf16_t*)(ws + O_VG);
    float g[8]; { const float* gp = a.in[I_GCOUT] + layer * 128 + (lane & 15) * 8; const f32x4 g0 = *(const f32x4*)gp, g1 = *(const f32x4*)(gp + 4); g[0] = g0.x; g[1] = g0.y; g[2] = g0.z; g[3] = g0.w; g[4] = g1.x; g[5] = g1.y; g[6] = g1.z; g[7] = g1.w; }
    for (int m0 = gw; m0 < M; m0 += 4 * NGW) {
        u32x4 rf[4], rb[4], rc[4];
#pragma unroll
        for (int q = 0; q < 4; ++q) { const int m_ = m0 + q * NGW, m = m_ < M ? m_ : gw;
            rf[q] = *(const u32x4*)(YC + (size_t)m * 512 + lane * 8); rb[q] = *(const u32x4*)(OCB + (size_t)m * 512 + lane * 8); rc[q] = *(const u32x4*)(Pm + (size_t)m * 1024 + 512 + lane * 8); }
#pragma unroll
        for (int q = 0; q < 4; ++q) { const int m = m0 + q * NGW;
            float f[8], bb[8], cg[8]; unpack8(rf[q], f); unpack8(rb[q], bb); unpack8(rc[q], cg);
            float ss = 0.f;
#pragma unroll
            for (int e = 0; e < 8; ++e) { f[e] += bb[e]; ss += f[e] * f[e]; }
            ss = sum16(ss);
            const float rstd = rsqrtf(ss * (1.0f / 128.0f) + EPS);
#pragma unroll
            for (int e = 0; e < 8; ++e) f[e] = f[e] * rstd * g[e] * (cg[e] * sigmoidf_(cg[e]));
            if (m < M) store8(YC + (size_t)m * 512 + lane * 8, f); }
    }
}
}

__device__ __forceinline__ void gla_naive_unit(const Ctx& a, int layer, int b, int h, LAS unsigned char* lds, int tid) {
    unsigned char* ws = a.ws; const bf16_t* P = (const bf16_t*)(ws + O_P); bf16_t* YC = (bf16_t*)(ws + O_YC);
    LAS float* qs = (LAS float*)lds; LAS float* ks = qs + 128; LAS float* as = ks + 128; LAS float* part = as + 128; LAS float* red = part + 512;
    const int j = tid & 127, qd = tid >> 7; const float gco = a.in[I_GCOUT][layer * 128 + j];
    for (int dir = 0; dir < 2; ++dir) {
        const float* LA = (const float*)(ws + O_QT) + (size_t)dir * M * 512;
        float S[32];
#pragma unroll
        for (int i = 0; i < 32; ++i) S[i] = 0.f;
        for (int step = 0; step < T; ++step) {
            const int tok = dir ? T - 1 - step : step; const size_t row = (size_t)b * T + tok;
            __syncthreads();
            if (tid < 128) { qs[tid] = bf2f(P[row * PW + PC_CQ + h * 128 + tid]) * GLA_QSCALE; ks[tid] = bf2f(P[row * PW + PC_CK + h * 128 + tid]); as[tid] = __expf(LA[row * 512 + h * 128 + tid]); }
            const float v = bf2f(((const bf16_t*)(ws + O_VG))[row * 1024 + h * 128 + j]);
            __syncthreads();
            float o = 0.f;
#pragma unroll
            for (int i = 0; i < 32; ++i) { const int dk = qd * 32 + i; S[i] = as[dk] * S[i] + ks[dk] * v; o = fmaf(qs[dk], S[i], o); }
            part[qd * 128 + j] = o;
            __syncthreads();
            float v2 = 0.f;
            if (tid < 128) {
                const float tot = (part[tid] + part[128 + tid]) + (part[256 + tid] + part[384 + tid]);
                if (dir == 0) YC[row * 512 + h * 128 + tid] = (bf16_t)f2bf(tot);
                else { v2 = tot + bf2f(YC[row * 512 + h * 128 + tid]); const float ss = wave_sum(v2 * v2); if ((tid & 63) == 0) red[tid >> 6] = ss; }
            }
            if (dir == 1) {
                __syncthreads();
                if (tid < 128) {
                    const float rstd = rsqrtf((red[0] + red[1]) * (1.0f / 128.0f) + EPS);
                    const float g = bf2f(((const bf16_t*)(ws + O_VG))[row * 1024 + 512 + h * 128 + tid]);
                    YC[row * 512 + h * 128 + tid] = (bf16_t)f2bf(v2 * rstd * gco * (g * sigmoidf_(g)));
                }
            }
        }
    }
}

__device__ __forceinline__ void router_item(const Ctx& a, int blk, LAS unsigned char* lds, int tid) {
    unsigned char* ws = a.ws; int* mi = (int*)(ws + O_MOEI); float* mf = (float*)(ws + O_MOEI);
    const int wave = __builtin_amdgcn_readfirstlane(tid >> 6), lane = tid & 63;
    LAS float* lg = (LAS float*)lds;
    const bf16_t* x1 = (const bf16_t*)(ws + O_XB); const float* g = a.in[I_GFFN] + 1024; const float* wr = a.in[I_WROUTER];
    __syncthreads();
    {
        u32x2 rx[8][4]; f32x4 gg[4]; f32x4 wq[4][4][2];
#pragma unroll
        for (int jj = 0; jj < 4; ++jj) gg[jj] = *(const f32x4*)(g + (lane + 64 * jj) * 4);
#pragma unroll
        for (int jj = 0; jj < 4; ++jj)
#pragma unroll
            for (int c = 0; c < 4; ++c) { const float* wp = wr + (size_t)((lane + 64 * jj) * 4 + c) * 8; wq[jj][c][0] = *(const f32x4*)wp; wq[jj][c][1] = *(const f32x4*)(wp + 4); }
#pragma unroll
        for (int j = 0; j < 8; ++j)
#pragma unroll
            for (int jj = 0; jj < 4; ++jj) rx[j][jj] = *(const u32x2*)(x1 + (size_t)(blk * 64 + wave * 8 + j) * D + (lane + 64 * jj) * 4);
#pragma unroll
        for (int j = 0; j < 8; ++j) {
            float acc[8], ss = 0.f;
#pragma unroll
            for (int e = 0; e < 8; ++e) acc[e] = 0.f;
#pragma unroll
            for (int jj = 0; jj < 4; ++jj) { const u32x2 xr = rx[j][jj];
                const f32x4 v = (f32x4){bf2f(xr.x & 0xffffu), bf2f(xr.x >> 16), bf2f(xr.y & 0xffffu), bf2f(xr.y >> 16)};
                ss += (v.x * v.x + v.y * v.y) + (v.z * v.z + v.w * v.w);
                const float hv[4] = {v.x * gg[jj].x, v.y * gg[jj].y, v.z * gg[jj].z, v.w * gg[jj].w};
#pragma unroll
                for (int c = 0; c < 4; ++c) { const f32x4 w0 = wq[jj][c][0], w1 = wq[jj][c][1];
                    acc[0] = fmaf(hv[c], w0.x, acc[0]); acc[1] = fmaf(hv[c], w0.y, acc[1]); acc[2] = fmaf(hv[c], w0.z, acc[2]); acc[3] = fmaf(hv[c], w0.w, acc[3]);
                    acc[4] = fmaf(hv[c], w1.x, acc[4]); acc[5] = fmaf(hv[c], w1.y, acc[5]); acc[6] = fmaf(hv[c], w1.z, acc[6]); acc[7] = fmaf(hv[c], w1.w, acc[7]); } }
            ss = wave_sum(ss); const float rstd = rsqrtf(ss * (1.0f / 1024.0f) + EPS);
#pragma unroll
            for (int e = 0; e < 8; ++e) { const float s = wave_sum(acc[e]); if (lane == 0) lg[(wave * 8 + j) * 8 + e] = s * rstd; }
        }
    }
    __syncthreads();
    if (wave == 0) {
        const int tok = blk * 64 + lane; float v[8];
#pragma unroll
        for (int e = 0; e < 8; ++e) v[e] = lg[lane * 8 + e];
        int e1 = 0; float v1 = v[0];
#pragma unroll
        for (int e = 1; e < 8; ++e) if (v[e] > v1) { v1 = v[e]; e1 = e; }
        int e2 = -1; float v2 = -3.0e38f;
#pragma unroll
        for (int e = 0; e < 8; ++e) if (e != e1 && v[e] > v2) { v2 = v[e]; e2 = e; }
        const float w1 = 1.0f / (1.0f + __expf(v2 - v1)), w2 = 1.0f - w1;
        const unsigned long long lt = (1ull << lane) - 1ull; int ra = 0, rb = 0, mycnt = 0;
#pragma unroll
        for (int e = 0; e < 8; ++e) { const unsigned long long m0 = __ballot(e1 == e), m1 = __ballot(e2 == e); const int c0 = __popcll(m0);
            if (e1 == e) ra = __popcll(m0 & lt); if (e2 == e) rb = c0 + __popcll(m1 & lt); if (lane == e) mycnt = c0 + __popcll(m1); }
        mi[MI_TOKE + tok] = e1 | (e2 << 8); mi[MI_TOKR + tok] = ra | (rb << 16); mf[MI_TOKW + tok * 2] = w1; mf[MI_TOKW + tok * 2 + 1] = w2;
        if (lane < 8) mi[MI_CNT + blk * 8 + lane] = mycnt;
    }
}
__device__ __forceinline__ void positions_phase(const Ctx& a, LAS unsigned char* lds, int G, int bid, int tid) {
    unsigned char* ws = a.ws; int* mi = (int*)(ws + O_MOEI); float* mf = (float*)(ws + O_MOEI);
    LAS int* cnt = (LAS int*)lds; LAS int* base = cnt + 2048;
    __syncthreads();
    for (int i = tid; i < 2048; i += NTHR) cnt[i] = mi[MI_CNT + i];
    __syncthreads();
    {
        LAS int* segs = base + 32; const int e = tid & 7, seg = tid >> 3; int c4[4], loc = 0;
#pragma unroll
        for (int k = 0; k < 4; ++k) { c4[k] = cnt[(seg * 4 + k) * 8 + e]; loc += c4[k]; }
        segs[seg * 8 + e] = loc;
        __syncthreads();
        int run = 0; for (int s = 0; s < seg; ++s) run += segs[s * 8 + e];
        if (seg == 63) base[8 + e] = run + loc;
#pragma unroll
        for (int k = 0; k < 4; ++k) { cnt[(seg * 4 + k) * 8 + e] = run; run += c4[k]; }
    }
    __syncthreads();
    if (tid == 0) { int off = 0; for (int e = 0; e < 8; ++e) { base[e] = off; off += (base[8 + e] + 255) & ~255; } base[16] = off >> 8; }
    __syncthreads();
    if (bid == 0) {
        const int nt = base[16];
        for (int t = tid; t < nt; t += NTHR) { int e = 0;
#pragma unroll
            for (int k = 1; k < 8; ++k) if (t * 256 >= base[k]) e = k;
            mi[MI_TILEE + t] = e; }
        if (tid == 0) mi[MI_TILEE + MAXTILES] = nt;
        {
            const int nunits = nt * 4, rem = nunits % G; const bool split = rem > 0 && rem <= MAXSPLIT; const int nmain = split ? nunits - rem : nunits, nsplit = split ? rem : 0;
            for (int i = tid; i < MAXTILES * 4; i += NTHR) mi[MI_SPLIT + i] = -1;
            __syncthreads();
            for (int i = tid; i < nsplit; i += NTHR) { int pm, pn; tile_order(nmain + i, nt, 4, pm, pn); mi[MI_SPLIT + pm * 4 + pn] = i; }
            if (tid == 0) { mi[MI_SPLIT + MAXTILES * 4] = nmain; mi[MI_SPLIT + MAXTILES * 4 + 1] = nsplit; }
        }
        for (int e = 0; e < 8; ++e) { const int lo = base[e] + base[8 + e], hi = base[e] + ((base[8 + e] + 255) & ~255);
            for (int r = lo + tid; r < hi; r += NTHR) { mi[MI_ROWTOK + r] = 0; mf[MI_ROWW + r] = 0.f; mf[MI_ROWSC + r] = 0.f; } }
    }
    for (int blk = bid; blk < 256; blk += G) if (tid < 64) {
        const int tok = blk * 64 + tid; const int ee = mi[MI_TOKE + tok], rr = mi[MI_TOKR + tok]; const int e1 = ee & 255, e2 = ee >> 8;
        const int pa = base[e1] + cnt[blk * 8 + e1] + (rr & 0xffff), pb = base[e2] + cnt[blk * 8 + e2] + (rr >> 16);
        mi[MI_ROWTOK + pa] = tok; mf[MI_ROWW + pa] = mf[MI_TOKW + tok * 2]; mi[MI_ROWTOK + pb] = tok; mf[MI_ROWW + pb] = mf[MI_TOKW + tok * 2 + 1];
        mi[MI_TOKPOS + tok * 2] = pa; mi[MI_TOKPOS + tok * 2 + 1] = pb;
        const float rs = row_rstd16((const float*)(ws + O_SSQ), tok); mf[MI_ROWSC + pa] = rs; mf[MI_ROWSC + pb] = rs;
    }
}
__device__ __forceinline__ void final_phase(const Ctx& a, int gw, int NGW, int lane) {
    unsigned char* ws = a.ws; const int* mi = (const int*)(ws + O_MOEI); const float* mf = (const float*)(ws + O_MOEI); const bf16_t* OUTS = (const bf16_t*)(ws + O_OUTS); const float* gf = a.in[I_GFINAL];
    const bf16_t* XBf = (const bf16_t*)(ws + O_XB); const float* SL = (const float*)(ws + O_SLAB);
    f32x4 g[4];
#pragma unroll
    for (int j = 0; j < 4; ++j) g[j] = *(const f32x4*)(gf + (lane + 64 * j) * 4);
    for (int m0 = gw; m0 < M; m0 += 2 * NGW) {
        int pos[2][2];
#pragma unroll
        for (int q = 0; q < 2; ++q) { const int m_ = m0 + q * NGW, m = m_ < M ? m_ : gw; pos[q][0] = mi[MI_TOKPOS + m * 2]; pos[q][1] = mi[MI_TOKPOS + m * 2 + 1]; }
        u32x2 rx[2][4], ro[2][2][4];
#pragma unroll
        for (int q = 0; q < 2; ++q) { const int m_ = m0 + q * NGW, m = m_ < M ? m_ : gw;
#pragma unroll
            for (int j = 0; j < 4; ++j) { const int idx = (lane + 64 * j) * 4; rx[q][j] = *(const u32x2*)(XBf + (size_t)m * D + idx);
                ro[q][0][j] = *(const u32x2*)(OUTS + (size_t)pos[q][0] * 1024 + idx); ro[q][1][j] = *(const u32x2*)(OUTS + (size_t)pos[q][1] * 1024 + idx); } }
#pragma unroll
        for (int q = 0; q < 2; ++q) { const int m = m0 + q * NGW; f32x4 v[4]; float s = 0.f;
#pragma unroll
            for (int j = 0; j < 4; ++j) {
                v[j] = (f32x4){bf2f(rx[q][j].x & 0xffffu), bf2f(rx[q][j].x >> 16), bf2f(rx[q][j].y & 0xffffu), bf2f(rx[q][j].y >> 16)};
#pragma unroll
                for (int e = 0; e < 2; ++e) { const int ps = pos[q][e]; const int sp = mi[MI_SPLIT + (ps >> 8) * 4 + j];
                    if (sp < 0) { const u32x2 ua = ro[q][e][j]; v[j].x += bf2f(ua.x & 0xffffu); v[j].y += bf2f(ua.x >> 16); v[j].z += bf2f(ua.y & 0xffffu); v[j].w += bf2f(ua.y >> 16); }
                    else { const float w = mf[MI_ROWW + ps]; f32x4 acc = (f32x4){0.f, 0.f, 0.f, 0.f};
#pragma unroll
                        for (int k = 0; k < KSPLIT; ++k) acc += *(const f32x4*)(SL + (size_t)(sp * KSPLIT + k) * 65536 + (ps & 255) * 256 + lane * 4);
                        v[j] += acc * w; } }
                s += (v[j].x * v[j].x + v[j].y * v[j].y) + (v[j].z * v[j].z + v[j].w * v[j].w); }
            s = wave_sum(s); const float rstd = rsqrtf(s * (1.0f / 1024.0f) + EPS);
            if (m < M) {
#pragma unroll
                for (int j = 0; j < 4; ++j) *(f32x4*)(a.out + (size_t)m * D + (lane + 64 * j) * 4) = (f32x4){v[j].x * rstd * g[j].x, v[j].y * rstd * g[j].y, v[j].z * rstd * g[j].z, v[j].w * rstd * g[j].w}; } }
    }
}

#ifndef FAST_MASK
#define FAST_MASK 0xfff
#endif
template <int SITE, bool GATHER = false, bool HALFN = false, class Sched, class Epi>
__device__ __forceinline__ void gemm_run(LAS unsigned char* lds, const Sched& S, const Epi& E, int K, int lda, int tid, int ldb = 0, bool tiled = false, bool tiledB_only = false) {
    if constexpr ((NAIVE_GEMM || !((FAST_MASK >> SITE) & 1)) && !HALFN) gemm_naive(S, E, K, lda);
    else pg8::gemm_phase<GATHER, HALFN>(lds, S, E, K, lda, tid, ldb, tiled, tiledB_only);
}

constexpr int NPHASE = 20;
__global__ void __launch_bounds__(NTHR, 2) mega_fwd(Args args) {
    extern __shared__ __attribute__((aligned(16))) unsigned char lds_raw[];
    LAS unsigned char* lds = (LAS unsigned char*)lds_raw;
    const int wave_s = __builtin_amdgcn_readfirstlane((int)threadIdx.x >> 6);
    { const int tid0 = threadIdx.x; for (int u = tid0; u < (LDS_BYTES - LDS_CTL) / 4; u += NTHR) ((LAS unsigned*)(lds + LDS_CTL))[u] = 0u; }
    __syncthreads();
    XcdBarrier bar; bar.bar = (unsigned*)args.ws + CW_BAR; bar.x = 0; bar.st = nullptr; bar.wave = wave_s;
#if N_LAUNCH_MODE == 1
    bar = xcd_barrier_post((unsigned*)args.ws + CW_BAR, (volatile LAS unsigned*)(lds + LDS_MISC) + 8, wave_s);
#endif
    const int lo = args.ph_lo, hi = args.ph_hi;
#define IN(k) in_phase(lo, hi, (k))
#define PROBE_SPIN(k) do { if ((PROBE_MASK >> (k)) & 1) { const unsigned long long t1_ = __builtin_amdgcn_s_memrealtime(), dt_ = t1_ - ph_t0; \
        while (__builtin_amdgcn_s_memrealtime() - t1_ < dt_) __builtin_amdgcn_s_sleep(8); } } while (0)
#if N_LAUNCH_MODE == 1
#define SEAM(k) do { PROBE_SPIN(k); if (IN(k) && IN((k) + 1)) { xcd_barrier(bar); if ((PROBE_MASK >> 20) & 1) xcd_barrier(bar); } } while (0)
#else
#define SEAM(k) do { } while (0)
#endif
#define PH_BEGIN unsigned char* ws = launder_s(args.ws); const Ctx A{InTab{(const float* const*)(ws + O_PTAB)}, (float*)(GAS float*)args.out, ws}; const int tid = (launder_i(wave_s) << 6) | (int)__builtin_amdgcn_mbcnt_hi(~0u, __builtin_amdgcn_mbcnt_lo(~0u, (unsigned)launder_v(0))); \
    const int G = launder_i((int)gridDim.x), bid = launder_i((int)blockIdx.x); \
    const int lane = tid & 63, wave = __builtin_amdgcn_readfirstlane(tid >> 6); const int vcu = (G % 8 == 0) ? (bid % 8) * (G / 8) + bid / 8 : bid; \
    const int gw = vcu * NWAVES + wave, NGW = G * NWAVES; (void)lane; (void)gw; (void)NGW; (void)ws; \
    const unsigned long long ph_t0 = PROBE_MASK ? __builtin_amdgcn_s_memrealtime() : 0ull; (void)ph_t0;

    if (IN(0)) {
        if (xb_thread0(wave_s)) { const float** tab = (const float**)(args.ws + O_PTAB);
#pragma unroll
            for (int i = 0; i < 28; ++i) tab[i] = args.in[i]; }
        asm volatile("s_waitcnt vmcnt(0)" ::: "memory"); __syncthreads();
        PH_BEGIN; phase_prologue(A, lds, vcu, G, tid); SEAM(0); }

    for (int l = 0; l < 2; ++l) {
        const int pb = l ? 9 : 1;
        if (IN(pb)) {
            PH_BEGIN;
            const bool tail = (G == 256), tail_first = tail && bid < 192 && ((bid >> 3) & 1) == 0;
            SchedDense S{(const bf16_t*)(ws + O_XB), (const bf16_t*)(ws + O_WIN + l * SZ_WIN1), 1024, 1024, 64, NIN / 256, G, bid, tail ? 6 * 256 : 0};
            EpiInProj E{(bf16_t*)(ws + O_P), (bf16_t*)(ws + O_GATES), (const float*)(ws + O_SSQ), A.in[I_BGATE] + l * 3072, (float*)(ws + O_RSP)};
            SchedInTail S2{(const bf16_t*)(ws + O_XB), (const bf16_t*)(ws + O_WIN + l * SZ_WIN1), G, bid}; EpiInProjH E2{E};
            if (tail_first) gemm_run<9, false, true>(lds, S2, E2, 1024, 1024, tid);
            gemm_run<0>(lds, S, E, 1024, 1024, tid);
            if (tail && !tail_first) gemm_run<10, false, true>(lds, S2, E2, 1024, 1024, tid);
            SEAM(pb);
        }
        if (IN(pb + 1)) {
            PH_BEGIN;
            for (int it = bid; it < 256; it += G) post_item<(NAIVE_GLA != 0)>(A, l, it, lds, tid);
            __syncthreads();
            SchedUp S{(const bf16_t*)(ws + O_P), (const bf16_t*)(ws + O_WQUP + l * SZ_WQUP1), (const bf16_t*)(ws + O_WKVUP + l * SZ_WKVUP1), G, bid};
            EpiUpProj E{(const float*)(ws + O_RSP), (bf16_t*)(ws + O_QB), (bf16_t*)(ws + O_KNOPE), (bf16_t*)(ws + O_VB)};
            gemm_run<1>(lds, S, E, 256, PW, tid);
            SEAM(pb + 1);
        }
        if (IN(pb + 2)) {
            PH_BEGIN;
            unsigned* qh = (unsigned*)ws + CW_Q + 64 * l; LAS unsigned* slot = (LAS unsigned*)(lds + LDS_CTL + 64);
            constexpr int NGLA = NAIVE_GLA ? 32 : 64;
            for (;;) {
                __syncthreads();
                if (tid == 0) *slot = __hip_atomic_fetch_add(qh, 1u, __ATOMIC_RELAXED, __HIP_MEMORY_SCOPE_AGENT);
                __syncthreads();
                const int u = (int)*slot;
                const int NCI = l == 0 ? 43 : 168, NCT = l == 0 ? 43 : 112;
                if (u >= NGLA + 1024 + NCI + NCT) break;
                int v = u - NGLA, ci = -1;
                if (v >= 1024 + NCI) ci = v - 1024;
                else if (v >= 0 && NCI > 0) { const int c0 = (v * NCI) / (1024 + NCI), c1 = ((v + 1) * NCI) / (1024 + NCI); if (c1 > c0) ci = c0; else v -= c0; }
                if (ci >= 0) { conv_unit0(A, lds, l, ci, wave, lane); continue; }
#if NAIVE_GLA
                if (u < NGLA) gla_naive_unit(A, l, u >> 2, u & 3, lds, tid);
#else
                if (u < NGLA) gla::unit(A, u >> 3, (u >> 1) & 3, u & 1, lds, tid);
#endif
#if NAIVE_ATTN
                else if (v < 512) { attn_naive_unit<1>(A, v >> 6, (v >> 3) & 7, v & 7, lds, tid); }
                else { v -= 512; attn_naive_unit<0>(A, v >> 6, (v >> 3) & 7, v & 7, lds, tid); }
#else
                else if (v < 512) { const int b_ = v >> 6, h_ = (v >> 3) & 7, qb_ = v & 7;
                    att96::attn_unit<8>(b_, h_, qb_, (const att96::bf16*)(ws + O_QB), (const att96::bf16*)(ws + O_KNOPE) + h_ * 64, (const att96::bf16*)(ws + O_KROPE), (const att96::bf16*)(ws + O_VB) + h_ * 64,
                                        (att96::bf16*)(ws + O_YB), (const float*)(ws + O_TABB), (char*)lds, tid); }
                else { v -= 512; const int b_ = v >> 6, h_ = (v >> 3) & 7, qb_ = v & 7;
                    att64::attn_unit<8>(b_, h_, qb_, (const att64::bf16*)(ws + O_QA), (const att64::bf16*)(ws + O_KA) + (h_ >> 2) * 64, (const att64::bf16*)(ws + O_VA) + (h_ >> 2) * 64,
                                        (att64::bf16*)(ws + O_YA), (char*)lds, tid); }
#endif
            }
            SEAM(pb + 2);
        }
        if (IN(pb + 3)) {
            PH_BEGIN;
#if !NAIVE_GLA
            gla::combine_phase(A, l, gw, NGW, lane);
#endif
            SEAM(pb + 3);
        }
        if (IN(pb + 4)) {
            PH_BEGIN;
            SchedMerge S{(const bf16_t*)(ws + O_YA), (const bf16_t*)(ws + O_WP + l * 3 * SZ_WP1), G, bid};
            EpiMergeR E{(const bf16_t*)(ws + O_GATES), (bf16_t*)(ws + O_MB)};
            gemm_run<2>(lds, S, E, 512, 512, tid);
            SEAM(pb + 4);
        }
        if (IN(pb + 5)) {
            PH_BEGIN;
            SchedDense S{(const bf16_t*)(ws + O_MB), (const bf16_t*)(ws + O_WOUT + l * SZ_WOUT1), 1024, 1024, 64, 4, G, bid};
            EpiResid E{(bf16_t*)(ws + O_XB), (float*)(ws + O_SSQ)};
            gemm_run<3>(lds, S, E, 1024, 1024, tid);
            SEAM(pb + 5);
        }
        if (l == 0) {
            if (IN(7)) {
                PH_BEGIN;
                SchedDense S{(const bf16_t*)(ws + O_XB), (const bf16_t*)(ws + O_WFFGU), 1024, 1024, 64, 2 * DFF / 256, G, bid};
                EpiSwiGLU E{(const float*)(ws + O_SSQ), nullptr, (bf16_t*)(ws + O_HID), DFF};
                gemm_run<4>(lds, S, E, 1024, 1024, tid);
                { const bool half_idle = (G == 256); const int w0 = half_idle ? (bid - 128) * NWAVES + wave : gw, nw = half_idle ? 128 * NWAVES : NGW;
                  if (!half_idle || bid >= 128) { LAS float* scr = (LAS float*)(lds + wave * 16384); TJob jb;
                      for (int it = w0; it < CONV2_ITEMS; it += nw) { int j, r; common_find(2, it, j, r); common_job(A, j, jb); transpose_item(jb, scr, r, lane); } } }
                SEAM(7);
            }
            if (IN(8)) {
                PH_BEGIN;
                SchedDense S{(const bf16_t*)(ws + O_HID), (const bf16_t*)(ws + O_WFFD), DFF, DFF, 64, 4, G, bid};
                EpiResid E{(bf16_t*)(ws + O_XB), (float*)(ws + O_SSQ)};
                gemm_run<5>(lds, S, E, DFF, 64, tid, 64, true);
                SEAM(8);
            }
        }
    }
    if (IN(15)) {
        PH_BEGIN;
        for (int blk = bid; blk < 256; blk += G) router_item(A, blk, lds, tid);
        __syncthreads();
        run_transposes<true>(A, lds, gw, NGW, wave, lane);
        SEAM(15);
    }
    if (IN(16)) { PH_BEGIN; positions_phase(A, lds, G, bid, tid); SEAM(16); }
    if (IN(17)) {
        PH_BEGIN; int* mi = (int*)(ws + O_MOEI);
        LAS int* te = (LAS int*)(lds + LDS_RING + 4096);
        __syncthreads(); if (tid < MAXTILES + 8) te[tid] = mi[MI_TILEE + tid]; __syncthreads();
        SchedMoe S{(const bf16_t*)(ws + O_XB), (const bf16_t*)(ws + O_WEGU), te, mi + MI_ROWTOK, 1024, 1024, 2 * DFE / 256, G, bid, (size_t)2 * DFE * 1024, true, te[MAXTILES], 0};
        EpiSwiGLU E{(const float*)(ws + O_SSQ), mi + MI_ROWSC, (bf16_t*)(ws + O_HIDS), DFE};
        gemm_run<6, true>(lds, S, E, 1024, 1024, tid, 64, true, true);
        {
            unsigned* qh = (unsigned*)ws + CW_Q + 64 * 2; LAS unsigned* slot = (LAS unsigned*)(lds + LDS_CTL + 64); LAS float* scr = (LAS float*)(lds + wave * 16384); TJob jb;
            for (;;) {
                __syncthreads();
                if (tid == 0) *slot = __hip_atomic_fetch_add(qh, 8u, __ATOMIC_RELAXED, __HIP_MEMORY_SCOPE_AGENT);
                __syncthreads();
                const int it = (int)*slot + wave; if (it >= NEXP * 896) break;
                expert_job(A, (it / 896) * 3 + 2, jb); transpose_item(jb, scr, it % 896, lane);
            }
        }
        SEAM(17);
    }
    if (IN(18)) {
        PH_BEGIN; int* mi = (int*)(ws + O_MOEI);
        LAS int* te = (LAS int*)(lds + LDS_RING + 4096);
        __syncthreads(); if (tid < MAXTILES + 8) te[tid] = mi[MI_TILEE + tid]; if (tid >= 256 && tid < 258) te[MAXTILES + 8 + (tid - 256)] = mi[MI_SPLIT + MAXTILES * 4 + (tid - 256)]; __syncthreads();
        const int nmain_ = te[MAXTILES + 8], nsplit_ = te[MAXTILES + 9];
        SchedMoe S{(const bf16_t*)(ws + O_HIDS), (const bf16_t*)(ws + O_WED), te, mi + MI_ROWTOK, DFE, DFE, 4, G, bid, (size_t)1024 * DFE, false, te[MAXTILES], nmain_};
        EpiMoeDown E{(const float*)(ws + O_MOEI) + MI_ROWW, (bf16_t*)(ws + O_OUTS)};
        gemm_run<7>(lds, S, E, DFE, 64, tid, 64, true);
        {
            SchedMoeSlice S2{(const bf16_t*)(ws + O_HIDS), (const bf16_t*)(ws + O_WED), te, te[MAXTILES], nmain_, nsplit_, G, bid};
            EpiSlab E2{(float*)(ws + O_SLAB)};
            gemm_run<8>(lds, S2, E2, DFE / KSPLIT, 64, tid, 64, true);
        }
        SEAM(18);
    }
    if (IN(19)) { PH_BEGIN; final_phase(A, gw, NGW, lane); PROBE_SPIN(19); }
#undef IN
#undef SEAM
#undef PH_BEGIN
}

extern "C" void kernel_launch(void* const* d_in, const int* in_sizes, int n_in, void* d_out, int out_size, void* d_ws, size_t ws_size, hipStream_t stream) {
    static int grid = 0;
    if (grid == 0) {
        if (n_in != 28 || out_size != M * D || ws_size < WS_NEED) { fprintf(stderr, "kernel_launch: unexpected shapes (n_in %d out %d ws %zu need %zu)\n", n_in, out_size, ws_size, (size_t)WS_NEED); grid = -1; return; }
        int dev = 0, cus = 0;
        if (hipGetDevice(&dev) != hipSuccess || hipDeviceGetAttribute(&cus, hipDeviceAttributeMultiprocessorCount, dev) != hipSuccess) { grid = -1; return; }
        if (hipFuncSetAttribute((const void*)mega_fwd, hipFuncAttributeMaxDynamicSharedMemorySize, LDS_BYTES) != hipSuccess) { grid = -1; return; }
        int per_cu = 0;
        if (hipOccupancyMaxActiveBlocksPerMultiprocessor(&per_cu, (const void*)mega_fwd, NTHR, LDS_BYTES) != hipSuccess || per_cu < 1) { fprintf(stderr, "kernel_launch: occupancy query says %d\n", per_cu); }
        (void)hipGetLastError();
        grid = cus;
    }
    if (grid < 0) return;
    (void)hipMemsetAsync(d_ws, 0, CTL_BYTES, stream);
    Args a{};
    for (int i = 0; i < 28; ++i) a.in[i] = (const float*)d_in[i];
    a.out = (float*)d_out; a.ws = (unsigned char*)d_ws; a.li = 0; a.pad = 0;
#if N_LAUNCH_MODE == 1
    a.ph_lo = 0; a.ph_hi = NPHASE;
    hipLaunchKernelGGL(mega_fwd, dim3(grid), dim3(NTHR), LDS_BYTES, stream, a);
#else
    for (int p = 0; p < NPHASE; ++p) { a.ph_lo = p; a.ph_hi = p + 1; hipLaunchKernelGGL(mega_fwd, dim3(grid), dim3(NTHR), LDS_BYTES, stream, a); }
#endif
}
```
